# Optimizing an MI355X kernel written in HIP

```python
import jax, jax.numpy as jnp
from jax import lax
import numpy as np

D_MODEL = 2048
BATCH = 4
SEQ = 2048
DEPTH = 2

D_MIX = D_MODEL
GLA_HEADS = 6
GLA_DK = 64
GLA_DV = 128
GLA_GATE_RANK = 16
GLA_GATE_TEMP = 16.0
GLA_CHUNK = 64
GLA_WIDTH = GLA_HEADS * GLA_DV
MLA_HEADS = 6
MLA_Q_LORA = 384
MLA_KV_LORA = 256
MLA_NOPE = 128
MLA_ROPE = 64
MLA_DV = 128
MLA_WIDTH = MLA_HEADS * MLA_DV
ROPE_THETA = 10000.0
Q_BLOCK = 128
CONV_CH = D_MIX - GLA_WIDTH - MLA_WIDTH
CONV_K = 3
EPS = 1e-6

IN_SPLIT_SIZES = (
    GLA_HEADS * GLA_DK,
    GLA_HEADS * GLA_DK,
    GLA_WIDTH,
    2 * GLA_GATE_RANK,
    MLA_Q_LORA,
    MLA_KV_LORA,
    MLA_ROPE,
    CONV_CH,
    CONV_CH,
    CONV_CH,
    D_MIX,
)
IN_DIM = sum(IN_SPLIT_SIZES)

kernel_name = "bidir_hybrid_gla_mla_shortconv_adaln"


def rms_norm(x, g):
    xf = x.astype(jnp.float32)
    y = xf * lax.rsqrt(jnp.mean(xf * xf, axis=-1, keepdims=True) + EPS)
    return (y * g.astype(jnp.float32)).astype(x.dtype)


def rope(x, cos, sin):
    x1, x2 = jnp.split(x.astype(jnp.float32), 2, axis=-1)
    out = jnp.concatenate([x1 * cos - x2 * sin, x2 * cos + x1 * sin], axis=-1)
    return out.astype(x.dtype)


def gla_chunked(q, k, v, log_a, strict):
    bsz, s, h, dk = q.shape
    dv = v.shape[-1]
    n = s // GLA_CHUNK

    def to_chunks(t):
        return t.reshape(bsz, n, GLA_CHUNK, h, t.shape[-1]).transpose(0, 3, 1, 2, 4).astype(jnp.float32)

    q, k, v, g = to_chunks(q), to_chunks(k), to_chunks(v), to_chunks(log_a)
    b = jnp.cumsum(g, axis=3)
    b_last = b[:, :, :, -1:, :]
    q_dec = q * jnp.exp(b)
    k_inv = k * jnp.exp(-b)
    k_to_end = k * jnp.exp(b_last - b)
    scores = jnp.einsum('bhncd,bhnjd->bhncj', q_dec, k_inv)
    mask = jnp.tril(jnp.ones((GLA_CHUNK, GLA_CHUNK), dtype=bool), k=-1 if strict else 0)
    o_intra = jnp.einsum('bhncj,bhnje->bhnce', jnp.where(mask, scores, 0.0), v)
    chunk_kv = jnp.einsum('bhncd,bhnce->bhnde', k_to_end, v)
    chunk_decay = jnp.exp(b_last[:, :, :, 0, :])

    def step(state, inp):
        decay, kv = inp
        return decay[..., None] * state + kv, state

    init = jnp.zeros((bsz, h, dk, dv), jnp.float32)
    _, s_before = lax.scan(step, init, (jnp.moveaxis(chunk_decay, 2, 0), jnp.moveaxis(chunk_kv, 2, 0)))
    s_before = jnp.moveaxis(s_before, 0, 2)
    o = o_intra + jnp.einsum('bhncd,bhnde->bhnce', q_dec, s_before)
    return o.transpose(0, 2, 3, 1, 4).reshape(bsz, s, h, dv)


def mla_attention(q_nope, q_rope, k_nope, k_rope, v):
    bsz, s, h, _ = q_nope.shape
    nb = s // Q_BLOCK
    scale = (MLA_NOPE + MLA_ROPE) ** -0.5

    def blocks(t):
        return t.reshape(bsz, nb, Q_BLOCK, *t.shape[2:]).swapaxes(0, 1)

    def attend(qb):
        qn, qr = qb
        sc = jnp.einsum('bqhd,bkhd->bhqk', qn, k_nope) + jnp.einsum('bqhr,bkr->bhqk', qr, k_rope)
        p = jax.nn.softmax(sc.astype(jnp.float32) * scale, axis=-1).astype(v.dtype)
        return jnp.einsum('bhqk,bkhd->bqhd', p, v)

    o = lax.map(attend, (blocks(q_nope), blocks(q_rope)))
    return o.swapaxes(0, 1).reshape(bsz, s, h * v.shape[-1])


def hybrid_layer(x, c_act, cos, sin, ada_w, ada_b, norm_g, w_in,
                 gla_wg_f, gla_bg_f, gla_wg_b, gla_bg_b, gla_norm_g,
                 mla_q_norm_g, mla_kv_norm_g, mla_w_uq, mla_w_ukv, mla_out_g,
                 conv_w, conv_out_g, w_out):
    bsz, s, _ = x.shape
    shift, scale, gate = jnp.split(c_act @ ada_w + ada_b, 3, axis=-1)
    h = rms_norm(x, norm_g) * (1.0 + scale[:, None, :]) + shift[:, None, :]
    proj = h @ w_in
    split_idx = [int(i) for i in np.cumsum(IN_SPLIT_SIZES)[:-1]]
    (gq, gk, gv, g_lr, mq, mkv, mkr, cb, cc, cx, z) = jnp.split(proj, split_idx, axis=-1)

    q = gq.reshape(bsz, s, GLA_HEADS, GLA_DK) * (GLA_DK ** -0.5)
    k = gk.reshape(bsz, s, GLA_HEADS, GLA_DK)
    v = gv.reshape(bsz, s, GLA_HEADS, GLA_DV)
    lr_f, lr_b = jnp.split(g_lr, 2, axis=-1)
    la_f = jax.nn.log_sigmoid((lr_f @ gla_wg_f + gla_bg_f).astype(jnp.float32)) / GLA_GATE_TEMP
    la_b = jax.nn.log_sigmoid((lr_b @ gla_wg_b + gla_bg_b).astype(jnp.float32)) / GLA_GATE_TEMP
    la_f = la_f.reshape(bsz, s, GLA_HEADS, GLA_DK)
    la_b = la_b.reshape(bsz, s, GLA_HEADS, GLA_DK)
    o_fwd = gla_chunked(q, k, v, la_f, strict=False)
    o_bwd = jnp.flip(gla_chunked(jnp.flip(q, 1), jnp.flip(k, 1), jnp.flip(v, 1), jnp.flip(la_b, 1), strict=True), 1)
    o_gla = rms_norm((o_fwd + o_bwd).astype(x.dtype), gla_norm_g).reshape(bsz, s, GLA_WIDTH)

    cq = rms_norm(mq, mla_q_norm_g)
    qm = (cq @ mla_w_uq).reshape(bsz, s, MLA_HEADS, MLA_NOPE + MLA_ROPE)
    q_nope, q_rope = qm[..., :MLA_NOPE], rope(qm[..., MLA_NOPE:], cos[:, :, None, :], sin[:, :, None, :])
    ckv = rms_norm(mkv, mla_kv_norm_g)
    kv = (ckv @ mla_w_ukv).reshape(bsz, s, MLA_HEADS, MLA_NOPE + MLA_DV)
    k_nope, v_m = kv[..., :MLA_NOPE], kv[..., MLA_NOPE:]
    k_rope = rope(mkr, cos, sin)
    o_mla = rms_norm(mla_attention(q_nope, q_rope, k_nope, k_rope, v_m), mla_out_g)

    u = cc * cx
    up = jnp.pad(u, ((0, 0), (1, 1), (0, 0)))
    conv = up[:, :-2] * conv_w[0] + up[:, 1:-1] * conv_w[1] + up[:, 2:] * conv_w[2]
    o_conv = rms_norm(cb * conv, conv_out_g)

    y = jnp.concatenate([o_gla, o_mla, o_conv], axis=-1) * jax.nn.silu(z)
    return x + gate[:, None, :] * (y @ w_out)


def setup_inputs(seed: int = 0) -> dict:
    key = jax.random.key(seed)
    ks = jax.random.split(key, 24)
    f32 = jnp.float32

    def nrm(k, shape, std):
        return std * jax.random.normal(k, shape, f32)

    def gain(k, shape):
        return 1.0 + 0.1 * jax.random.normal(k, shape, f32)

    L = DEPTH
    offsets = jax.random.randint(ks[2], (BATCH, 1), 0, 1024, dtype=jnp.int32)
    positions = offsets + jnp.arange(SEQ, dtype=jnp.int32)[None, :]
    return {
        "x": nrm(ks[0], (BATCH, SEQ, D_MODEL), 1.0),
        "c": nrm(ks[1], (BATCH, D_MODEL), 1.0),
        "positions": positions,
        "ada_w": nrm(ks[3], (L, D_MODEL, 3 * D_MODEL), 0.5 * D_MODEL ** -0.5),
        "ada_b": nrm(ks[4], (L, 3 * D_MODEL), 0.02),
        "norm_g": gain(ks[5], (L, D_MODEL)),
        "w_in": nrm(ks[6], (L, D_MODEL, IN_DIM), D_MODEL ** -0.5),
        "gla_wg_f": nrm(ks[7], (L, GLA_GATE_RANK, GLA_HEADS * GLA_DK), GLA_GATE_RANK ** -0.5),
        "gla_bg_f": nrm(ks[8], (L, GLA_HEADS * GLA_DK), 0.1),
        "gla_wg_b": nrm(ks[9], (L, GLA_GATE_RANK, GLA_HEADS * GLA_DK), GLA_GATE_RANK ** -0.5),
        "gla_bg_b": nrm(ks[10], (L, GLA_HEADS * GLA_DK), 0.1),
        "gla_norm_g": gain(ks[11], (L, GLA_DV)),
        "mla_q_norm_g": gain(ks[12], (L, MLA_Q_LORA)),
        "mla_kv_norm_g": gain(ks[13], (L, MLA_KV_LORA)),
        "mla_w_uq": nrm(ks[14], (L, MLA_Q_LORA, MLA_HEADS * (MLA_NOPE + MLA_ROPE)), MLA_Q_LORA ** -0.5),
        "mla_w_ukv": nrm(ks[15], (L, MLA_KV_LORA, MLA_HEADS * (MLA_NOPE + MLA_DV)), MLA_KV_LORA ** -0.5),
        "mla_out_g": gain(ks[16], (L, MLA_WIDTH)),
        "conv_w": nrm(ks[17], (L, CONV_K, CONV_CH), CONV_K ** -0.5),
        "conv_out_g": gain(ks[18], (L, CONV_CH)),
        "w_out": nrm(ks[19], (L, D_MIX, D_MODEL), D_MIX ** -0.5),
        "final_g": gain(ks[20], (D_MODEL,)),
    }


def reference(x, c, positions, ada_w, ada_b, norm_g, w_in,
              gla_wg_f, gla_bg_f, gla_wg_b, gla_bg_b, gla_norm_g,
              mla_q_norm_g, mla_kv_norm_g, mla_w_uq, mla_w_ukv, mla_out_g,
              conv_w, conv_out_g, w_out, final_g):
    inv_freq = ROPE_THETA ** (-jnp.arange(0, MLA_ROPE, 2, dtype=jnp.float32) / MLA_ROPE)
    ang = positions.astype(jnp.float32)[..., None] * inv_freq
    cos, sin = jnp.cos(ang), jnp.sin(ang)
    c_act = jax.nn.silu(c)
    h = x
    for l in range(DEPTH):
        h = hybrid_layer(h, c_act, cos, sin, ada_w[l], ada_b[l], norm_g[l], w_in[l],
                         gla_wg_f[l], gla_bg_f[l], gla_wg_b[l], gla_bg_b[l], gla_norm_g[l],
                         mla_q_norm_g[l], mla_kv_norm_g[l], mla_w_uq[l], mla_w_ukv[l], mla_out_g[l],
                         conv_w[l], conv_out_g[l], w_out[l])
    return rms_norm(h, final_g)
```

```cpp
#include <hip/hip_runtime.h>
#include <cstdio>
#include <cstdint>
#define MK_CUT 14
#define MK_NAIVE_BASE_MIB 240
#define MK_REP_PH -1
namespace pg8 {
#define PG8_LAS __attribute__((address_space(3)))
typedef unsigned short bf16_t;
typedef short bf16x8 __attribute__((ext_vector_type(8)));
typedef float f32x4 __attribute__((ext_vector_type(4)));
typedef unsigned u32x4 __attribute__((ext_vector_type(4)));
constexpr int BM = 256, BK = 64, HALF = 128, HTB = HALF * BK * 2, STAGE_BYTES = 8 * HTB, NXCD = 8, WGM = 8;

__host__ __device__ __forceinline__ int lds_byte(int r, int c) { const int st = (r >> 4) * 2 + (c >> 5), rr = r & 15, cc = c & 31, ob = rr * 64 + cc * 2; return st * 1024 + (ob ^ (((ob >> 9) & 1) << 5)); }
__host__ __device__ __forceinline__ void stage_rc(int b, int& R, int& C) { const int st = b / 1024, sb = b % 1024, swz = sb ^ (((sb >> 9) & 1) << 5); R = (st >> 1) * 16 + swz / 64; C = (st & 1) * 32 + (swz % 64) / 2; }
__host__ __device__ __forceinline__ int perm32(int rho) { const int n = rho >> 4, i = rho & 15; return 8 * (i >> 2) + 4 * n + (i & 3); }

struct Unit { int pm, pn; };
struct Gemm { const bf16_t* A; const bf16_t* Bt; int M, N, K, lda; };

struct StaticOrder {
    int nM, nN, nwg, G, c;
    __host__ __device__ void init(int M, int N, int G_, int c_) { nM = M / BM; nN = N / BM; nwg = nM * nN; G = G_; c = c_; }
    __host__ __device__ bool next(int i, Unit& u) const {
        const long L = (long)i * G + c; if (L >= nwg) return false;
        int wgid = (int)L; { const int q = nwg / NXCD, r = nwg % NXCD, xcd = wgid % NXCD, off = wgid / NXCD; wgid = (xcd < r ? xcd * (q + 1) : r * (q + 1) + (xcd - r) * q) + off; }
        const int nig = WGM * nN, gid = wgid / nig, fm = gid * WGM, gsz = (nM - fm) < WGM ? (nM - fm) : WGM;
        u.pm = fm + ((wgid % nig) % gsz); u.pn = (wgid % nig) / gsz; return true;
    }
    __device__ __forceinline__ void a_ready(const Unit&) const {}
    __device__ __forceinline__ void done(const Unit&) const {}
};

__device__ __forceinline__ unsigned cvt_pk_bf16(float lo, float hi) { unsigned r; asm volatile("v_cvt_pk_bf16_f32 %0, %1, %2" : "=v"(r) : "v"(lo), "v"(hi)); return r; }

template <class Epi, class Sched, bool ALIGN_EPI = false, bool SP2 = false>
__device__ __forceinline__ void gemm_phase(PG8_LAS unsigned char* lds, const Gemm g, const Sched& S, const Epi& E) {
    int tid_ = threadIdx.x; asm volatile("" : "+v"(tid_));
    const int tid = tid_, wid = __builtin_amdgcn_readfirstlane(tid >> 6), lane = tid & 63, wr = wid >> 2, wc = wid & 3, fr = lane & 15, fq = lane >> 4;
    int K_ = g.K, lda_ = g.lda; asm volatile("" : "+s"(K_), "+s"(lda_));
    const int K = K_, nt = K / BK, lda = lda_;
    unsigned voffA[2], voffB[2];
#pragma unroll
    for (int i = 0; i < 2; ++i) { int R, C; stage_rc(tid * 16 + i * 8192, R, C); const int Rb = Epi::PERM ? ((R & ~31) + perm32(R & 31)) : R;
        voffA[i] = (unsigned)(R * lda + C) * 2u; voffB[i] = (unsigned)(Rb * K + C) * 2u; }
    const size_t kstep = (size_t)(BK * 2);
    const size_t hstepA = (size_t)HALF * lda * 2, hstepB = (size_t)HALF * K * 2;
    const size_t tstepA = 2 * hstepA, tstepB = 2 * hstepB;
    const unsigned ldsw = (unsigned)wid * 1024u;
    const int aoff = lds_byte(wr * 64 + fr, fq * 8), boff = lds_byte(wc * 32 + fr, fq * 8);
#define PG8_SA(b, h) (((b) * 2 + (h)) * HTB)
#define PG8_SB(b, h) ((4 + (b) * 2 + (h)) * HTB)
#define PG8_STAGE(bufoff, gbase, voff) do { _Pragma("unroll") for (int _i = 0; _i < 2; ++_i) \
        __builtin_amdgcn_global_load_lds((const unsigned*)((const char*)(gbase) + (voff)[_i]), (PG8_LAS unsigned*)(lds + (bufoff) + ldsw + _i * 8192), 16, 0, 0); } while (0)
#define PG8_LDA(dst, b, h) do { _Pragma("unroll") for (int m = 0; m < 4; ++m) _Pragma("unroll") for (int k = 0; k < 2; ++k) dst[m][k] = *(const PG8_LAS bf16x8*)(lds + PG8_SA(b, h) + aoff + m * 2048 + k * 1024); } while (0)
#define PG8_LDB(dst, b, h) do { _Pragma("unroll") for (int n = 0; n < 2; ++n) _Pragma("unroll") for (int k = 0; k < 2; ++k) dst[n][k] = *(const PG8_LAS bf16x8*)(lds + PG8_SB(b, h) + boff + n * 2048 + k * 1024); } while (0)
#define PG8_MMA(ai, bj, At, Bt) do { __builtin_amdgcn_s_setprio(1); _Pragma("unroll") for (int m = 0; m < 4; ++m) _Pragma("unroll") for (int n = 0; n < 2; ++n) _Pragma("unroll") for (int k = 0; k < 2; ++k) \
        acc[ai][bj][m][n] = __builtin_amdgcn_mfma_f32_16x16x32_bf16(Bt[n][k], At[m][k], acc[ai][bj][m][n], 0, 0, 0); __builtin_amdgcn_s_setprio(0); } while (0)
#define PG8_WAIT_V(n) asm volatile("s_waitcnt vmcnt(" #n ")" ::: "memory")
#define PG8_WAIT_L(n) asm volatile("s_waitcnt lgkmcnt(" #n ")" ::: "memory")
#define PG8_BAR __builtin_amdgcn_s_barrier()
#define PG8_SCHED __builtin_amdgcn_sched_barrier(0)
    Unit cur, nxt; int ui = 0;
    if (!S.next(0, cur)) return;
    f32x4 acc[2][2][4][2];
#pragma unroll
    for (int a = 0; a < 2; ++a)
#pragma unroll
        for (int b = 0; b < 2; ++b)
#pragma unroll
            for (int m = 0; m < 4; ++m)
#pragma unroll
                for (int n = 0; n < 2; ++n) acc[a][b][m][n] = (f32x4){0.f, 0.f, 0.f, 0.f};
    bf16x8 At[4][2], B0[2][2], B1[2][2];
    const char* cA = (const char*)g.A + (size_t)cur.pm * tstepA; const char* cB = (const char*)g.Bt + (size_t)cur.pn * tstepB;
    S.a_ready(cur);
    if constexpr (SP2) {
        PG8_STAGE(PG8_SB(0, 0), cB, voffB); PG8_STAGE(PG8_SB(0, 1), cB + hstepB, voffB); PG8_STAGE(PG8_SA(0, 0), cA, voffA); PG8_STAGE(PG8_SA(0, 1), cA + hstepA, voffA);
        if (wr == 1) PG8_BAR;
        PG8_WAIT_V(2); PG8_BAR;
        PG8_STAGE(PG8_SB(1, 0), cB + kstep, voffB); PG8_STAGE(PG8_SA(1, 0), cA + kstep, voffA); PG8_STAGE(PG8_SB(1, 1), cB + hstepB + kstep, voffB);
        PG8_WAIT_V(6); PG8_BAR;
    } else {
        PG8_STAGE(PG8_SB(0, 0), cB, voffB); PG8_STAGE(PG8_SA(0, 0), cA, voffA); PG8_STAGE(PG8_SB(0, 1), cB + hstepB, voffB); PG8_STAGE(PG8_SA(0, 1), cA + hstepA, voffA);
        if (wr == 1) PG8_BAR;
        PG8_WAIT_V(4); PG8_BAR;
        PG8_STAGE(PG8_SB(1, 0), cB + kstep, voffB); PG8_STAGE(PG8_SA(1, 0), cA + kstep, voffA); PG8_STAGE(PG8_SB(1, 1), cB + hstepB + kstep, voffB);
        PG8_WAIT_V(6); PG8_BAR;
    }
    for (;;) {
        const bool has_next = S.next(ui + 1, nxt);
        const char* nA = has_next ? (const char*)g.A + (size_t)nxt.pm * tstepA : cA; const char* nB = has_next ? (const char*)g.Bt + (size_t)nxt.pn * tstepB : cB;
        for (int t = 0; t < nt; t += 2) {
            const bool last = (t == nt - 2);
            const char* a1 = cA + (size_t)(t + 1) * kstep;
            const char* a2 = last ? nA : cA + (size_t)(t + 2) * kstep; const char* b2 = last ? nB : cB + (size_t)(t + 2) * kstep;
            const char* a3 = a2 + kstep; const char* b3 = b2 + kstep;
            if (last && has_next) S.a_ready(nxt);
            if constexpr (SP2) {
            PG8_LDB(B0, 0, 0); PG8_LDB(B1, 0, 1); PG8_SCHED; PG8_LDA(At, 0, 0); PG8_STAGE(PG8_SA(1, 1), a1 + hstepA, voffA);
            PG8_WAIT_V(8); PG8_WAIT_L(0); PG8_BAR; PG8_MMA(0, 0, At, B0); PG8_MMA(0, 1, At, B1); PG8_BAR; PG8_SCHED;
            PG8_LDA(At, 0, 1); PG8_STAGE(PG8_SB(0, 0), b2, voffB); PG8_STAGE(PG8_SB(0, 1), b2 + hstepB, voffB); PG8_STAGE(PG8_SA(0, 0), a2, voffA);
            PG8_WAIT_V(8); PG8_WAIT_L(0); PG8_BAR; PG8_MMA(1, 0, At, B0); PG8_MMA(1, 1, At, B1); PG8_BAR; PG8_SCHED;
            PG8_LDB(B0, 1, 0); PG8_LDB(B1, 1, 1); PG8_SCHED; PG8_LDA(At, 1, 0); PG8_STAGE(PG8_SA(0, 1), a2 + hstepA, voffA);
            PG8_WAIT_V(8); PG8_WAIT_L(0); PG8_BAR; PG8_MMA(0, 0, At, B0); PG8_MMA(0, 1, At, B1); PG8_BAR; PG8_SCHED;
            PG8_LDA(At, 1, 1); PG8_STAGE(PG8_SB(1, 0), b3, voffB); PG8_STAGE(PG8_SB(1, 1), b3 + hstepB, voffB); PG8_STAGE(PG8_SA(1, 0), a3, voffA);
            PG8_WAIT_V(8); PG8_WAIT_L(0); PG8_BAR; PG8_MMA(1, 0, At, B0); PG8_MMA(1, 1, At, B1); PG8_BAR; PG8_SCHED;
            if constexpr (Epi::HOOK_T > 0) { if (t + 2 == Epi::HOOK_T) E.hook(acc, cur, wr, wc, fr, fq); }
            } else {
            PG8_LDB(B0, 0, 0); PG8_SCHED; PG8_LDA(At, 0, 0); PG8_STAGE(PG8_SA(1, 1), a1 + hstepA, voffA);
            PG8_WAIT_L(8); PG8_BAR; PG8_WAIT_L(0); PG8_MMA(0, 0, At, B0); PG8_BAR; PG8_SCHED;
            PG8_LDB(B1, 0, 1); PG8_STAGE(PG8_SB(0, 0), b2, voffB);
            PG8_BAR; PG8_WAIT_L(0); PG8_MMA(0, 1, At, B1); PG8_BAR;
            PG8_LDA(At, 0, 1); PG8_STAGE(PG8_SA(0, 0), a2, voffA);
            PG8_BAR; PG8_WAIT_L(0); PG8_MMA(1, 0, At, B0); PG8_BAR; PG8_SCHED;
            PG8_STAGE(PG8_SB(0, 1), b2 + hstepB, voffB);
            PG8_WAIT_V(6); PG8_BAR; PG8_MMA(1, 1, At, B1); PG8_BAR;
            PG8_LDB(B0, 1, 0); PG8_SCHED; PG8_LDA(At, 1, 0); PG8_STAGE(PG8_SA(0, 1), a2 + hstepA, voffA);
            PG8_WAIT_L(8); PG8_BAR; PG8_WAIT_L(0); PG8_MMA(0, 0, At, B0); PG8_BAR; PG8_SCHED;
            PG8_LDB(B1, 1, 1); PG8_STAGE(PG8_SB(1, 0), b3, voffB);
            PG8_BAR; PG8_WAIT_L(0); PG8_MMA(0, 1, At, B1); PG8_BAR;
            PG8_LDA(At, 1, 1); PG8_STAGE(PG8_SA(1, 0), a3, voffA);
            PG8_BAR; PG8_WAIT_L(0); PG8_MMA(1, 0, At, B0); PG8_BAR; PG8_SCHED;
            PG8_STAGE(PG8_SB(1, 1), b3 + hstepB, voffB);
            PG8_WAIT_V(6); PG8_BAR; PG8_MMA(1, 1, At, B1); PG8_BAR;
            }
        }
        if constexpr (ALIGN_EPI) { if (wr == 0) PG8_BAR; }
        E(acc, cur, wr, wc, fr, fq); S.done(cur);
        if (!has_next) break;
#pragma unroll
        for (int a = 0; a < 2; ++a)
#pragma unroll
            for (int b = 0; b < 2; ++b)
#pragma unroll
                for (int m = 0; m < 4; ++m)
#pragma unroll
                    for (int n = 0; n < 2; ++n) acc[a][b][m][n] = (f32x4){0.f, 0.f, 0.f, 0.f};
        cur = nxt; cA = nA; cB = nB; ++ui;
        if constexpr (ALIGN_EPI) { if (wr == 1) PG8_BAR; }
    }
    PG8_WAIT_V(0);
    if constexpr (!ALIGN_EPI) { if (wr == 0) PG8_BAR; }
    PG8_BAR;
#undef PG8_SA
#undef PG8_SB
#undef PG8_STAGE
#undef PG8_LDA
#undef PG8_LDB
#undef PG8_MMA
#undef PG8_WAIT_V
#undef PG8_WAIT_L
#undef PG8_BAR
#undef PG8_SCHED
}
}
#define GAS __attribute__((address_space(1)))
#define LAS __attribute__((address_space(3)))
typedef unsigned short bf16;
typedef unsigned v4u __attribute__((ext_vector_type(4)));
typedef unsigned v2u __attribute__((ext_vector_type(2)));
typedef float f32x4 __attribute__((ext_vector_type(4)));
typedef float f32x16 __attribute__((ext_vector_type(16)));
typedef short bf16x8 __attribute__((ext_vector_type(8)));
typedef short s16x4 __attribute__((ext_vector_type(4)));
typedef GAS unsigned gu32;

constexpr int NWAVES = 8, NTHR = 512;
constexpr int BATCH = 4, SEQ = 2048, DM = 2048, T = BATCH * SEQ, DEPTH = 2, IN_DIM = 5856;
constexpr int NP = 5888;
constexpr int C_GQ = 0, C_GK = 384, C_GV = 768, C_MKV = 1536, C_MQ = 1792, C_MKR = 2176, C_LR = 2240, C_CB = 2304, C_CC = 2816, C_CX = 3328, C_Z = 3840;
constexpr int R_GQ = 0, R_GK = 384, R_GV = 768, R_LR = 1536, R_MQ = 1568, R_MKV = 1952, R_MKR = 2208, R_CB = 2272, R_CC = 2784, R_CX = 3296, R_Z = 3808;
constexpr int NQ = 1280, NKV = 1536;
constexpr float EPS = 1e-6f;
constexpr float QSCALE = 0.07216878364870322f * 1.4426950408889634f;
constexpr int NITEM = BATCH * 32 * 6;

constexpr size_t MiB = 1u << 20;
constexpr size_t WS_CTL = 0, CTL_ZERO_BYTES = 1 * MiB;
constexpr size_t WS_MODS = 256 * 1024;
constexpr size_t WS_CS = 2 * MiB, WS_SN = 3 * MiB;
constexpr size_t WS_WUQ = 4 * MiB;
constexpr size_t WS_WUKV = 6 * MiB;
constexpr size_t WS_WOUT = 8 * MiB;
constexpr size_t WS_WIN = 24 * MiB;
constexpr size_t WS_HY = 70 * MiB;
constexpr size_t WS_PROJ = 102 * MiB;
constexpr size_t WS_QUP = 194 * MiB;
constexpr size_t WS_KVUP = 214 * MiB;
constexpr size_t WS_OMLA = 238 * MiB;
constexpr size_t WS_OINTRA = 262 * MiB;
constexpr size_t WS_KVC = 286 * MiB;
constexpr size_t WS_ST = 334 * MiB;
constexpr size_t WS_QDEC = 358 * MiB;
constexpr size_t WS_DECAY = 370 * MiB;
constexpr size_t WS_PARTQ = 371 * MiB;
constexpr size_t WS_PARTKV = 371 * MiB + 512 * 1024;
constexpr size_t WS_PARTM = 371 * MiB + 768 * 1024;
constexpr size_t WS_END = 372 * MiB;
constexpr int CW_BAR = 4096;

constexpr int RING_BYTES = 131072, LDSCTL_OFF = RING_BYTES, MISC_OFF = LDSCTL_OFF + 320, LDS_BYTES = 147456;

#define LDS_WAIT() asm volatile("s_waitcnt lgkmcnt(0)" ::: "memory")
#define VM_WAIT() asm volatile("s_waitcnt vmcnt(0)" ::: "memory")
__device__ __forceinline__ unsigned f2bf(float f) { unsigned u = __builtin_bit_cast(unsigned, f); return (u + 0x7fffu + ((u >> 16) & 1u)) >> 16; }
__device__ __forceinline__ unsigned pk2(float lo, float hi) { return pg8::cvt_pk_bf16(lo, hi); }
__device__ __forceinline__ float bf2f(unsigned short h) { return __builtin_bit_cast(float, (unsigned)h << 16); }
__device__ __forceinline__ float bflo(unsigned w) { return __builtin_bit_cast(float, w << 16); }
__device__ __forceinline__ float bfhi(unsigned w) { return __builtin_bit_cast(float, w & 0xffff0000u); }
__device__ __forceinline__ float silu_fast(float v) { return v * __builtin_amdgcn_rcpf(1.f + __expf(-v)); }
__device__ __forceinline__ float wave_sum(float v) {
#pragma unroll
    for (int o = 1; o < 64; o <<= 1) v += __shfl_xor(v, o);
    return v;
}

__device__ __forceinline__ int map_in(int n) {
    if (n < C_MKV) return n;
    if (n < C_MQ) return R_MKV + (n - C_MKV);
    if (n < C_MKR) return R_MQ + (n - C_MQ);
    if (n < C_LR) { const int j = n - C_MKR; return R_MKR + (j & 1) * 32 + (j >> 1); }
    if (n < C_LR + 32) return R_LR + (n - C_LR);
    if (n < C_CB) return -1;
    if (n < C_Z) return R_CB + (n - C_CB);
    return R_Z + (n - C_Z);
}
__device__ __forceinline__ int map_uq(int n) {
    if (n >= 1152) return -1;
    const int h = n / 192, d = n % 192;
    if (d < 128) return n;
    const int j = d - 128; return h * 192 + 128 + (j & 1) * 32 + (j >> 1);
}

struct EpiIn {
    static constexpr bool PERM = true; static constexpr int HOOK_T = 0;
    bf16* O; const float* cs; const float* sn; float* partq; float* partkv;
    __device__ __forceinline__ void operator()(const f32x4 (&acc)[2][2][4][2], const pg8::Unit& u, int wr, int wc, int fr, int fq) const {
        const int pn = u.pn, row0 = u.pm * 256 + wr * 64 + fr, col0 = pn * 256 + wc * 32 + 8 * fq;
        const bool stat = (pn >= 6 && pn <= 8);
#pragma unroll
        for (int ai = 0; ai < 2; ++ai)
#pragma unroll
            for (int m = 0; m < 4; ++m) {
                const int row = row0 + ai * 128 + m * 16; bf16* rowp = O + (size_t)row * NP + col0; float ss = 0.f;
#pragma unroll
                for (int bj = 0; bj < 2; ++bj) {
                    f32x4 v0 = acc[ai][bj][m][0], v1 = acc[ai][bj][m][1]; const int c = col0 + bj * 128;
                    if (pn >= 15) {
#pragma unroll
                        for (int e = 0; e < 4; ++e) { v0[e] = silu_fast(v0[e]); v1[e] = silu_fast(v1[e]); }
                    } else if (pn == 8 && bj == 1 && c < C_LR) {
                        const int i0 = (c - C_MKR) >> 1; const f32x4 cc = *(const f32x4*)(cs + (size_t)row * 32 + i0), sv = *(const f32x4*)(sn + (size_t)row * 32 + i0);
                        f32x4 a0, a1;
                        a0[0] = v0[0] * cc[0] - v0[1] * sv[0]; a0[1] = v0[1] * cc[0] + v0[0] * sv[0]; a0[2] = v0[2] * cc[1] - v0[3] * sv[1]; a0[3] = v0[3] * cc[1] + v0[2] * sv[1];
                        a1[0] = v1[0] * cc[2] - v1[1] * sv[2]; a1[1] = v1[1] * cc[2] + v1[0] * sv[2]; a1[2] = v1[2] * cc[3] - v1[3] * sv[3]; a1[3] = v1[3] * cc[3] + v1[2] * sv[3];
                        v0 = a0; v1 = a1;
                    }
                    if (stat && (pn != 8 || bj == 0)) ss += (v0[0] * v0[0] + v0[1] * v0[1]) + (v0[2] * v0[2] + v0[3] * v0[3]) + (v1[0] * v1[0] + v1[1] * v1[1]) + (v1[2] * v1[2] + v1[3] * v1[3]);
                    v4u w; w.x = pk2(v0[0], v0[1]); w.y = pk2(v0[2], v0[3]); w.z = pk2(v1[0], v1[1]); w.w = pk2(v1[2], v1[3]);
                    *(v4u*)(rowp + bj * 128) = w;
                }
                asm volatile("" ::: "memory");
                if (stat) { ss += __shfl_xor(ss, 16); ss += __shfl_xor(ss, 32);
                    if (fq == 0) { if (pn == 6) partkv[(size_t)row * 4 + wc] = ss; else partq[(size_t)row * 8 + (pn - 7) * 4 + wc] = ss; } }
            }
    }
};
struct EpiUq {
    static constexpr bool PERM = true; static constexpr int HOOK_T = 0;
    bf16* O; const float* cs; const float* sn; const float* partq;
    __device__ __forceinline__ void operator()(const f32x4 (&acc)[2][2][4][2], const pg8::Unit& u, int wr, int wc, int fr, int fq) const {
        const int row0 = u.pm * 256 + wr * 64 + fr, col0 = u.pn * 256 + wc * 32 + 8 * fq;
#pragma unroll
        for (int ai = 0; ai < 2; ++ai)
#pragma unroll
            for (int m = 0; m < 4; ++m) {
                const int row = row0 + ai * 128 + m * 16; bf16* rowp = O + (size_t)row * NQ + col0;
                const f32x4 p0 = *(const f32x4*)(partq + (size_t)row * 8), p1 = *(const f32x4*)(partq + (size_t)row * 8 + 4);
                const float rs = __builtin_amdgcn_rsqf(((p0[0] + p0[1]) + (p0[2] + p0[3]) + (p1[0] + p1[1]) + (p1[2] + p1[3])) * (1.f / 384.f) + EPS) * QSCALE;
#pragma unroll
                for (int bj = 0; bj < 2; ++bj) {
                    const int c = col0 + bj * 128; if (c >= 1152) continue;
                    f32x4 v0 = acc[ai][bj][m][0] * rs, v1 = acc[ai][bj][m][1] * rs; const int d = c % 192;
                    if (d >= 128) {
                        const int i0 = (d - 128) >> 1; const f32x4 cc = *(const f32x4*)(cs + (size_t)row * 32 + i0), sv = *(const f32x4*)(sn + (size_t)row * 32 + i0);
                        f32x4 a0, a1;
                        a0[0] = v0[0] * cc[0] - v0[1] * sv[0]; a0[1] = v0[1] * cc[0] + v0[0] * sv[0]; a0[2] = v0[2] * cc[1] - v0[3] * sv[1]; a0[3] = v0[3] * cc[1] + v0[2] * sv[1];
                        a1[0] = v1[0] * cc[2] - v1[1] * sv[2]; a1[1] = v1[1] * cc[2] + v1[0] * sv[2]; a1[2] = v1[2] * cc[3] - v1[3] * sv[3]; a1[3] = v1[3] * cc[3] + v1[2] * sv[3];
                        v0 = a0; v1 = a1;
                    }
                    v4u w; w.x = pk2(v0[0], v0[1]); w.y = pk2(v0[2], v0[3]); w.z = pk2(v1[0], v1[1]); w.w = pk2(v1[2], v1[3]);
                    *(v4u*)(rowp + bj * 128) = w;
                }
                asm volatile("" ::: "memory");
            }
    }
};
struct EpiUkv {
    static constexpr bool PERM = true; static constexpr int HOOK_T = 0;
    bf16* O; const float* partkv;
    __device__ __forceinline__ void operator()(const f32x4 (&acc)[2][2][4][2], const pg8::Unit& u, int wr, int wc, int fr, int fq) const {
        const int row0 = u.pm * 256 + wr * 64 + fr, col0 = u.pn * 256 + wc * 32 + 8 * fq;
#pragma unroll
        for (int ai = 0; ai < 2; ++ai)
#pragma unroll
            for (int m = 0; m < 4; ++m) {
                const int row = row0 + ai * 128 + m * 16; bf16* rowp = O + (size_t)row * NKV + col0;
                const f32x4 p0 = *(const f32x4*)(partkv + (size_t)row * 4);
                const float rs = __builtin_amdgcn_rsqf(((p0[0] + p0[1]) + (p0[2] + p0[3])) * (1.f / 256.f) + EPS);
#pragma unroll
                for (int bj = 0; bj < 2; ++bj) {
                    const f32x4 v0 = acc[ai][bj][m][0] * rs, v1 = acc[ai][bj][m][1] * rs;
                    v4u w; w.x = pk2(v0[0], v0[1]); w.y = pk2(v0[2], v0[3]); w.z = pk2(v1[0], v1[1]); w.w = pk2(v1[2], v1[3]);
                    *(v4u*)(rowp + bj * 128) = w;
                }
                asm volatile("" ::: "memory");
            }
    }
};
struct EpiOut {
    static constexpr bool PERM = false; static constexpr int HOOK_T = 12;
    const float* xin; float* out; const float* gate;
    const float* partm;
    __device__ __forceinline__ void hook(f32x4 (&acc)[2][2][4][2], const pg8::Unit& u, int wr, int wc, int fr, int fq) const {
        const int row0 = u.pm * 256 + wr * 64 + fr;
#pragma unroll
        for (int ai = 0; ai < 2; ++ai)
#pragma unroll
            for (int m = 0; m < 4; ++m) { const float* p = partm + (size_t)(row0 + ai * 128 + m * 16) * 8; const f32x4 p0 = *(const f32x4*)p; const float p4 = p[4], p5 = p[5];
                const float rs = __builtin_amdgcn_rsqf(((p0[0] + p0[1]) + (p0[2] + p0[3]) + (p4 + p5)) * (1.f / 768.f) + EPS);
#pragma unroll
                for (int bj = 0; bj < 2; ++bj)
#pragma unroll
                    for (int n = 0; n < 2; ++n) acc[ai][bj][m][n] *= rs; }
    }
    __device__ __forceinline__ void operator()(const f32x4 (&acc)[2][2][4][2], const pg8::Unit& u, int wr, int wc, int fr, int fq) const {
        const int row0 = u.pm * 256 + wr * 64 + fr, col0 = u.pn * 256 + wc * 32 + 4 * fq; const float* gb = gate + (size_t)(u.pm >> 3) * 3 * DM;
        f32x4 gv[2][2];
#pragma unroll
        for (int bj = 0; bj < 2; ++bj)
#pragma unroll
            for (int n = 0; n < 2; ++n) gv[bj][n] = *(const f32x4*)(gb + col0 + bj * 128 + n * 16);
#pragma unroll
        for (int ai = 0; ai < 2; ++ai)
#pragma unroll
            for (int m = 0; m < 4; ++m) {
                const size_t off = (size_t)(row0 + ai * 128 + m * 16) * DM + col0;
#pragma unroll
                for (int bj = 0; bj < 2; ++bj)
#pragma unroll
                    for (int n = 0; n < 2; ++n) { const f32x4 xv = *(const f32x4*)(xin + off + bj * 128 + n * 16); *(f32x4*)(out + off + bj * 128 + n * 16) = xv + gv[bj][n] * acc[ai][bj][m][n]; }
                asm volatile("" ::: "memory");
            }
    }
};
namespace mla {
constexpr int NW = 8, QBLK = 32, KVBLK = 64;
constexpr int SHM_V = 16384, SHM_KN = 16384, SHM_KR = 8192;
constexpr int OFF_V = 0, OFF_KN = 2 * SHM_V, OFF_KR = OFF_KN + 2 * SHM_KN, OFF_WS = OFF_KR + 2 * SHM_KR, OFF_QR = OFF_WS + NW * 64 * 4, ATTN_LDS = OFF_QR + NW * 4096;
constexpr float THR = 8.f;
#define KSWZ(row, colB) ((row) * 256 + ((colB) ^ (((row) & 7) << 4)))
#define KRSWZ(row, colB) ((row) * 128 + ((colB) ^ ((((row) >> 1) & 7) << 4)))
#define SBAR() __builtin_amdgcn_sched_barrier(0)
__device__ __forceinline__ int crow(int r, int hi) { return (r & 3) + 8 * (r >> 2) + 4 * hi; }
__device__ __forceinline__ unsigned cvtpk(float lo, float hi) { unsigned r; asm volatile("v_cvt_pk_bf16_f32 %0, %1, %2" : "=v"(r) : "v"(lo), "v"(hi)); return r; }

__device__ __forceinline__ void partialSM(f32x16& p0, f32x16& p1, float& m_reg, float& mn, float& alpha) {
  float pmax = p0[0];
#pragma unroll
  for (int r = 1; r < 16; ++r) pmax = fmaxf(pmax, p0[r]);
#pragma unroll
  for (int r = 0; r < 16; ++r) pmax = fmaxf(pmax, p1[r]);
  { auto rr = __builtin_amdgcn_permlane32_swap(__float_as_uint(pmax), __float_as_uint(pmax), false, false);
    pmax = fmaxf(__uint_as_float(rr[0]), __uint_as_float(rr[1])); }
  if (__builtin_expect(__all(pmax - m_reg <= THR), 1)) { mn = m_reg; alpha = 1.f; }
  else { mn = fmaxf(m_reg, pmax); alpha = __builtin_amdgcn_exp2f(m_reg - mn); m_reg = mn; }
#pragma unroll
  for (int r = 0; r < 16; ++r) p0[r] = p0[r] - mn;
#pragma unroll
  for (int r = 0; r < 16; ++r) p1[r] = p1[r] - mn;
#pragma unroll
  for (int r = 0; r < 16; ++r) p0[r] = __builtin_amdgcn_exp2f(p0[r]);
}
__device__ __forceinline__ void finishSM(f32x16& p0, f32x16& p1, float alpha, float& l_reg, bf16x8& pa0, bf16x8& pa1, bf16x8& pa2, bf16x8& pa3) {
#pragma unroll
  for (int r = 0; r < 16; ++r) p1[r] = __builtin_amdgcn_exp2f(p1[r]);
  float ps = 0;
#pragma unroll
  for (int r = 0; r < 16; ++r) ps += p0[r];
#pragma unroll
  for (int r = 0; r < 16; ++r) ps += p1[r];
  { auto rr = __builtin_amdgcn_permlane32_swap(__float_as_uint(ps), __float_as_uint(ps), false, false);
    ps = __uint_as_float(rr[0]) + __uint_as_float(rr[1]); }
  l_reg = l_reg * alpha + ps;
#define PK4(P, BASE, OUT) do { unsigned a0 = cvtpk(P[BASE + 0], P[BASE + 1]), a1 = cvtpk(P[BASE + 2], P[BASE + 3]);   \
    unsigned b0 = cvtpk(P[BASE + 4], P[BASE + 5]), b1 = cvtpk(P[BASE + 6], P[BASE + 7]);                              \
    auto r0 = __builtin_amdgcn_permlane32_swap(a0, b0, false, false); auto r1 = __builtin_amdgcn_permlane32_swap(a1, b1, false, false); \
    v4u w = {r0[0], r1[0], r0[1], r1[1]}; OUT = *reinterpret_cast<bf16x8*>(&w); } while (0)
  PK4(p0, 0, pa0); PK4(p0, 8, pa1); PK4(p1, 0, pa2); PK4(p1, 8, pa3);
#undef PK4
}
__device__ __forceinline__ void qkt(f32x16& p0, f32x16& p1, const char* Kn, const char* Kr, const bf16x8* qr, const char* Qr, int r32, int hi) {
  p0 = f32x16{}; p1 = f32x16{};
  int tn = (hi * 16) ^ ((r32 & 7) << 4), tr = (hi * 16) ^ (((r32 >> 1) & 7) << 4);
  asm volatile("" : "+v"(tn), "+v"(tr));
  const char* knb = Kn + r32 * 256; const char* krb = Kr + r32 * 128; const char* qrb = Qr + r32 * 128;
#pragma unroll
  for (int d0 = 0; d0 < 8; ++d0) { const int off = (d0 * 32) ^ tn;
    const bf16x8 b0 = *reinterpret_cast<const bf16x8*>(knb + off);
    const bf16x8 b1 = *reinterpret_cast<const bf16x8*>(knb + off + 8192);
    p0 = __builtin_amdgcn_mfma_f32_32x32x16_bf16(b0, qr[d0], p0, 0, 0, 0);
    p1 = __builtin_amdgcn_mfma_f32_32x32x16_bf16(b1, qr[d0], p1, 0, 0, 0); }
#pragma unroll
  for (int d0 = 0; d0 < 4; ++d0) { const int off = (d0 * 32) ^ tr;
    const bf16x8 b0 = *reinterpret_cast<const bf16x8*>(krb + off);
    const bf16x8 b1 = *reinterpret_cast<const bf16x8*>(krb + off + 4096);
    const bf16x8 qv = *reinterpret_cast<const bf16x8*>(qrb + off);
    p0 = __builtin_amdgcn_mfma_f32_32x32x16_bf16(b0, qv, p0, 0, 0, 0);
    p1 = __builtin_amdgcn_mfma_f32_32x32x16_bf16(b1, qv, p1, 0, 0, 0); }
}
__device__ __forceinline__ int v_st(int k, int c) { const int kk = (k & ~0xC) | ((k & 4) << 1) | ((k & 8) >> 1); return ((kk >> 3) * 4 + (c >> 5)) * 512 + ((kk & 7) * 32 + (c & 31)) * 2; }
__device__ __forceinline__ int v_rd_base(int lane) { return ((lane & 3) << 3) | (((lane >> 2) & 3) << 6) | (((lane >> 4) & 1) << 5) | (((lane >> 5) & 1) << 8); }
constexpr int v_rd_off(int d0, int ks, int half) { return d0 * 512 + ks * 4096 + half * 2048; }
template <int OFF> __device__ __forceinline__ s16x4 tr_read(int vb) {
  s16x4 r; asm volatile("ds_read_b64_tr_b16 %0, %1 offset:%2" : "=&v"(r) : "v"(vb), "i"(OFF) : "memory"); return r;
}
template <int D0> __device__ __forceinline__ void pv_one(f32x16& od, int vb, bf16x8 pa0, bf16x8 pa1, bf16x8 pa2, bf16x8 pa3) {
  const s16x4 l0 = tr_read<v_rd_off(D0, 0, 0)>(vb), h0 = tr_read<v_rd_off(D0, 0, 1)>(vb), l1 = tr_read<v_rd_off(D0, 1, 0)>(vb), h1 = tr_read<v_rd_off(D0, 1, 1)>(vb);
  const s16x4 l2 = tr_read<v_rd_off(D0, 2, 0)>(vb), h2 = tr_read<v_rd_off(D0, 2, 1)>(vb), l3 = tr_read<v_rd_off(D0, 3, 0)>(vb), h3 = tr_read<v_rd_off(D0, 3, 1)>(vb);
  asm volatile("s_waitcnt lgkmcnt(0)" ::: "memory"); SBAR();
#define PK(L, H) (bf16x8){L[0], L[1], L[2], L[3], H[0], H[1], H[2], H[3]}
  od = __builtin_amdgcn_mfma_f32_32x32x16_bf16(pa0, PK(l0, h0), od, 0, 0, 0);
  od = __builtin_amdgcn_mfma_f32_32x32x16_bf16(pa1, PK(l1, h1), od, 0, 0, 0);
  od = __builtin_amdgcn_mfma_f32_32x32x16_bf16(pa2, PK(l2, h2), od, 0, 0, 0);
  od = __builtin_amdgcn_mfma_f32_32x32x16_bf16(pa3, PK(l3, h3), od, 0, 0, 0);
#undef PK
}
__device__ __forceinline__ void pv_d0(f32x16* o, int vb, bf16x8 pa0, bf16x8 pa1, bf16x8 pa2, bf16x8 pa3) {
  pv_one<0>(o[0], vb, pa0, pa1, pa2, pa3); pv_one<1>(o[1], vb, pa0, pa1, pa2, pa3); pv_one<2>(o[2], vb, pa0, pa1, pa2, pa3); pv_one<3>(o[3], vb, pa0, pa1, pa2, pa3);
}

__device__ __forceinline__ void attn_unit(const bf16* __restrict__ Qb, const bf16* __restrict__ Knh, const bf16* __restrict__ Vh, const bf16* __restrict__ Krh,
                                          bf16* __restrict__ Yb, const bf16* __restrict__ Zb, const float* __restrict__ gh, float* __restrict__ part, int seq, char* lds) {
  int tid_ = threadIdx.x; asm volatile("" : "+v"(tid_));
  const int tid = tid_, wid = tid >> 6, lane = tid & 63, r32 = lane & 31, hi = lane >> 5;
  char* V_lds = lds + OFF_V; char* KN_lds = lds + OFF_KN; char* KR_lds = lds + OFF_KR;
  float* ws = (float*)(lds + OFF_WS) + wid * 64; float* li_l = ws; float* al_l = ws + 32;
  float m_reg = -1e30f, l_reg = 0; f32x16 o[4] = {}; bf16x8 qr[8]; char* QR_lds = lds + OFF_QR + wid * 4096;
  const bf16* Qw = Qb + (long)(wid * QBLK + r32) * NQ + hi * 8;
#pragma unroll
  for (int d0 = 0; d0 < 8; ++d0) qr[d0] = *reinterpret_cast<const bf16x8*>(Qw + d0 * 16);
#pragma unroll
  for (int d0 = 0; d0 < 4; ++d0) *reinterpret_cast<bf16x8*>(QR_lds + KRSWZ(r32, (d0 * 16 + hi * 8) * 2)) = *reinterpret_cast<const bf16x8*>(Qw + 128 + d0 * 16);
  const int sr = tid >> 4, sc = (tid & 15) * 8, vst0 = v_st(sr, sc), vst1 = v_st(32 + sr, sc);
  const int krr = tid >> 3, krc = (tid & 7) * 8;
  const int vb0 = (int)(uintptr_t)V_lds + v_rd_base(lane);
  bf16x8 vs0, vs1, ks0, ks1, kr0;
#define SLOAD(k0) do { vs0 = *reinterpret_cast<const bf16x8*>(&Vh[(long)((k0) + sr) * NKV + sc]); vs1 = *reinterpret_cast<const bf16x8*>(&Vh[(long)((k0) + 32 + sr) * NKV + sc]); \
    ks0 = *reinterpret_cast<const bf16x8*>(&Knh[(long)((k0) + sr) * NKV + sc]); ks1 = *reinterpret_cast<const bf16x8*>(&Knh[(long)((k0) + 32 + sr) * NKV + sc]); \
    kr0 = *reinterpret_cast<const bf16x8*>(&Krh[(long)((k0) + krr) * NP + krc]); } while (0)
#define SWRITE(b) do { *(bf16x8*)(V_lds + (b) * SHM_V + vst0) = vs0; *(bf16x8*)(V_lds + (b) * SHM_V + vst1) = vs1; const int kc = sc * 2;   \
    *(bf16x8*)(KN_lds + (b) * SHM_KN + KSWZ(sr, kc)) = ks0; *(bf16x8*)(KN_lds + (b) * SHM_KN + KSWZ(32 + sr, kc)) = ks1;                       \
    *(bf16x8*)(KR_lds + (b) * SHM_KR + KRSWZ(krr, krc * 2)) = kr0; } while (0)
#define SWAIT() asm volatile("s_waitcnt vmcnt(0)" ::: "memory")
#define RESC(a) do { if (__any((a) < 1.f)) { if (hi == 0) al_l[r32] = (a); asm volatile("s_waitcnt lgkmcnt(0)" ::: "memory"); \
    _Pragma("unroll") for (int d = 0; d < 4; ++d) _Pragma("unroll") for (int r = 0; r < 16; ++r) o[d][r] *= al_l[crow(r, hi)]; } } while (0)
  f32x16 pA0, pA1, pB0, pB1; float mnA, mnB, alA, alB; bf16x8 pa0, pa1, pa2, pa3; const int NT = seq / KVBLK;
  SLOAD(0); SWAIT(); SWRITE(0); __syncthreads();
  qkt(pA0, pA1, KN_lds, KR_lds, qr, QR_lds, r32, hi); partialSM(pA0, pA1, m_reg, mnA, alA);
  SLOAD(KVBLK);
  SWAIT(); SWRITE(1); __syncthreads();
  for (int j = 1; j + 1 < NT; j += 2) {
    SBAR(); qkt(pB0, pB1, KN_lds + SHM_KN, KR_lds + SHM_KR, qr, QR_lds, r32, hi);
    finishSM(pA0, pA1, alA, l_reg, pa0, pa1, pa2, pa3); SBAR();
    SLOAD((j + 1) * KVBLK); SBAR();
    pv_d0(o, vb0, pa0, pa1, pa2, pa3); partialSM(pB0, pB1, m_reg, mnB, alB);
    __syncthreads(); SWAIT(); SWRITE(0);
    RESC(alB); __syncthreads();
    SBAR(); qkt(pA0, pA1, KN_lds, KR_lds, qr, QR_lds, r32, hi);
    finishSM(pB0, pB1, alB, l_reg, pa0, pa1, pa2, pa3); SBAR();
    SLOAD((j + 2) * KVBLK); SBAR();
    pv_d0(o, vb0 + SHM_V, pa0, pa1, pa2, pa3); partialSM(pA0, pA1, m_reg, mnA, alA);
    __syncthreads(); SWAIT(); SWRITE(1);
    RESC(alA); __syncthreads();
  }
  SBAR(); qkt(pB0, pB1, KN_lds + SHM_KN, KR_lds + SHM_KR, qr, QR_lds, r32, hi);
  finishSM(pA0, pA1, alA, l_reg, pa0, pa1, pa2, pa3); SBAR();
  pv_d0(o, vb0, pa0, pa1, pa2, pa3); partialSM(pB0, pB1, m_reg, mnB, alB);
  __syncthreads(); RESC(alB);
  finishSM(pB0, pB1, alB, l_reg, pa0, pa1, pa2, pa3); SBAR();
  pv_d0(o, vb0 + SHM_V, pa0, pa1, pa2, pa3);
  if (hi == 0) li_l[r32] = l_reg; asm volatile("s_waitcnt lgkmcnt(0)" ::: "memory");
  float rli[16];
#pragma unroll
  for (int r = 0; r < 16; ++r) rli[r] = __builtin_amdgcn_rcpf(li_l[crow(r, hi)]);
  float gg[4];
#pragma unroll
  for (int d0 = 0; d0 < 4; ++d0) gg[d0] = gh[d0 * 32 + r32];
#pragma unroll
  for (int r = 0; r < 16; ++r) { const long row = wid * QBLK + crow(r, hi); float v[4], ss = 0.f;
#pragma unroll
    for (int d0 = 0; d0 < 4; ++d0) { v[d0] = o[d0][r] * rli[r]; ss += v[d0] * v[d0]; }
    ss += __shfl_xor(ss, 1); ss += __shfl_xor(ss, 2); ss += __shfl_xor(ss, 4); ss += __shfl_xor(ss, 8); ss += __shfl_xor(ss, 16);
    if (r32 == 0) part[row * 8] = ss;
#pragma unroll
    for (int d0 = 0; d0 < 4; ++d0) { const float sz = bf2f(Zb[row * NP + d0 * 32 + r32]); Yb[row * DM + d0 * 32 + r32] = (unsigned short)f2bf(v[d0] * gg[d0] * sz); } }
  __syncthreads();
#undef SLOAD
#undef SWRITE
#undef SWAIT
#undef RESC
}
#undef SBAR
}
struct Frame {
    LAS unsigned char* lds; char* ldsg;
    int tid, lane, wave, vcu, G;
    float* out; unsigned char* ws;
};
__device__ __forceinline__ const float* ld_in(int i) {
    const __attribute__((address_space(4))) char* ka = (const __attribute__((address_space(4))) char*)__builtin_amdgcn_kernarg_segment_ptr();
    asm volatile("" : "+s"(i));
    const GAS float* p = *(const GAS float* const __attribute__((address_space(4)))*)(ka + 8 * i);
    return (const float*)p;
}
#define WSP(T_, off) ((T_*)(F.ws + (off)))

__device__ __forceinline__ void p0_mods(Frame& F, size_t mods_off) {
    LAS float* sc = (LAS float*)F.lds;
    LAS float* part = (LAS float*)(F.lds + 32768);
    const float* c = ld_in(1); const float* aw = ld_in(3); const float* ab = ld_in(4);
    for (int i = F.tid; i < BATCH * DM; i += NTHR) { const float v = c[i]; sc[i] = v / (1.f + __expf(-v)); }
    __syncthreads();
    for (int item = (int)blockIdx.x; item < 768; item += F.G) {
        const int ks = item & 15, cb = (item >> 4) % 24, l = item / 384, j0 = cb * 256, kb = ks * 128 + F.wave * 16;
        const f32x4* w = (const f32x4*)(aw + (size_t)l * DM * 3 * DM + (size_t)kb * 3 * DM + j0) + F.lane;
        f32x4 wv[16];
#pragma unroll
        for (int k = 0; k < 16; ++k) wv[k] = w[(size_t)k * (3 * DM / 4)];
        f32x4 a[4] = {};
#pragma unroll
        for (int k = 0; k < 16; ++k)
#pragma unroll
            for (int b = 0; b < 4; ++b) a[b] += wv[k] * sc[b * DM + kb + k];
#pragma unroll
        for (int b = 0; b < 4; ++b) *(LAS f32x4*)(part + (F.wave * 4 + b) * 256 + F.lane * 4) = a[b];
        __syncthreads();
        for (int o = F.tid; o < 1024; o += NTHR) { const int b = o >> 8, col = o & 255; float s = 0.f;
#pragma unroll
            for (int wv2 = 0; wv2 < 8; ++wv2) s += part[(wv2 * 4 + b) * 256 + col];
            if (ks == 0) s += ab[l * 3 * DM + j0 + col];
            atomicAdd(WSP(float, mods_off) + ((size_t)l * BATCH + b) * 3 * DM + j0 + col, s); }
        __syncthreads();
    }
}
__device__ __forceinline__ int kmap_out(int k) { return k < 768 ? k + 768 : (k < 1536 ? k - 768 : k); }
template <int MAP, bool KMAP> __device__ __forceinline__ void p0_transpose_item(const float* W, int K, int N, bf16* WT, const float* kgain, LAS bf16* tl, int item, int nblk, int lane) {
    const int kb = item / nblk, nb = item % nblk, k0 = 64 * kb, n0 = 64 * nb, ks0 = KMAP ? kmap_out(k0) : k0;
    const int nq = (lane & 15) * 4, kr = lane >> 4;
    const int s0 = MAP == 1 ? map_in(n0) : (MAP == 2 ? map_uq(n0) : n0), s63 = MAP == 1 ? map_in(n0 + 63) : (MAP == 2 ? map_uq(n0 + 63) : n0 + 63);
    const int s1 = MAP == 1 ? map_in(n0 + 1) : (MAP == 2 ? map_uq(n0 + 1) : n0 + 1);
    if (s0 >= 0 && s63 - s0 == 63 && s1 == s0 + 1) {
        f32x4 v[16];
#pragma unroll
        for (int i = 0; i < 16; ++i) v[i] = *(const f32x4*)(W + (size_t)(ks0 + 4 * i + kr) * N + s0 + nq);
#pragma unroll
        for (int i = 0; i < 16; ++i) { const int kk = 4 * i + kr; const float gsc = kgain ? kgain[k0 + kk] : 1.f;
#pragma unroll
            for (int e = 0; e < 4; ++e) tl[(nq + e) * 72 + kk] = (unsigned short)f2bf(v[i][e] * gsc); }
    } else {
        const int np = n0 + lane; const int src = MAP == 1 ? map_in(np) : (MAP == 2 ? map_uq(np) : np);
        float v[64];
#pragma unroll
        for (int i = 0; i < 64; ++i) v[i] = src >= 0 ? W[(size_t)(ks0 + i) * N + src] : 0.f;
#pragma unroll
        for (int i = 0; i < 64; i += 2) { const float g0 = kgain ? kgain[k0 + i] : 1.f, g1 = kgain ? kgain[k0 + i + 1] : 1.f;
            *(LAS unsigned*)(tl + lane * 72 + i) = pk2(v[i] * g0, v[i + 1] * g1); }
    }
    LDS_WAIT(); asm volatile("" ::: "memory");
    bf16* orow = WT + (size_t)(n0 + lane) * K + k0;
#pragma unroll
    for (int cch = 0; cch < 8; ++cch) *(GAS v4u*)(orow + 8 * cch) = *(const LAS v4u*)(tl + lane * 72 + 8 * cch);
    LDS_WAIT(); asm volatile("" ::: "memory");
}
__device__ __forceinline__ void p0_prologue(Frame& F, size_t mods_off) {
    p0_mods(F, mods_off);
    LAS bf16* tl = (LAS bf16*)(F.lds + F.wave * 9216);
    const int gw = F.vcu * NWAVES + F.wave, NGW = F.G * NWAVES;
    constexpr int I_IN = (DM / 64) * (NP / 64), I_OUT = (DM / 64) * (DM / 64), I_UQ = (384 / 64) * (NQ / 64), I_UKV = (256 / 64) * (NKV / 64), I_L = I_IN + I_OUT + I_UQ + I_UKV;
    for (int it = gw; it < DEPTH * I_L; it += NGW) {
        const int l = it / I_L; int r = it % I_L;
        if (r < I_IN) { p0_transpose_item<1, false>(ld_in(6) + (size_t)l * DM * IN_DIM, DM, IN_DIM, WSP(bf16, WS_WIN) + (size_t)l * NP * DM, nullptr, tl, r, NP / 64, F.lane); continue; } r -= I_IN;
        if (r < I_OUT) { p0_transpose_item<0, true>(ld_in(19) + (size_t)l * DM * DM, DM, DM, WSP(bf16, WS_WOUT) + (size_t)l * DM * DM, nullptr, tl, r, DM / 64, F.lane); continue; } r -= I_OUT;
        if (r < I_UQ) { p0_transpose_item<2, false>(ld_in(14) + (size_t)l * 384 * 1152, 384, 1152, WSP(bf16, WS_WUQ) + (size_t)l * NQ * 384, ld_in(12) + l * 384, tl, r, NQ / 64, F.lane); continue; } r -= I_UQ;
        p0_transpose_item<0, false>(ld_in(15) + (size_t)l * 256 * 1536, 256, 1536, WSP(bf16, WS_WUKV) + (size_t)l * NKV * 256, ld_in(13) + l * 256, tl, r, NKV / 64, F.lane);
    }
    const int* pos = (const int*)ld_in(2);
    for (int i = (int)blockIdx.x * NTHR + F.tid; i < T * 32; i += F.G * NTHR) {
        const int t = i >> 5, f = i & 31;
        const float inv = (float)exp2(-(double)f * (13.287712379549449 / 32.0));
        const float ang = (float)pos[t] * inv;
        const double rev = (double)ang * 0.15915494309189535; const float fr = (float)(rev - floor(rev));
        WSP(float, WS_CS)[i] = __builtin_amdgcn_cosf(fr); WSP(float, WS_SN)[i] = __builtin_amdgcn_sinf(fr);
    }
}
__device__ __forceinline__ void modnorm_rows(Frame& F, const float* x, const float* g, const float* mods_l, bf16* H) {
    const int gw = F.vcu * NWAVES + F.wave, NGW = F.G * NWAVES;
    for (int t = gw; t < T; t += NGW) {
        const GAS f32x4* xr = (const GAS f32x4*)(x + (size_t)t * DM) + F.lane;
        f32x4 v[8]; float s = 0.f;
#pragma unroll
        for (int j = 0; j < 8; ++j) { v[j] = xr[64 * j]; s += (v[j][0] * v[j][0] + v[j][1] * v[j][1]) + (v[j][2] * v[j][2] + v[j][3] * v[j][3]); }
        const float rstd = __builtin_amdgcn_rsqf(wave_sum(s) * (1.f / DM) + EPS);
        const float* sh = mods_l + (size_t)(t / SEQ) * 3 * DM; const float* scl = sh + DM;
        GAS v2u* o8 = (GAS v2u*)(H + (size_t)t * DM) + F.lane;
#pragma unroll
        for (int j = 0; j < 8; ++j) { const int col = (F.lane + 64 * j) * 4;
            const f32x4 gg = *(const f32x4*)(g + col), sv = *(const f32x4*)(scl + col), hv = *(const f32x4*)(sh + col);
            const f32x4 r = v[j] * rstd * gg * (sv + 1.f) + hv;
            v2u w; w.x = pk2(r[0], r[1]); w.y = pk2(r[2], r[3]); o8[64 * j] = w; }
    }
}
__device__ __forceinline__ void finalnorm_rows(Frame& F, float* x, const float* g) {
    const int gw = F.vcu * NWAVES + F.wave, NGW = F.G * NWAVES;
    for (int t = gw; t < T; t += NGW) {
        GAS f32x4* xr = (GAS f32x4*)(x + (size_t)t * DM) + F.lane;
        f32x4 v[8]; float s = 0.f;
#pragma unroll
        for (int j = 0; j < 8; ++j) { v[j] = xr[64 * j]; s += (v[j][0] * v[j][0] + v[j][1] * v[j][1]) + (v[j][2] * v[j][2] + v[j][3] * v[j][3]); }
        const float rstd = __builtin_amdgcn_rsqf(wave_sum(s) * (1.f / DM) + EPS);
#pragma unroll
        for (int j = 0; j < 8; ++j) { const f32x4 gg = *(const f32x4*)(g + (F.lane + 64 * j) * 4); xr[64 * j] = v[j] * rstd * gg; }
    }
}
__device__ __forceinline__ void unpack8(const v4u w, float* f) { f[0] = bflo(w.x); f[1] = bfhi(w.x); f[2] = bflo(w.y); f[3] = bfhi(w.y); f[4] = bflo(w.z); f[5] = bfhi(w.z); f[6] = bflo(w.w); f[7] = bfhi(w.w); }
__device__ __forceinline__ void conv_rows(Frame& F, int l) {
    const int gw = F.vcu * NWAVES + F.wave, NGW = F.G * NWAVES;
    const bf16* P = WSP(bf16, WS_PROJ); bf16* Y = WSP(bf16, WS_HY);
    const float* cw = ld_in(17) + l * 3 * 512; const float* cg = ld_in(18) + l * 512;
    const int ch = F.lane * 8;
    for (int t = gw; t < T; t += NGW) {
        const int s = t % SEQ; const bf16* p = P + (size_t)t * NP;
        float u[3][8];
#pragma unroll
        for (int d = 0; d < 3; ++d) { const int ss = s + d - 1;
            if (ss >= 0 && ss < SEQ) { const bf16* q = p + (long)(d - 1) * NP; float a[8], b[8]; unpack8(*(const v4u*)(q + C_CC + ch), a); unpack8(*(const v4u*)(q + C_CX + ch), b);
#pragma unroll
                for (int e = 0; e < 8; ++e) u[d][e] = a[e] * b[e]; }
            else {
#pragma unroll
                for (int e = 0; e < 8; ++e) u[d][e] = 0.f; } }
        float cb[8], sz[8], pre[8]; unpack8(*(const v4u*)(p + C_CB + ch), cb); unpack8(*(const v4u*)(p + C_Z + 1536 + ch), sz);
        float ssq = 0.f;
#pragma unroll
        for (int e = 0; e < 8; ++e) { pre[e] = cb[e] * (u[0][e] * cw[ch + e] + u[1][e] * cw[512 + ch + e] + u[2][e] * cw[1024 + ch + e]); ssq += pre[e] * pre[e]; }
        const float rstd = __builtin_amdgcn_rsqf(wave_sum(ssq) * (1.f / 512.f) + EPS);
        float r[8];
#pragma unroll
        for (int e = 0; e < 8; ++e) r[e] = pre[e] * rstd * cg[ch + e] * sz[e];
        v4u w; w.x = pk2(r[0], r[1]); w.y = pk2(r[2], r[3]); w.z = pk2(r[4], r[5]); w.w = pk2(r[6], r[7]);
        *(v4u*)(Y + (size_t)t * DM + 1536 + ch) = w;
    }
}
__device__ __forceinline__ void mlaout_rows(Frame& F, int l) {
    const int gw = F.vcu * NWAVES + F.wave, NGW = F.G * NWAVES;
    const bf16* P = WSP(bf16, WS_PROJ); bf16* Y = WSP(bf16, WS_HY); const float* O = WSP(float, WS_OMLA); const float* g = ld_in(16) + l * 768;
    for (int t = gw; t < T; t += NGW) {
        f32x4 v[3]; float s = 0.f;
#pragma unroll
        for (int j = 0; j < 3; ++j) { v[j] = *(const f32x4*)(O + (size_t)t * 768 + (F.lane + 64 * j) * 4); s += (v[j][0] * v[j][0] + v[j][1] * v[j][1]) + (v[j][2] * v[j][2] + v[j][3] * v[j][3]); }
        const float rstd = __builtin_amdgcn_rsqf(wave_sum(s) * (1.f / 768.f) + EPS);
#pragma unroll
        for (int j = 0; j < 3; ++j) { const int col = (F.lane + 64 * j) * 4; const f32x4 gg = *(const f32x4*)(g + col);
            const v2u zw = *(const v2u*)(P + (size_t)t * NP + C_Z + 768 + col);
            const f32x4 r = v[j] * rstd * gg; v2u w; w.x = pk2(r[0] * bflo(zw.x), r[1] * bfhi(zw.x)); w.y = pk2(r[2] * bflo(zw.y), r[3] * bfhi(zw.y));
            *(v2u*)(Y + (size_t)t * DM + col) = w; }
    }
}

template <int KS> __device__ __forceinline__ f32x16 tile_mm(const LAS bf16* A, const LAS bf16* Bt, int r, int hh, f32x16 acc) {
#pragma unroll
    for (int s = 0; s < KS; ++s) {
        const bf16x8 a = *(const LAS bf16x8*)(A + r * 72 + 16 * s + 8 * hh), b = *(const LAS bf16x8*)(Bt + r * 72 + 16 * s + 8 * hh);
        acc = __builtin_amdgcn_mfma_f32_32x32x16_bf16(a, b, acc, 0, 0, 0);
    }
    return acc;
}
__device__ __forceinline__ float logsig16(float a) { return (fminf(a, 0.f) - __logf(1.f + __expf(-fabsf(a)))) * (1.f / 16.f); }
__device__ __forceinline__ void gla_a_item(Frame& F, int l, int item) {
    const int h = item % 6, bn = item / 6, t0 = bn * 64;
    const int tid = F.tid, lane = F.lane, wave = F.wave;
    LAS unsigned char* L = F.lds;
    LAS bf16* QB = (LAS bf16*)(L);
    LAS bf16* KB = (LAS bf16*)(L + 9216);
    LAS bf16* Mm = (LAS bf16*)(L);
    LAS bf16* VT = (LAS bf16*)(L + 18432);
    LAS float* LR = (LAS float*)(L + 36864);
    LAS float* WG = (LAS float*)(L + 36864 + 8192);
    LAS float* BG = (LAS float*)(L + 36864 + 16384);
    LAS bf16* KDT = (LAS bf16*)(L + 36864);
    LAS float* LA = (LAS float*)(L + 55296);
    LAS float* SEGT = (LAS float*)(L + 88576);
    LAS bf16* QF = (LAS bf16*)(L + 90624);
    LAS bf16* KF = (LAS bf16*)(L + 90624 + 18432);
    const bf16* P = WSP(bf16, WS_PROJ) + (size_t)t0 * NP;
    { const int r = tid >> 3, c8 = (tid & 7) * 8;
      *(LAS v4u*)(QB + r * 72 + c8) = *(const v4u*)(P + (size_t)r * NP + C_GQ + h * 64 + c8);
      *(LAS v4u*)(KB + r * 72 + c8) = *(const v4u*)(P + (size_t)r * NP + C_GK + h * 64 + c8); }
#pragma unroll
    for (int i = 0; i < 2; ++i) { const int idx = tid + i * 512, r = idx >> 4, c8 = (idx & 15) * 8;
        const v4u raw = *(const v4u*)(P + (size_t)r * NP + C_GV + h * 128 + c8);
        VT[(c8 + 0) * 72 + r] = (unsigned short)(raw.x & 0xffffu); VT[(c8 + 1) * 72 + r] = (unsigned short)(raw.x >> 16);
        VT[(c8 + 2) * 72 + r] = (unsigned short)(raw.y & 0xffffu); VT[(c8 + 3) * 72 + r] = (unsigned short)(raw.y >> 16);
        VT[(c8 + 4) * 72 + r] = (unsigned short)(raw.z & 0xffffu); VT[(c8 + 5) * 72 + r] = (unsigned short)(raw.z >> 16);
        VT[(c8 + 6) * 72 + r] = (unsigned short)(raw.w & 0xffffu); VT[(c8 + 7) * 72 + r] = (unsigned short)(raw.w >> 16); }
    if (tid < 256) { const int r = tid >> 2, c8 = (tid & 3) * 8; float f[8]; unpack8(*(const v4u*)(P + (size_t)r * NP + C_LR + c8), f);
#pragma unroll
        for (int e = 0; e < 8; ++e) LR[r * 32 + c8 + e] = f[e]; }
    { const int dir = tid >> 8, r = (tid >> 4) & 15, c4 = (tid & 15) * 4; const float* wgf_ = ld_in(7); const float* wgb_ = ld_in(9); const float* wsrc = (dir ? wgb_ : wgf_) + (size_t)l * 16 * 384 + r * 384 + h * 64 + c4;
      *(LAS f32x4*)(WG + (dir * 16 + r) * 64 + c4) = *(const f32x4*)wsrc; }
    if (tid < 128) { const int dir = tid >> 6, dk = tid & 63; const float* bgf_ = ld_in(8); const float* bgb_ = ld_in(10); BG[dir * 64 + dk] = (dir ? bgb_ : bgf_)[l * 384 + h * 64 + dk]; }
    LDS_WAIT(); __syncthreads();
    { const int tok = tid >> 3, dkg = (tid & 7) * 8;
#pragma unroll
      for (int dir = 0; dir < 2; ++dir) { float a[8];
#pragma unroll
        for (int e = 0; e < 8; ++e) a[e] = BG[dir * 64 + dkg + e];
#pragma unroll
        for (int r = 0; r < 16; ++r) { const float x = LR[tok * 32 + dir * 16 + r];
#pragma unroll
            for (int e = 0; e < 8; ++e) a[e] += x * WG[(dir * 16 + r) * 64 + dkg + e]; }
#pragma unroll
        for (int e = 0; e < 8; ++e) LA[(dir * 64 + tok) * 65 + dkg + e] = logsig16(a[e]); } }
    LDS_WAIT(); __syncthreads();
    const int cdir = (tid >> 6) & 1, cdk = tid & 63, seg = tid >> 7;
    float pb[16];
#pragma unroll
    for (int i = 0; i < 16; ++i) pb[i] = LA[(cdir * 64 + seg * 16 + i) * 65 + cdk];
    if (cdir == 0) {
#pragma unroll
        for (int i = 1; i < 16; ++i) pb[i] += pb[i - 1];
    } else {
#pragma unroll
        for (int i = 14; i >= 0; --i) pb[i] += pb[i + 1];
    }
    SEGT[(cdir * 4 + seg) * 64 + cdk] = cdir == 0 ? pb[15] : pb[0];
    LDS_WAIT(); __syncthreads();
    { float offv = 0.f, tot = 0.f;
#pragma unroll
      for (int s2 = 0; s2 < 4; ++s2) { const float sv = SEGT[(cdir * 4 + s2) * 64 + cdk]; tot += sv; if (cdir == 0 ? (s2 < seg) : (s2 > seg)) offv += sv; }
      bf16* QD = WSP(bf16, WS_QDEC) + (size_t)cdir * T * 384 + (size_t)t0 * 384 + h * 64 + cdk;
      unsigned kd[8];
#pragma unroll
      for (int i = 0; i < 16; ++i) { const int tok = seg * 16 + i; const float bv = pb[i] + offv;
          const float q = bf2f(QB[tok * 72 + cdk]), k = bf2f(KB[tok * 72 + cdk]);
          const unsigned short qd = (unsigned short)f2bf(q * 0.125f * __expf(bv)), ki = (unsigned short)f2bf(k * __expf(-bv)), kdv = (unsigned short)f2bf(k * __expf(tot - bv));
          QF[(cdir * 64 + tok) * 72 + cdk] = qd; KF[(cdir * 64 + tok) * 72 + cdk] = ki; QD[(size_t)tok * 384] = qd;
          if (i & 1) kd[i >> 1] |= (unsigned)kdv << 16; else kd[i >> 1] = kdv;
          if ((i & 3) == 3) __builtin_amdgcn_sched_barrier(0); }
      *(LAS v4u*)(KDT + (cdir * 64 + cdk) * 72 + seg * 16) = (v4u){kd[0], kd[1], kd[2], kd[3]};
      *(LAS v4u*)(KDT + (cdir * 64 + cdk) * 72 + seg * 16 + 8) = (v4u){kd[4], kd[5], kd[6], kd[7]};
      if (seg == 0) WSP(float, WS_DECAY)[((size_t)item * 2 + cdir) * 64 + cdk] = __expf(tot); }
    LDS_WAIT(); __syncthreads();
    const int r = lane & 31, hh = lane >> 5;
    if (wave < 4) {
        const int pb2 = wave >> 1, jb = wave & 1; f32x16 sf = {}, sb = {};
        if (pb2 >= jb) sf = tile_mm<4>(QF + (0 * 64 + pb2 * 32) * 72, KF + (0 * 64 + jb * 32) * 72, r, hh, sf);
        if (pb2 <= jb) sb = tile_mm<4>(QF + (1 * 64 + pb2 * 32) * 72, KF + (1 * 64 + jb * 32) * 72, r, hh, sb);
#pragma unroll
        for (int reg = 0; reg < 16; ++reg) { const int p = (reg & 3) + 8 * (reg >> 2) + 4 * hh; float v;
            if (pb2 > jb) v = sf[reg]; else if (pb2 < jb) v = sb[reg]; else v = (r <= p) ? sf[reg] : sb[reg];
            Mm[(pb2 * 32 + p) * 72 + jb * 32 + r] = (unsigned short)f2bf(v); }
    } else {
        const int dvb = wave - 4; float* KV = WSP(float, WS_KVC) + (size_t)item * 2 * 8192;
#pragma unroll
        for (int dir = 0; dir < 2; ++dir)
#pragma unroll
            for (int dkb = 0; dkb < 2; ++dkb) { f32x16 a = {}; a = tile_mm<4>(VT + (dvb * 32) * 72, KDT + (dir * 64 + dkb * 32) * 72, r, hh, a);
#pragma unroll
                for (int reg = 0; reg < 16; ++reg) { const int dv = dvb * 32 + (reg & 3) + 8 * (reg >> 2) + 4 * hh; KV[(size_t)dir * 8192 + dv * 64 + dkb * 32 + r] = a[reg]; } }
    }
    LDS_WAIT(); __syncthreads();
    { const int pb2 = wave >> 2, dvb = wave & 3; f32x16 a = {}; a = tile_mm<4>(Mm + (pb2 * 32) * 72, VT + (dvb * 32) * 72, r, hh, a);
      float* OI = WSP(float, WS_OINTRA) + (size_t)(t0 + pb2 * 32) * 768 + h * 128 + dvb * 32 + r;
#pragma unroll
      for (int reg = 0; reg < 16; ++reg) { const int p = (reg & 3) + 8 * (reg >> 2) + 4 * hh; OI[(size_t)p * 768] = a[reg]; } }
    __syncthreads();
}
__device__ __forceinline__ void gla_scan_item(Frame& F, int item) {
    const int quarter = item & 3, dir = (item >> 2) & 1, bh = item >> 3, b = bh / 6, h = bh % 6;
    const int e = quarter * 2048 + F.tid * 4, dk = e & 63;
    const float* KV = WSP(float, WS_KVC); const float* DC = WSP(float, WS_DECAY); bf16* ST = WSP(bf16, WS_ST);
    f32x4 st = {0.f, 0.f, 0.f, 0.f};
#pragma unroll 4
    for (int i = 0; i < 32; ++i) { const int n = dir ? 31 - i : i; const size_t it = (size_t)((b * 32 + n) * 6 + h) * 2 + dir;
        const f32x4 kv = *(const f32x4*)(KV + it * 8192 + e), dc = *(const f32x4*)(DC + it * 64 + dk);
        v2u w; w.x = pk2(st[0], st[1]); w.y = pk2(st[2], st[3]); *(v2u*)(ST + it * 8192 + e) = w;
        st = dc * st + kv; }
}
__device__ __forceinline__ void gla_c_task(Frame& F, int l, int task) {
    const int item = task >> 1, half = task & 1, h = item % 6, bn = item / 6, tk0 = bn * 64 + half * 32;
    const int r = F.lane & 31, hh = F.lane >> 5;
    const bf16* QD = WSP(bf16, WS_QDEC); const bf16* ST = WSP(bf16, WS_ST) + (size_t)item * 2 * 8192;
    bf16x8 af[2][4];
#pragma unroll
    for (int dir = 0; dir < 2; ++dir)
#pragma unroll
        for (int s = 0; s < 4; ++s) af[dir][s] = *(const bf16x8*)(QD + (size_t)dir * T * 384 + (size_t)(tk0 + r) * 384 + h * 64 + 16 * s + 8 * hh);
    f32x16 acc[4];
#pragma unroll
    for (int dvb = 0; dvb < 4; ++dvb) { acc[dvb] = f32x16{};
#pragma unroll
        for (int dir = 0; dir < 2; ++dir)
#pragma unroll
            for (int s = 0; s < 4; ++s) { const bf16x8 bfr = *(const bf16x8*)(ST + (size_t)dir * 8192 + (dvb * 32 + r) * 64 + 16 * s + 8 * hh);
                acc[dvb] = __builtin_amdgcn_mfma_f32_32x32x16_bf16(af[dir][s], bfr, acc[dvb], 0, 0, 0); } }
    const float* OI = WSP(float, WS_OINTRA); const bf16* P = WSP(bf16, WS_PROJ); bf16* Y = WSP(bf16, WS_HY); const float* g = ld_in(11) + l * 128;
    float gg[4];
#pragma unroll
    for (int dvb = 0; dvb < 4; ++dvb) gg[dvb] = g[dvb * 32 + r];
#pragma unroll
    for (int reg = 0; reg < 16; ++reg) { const int p = (reg & 3) + 8 * (reg >> 2) + 4 * hh; const size_t t = (size_t)(tk0 + p);
        float v[4], ss = 0.f;
#pragma unroll
        for (int dvb = 0; dvb < 4; ++dvb) { v[dvb] = acc[dvb][reg] + OI[t * 768 + h * 128 + dvb * 32 + r]; ss += v[dvb] * v[dvb]; }
        ss += __shfl_xor(ss, 1); ss += __shfl_xor(ss, 2); ss += __shfl_xor(ss, 4); ss += __shfl_xor(ss, 8); ss += __shfl_xor(ss, 16);
        const float rstd = __builtin_amdgcn_rsqf(ss * (1.f / 128.f) + EPS);
#pragma unroll
        for (int dvb = 0; dvb < 4; ++dvb) { const int col = h * 128 + dvb * 32 + r; const float sz = bf2f(P[t * NP + C_Z + col]);
            Y[t * DM + 768 + col] = (unsigned short)f2bf(v[dvb] * rstd * gg[dvb] * sz); } }
}
#define XB_TMO      128
#define XB_XCNT(j)  (256  + 64 * (j))
#define XB_XSUB(j)  (1280 + 64 * (j))
#define XB_XGEN(j)  (2304 + 64 * (j))
#define XB_TOP      3328
#define XB_TOPGEN   3392
#define XCD_BAR_WORDS 3456
#define XB_SPIN_CAP (1u << 18)
__device__ __forceinline__ unsigned xb_ld(unsigned* p)              { return __hip_atomic_load(p, __ATOMIC_RELAXED, __HIP_MEMORY_SCOPE_AGENT); }
__device__ __forceinline__ unsigned xb_add(unsigned* p, unsigned v) { return __hip_atomic_fetch_add(p, v, __ATOMIC_RELAXED, __HIP_MEMORY_SCOPE_AGENT); }
__device__ __forceinline__ unsigned xb_xcc_id() { return (unsigned)__builtin_amdgcn_s_getreg((3 << 11) | 20) & 0xFu; }
#define XB_SPIN(cond, bar) do { unsigned _sp = 0; while (cond) { __builtin_amdgcn_s_sleep(1); \
    if ((++_sp & 255u) == 0u) { if (xb_ld(&(bar)[XB_TMO])) break; if (_sp > XB_SPIN_CAP) { atomicAdd(&(bar)[XB_TMO], 1u); break; } } } } while (0)
struct XcdBarrier { unsigned* bar; unsigned x; volatile LAS unsigned* st; };
__device__ __forceinline__ XcdBarrier xcd_barrier_post(unsigned* bar, volatile LAS unsigned* st) {
    XcdBarrier b; b.bar = bar; b.x = xb_xcc_id(); b.st = st;
    if (threadIdx.x == 0) (void)xb_add(&bar[XB_XCNT(b.x)], 1u);
    return b;
}
__device__ __forceinline__ void xcd_barrier_complete(unsigned* bar, unsigned x, unsigned& nloc, unsigned& nx) {
    const unsigned G = gridDim.x * gridDim.y * gridDim.z;
    unsigned sum, cnt, mine, sp = 0u;
    for (;;) {
        sum = 0u; cnt = 0u; mine = 0u;
#pragma unroll
        for (unsigned j = 0; j < 16; ++j) { const unsigned c = xb_ld(&bar[XB_XCNT(j)]); sum += c; cnt += (c > 0u) ? 1u : 0u; mine = (j == x) ? c : mine; }
        if (sum == G) break;
        __builtin_amdgcn_s_sleep(1);
        if ((++sp & 255u) == 0u) { if (xb_ld(&bar[XB_TMO])) break; if (sp > XB_SPIN_CAP) { atomicAdd(&bar[XB_TMO], 1u); break; } }
    }
    nloc = mine > 0u ? mine : 1u; nx = cnt > 0u ? cnt : 1u;
}
__device__ __forceinline__ void xcd_barrier(const XcdBarrier& b) {
    asm volatile("s_waitcnt vmcnt(0)" ::: "memory");
    __syncthreads();
    if (threadIdx.x == 0) {
        unsigned* bar = b.bar;
        __builtin_amdgcn_s_waitcnt(0);
        unsigned nloc = b.st[0], nx = b.st[1];
        if (nloc == 0u) { xcd_barrier_complete(bar, b.x, nloc, nx); b.st[0] = nloc; b.st[1] = nx; }
        const unsigned old = xb_add(&bar[XB_XSUB(b.x)], 1u);
        const unsigned gen = old / nloc;
        if (old + 1u == (gen + 1u) * nloc) {
            __builtin_amdgcn_fence(__ATOMIC_RELEASE, "agent");
            asm volatile("s_waitcnt vmcnt(0)" ::: "memory");
            const unsigned og = xb_add(&bar[XB_TOP], 1u);
            const unsigned tg = og / nx;
            if (og + 1u == (tg + 1u) * nx) xb_add(&bar[XB_TOPGEN], 1u);
            else XB_SPIN(xb_ld(&bar[XB_TOPGEN]) == tg, bar);
            __builtin_amdgcn_fence(__ATOMIC_ACQUIRE, "agent");
            xb_add(&bar[XB_XGEN(b.x)], 1u);
            asm volatile("s_waitcnt vmcnt(0)" ::: "memory");
        } else {
            XB_SPIN(xb_ld(&bar[XB_XGEN(b.x)]) == gen, bar);
            __builtin_amdgcn_fence(__ATOMIC_ACQUIRE, "agent");
            asm volatile("s_waitcnt vmcnt(0)" ::: "memory");
        }
    }
    __syncthreads();
}

__device__ __forceinline__ void sub_barrier(unsigned* cnt, unsigned target) {
    asm volatile("s_waitcnt vmcnt(0)" ::: "memory");
    __syncthreads();
    if (threadIdx.x == 0) {
        __builtin_amdgcn_fence(__ATOMIC_RELEASE, "agent");
        asm volatile("s_waitcnt vmcnt(0)" ::: "memory");
        (void)xb_add(cnt, 1u);
        unsigned sp = 0u; while (xb_ld(cnt) < target) { __builtin_amdgcn_s_sleep(2); if (++sp > (1u << 22)) break; }
        __builtin_amdgcn_fence(__ATOMIC_ACQUIRE, "agent");
        asm volatile("s_waitcnt vmcnt(0)" ::: "memory");
    }
    __syncthreads();
}

struct Args { const float* in[21]; float* out; unsigned char* ws; int ph_lo, ph_hi; };
constexpr int N_PHASES = 2 + 6 * DEPTH;
__global__ void __launch_bounds__(NTHR, 2) mega_fwd(Args args) {
    extern __shared__ __attribute__((aligned(16))) unsigned char lds[];
    Frame F;
    F.lds = (LAS unsigned char*)lds; F.ldsg = (char*)lds;
    F.tid = threadIdx.x; F.lane = F.tid & 63; F.wave = __builtin_amdgcn_readfirstlane(F.tid >> 6);
    F.G = gridDim.x; { const int bx = blockIdx.x; F.vcu = (F.G % 8 == 0) ? (bx % 8) * (F.G / 8) + bx / 8 : bx; }
    F.out = args.out; F.ws = args.ws;
    volatile LAS unsigned* MISC = (volatile LAS unsigned*)(F.lds + MISC_OFF);
    for (int u = F.tid; u < (LDS_BYTES - LDSCTL_OFF) / 4; u += NTHR) ((LAS unsigned*)(F.lds + LDSCTL_OFF))[u] = 0u;
    __syncthreads();
    XcdBarrier bar = xcd_barrier_post((unsigned*)(F.ws + WS_CTL) + CW_BAR, MISC + 8);
    const int lo = args.ph_lo, hi = args.ph_hi;
#ifndef MK_MASK
#define MK_MASK 0xFF
#endif
#define PHON(b) ((MK_MASK >> (b)) & 1)
#ifndef MK_REP_PH
#define MK_REP_PH -1
#endif
#define REPS(ph) for (int rep_ = 0; rep_ < ((ph) == MK_REP_PH ? 2 : 1); ++rep_)
#define REPBAR() do { if (rep_ == 0 && false) {} } while (0)
#define IN(k) (lo <= (k) && (k) < hi)
#define FRESH() do { int t_ = threadIdx.x; asm volatile("" : "+v"(t_)); F.tid = t_; F.lane = t_ & 63; F.wave = __builtin_amdgcn_readfirstlane(t_ >> 6); GAS unsigned char* w_ = (GAS unsigned char*)args.ws; asm volatile("" : "+s"(w_)); F.ws = (unsigned char*)w_; GAS float* o_ = (GAS float*)args.out; asm volatile("" : "+s"(o_)); F.out = (float*)o_; } while (0)
#define SEAM(k) do { if (IN(k) && IN((k) + 1)) xcd_barrier(bar); } while (0)
    REPS(100) { if (PHON(0) && IN(0)) { p0_prologue(F, rep_ == 0 ? WS_MODS : (size_t)(1 * MiB)); } SEAM(0); }
    REPS(101) { if (PHON(1) && IN(1)) { modnorm_rows(F, ld_in(0), ld_in(5), WSP(float, WS_MODS), WSP(bf16, WS_HY)); } SEAM(1); }
#pragma unroll 1
    for (int l = 0; l < DEPTH; ++l) {
        const int pb = 2 + 6 * l;
#define mods_l (WSP(float, WS_MODS) + (size_t)l * BATCH * 3 * DM)
        REPS(0) { if (PHON(2) && IN(pb)) {
            FRESH();
            pg8::Gemm g{WSP(bf16, WS_HY), WSP(bf16, WS_WIN) + (size_t)l * NP * DM, T, NP, DM, DM}; pg8::StaticOrder S; S.init(T, NP, F.G, (int)blockIdx.x);
            EpiIn E{WSP(bf16, WS_PROJ), WSP(float, WS_CS), WSP(float, WS_SN), WSP(float, WS_PARTQ), WSP(float, WS_PARTKV)};
            pg8::gemm_phase<EpiIn, pg8::StaticOrder, true, true>(F.lds, g, S, E);
        } SEAM(pb); }
        REPS(1) { if (PHON(3) && IN(pb + 1)) {
#ifndef MK_SUB
#define MK_SUB 0xFF
#endif
            FRESH();
            if (MK_SUB & 1) { pg8::Gemm g{WSP(bf16, WS_PROJ) + C_MKV, WSP(bf16, WS_WUKV) + (size_t)l * NKV * 256, T, NKV, 256, NP}; pg8::StaticOrder S; S.init(T, NKV, F.G, (int)blockIdx.x);
              EpiUkv E{WSP(bf16, WS_KVUP), WSP(float, WS_PARTKV)};
              pg8::gemm_phase<EpiUkv, pg8::StaticOrder, true, true>(F.lds, g, S, E); }
            FRESH();
            if (MK_SUB & 2) { pg8::Gemm g{WSP(bf16, WS_PROJ) + C_MQ, WSP(bf16, WS_WUQ) + (size_t)l * NQ * 384, T, NQ, 384, NP}; pg8::StaticOrder S; S.init(T, NQ, F.G, ((int)blockIdx.x + 64) % F.G);
              EpiUq E{WSP(bf16, WS_QUP), WSP(float, WS_CS), WSP(float, WS_SN), WSP(float, WS_PARTQ)};
              pg8::gemm_phase<EpiUq, pg8::StaticOrder, true, true>(F.lds, g, S, E); }
            __syncthreads(); FRESH();
            if (MK_SUB & 4) for (int it = (int)blockIdx.x; it < NITEM; it += F.G) gla_a_item(F, l, it);
            FRESH();
            if (MK_SUB & 8) conv_rows(F, l);
        } SEAM(pb + 1); }
        REPS(2) { if (PHON(4) && IN(pb + 2)) {
            const int bx = (int)blockIdx.x; FRESH();
            if (F.G == 256) {
                if (bx < 192) { const int u = bx, bh = u >> 3, qb = u & 7, b = bh / 6, h = bh % 6; const size_t row0 = (size_t)b * SEQ, qrow = row0 + qb * 256;
                    mla::attn_unit(WSP(bf16, WS_QUP) + qrow * NQ + h * 192, WSP(bf16, WS_KVUP) + row0 * NKV + h * 256, WSP(bf16, WS_KVUP) + row0 * NKV + h * 256 + 128,
                                   WSP(bf16, WS_PROJ) + row0 * NP + C_MKR, WSP(bf16, WS_HY) + qrow * DM + h * 128, WSP(bf16, WS_PROJ) + qrow * NP + C_Z + 768 + h * 128,
                                   ld_in(16) + l * 768 + h * 128, WSP(float, WS_PARTM) + qrow * 8 + h, SEQ, F.ldsg);
                } else {
                    for (int it = bx - 192; it < 192; it += 64) gla_scan_item(F, it);
                    sub_barrier((unsigned*)(F.ws + WS_CTL) + 64 + 64 * (l * 2 + rep_), 64u);
                    FRESH(); const int gw = (bx - 192) * NWAVES + F.wave;
                    for (int task = gw; task < 2 * NITEM; task += 64 * NWAVES) gla_c_task(F, l, task);
                }
            } else {
                for (int u = bx; u < 192; u += F.G) { const int bh = u >> 3, qb = u & 7, b = bh / 6, h = bh % 6; const size_t row0 = (size_t)b * SEQ, qrow = row0 + qb * 256;
                    mla::attn_unit(WSP(bf16, WS_QUP) + qrow * NQ + h * 192, WSP(bf16, WS_KVUP) + row0 * NKV + h * 256, WSP(bf16, WS_KVUP) + row0 * NKV + h * 256 + 128,
                                   WSP(bf16, WS_PROJ) + row0 * NP + C_MKR, WSP(bf16, WS_HY) + qrow * DM + h * 128, WSP(bf16, WS_PROJ) + qrow * NP + C_Z + 768 + h * 128,
                                   ld_in(16) + l * 768 + h * 128, WSP(float, WS_PARTM) + qrow * 8 + h, SEQ, F.ldsg); }
                for (int it = bx; it < 192; it += F.G) gla_scan_item(F, it);
                xcd_barrier(bar);
                FRESH(); const int gw = F.vcu * NWAVES + F.wave, NGW = F.G * NWAVES;
                for (int task = gw; task < 2 * NITEM; task += NGW) gla_c_task(F, l, task);
            }
        } SEAM(pb + 2); }
        for (int rep_ = 0; rep_ < ((MK_REP_PH == 4 && l == 0) ? 2 : 1); ++rep_) { if (PHON(6) && IN(pb + 4)) {
            FRESH();
            pg8::Gemm g{WSP(bf16, WS_HY), WSP(bf16, WS_WOUT) + (size_t)l * DM * DM, T, DM, DM, DM}; pg8::StaticOrder S; S.init(T, DM, F.G, (int)blockIdx.x);
            EpiOut E{l == 0 ? ld_in(0) : F.out, F.out, mods_l + 2 * DM, WSP(float, WS_PARTM)};
            pg8::gemm_phase<EpiOut, pg8::StaticOrder, true, true>(F.lds, g, S, E);
        } SEAM(pb + 4); }
        for (int rep_ = 0; rep_ < ((MK_REP_PH == 5 && l == 0) ? 2 : 1); ++rep_) { if (PHON(7) && IN(pb + 5)) {
            FRESH();
            if (l + 1 < DEPTH) modnorm_rows(F, F.out, ld_in(5) + (l + 1) * DM, mods_l + (size_t)BATCH * 3 * DM, WSP(bf16, WS_HY));
            else finalnorm_rows(F, F.out, ld_in(20));
        } SEAM(pb + 5); }
        if (MK_REP_PH == 6) { for (int r_ = 0; r_ < 4; ++r_) xcd_barrier(bar); }
    }
#undef mods_l
#undef IN
#undef SEAM
}

#ifndef MK_CUT
#define MK_CUT 14
#endif
#if MK_CUT < 14
__global__ void glue_proj(const bf16* P, float* proj, float* y, int row0) {
    const int t = blockIdx.x; const bf16* p = P + (size_t)(row0 + t) * NP;
    for (int c = threadIdx.x; c < NP; c += 256) { const float v = bf2f(p[c]);
        if (c < C_MKV) proj[(size_t)t * nv::PW + c] = v;
        else if (c < C_MQ) proj[(size_t)t * nv::PW + nv::O_MKV + (c - C_MKV)] = v;
        else if (c < C_MKR) proj[(size_t)t * nv::PW + nv::O_MQ + (c - C_MQ)] = v;
        else if (c < C_LR) { const int j = c - C_MKR; proj[(size_t)t * nv::PW + nv::O_MKR + (j & 1) * 32 + (j >> 1)] = v; }
        else if (c < C_LR + 32) proj[(size_t)t * nv::PW + nv::O_LR + (c - C_LR)] = v;
        else if (c < C_CB) {}
        else if (c < C_Z) proj[(size_t)t * nv::PW + nv::O_CB + (c - C_CB)] = v;
        else y[(size_t)t * DM + (c - C_Z)] = v; }
}
__global__ void glue_qkv(const bf16* Q, const bf16* KV, float* qm, float* kv, int row0) {
    const int t = blockIdx.x;
    for (int c = threadIdx.x; c < 1152; c += 256) { const float v = bf2f(Q[(size_t)(row0 + t) * NQ + c]) * (1.f / QSCALE); const int h = c / 192, d = c % 192;
        if (d < 128) qm[(size_t)t * 1152 + c] = v; else { const int j = d - 128; qm[(size_t)t * 1152 + h * 192 + 128 + (j & 1) * 32 + (j >> 1)] = v; } }
    for (int c = threadIdx.x; c < 1536; c += 256) kv[(size_t)t * 1536 + c] = bf2f(KV[(size_t)(row0 + t) * NKV + c]);
}
__global__ void glue_y(const bf16* Y, float* y, int row0) {
    const int t = blockIdx.x; for (int c = threadIdx.x; c < DM; c += 256) { const int cr = c < 768 ? c + 768 : (c < 1536 ? c - 768 : c); y[(size_t)t * DM + cr] = bf2f(Y[(size_t)(row0 + t) * DM + c]); }
}
__global__ void glue_h(const bf16* H, float* h, int row0) {
    const int t = blockIdx.x; for (int c = threadIdx.x; c < DM; c += 256) h[(size_t)t * DM + c] = bf2f(H[(size_t)(row0 + t) * DM + c]);
}

#endif
#ifndef MK_NAIVE_BASE_MIB
#define MK_NAIVE_BASE_MIB 240
#endif
extern "C" void kernel_launch(void* const* d_in, const int* in_sizes, int n_in, void* d_out, int out_size, void* d_ws, size_t ws_size, hipStream_t stream) {
    static int grid = 0;
    if (grid == 0) {
        if (n_in != 21 || out_size != T * DM || in_sizes[0] != T * DM || ws_size < WS_END) { fprintf(stderr, "kernel_launch: unexpected shapes n_in %d out %d ws %zu\n", n_in, out_size, ws_size); grid = -1; return; }
        int dev = 0, cus = 0, per_cu = 0;
        if (hipGetDevice(&dev) != hipSuccess || hipDeviceGetAttribute(&cus, hipDeviceAttributeMultiprocessorCount, dev) != hipSuccess) { grid = -1; return; }
        if (hipFuncSetAttribute((const void*)mega_fwd, hipFuncAttributeMaxDynamicSharedMemorySize, LDS_BYTES) != hipSuccess) { fprintf(stderr, "kernel_launch: hipFuncSetAttribute failed\n"); grid = -1; return; }
        if (hipOccupancyMaxActiveBlocksPerMultiprocessor(&per_cu, (const void*)mega_fwd, NTHR, LDS_BYTES) != hipSuccess || per_cu < 1) { fprintf(stderr, "kernel_launch: occupancy query says %d blocks/CU\n", per_cu); grid = -1; (void)hipGetLastError(); return; }
        grid = cus;
    }
    if (grid < 0) return;
    (void)hipMemsetAsync((char*)d_ws + WS_CTL, 0, CTL_ZERO_BYTES, stream);
    Args a{};
    for (int i = 0; i < 21; ++i) a.in[i] = (const float*)d_in[i];
    a.out = (float*)d_out; a.ws = (unsigned char*)d_ws; a.ph_lo = 0; a.ph_hi = MK_CUT < N_PHASES ? MK_CUT : N_PHASES;
    hipLaunchKernelGGL(mega_fwd, dim3(grid), dim3(NTHR), LDS_BYTES, stream, a);
#if MK_CUT < 14
    {
        char* ws = (char*)d_ws; float* out = (float*)d_out; const float* x = (const float*)d_in[0];
        const float* mods = (const float*)(ws + WS_MODS); const float* cs = (const float*)(ws + WS_CS); const float* sn = (const float*)(ws + WS_SN);
        nv::Buf B = nv::carve(ws + (size_t)MK_NAIVE_BASE_MIB * MiB);
        const int l0 = (MK_CUT - 2) / 6, ph = (MK_CUT - 2) % 6;
        for (int l = l0; l < DEPTH; ++l)
            for (int b = 0; b < BATCH; ++b) {
                const int row0 = b * SEQ; int entry = 0; const float* xin = (l == 0 ? x : out) + (size_t)row0 * DM; float* xo = out + (size_t)row0 * DM;
                if (l == l0) {
                    if (ph >= 1 && ph <= 3) { glue_proj<<<SEQ, 256, 0, stream>>>((const bf16*)(ws + WS_PROJ), B.proj, B.y, row0); entry = 1; }
                    if (ph == 2) { glue_qkv<<<SEQ, 256, 0, stream>>>((const bf16*)(ws + WS_QUP), (const bf16*)(ws + WS_KVUP), nv::sc_qm(B), nv::sc_kv(B), row0); entry = 2; }
                    if (ph == 3) { hipMemcpyAsync(nv::sc_omla(B), ws + WS_OMLA + (size_t)row0 * 768 * 4, (size_t)SEQ * 768 * 4, hipMemcpyDeviceToDevice, stream); entry = 4; }
                    if (ph == 4) { glue_y<<<SEQ, 256, 0, stream>>>((const bf16*)(ws + WS_HY), B.y, row0); entry = 3; }
                    if (ph == 5) continue;
                }
                nv::layer_batch(d_in, l, b, entry, xin, xo, mods, cs, sn, B, stream);
            }
        nv::k_rms<<<T, 256, 0, stream>>>(out, DM, DM, (const float*)d_in[20], out, DM);
    }
#endif
}
```

```cpp
#include <hip/hip_runtime.h>
#include <cstdio>
#include <cstdint>
#define MK_CUT 14
#define MK_NAIVE_BASE_MIB 240
#define MK_REP_PH -1
namespace pg8 {
#define PG8_LAS __attribute__((address_space(3)))
typedef unsigned short bf16_t;
typedef short bf16x8 __attribute__((ext_vector_type(8)));
typedef float f32x4 __attribute__((ext_vector_type(4)));
typedef unsigned u32x4 __attribute__((ext_vector_type(4)));
constexpr int BM = 256, BK = 64, HALF = 128, HTB = HALF * BK * 2, STAGE_BYTES = 8 * HTB, NXCD = 8, WGM = 8;

__host__ __device__ __forceinline__ int lds_byte(int r, int c) { const int st = (r >> 4) * 2 + (c >> 5), rr = r & 15, cc = c & 31, ob = rr * 64 + cc * 2; return st * 1024 + (ob ^ (((ob >> 9) & 1) << 5)); }
__host__ __device__ __forceinline__ void stage_rc(int b, int& R, int& C) { const int st = b / 1024, sb = b % 1024, swz = sb ^ (((sb >> 9) & 1) << 5); R = (st >> 1) * 16 + swz / 64; C = (st & 1) * 32 + (swz % 64) / 2; }
__host__ __device__ __forceinline__ int perm32(int rho) { const int n = rho >> 4, i = rho & 15; return 8 * (i >> 2) + 4 * n + (i & 3); }

struct Unit { int pm, pn; };
struct Gemm { const bf16_t* A; const bf16_t* Bt; int M, N, K, lda; };

struct StaticOrder {
    int nM, nN, nwg, G, c;
    __host__ __device__ void init(int M, int N, int G_, int c_) { nM = M / BM; nN = N / BM; nwg = nM * nN; G = G_; c = c_; }
    __host__ __device__ bool next(int i, Unit& u) const {
        const long L = (long)i * G + c; if (L >= nwg) return false;
        int wgid = (int)L; { const int q = nwg / NXCD, r = nwg % NXCD, xcd = wgid % NXCD, off = wgid / NXCD; wgid = (xcd < r ? xcd * (q + 1) : r * (q + 1) + (xcd - r) * q) + off; }
        const int nig = WGM * nN, gid = wgid / nig, fm = gid * WGM, gsz = (nM - fm) < WGM ? (nM - fm) : WGM;
        u.pm = fm + ((wgid % nig) % gsz); u.pn = (wgid % nig) / gsz; return true;
    }
    __device__ __forceinline__ void a_ready(const Unit&) const {}
    __device__ __forceinline__ void done(const Unit&) const {}
};

__device__ __forceinline__ unsigned cvt_pk_bf16(float lo, float hi) { unsigned r; asm volatile("v_cvt_pk_bf16_f32 %0, %1, %2" : "=v"(r) : "v"(lo), "v"(hi)); return r; }

template <class Epi, class Sched, bool ALIGN_EPI = false, bool SP2 = false>
__device__ __forceinline__ void gemm_phase(PG8_LAS unsigned char* lds, const Gemm g, const Sched& S, const Epi& E) {
    int tid_ = threadIdx.x; asm volatile("" : "+v"(tid_));
    const int tid = tid_, wid = __builtin_amdgcn_readfirstlane(tid >> 6), lane = tid & 63, wr = wid >> 2, wc = wid & 3, fr = lane & 15, fq = lane >> 4;
    int K_ = g.K, lda_ = g.lda; asm volatile("" : "+s"(K_), "+s"(lda_));
    const int K = K_, nt = K / BK, lda = lda_;
    unsigned voffA[2], voffB[2];
#pragma unroll
    for (int i = 0; i < 2; ++i) { int R, C; stage_rc(tid * 16 + i * 8192, R, C); const int Rb = Epi::PERM ? ((R & ~31) + perm32(R & 31)) : R;
        voffA[i] = (unsigned)(R * lda + C) * 2u; voffB[i] = (unsigned)(Rb * K + C) * 2u; }
    const size_t kstep = (size_t)(BK * 2);
    const size_t hstepA = (size_t)HALF * lda * 2, hstepB = (size_t)HALF * K * 2;
    const size_t tstepA = 2 * hstepA, tstepB = 2 * hstepB;
    const unsigned ldsw = (unsigned)wid * 1024u;
    const int aoff = lds_byte(wr * 64 + fr, fq * 8), boff = lds_byte(wc * 32 + fr, fq * 8);
#define PG8_SA(b, h) (((b) * 2 + (h)) * HTB)
#define PG8_SB(b, h) ((4 + (b) * 2 + (h)) * HTB)
#define PG8_STAGE(bufoff, gbase, voff) do { _Pragma("unroll") for (int _i = 0; _i < 2; ++_i) \
        __builtin_amdgcn_global_load_lds((const unsigned*)((const char*)(gbase) + (voff)[_i]), (PG8_LAS unsigned*)(lds + (bufoff) + ldsw + _i * 8192), 16, 0, 0); } while (0)
#define PG8_LDA(dst, b, h) do { _Pragma("unroll") for (int m = 0; m < 4; ++m) _Pragma("unroll") for (int k = 0; k < 2; ++k) dst[m][k] = *(const PG8_LAS bf16x8*)(lds + PG8_SA(b, h) + aoff + m * 2048 + k * 1024); } while (0)
#define PG8_LDB(dst, b, h) do { _Pragma("unroll") for (int n = 0; n < 2; ++n) _Pragma("unroll") for (int k = 0; k < 2; ++k) dst[n][k] = *(const PG8_LAS bf16x8*)(lds + PG8_SB(b, h) + boff + n * 2048 + k * 1024); } while (0)
#define PG8_MMA(ai, bj, At, Bt) do { __builtin_amdgcn_s_setprio(1); _Pragma("unroll") for (int m = 0; m < 4; ++m) _Pragma("unroll") for (int n = 0; n < 2; ++n) _Pragma("unroll") for (int k = 0; k < 2; ++k) \
        acc[ai][bj][m][n] = __builtin_amdgcn_mfma_f32_16x16x32_bf16(Bt[n][k], At[m][k], acc[ai][bj][m][n], 0, 0, 0); __builtin_amdgcn_s_setprio(0); } while (0)
#define PG8_WAIT_V(n) asm volatile("s_waitcnt vmcnt(" #n ")" ::: "memory")
#define PG8_WAIT_L(n) asm volatile("s_waitcnt lgkmcnt(" #n ")" ::: "memory")
#define PG8_BAR __builtin_amdgcn_s_barrier()
#define PG8_SCHED __builtin_amdgcn_sched_barrier(0)
    Unit cur, nxt; int ui = 0;
    if (!S.next(0, cur)) return;
    f32x4 acc[2][2][4][2];
#pragma unroll
    for (int a = 0; a < 2; ++a)
#pragma unroll
        for (int b = 0; b < 2; ++b)
#pragma unroll
            for (int m = 0; m < 4; ++m)
#pragma unroll
                for (int n = 0; n < 2; ++n) acc[a][b][m][n] = (f32x4){0.f, 0.f, 0.f, 0.f};
    bf16x8 At[4][2], B0[2][2], B1[2][2];
    const char* cA = (const char*)g.A + (size_t)cur.pm * tstepA; const char* cB = (const char*)g.Bt + (size_t)cur.pn * tstepB;
    S.a_ready(cur);
    if constexpr (SP2) {
        PG8_STAGE(PG8_SB(0, 0), cB, voffB); PG8_STAGE(PG8_SB(0, 1), cB + hstepB, voffB); PG8_STAGE(PG8_SA(0, 0), cA, voffA); PG8_STAGE(PG8_SA(0, 1), cA + hstepA, voffA);
        if (wr == 1) PG8_BAR;
        PG8_WAIT_V(2); PG8_BAR;
        PG8_STAGE(PG8_SB(1, 0), cB + kstep, voffB); PG8_STAGE(PG8_SA(1, 0), cA + kstep, voffA); PG8_STAGE(PG8_SB(1, 1), cB + hstepB + kstep, voffB);
        PG8_WAIT_V(6); PG8_BAR;
    } else {
        PG8_STAGE(PG8_SB(0, 0), cB, voffB); PG8_STAGE(PG8_SA(0, 0), cA, voffA); PG8_STAGE(PG8_SB(0, 1), cB + hstepB, voffB); PG8_STAGE(PG8_SA(0, 1), cA + hstepA, voffA);
        if (wr == 1) PG8_BAR;
        PG8_WAIT_V(4); PG8_BAR;
        PG8_STAGE(PG8_SB(1, 0), cB + kstep, voffB); PG8_STAGE(PG8_SA(1, 0), cA + kstep, voffA); PG8_STAGE(PG8_SB(1, 1), cB + hstepB + kstep, voffB);
        PG8_WAIT_V(6); PG8_BAR;
    }
    for (;;) {
        const bool has_next = S.next(ui + 1, nxt);
        const char* nA = has_next ? (const char*)g.A + (size_t)nxt.pm * tstepA : cA; const char* nB = has_next ? (const char*)g.Bt + (size_t)nxt.pn * tstepB : cB;
        for (int t = 0; t < nt; t += 2) {
            const bool last = (t == nt - 2);
            const char* a1 = cA + (size_t)(t + 1) * kstep;
            const char* a2 = last ? nA : cA + (size_t)(t + 2) * kstep; const char* b2 = last ? nB : cB + (size_t)(t + 2) * kstep;
            const char* a3 = a2 + kstep; const char* b3 = b2 + kstep;
            if (last && has_next) S.a_ready(nxt);
            if constexpr (SP2) {
            PG8_LDB(B0, 0, 0); PG8_LDB(B1, 0, 1); PG8_SCHED; PG8_LDA(At, 0, 0); PG8_STAGE(PG8_SA(1, 1), a1 + hstepA, voffA);
            PG8_WAIT_V(8); PG8_WAIT_L(0); PG8_BAR; PG8_MMA(0, 0, At, B0); PG8_MMA(0, 1, At, B1); PG8_BAR; PG8_SCHED;
            PG8_LDA(At, 0, 1); PG8_STAGE(PG8_SB(0, 0), b2, voffB); PG8_STAGE(PG8_SB(0, 1), b2 + hstepB, voffB); PG8_STAGE(PG8_SA(0, 0), a2, voffA);
            PG8_WAIT_V(8); PG8_WAIT_L(0); PG8_BAR; PG8_MMA(1, 0, At, B0); PG8_MMA(1, 1, At, B1); PG8_BAR; PG8_SCHED;
            PG8_LDB(B0, 1, 0); PG8_LDB(B1, 1, 1); PG8_SCHED; PG8_LDA(At, 1, 0); PG8_STAGE(PG8_SA(0, 1), a2 + hstepA, voffA);
            PG8_WAIT_V(8); PG8_WAIT_L(0); PG8_BAR; PG8_MMA(0, 0, At, B0); PG8_MMA(0, 1, At, B1); PG8_BAR; PG8_SCHED;
            PG8_LDA(At, 1, 1); PG8_STAGE(PG8_SB(1, 0), b3, voffB); PG8_STAGE(PG8_SB(1, 1), b3 + hstepB, voffB); PG8_STAGE(PG8_SA(1, 0), a3, voffA);
            PG8_WAIT_V(8); PG8_WAIT_L(0); PG8_BAR; PG8_MMA(1, 0, At, B0); PG8_MMA(1, 1, At, B1); PG8_BAR; PG8_SCHED;
            if constexpr (Epi::HOOK_T > 0) { if (t + 2 == Epi::HOOK_T) E.hook(acc, cur, wr, wc, fr, fq); }
            } else {
            PG8_LDB(B0, 0, 0); PG8_SCHED; PG8_LDA(At, 0, 0); PG8_STAGE(PG8_SA(1, 1), a1 + hstepA, voffA);
            PG8_WAIT_L(8); PG8_BAR; PG8_WAIT_L(0); PG8_MMA(0, 0, At, B0); PG8_BAR; PG8_SCHED;
            PG8_LDB(B1, 0, 1); PG8_STAGE(PG8_SB(0, 0), b2, voffB);
            PG8_BAR; PG8_WAIT_L(0); PG8_MMA(0, 1, At, B1); PG8_BAR;
            PG8_LDA(At, 0, 1); PG8_STAGE(PG8_SA(0, 0), a2, voffA);
            PG8_BAR; PG8_WAIT_L(0); PG8_MMA(1, 0, At, B0); PG8_BAR; PG8_SCHED;
            PG8_STAGE(PG8_SB(0, 1), b2 + hstepB, voffB);
            PG8_WAIT_V(6); PG8_BAR; PG8_MMA(1, 1, At, B1); PG8_BAR;
            PG8_LDB(B0, 1, 0); PG8_SCHED; PG8_LDA(At, 1, 0); PG8_STAGE(PG8_SA(0, 1), a2 + hstepA, voffA);
            PG8_WAIT_L(8); PG8_BAR; PG8_WAIT_L(0); PG8_MMA(0, 0, At, B0); PG8_BAR; PG8_SCHED;
            PG8_LDB(B1, 1, 1); PG8_STAGE(PG8_SB(1, 0), b3, voffB);
            PG8_BAR; PG8_WAIT_L(0); PG8_MMA(0, 1, At, B1); PG8_BAR;
            PG8_LDA(At, 1, 1); PG8_STAGE(PG8_SA(1, 0), a3, voffA);
            PG8_BAR; PG8_WAIT_L(0); PG8_MMA(1, 0, At, B0); PG8_BAR; PG8_SCHED;
            PG8_STAGE(PG8_SB(1, 1), b3 + hstepB, voffB);
            PG8_WAIT_V(6); PG8_BAR; PG8_MMA(1, 1, At, B1); PG8_BAR;
            }
        }
        if constexpr (ALIGN_EPI) { if (wr == 0) PG8_BAR; }
        E(acc, cur, wr, wc, fr, fq); S.done(cur);
        if (!has_next) break;
#pragma unroll
        for (int a = 0; a < 2; ++a)
#pragma unroll
            for (int b = 0; b < 2; ++b)
#pragma unroll
                for (int m = 0; m < 4; ++m)
#pragma unroll
                    for (int n = 0; n < 2; ++n) acc[a][b][m][n] = (f32x4){0.f, 0.f, 0.f, 0.f};
        cur = nxt; cA = nA; cB = nB; ++ui;
        if constexpr (ALIGN_EPI) { if (wr == 1) PG8_BAR; }
    }
    PG8_WAIT_V(0);
    if constexpr (!ALIGN_EPI) { if (wr == 0) PG8_BAR; }
    PG8_BAR;
#undef PG8_SA
#undef PG8_SB
#undef PG8_STAGE
#undef PG8_LDA
#undef PG8_LDB
#undef PG8_MMA
#undef PG8_WAIT_V
#undef PG8_WAIT_L
#undef PG8_BAR
#undef PG8_SCHED
}
}
#define GAS __attribute__((address_space(1)))
#define LAS __attribute__((address_space(3)))
typedef unsigned short bf16;
typedef unsigned v4u __attribute__((ext_vector_type(4)));
typedef unsigned v2u __attribute__((ext_vector_type(2)));
typedef float f32x4 __attribute__((ext_vector_type(4)));
typedef float f32x16 __attribute__((ext_vector_type(16)));
typedef short bf16x8 __attribute__((ext_vector_type(8)));
typedef short s16x4 __attribute__((ext_vector_type(4)));
typedef GAS unsigned gu32;

constexpr int NWAVES = 8, NTHR = 512;
constexpr int BATCH = 4, SEQ = 2048, DM = 2048, T = BATCH * SEQ, DEPTH = 2, IN_DIM = 5856;
constexpr int NP = 5888;
constexpr int C_GQ = 0, C_GK = 384, C_GV = 768, C_MKV = 1536, C_MQ = 1792, C_MKR = 2176, C_LR = 2240, C_CB = 2304, C_CC = 2816, C_CX = 3328, C_Z = 3840;
constexpr int R_GQ = 0, R_GK = 384, R_GV = 768, R_LR = 1536, R_MQ = 1568, R_MKV = 1952, R_MKR = 2208, R_CB = 2272, R_CC = 2784, R_CX = 3296, R_Z = 3808;
constexpr int NQ = 1280, NKV = 1536;
constexpr float EPS = 1e-6f;
constexpr float QSCALE = 0.07216878364870322f * 1.4426950408889634f;
constexpr int NITEM = BATCH * 32 * 6;

constexpr size_t MiB = 1u << 20;
constexpr size_t WS_CTL = 0, CTL_ZERO_BYTES = 1 * MiB;
constexpr size_t WS_MODS = 256 * 1024;
constexpr size_t WS_CS = 2 * MiB, WS_SN = 3 * MiB;
constexpr size_t WS_WUQ = 4 * MiB;
constexpr size_t WS_WUKV = 6 * MiB;
constexpr size_t WS_WOUT = 8 * MiB;
constexpr size_t WS_WIN = 24 * MiB;
constexpr size_t WS_HY = 70 * MiB;
constexpr size_t WS_PROJ = 102 * MiB;
constexpr size_t WS_QUP = 194 * MiB;
constexpr size_t WS_KVUP = 214 * MiB;
constexpr size_t WS_OMLA = 238 * MiB;
constexpr size_t WS_OINTRA = 262 * MiB;
constexpr size_t WS_KVC = 286 * MiB;
constexpr size_t WS_ST = 334 * MiB;
constexpr size_t WS_QDEC = 358 * MiB;
constexpr size_t WS_DECAY = 370 * MiB;
constexpr size_t WS_PARTQ = 371 * MiB;
constexpr size_t WS_PARTKV = 371 * MiB + 512 * 1024;
constexpr size_t WS_PARTM = 371 * MiB + 768 * 1024;
constexpr size_t WS_END = 372 * MiB;
constexpr int CW_BAR = 4096;

constexpr int RING_BYTES = 131072, LDSCTL_OFF = RING_BYTES, MISC_OFF = LDSCTL_OFF + 320, LDS_BYTES = 147456;

#define LDS_WAIT() asm volatile("s_waitcnt lgkmcnt(0)" ::: "memory")
#define VM_WAIT() asm volatile("s_waitcnt vmcnt(0)" ::: "memory")
__device__ __forceinline__ unsigned f2bf(float f) { unsigned u = __builtin_bit_cast(unsigned, f); return (u + 0x7fffu + ((u >> 16) & 1u)) >> 16; }
__device__ __forceinline__ unsigned pk2(float lo, float hi) { return pg8::cvt_pk_bf16(lo, hi); }
__device__ __forceinline__ float bf2f(unsigned short h) { return __builtin_bit_cast(float, (unsigned)h << 16); }
__device__ __forceinline__ float bflo(unsigned w) { return __builtin_bit_cast(float, w << 16); }
__device__ __forceinline__ float bfhi(unsigned w) { return __builtin_bit_cast(float, w & 0xffff0000u); }
__device__ __forceinline__ float silu_fast(float v) { return v * __builtin_amdgcn_rcpf(1.f + __expf(-v)); }
__device__ __forceinline__ float wave_sum(float v) {
#pragma unroll
    for (int o = 1; o < 64; o <<= 1) v += __shfl_xor(v, o);
    return v;
}

__device__ __forceinline__ int map_in(int n) {
    if (n < C_MKV) return n;
    if (n < C_MQ) return R_MKV + (n - C_MKV);
    if (n < C_MKR) return R_MQ + (n - C_MQ);
    if (n < C_LR) { const int j = n - C_MKR; return R_MKR + (j & 1) * 32 + (j >> 1); }
    if (n < C_LR + 32) return R_LR + (n - C_LR);
    if (n < C_CB) return -1;
    if (n < C_Z) return R_CB + (n - C_CB);
    return R_Z + (n - C_Z);
}
__device__ __forceinline__ int map_uq(int n) {
    if (n >= 1152) return -1;
    const int h = n / 192, d = n % 192;
    if (d < 128) return n;
    const int j = d - 128; return h * 192 + 128 + (j & 1) * 32 + (j >> 1);
}

struct EpiIn {
    static constexpr bool PERM = true; static constexpr int HOOK_T = 0;
    bf16* O; const float* cs; const float* sn; float* partq; float* partkv;
    __device__ __forceinline__ void operator()(const f32x4 (&acc)[2][2][4][2], const pg8::Unit& u, int wr, int wc, int fr, int fq) const {
        const int pn = u.pn, row0 = u.pm * 256 + wr * 64 + fr, col0 = pn * 256 + wc * 32 + 8 * fq;
        const bool stat = (pn >= 6 && pn <= 8);
#pragma unroll
        for (int ai = 0; ai < 2; ++ai)
#pragma unroll
            for (int m = 0; m < 4; ++m) {
                const int row = row0 + ai * 128 + m * 16; bf16* rowp = O + (size_t)row * NP + col0; float ss = 0.f;
#pragma unroll
                for (int bj = 0; bj < 2; ++bj) {
                    f32x4 v0 = acc[ai][bj][m][0], v1 = acc[ai][bj][m][1]; const int c = col0 + bj * 128;
                    if (pn >= 15) {
#pragma unroll
                        for (int e = 0; e < 4; ++e) { v0[e] = silu_fast(v0[e]); v1[e] = silu_fast(v1[e]); }
                    } else if (pn == 8 && bj == 1 && c < C_LR) {
                        const int i0 = (c - C_MKR) >> 1; const f32x4 cc = *(const f32x4*)(cs + (size_t)row * 32 + i0), sv = *(const f32x4*)(sn + (size_t)row * 32 + i0);
                        f32x4 a0, a1;
                        a0[0] = v0[0] * cc[0] - v0[1] * sv[0]; a0[1] = v0[1] * cc[0] + v0[0] * sv[0]; a0[2] = v0[2] * cc[1] - v0[3] * sv[1]; a0[3] = v0[3] * cc[1] + v0[2] * sv[1];
                        a1[0] = v1[0] * cc[2] - v1[1] * sv[2]; a1[1] = v1[1] * cc[2] + v1[0] * sv[2]; a1[2] = v1[2] * cc[3] - v1[3] * sv[3]; a1[3] = v1[3] * cc[3] + v1[2] * sv[3];
                        v0 = a0; v1 = a1;
                    }
                    if (stat && (pn != 8 || bj == 0)) ss += (v0[0] * v0[0] + v0[1] * v0[1]) + (v0[2] * v0[2] + v0[3] * v0[3]) + (v1[0] * v1[0] + v1[1] * v1[1]) + (v1[2] * v1[2] + v1[3] * v1[3]);
                    v4u w; w.x = pk2(v0[0], v0[1]); w.y = pk2(v0[2], v0[3]); w.z = pk2(v1[0], v1[1]); w.w = pk2(v1[2], v1[3]);
                    *(v4u*)(rowp + bj * 128) = w;
                }
                asm volatile("" ::: "memory");
                if (stat) { ss += __shfl_xor(ss, 16); ss += __shfl_xor(ss, 32);
                    if (fq == 0) { if (pn == 6) partkv[(size_t)row * 4 + wc] = ss; else partq[(size_t)row * 8 + (pn - 7) * 4 + wc] = ss; } }
            }
    }
};
struct EpiUq {
    static constexpr bool PERM = true; static constexpr int HOOK_T = 0;
    bf16* O; const float* cs; const float* sn; const float* partq;
    __device__ __forceinline__ void operator()(const f32x4 (&acc)[2][2][4][2], const pg8::Unit& u, int wr, int wc, int fr, int fq) const {
        const int row0 = u.pm * 256 + wr * 64 + fr, col0 = u.pn * 256 + wc * 32 + 8 * fq;
#pragma unroll
        for (int ai = 0; ai < 2; ++ai)
#pragma unroll
            for (int m = 0; m < 4; ++m) {
                const int row = row0 + ai * 128 + m * 16; bf16* rowp = O + (size_t)row * NQ + col0;
                const f32x4 p0 = *(const f32x4*)(partq + (size_t)row * 8), p1 = *(const f32x4*)(partq + (size_t)row * 8 + 4);
                const float rs = __builtin_amdgcn_rsqf(((p0[0] + p0[1]) + (p0[2] + p0[3]) + (p1[0] + p1[1]) + (p1[2] + p1[3])) * (1.f / 384.f) + EPS) * QSCALE;
#pragma unroll
                for (int bj = 0; bj < 2; ++bj) {
                    const int c = col0 + bj * 128; if (c >= 1152) continue;
                    f32x4 v0 = acc[ai][bj][m][0] * rs, v1 = acc[ai][bj][m][1] * rs; const int d = c % 192;
                    if (d >= 128) {
                        const int i0 = (d - 128) >> 1; const f32x4 cc = *(const f32x4*)(cs + (size_t)row * 32 + i0), sv = *(const f32x4*)(sn + (size_t)row * 32 + i0);
                        f32x4 a0, a1;
                        a0[0] = v0[0] * cc[0] - v0[1] * sv[0]; a0[1] = v0[1] * cc[0] + v0[0] * sv[0]; a0[2] = v0[2] * cc[1] - v0[3] * sv[1]; a0[3] = v0[3] * cc[1] + v0[2] * sv[1];
                        a1[0] = v1[0] * cc[2] - v1[1] * sv[2]; a1[1] = v1[1] * cc[2] + v1[0] * sv[2]; a1[2] = v1[2] * cc[3] - v1[3] * sv[3]; a1[3] = v1[3] * cc[3] + v1[2] * sv[3];
                        v0 = a0; v1 = a1;
                    }
                    v4u w; w.x = pk2(v0[0], v0[1]); w.y = pk2(v0[2], v0[3]); w.z = pk2(v1[0], v1[1]); w.w = pk2(v1[2], v1[3]);
                    *(v4u*)(rowp + bj * 128) = w;
                }
                asm volatile("" ::: "memory");
            }
    }
};
struct EpiUkv {
    static constexpr bool PERM = true; static constexpr int HOOK_T = 0;
    bf16* O; const float* partkv;
    __device__ __forceinline__ void operator()(const f32x4 (&acc)[2][2][4][2], const pg8::Unit& u, int wr, int wc, int fr, int fq) const {
        const int row0 = u.pm * 256 + wr * 64 + fr, col0 = u.pn * 256 + wc * 32 + 8 * fq;
#pragma unroll
        for (int ai = 0; ai < 2; ++ai)
#pragma unroll
            for (int m = 0; m < 4; ++m) {
                const int row = row0 + ai * 128 + m * 16; bf16* rowp = O + (size_t)row * NKV + col0;
                const f32x4 p0 = *(const f32x4*)(partkv + (size_t)row * 4);
                const float rs = __builtin_amdgcn_rsqf(((p0[0] + p0[1]) + (p0[2] + p0[3])) * (1.f / 256.f) + EPS);
#pragma unroll
                for (int bj = 0; bj < 2; ++bj) {
                    const f32x4 v0 = acc[ai][bj][m][0] * rs, v1 = acc[ai][bj][m][1] * rs;
                    v4u w; w.x = pk2(v0[0], v0[1]); w.y = pk2(v0[2], v0[3]); w.z = pk2(v1[0], v1[1]); w.w = pk2(v1[2], v1[3]);
                    *(v4u*)(rowp + bj * 128) = w;
                }
                asm volatile("" ::: "memory");
            }
    }
};
struct EpiOut {
    static constexpr bool PERM = false; static constexpr int HOOK_T = 12;
    const float* xin; float* out; const float* gate;
    const float* partm;
    __device__ __forceinline__ void hook(f32x4 (&acc)[2][2][4][2], const pg8::Unit& u, int wr, int wc, int fr, int fq) const {
        const int row0 = u.pm * 256 + wr * 64 + fr;
#pragma unroll
        for (int ai = 0; ai < 2; ++ai)
#pragma unroll
            for (int m = 0; m < 4; ++m) { const float* p = partm + (size_t)(row0 + ai * 128 + m * 16) * 8; const f32x4 p0 = *(const f32x4*)p; const float p4 = p[4], p5 = p[5];
                const float rs = __builtin_amdgcn_rsqf(((p0[0] + p0[1]) + (p0[2] + p0[3]) + (p4 + p5)) * (1.f / 768.f) + EPS);
#pragma unroll
                for (int bj = 0; bj < 2; ++bj)
#pragma unroll
                    for (int n = 0; n < 2; ++n) acc[ai][bj][m][n] *= rs; }
    }
    __device__ __forceinline__ void operator()(const f32x4 (&acc)[2][2][4][2], const pg8::Unit& u, int wr, int wc, int fr, int fq) const {
        const int row0 = u.pm * 256 + wr * 64 + fr, col0 = u.pn * 256 + wc * 32 + 4 * fq; const float* gb = gate + (size_t)(u.pm >> 3) * 3 * DM;
        f32x4 gv[2][2];
#pragma unroll
        for (int bj = 0; bj < 2; ++bj)
#pragma unroll
            for (int n = 0; n < 2; ++n) gv[bj][n] = *(const f32x4*)(gb + col0 + bj * 128 + n * 16);
#pragma unroll
        for (int ai = 0; ai < 2; ++ai)
#pragma unroll
            for (int m = 0; m < 4; ++m) {
                const size_t off = (size_t)(row0 + ai * 128 + m * 16) * DM + col0;
#pragma unroll
                for (int bj = 0; bj < 2; ++bj)
#pragma unroll
                    for (int n = 0; n < 2; ++n) { const f32x4 xv = *(const f32x4*)(xin + off + bj * 128 + n * 16); *(f32x4*)(out + off + bj * 128 + n * 16) = xv + gv[bj][n] * acc[ai][bj][m][n]; }
                asm volatile("" ::: "memory");
            }
    }
};
namespace mla {
constexpr int NW = 8, QBLK = 32, KVBLK = 64;
constexpr int SHM_V = 16384, SHM_KN = 16384, SHM_KR = 8192;
constexpr int OFF_V = 0, OFF_KN = 2 * SHM_V, OFF_KR = OFF_KN + 2 * SHM_KN, OFF_WS = OFF_KR + 2 * SHM_KR, OFF_QR = OFF_WS + NW * 64 * 4, ATTN_LDS = OFF_QR + NW * 4096;
constexpr float THR = 8.f;
#define KSWZ(row, colB) ((row) * 256 + ((colB) ^ (((row) & 7) << 4)))
#define KRSWZ(row, colB) ((row) * 128 + ((colB) ^ ((((row) >> 1) & 7) << 4)))
#define SBAR() __builtin_amdgcn_sched_barrier(0)
__device__ __forceinline__ int crow(int r, int hi) { return (r & 3) + 8 * (r >> 2) + 4 * hi; }
__device__ __forceinline__ unsigned cvtpk(float lo, float hi) { unsigned r; asm volatile("v_cvt_pk_bf16_f32 %0, %1, %2" : "=v"(r) : "v"(lo), "v"(hi)); return r; }

__device__ __forceinline__ void partialSM(f32x16& p0, f32x16& p1, float& m_reg, float& mn, float& alpha) {
  float pmax = p0[0];
#pragma unroll
  for (int r = 1; r < 16; ++r) pmax = fmaxf(pmax, p0[r]);
#pragma unroll
  for (int r = 0; r < 16; ++r) pmax = fmaxf(pmax, p1[r]);
  { auto rr = __builtin_amdgcn_permlane32_swap(__float_as_uint(pmax), __float_as_uint(pmax), false, false);
    pmax = fmaxf(__uint_as_float(rr[0]), __uint_as_float(rr[1])); }
  if (__builtin_expect(__all(pmax - m_reg <= THR), 1)) { mn = m_reg; alpha = 1.f; }
  else { mn = fmaxf(m_reg, pmax); alpha = __builtin_amdgcn_exp2f(m_reg - mn); m_reg = mn; }
#pragma unroll
  for (int r = 0; r < 16; ++r) p0[r] = p0[r] - mn;
#pragma unroll
  for (int r = 0; r < 16; ++r) p1[r] = p1[r] - mn;
#pragma unroll
  for (int r = 0; r < 16; ++r) p0[r] = __builtin_amdgcn_exp2f(p0[r]);
}
__device__ __forceinline__ void finishSM(f32x16& p0, f32x16& p1, float alpha, float& l_reg, bf16x8& pa0, bf16x8& pa1, bf16x8& pa2, bf16x8& pa3) {
#pragma unroll
  for (int r = 0; r < 16; ++r) p1[r] = __builtin_amdgcn_exp2f(p1[r]);
  float ps = 0;
#pragma unroll
  for (int r = 0; r < 16; ++r) ps += p0[r];
#pragma unroll
  for (int r = 0; r < 16; ++r) ps += p1[r];
  { auto rr = __builtin_amdgcn_permlane32_swap(__float_as_uint(ps), __float_as_uint(ps), false, false);
    ps = __uint_as_float(rr[0]) + __uint_as_float(rr[1]); }
  l_reg = l_reg * alpha + ps;
#define PK4(P, BASE, OUT) do { unsigned a0 = cvtpk(P[BASE + 0], P[BASE + 1]), a1 = cvtpk(P[BASE + 2], P[BASE + 3]);   \
    unsigned b0 = cvtpk(P[BASE + 4], P[BASE + 5]), b1 = cvtpk(P[BASE + 6], P[BASE + 7]);                              \
    auto r0 = __builtin_amdgcn_permlane32_swap(a0, b0, false, false); auto r1 = __builtin_amdgcn_permlane32_swap(a1, b1, false, false); \
    v4u w = {r0[0], r1[0], r0[1], r1[1]}; OUT = *reinterpret_cast<bf16x8*>(&w); } while (0)
  PK4(p0, 0, pa0); PK4(p0, 8, pa1); PK4(p1, 0, pa2); PK4(p1, 8, pa3);
#undef PK4
}
__device__ __forceinline__ void qkt(f32x16& p0, f32x16& p1, const char* Kn, const char* Kr, const bf16x8* qr, const char* Qr, int r32, int hi) {
  p0 = f32x16{}; p1 = f32x16{};
  int tn = (hi * 16) ^ ((r32 & 7) << 4), tr = (hi * 16) ^ (((r32 >> 1) & 7) << 4);
  asm volatile("" : "+v"(tn), "+v"(tr));
  const char* knb = Kn + r32 * 256; const char* krb = Kr + r32 * 128; const char* qrb = Qr + r32 * 128;
#pragma unroll
  for (int d0 = 0; d0 < 8; ++d0) { const int off = (d0 * 32) ^ tn;
    const bf16x8 b0 = *reinterpret_cast<const bf16x8*>(knb + off);
    const bf16x8 b1 = *reinterpret_cast<const bf16x8*>(knb + off + 8192);
    p0 = __builtin_amdgcn_mfma_f32_32x32x16_bf16(b0, qr[d0], p0, 0, 0, 0);
    p1 = __builtin_amdgcn_mfma_f32_32x32x16_bf16(b1, qr[d0], p1, 0, 0, 0); }
#pragma unroll
  for (int d0 = 0; d0 < 4; ++d0) { const int off = (d0 * 32) ^ tr;
    const bf16x8 b0 = *reinterpret_cast<const bf16x8*>(krb + off);
    const bf16x8 b1 = *reinterpret_cast<const bf16x8*>(krb + off + 4096);
    const bf16x8 qv = *reinterpret_cast<const bf16x8*>(qrb + off);
    p0 = __builtin_amdgcn_mfma_f32_32x32x16_bf16(b0, qv, p0, 0, 0, 0);
    p1 = __builtin_amdgcn_mfma_f32_32x32x16_bf16(b1, qv, p1, 0, 0, 0); }
}
__device__ __forceinline__ int v_st(int k, int c) { const int kk = (k & ~0xC) | ((k & 4) << 1) | ((k & 8) >> 1); return ((kk >> 3) * 4 + (c >> 5)) * 512 + ((kk & 7) * 32 + (c & 31)) * 2; }
__device__ __forceinline__ int v_rd_base(int lane) { return ((lane & 3) << 3) | (((lane >> 2) & 3) << 6) | (((lane >> 4) & 1) << 5) | (((lane >> 5) & 1) << 8); }
constexpr int v_rd_off(int d0, int ks, int half) { return d0 * 512 + ks * 4096 + half * 2048; }
template <int OFF> __device__ __forceinline__ s16x4 tr_read(int vb) {
  s16x4 r; asm volatile("ds_read_b64_tr_b16 %0, %1 offset:%2" : "=&v"(r) : "v"(vb), "i"(OFF) : "memory"); return r;
}
template <int D0> __device__ __forceinline__ void pv_one(f32x16& od, int vb, bf16x8 pa0, bf16x8 pa1, bf16x8 pa2, bf16x8 pa3) {
  const s16x4 l0 = tr_read<v_rd_off(D0, 0, 0)>(vb), h0 = tr_read<v_rd_off(D0, 0, 1)>(vb), l1 = tr_read<v_rd_off(D0, 1, 0)>(vb), h1 = tr_read<v_rd_off(D0, 1, 1)>(vb);
  const s16x4 l2 = tr_read<v_rd_off(D0, 2, 0)>(vb), h2 = tr_read<v_rd_off(D0, 2, 1)>(vb), l3 = tr_read<v_rd_off(D0, 3, 0)>(vb), h3 = tr_read<v_rd_off(D0, 3, 1)>(vb);
  asm volatile("s_waitcnt lgkmcnt(0)" ::: "memory"); SBAR();
#define PK(L, H) (bf16x8){L[0], L[1], L[2], L[3], H[0], H[1], H[2], H[3]}
  od = __builtin_amdgcn_mfma_f32_32x32x16_bf16(pa0, PK(l0, h0), od, 0, 0, 0);
  od = __builtin_amdgcn_mfma_f32_32x32x16_bf16(pa1, PK(l1, h1), od, 0, 0, 0);
  od = __builtin_amdgcn_mfma_f32_32x32x16_bf16(pa2, PK(l2, h2), od, 0, 0, 0);
  od = __builtin_amdgcn_mfma_f32_32x32x16_bf16(pa3, PK(l3, h3), od, 0, 0, 0);
#undef PK
}
__device__ __forceinline__ void pv_d0(f32x16* o, int vb, bf16x8 pa0, bf16x8 pa1, bf16x8 pa2, bf16x8 pa3) {
  pv_one<0>(o[0], vb, pa0, pa1, pa2, pa3); pv_one<1>(o[1], vb, pa0, pa1, pa2, pa3); pv_one<2>(o[2], vb, pa0, pa1, pa2, pa3); pv_one<3>(o[3], vb, pa0, pa1, pa2, pa3);
}

__device__ __forceinline__ void attn_unit(const bf16* __restrict__ Qb, const bf16* __restrict__ Knh, const bf16* __restrict__ Vh, const bf16* __restrict__ Krh,
                                          bf16* __restrict__ Yb, const bf16* __restrict__ Zb, const float* __restrict__ gh, float* __restrict__ part, int seq, char* lds) {
  int tid_ = threadIdx.x; asm volatile("" : "+v"(tid_));
  const int tid = tid_, wid = tid >> 6, lane = tid & 63, r32 = lane & 31, hi = lane >> 5;
  char* V_lds = lds + OFF_V; char* KN_lds = lds + OFF_KN; char* KR_lds = lds + OFF_KR;
  float* ws = (float*)(lds + OFF_WS) + wid * 64; float* li_l = ws; float* al_l = ws + 32;
  float m_reg = -1e30f, l_reg = 0; f32x16 o[4] = {}; bf16x8 qr[8]; char* QR_lds = lds + OFF_QR + wid * 4096;
  const bf16* Qw = Qb + (long)(wid * QBLK + r32) * NQ + hi * 8;
#pragma unroll
  for (int d0 = 0; d0 < 8; ++d0) qr[d0] = *reinterpret_cast<const bf16x8*>(Qw + d0 * 16);
#pragma unroll
  for (int d0 = 0; d0 < 4; ++d0) *reinterpret_cast<bf16x8*>(QR_lds + KRSWZ(r32, (d0 * 16 + hi * 8) * 2)) = *reinterpret_cast<const bf16x8*>(Qw + 128 + d0 * 16);
  const int sr = tid >> 4, sc = (tid & 15) * 8, vst0 = v_st(sr, sc), vst1 = v_st(32 + sr, sc);
  const int krr = tid >> 3, krc = (tid & 7) * 8;
  const int vb0 = (int)(uintptr_t)V_lds + v_rd_base(lane);
  bf16x8 vs0, vs1, ks0, ks1, kr0;
#define SLOAD(k0) do { vs0 = *reinterpret_cast<const bf16x8*>(&Vh[(long)((k0) + sr) * NKV + sc]); vs1 = *reinterpret_cast<const bf16x8*>(&Vh[(long)((k0) + 32 + sr) * NKV + sc]); \
    ks0 = *reinterpret_cast<const bf16x8*>(&Knh[(long)((k0) + sr) * NKV + sc]); ks1 = *reinterpret_cast<const bf16x8*>(&Knh[(long)((k0) + 32 + sr) * NKV + sc]); \
    kr0 = *reinterpret_cast<const bf16x8*>(&Krh[(long)((k0) + krr) * NP + krc]); } while (0)
#define SWRITE(b) do { *(bf16x8*)(V_lds + (b) * SHM_V + vst0) = vs0; *(bf16x8*)(V_lds + (b) * SHM_V + vst1) = vs1; const int kc = sc * 2;   \
    *(bf16x8*)(KN_lds + (b) * SHM_KN + KSWZ(sr, kc)) = ks0; *(bf16x8*)(KN_lds + (b) * SHM_KN + KSWZ(32 + sr, kc)) = ks1;                       \
    *(bf16x8*)(KR_lds + (b) * SHM_KR + KRSWZ(krr, krc * 2)) = kr0; } while (0)
#define SWAIT() asm volatile("s_waitcnt vmcnt(0)" ::: "memory")
#define RESC(a) do { if (__any((a) < 1.f)) { if (hi == 0) al_l[r32] = (a); asm volatile("s_waitcnt lgkmcnt(0)" ::: "memory"); \
    _Pragma("unroll") for (int d = 0; d < 4; ++d) _Pragma("unroll") for (int r = 0; r < 16; ++r) o[d][r] *= al_l[crow(r, hi)]; } } while (0)
  f32x16 pA0, pA1, pB0, pB1; float mnA, mnB, alA, alB; bf16x8 pa0, pa1, pa2, pa3; const int NT = seq / KVBLK;
  SLOAD(0); SWAIT(); SWRITE(0); __syncthreads();
  qkt(pA0, pA1, KN_lds, KR_lds, qr, QR_lds, r32, hi); partialSM(pA0, pA1, m_reg, mnA, alA);
  SLOAD(KVBLK);
  SWAIT(); SWRITE(1); __syncthreads();
  for (int j = 1; j + 1 < NT; j += 2) {
    SBAR(); qkt(pB0, pB1, KN_lds + SHM_KN, KR_lds + SHM_KR, qr, QR_lds, r32, hi);
    finishSM(pA0, pA1, alA, l_reg, pa0, pa1, pa2, pa3); SBAR();
    SLOAD((j + 1) * KVBLK); SBAR();
    pv_d0(o, vb0, pa0, pa1, pa2, pa3); partialSM(pB0, pB1, m_reg, mnB, alB);
    __syncthreads(); SWAIT(); SWRITE(0);
    RESC(alB); __syncthreads();
    SBAR(); qkt(pA0, pA1, KN_lds, KR_lds, qr, QR_lds, r32, hi);
    finishSM(pB0, pB1, alB, l_reg, pa0, pa1, pa2, pa3); SBAR();
    SLOAD((j + 2) * KVBLK); SBAR();
    pv_d0(o, vb0 + SHM_V, pa0, pa1, pa2, pa3); partialSM(pA0, pA1, m_reg, mnA, alA);
    __syncthreads(); SWAIT(); SWRITE(1);
    RESC(alA); __syncthreads();
  }
  SBAR(); qkt(pB0, pB1, KN_lds + SHM_KN, KR_lds + SHM_KR, qr, QR_lds, r32, hi);
  finishSM(pA0, pA1, alA, l_reg, pa0, pa1, pa2, pa3); SBAR();
  pv_d0(o, vb0, pa0, pa1, pa2, pa3); partialSM(pB0, pB1, m_reg, mnB, alB);
  __syncthreads(); RESC(alB);
  finishSM(pB0, pB1, alB, l_reg, pa0, pa1, pa2, pa3); SBAR();
  pv_d0(o, vb0 + SHM_V, pa0, pa1, pa2, pa3);
  if (hi == 0) li_l[r32] = l_reg; asm volatile("s_waitcnt lgkmcnt(0)" ::: "memory");
  float rli[16];
#pragma unroll
  for (int r = 0; r < 16; ++r) rli[r] = __builtin_amdgcn_rcpf(li_l[crow(r, hi)]);
  float gg[4];
#pragma unroll
  for (int d0 = 0; d0 < 4; ++d0) gg[d0] = gh[d0 * 32 + r32];
#pragma unroll
  for (int r = 0; r < 16; ++r) { const long row = wid * QBLK + crow(r, hi); float v[4], ss = 0.f;
#pragma unroll
    for (int d0 = 0; d0 < 4; ++d0) { v[d0] = o[d0][r] * rli[r]; ss += v[d0] * v[d0]; }
    ss += __shfl_xor(ss, 1); ss += __shfl_xor(ss, 2); ss += __shfl_xor(ss, 4); ss += __shfl_xor(ss, 8); ss += __shfl_xor(ss, 16);
    if (r32 == 0) part[row * 8] = ss;
#pragma unroll
    for (int d0 = 0; d0 < 4; ++d0) { const float sz = bf2f(Zb[row * NP + d0 * 32 + r32]); Yb[row * DM + d0 * 32 + r32] = (unsigned short)f2bf(v[d0] * gg[d0] * sz); } }
  __syncthreads();
#undef SLOAD
#undef SWRITE
#undef SWAIT
#undef RESC
}
#undef SBAR
}
struct Frame {
    LAS unsigned char* lds; char* ldsg;
    int tid, lane, wave, vcu, G;
    float* out; unsigned char* ws;
};
__device__ __forceinline__ const float* ld_in(int i) {
    const __attribute__((address_space(4))) char* ka = (const __attribute__((address_space(4))) char*)__builtin_amdgcn_kernarg_segment_ptr();
    asm volatile("" : "+s"(i));
    const GAS float* p = *(const GAS float* const __attribute__((address_space(4)))*)(ka + 8 * i);
    return (const float*)p;
}
#define WSP(T_, off) ((T_*)(F.ws + (off)))

__device__ __forceinline__ void p0_mods(Frame& F, size_t mods_off) {
    LAS float* sc = (LAS float*)F.lds;
    LAS float* part = (LAS float*)(F.lds + 32768);
    const float* c = ld_in(1); const float* aw = ld_in(3); const float* ab = ld_in(4);
    for (int i = F.tid; i < BATCH * DM; i += NTHR) { const float v = c[i]; sc[i] = v / (1.f + __expf(-v)); }
    __syncthreads();
    for (int item = (int)blockIdx.x; item < 768; item += F.G) {
        const int ks = item & 15, cb = (item >> 4) % 24, l = item / 384, j0 = cb * 256, kb = ks * 128 + F.wave * 16;
        const f32x4* w = (const f32x4*)(aw + (size_t)l * DM * 3 * DM + (size_t)kb * 3 * DM + j0) + F.lane;
        f32x4 wv[16];
#pragma unroll
        for (int k = 0; k < 16; ++k) wv[k] = w[(size_t)k * (3 * DM / 4)];
        f32x4 a[4] = {};
#pragma unroll
        for (int k = 0; k < 16; ++k)
#pragma unroll
            for (int b = 0; b < 4; ++b) a[b] += wv[k] * sc[b * DM + kb + k];
#pragma unroll
        for (int b = 0; b < 4; ++b) *(LAS f32x4*)(part + (F.wave * 4 + b) * 256 + F.lane * 4) = a[b];
        __syncthreads();
        for (int o = F.tid; o < 1024; o += NTHR) { const int b = o >> 8, col = o & 255; float s = 0.f;
#pragma unroll
            for (int wv2 = 0; wv2 < 8; ++wv2) s += part[(wv2 * 4 + b) * 256 + col];
            if (ks == 0) s += ab[l * 3 * DM + j0 + col];
            atomicAdd(WSP(float, mods_off) + ((size_t)l * BATCH + b) * 3 * DM + j0 + col, s); }
        __syncthreads();
    }
}
__device__ __forceinline__ int kmap_out(int k) { return k < 768 ? k + 768 : (k < 1536 ? k - 768 : k); }
template <int MAP, bool KMAP> __device__ __forceinline__ void p0_transpose_item(const float* W, int K, int N, bf16* WT, const float* kgain, LAS bf16* tl, int item, int nblk, int lane) {
    const int kb = item / nblk, nb = item % nblk, k0 = 64 * kb, n0 = 64 * nb, ks0 = KMAP ? kmap_out(k0) : k0;
    const int nq = (lane & 15) * 4, kr = lane >> 4;
    const int s0 = MAP == 1 ? map_in(n0) : (MAP == 2 ? map_uq(n0) : n0), s63 = MAP == 1 ? map_in(n0 + 63) : (MAP == 2 ? map_uq(n0 + 63) : n0 + 63);
    const int s1 = MAP == 1 ? map_in(n0 + 1) : (MAP == 2 ? map_uq(n0 + 1) : n0 + 1);
    if (s0 >= 0 && s63 - s0 == 63 && s1 == s0 + 1) {
        f32x4 v[16];
#pragma unroll
        for (int i = 0; i < 16; ++i) v[i] = *(const f32x4*)(W + (size_t)(ks0 + 4 * i + kr) * N + s0 + nq);
#pragma unroll
        for (int i = 0; i < 16; ++i) { const int kk = 4 * i + kr; const float gsc = kgain ? kgain[k0 + kk] : 1.f;
#pragma unroll
            for (int e = 0; e < 4; ++e) tl[(nq + e) * 72 + kk] = (unsigned short)f2bf(v[i][e] * gsc); }
    } else {
        const int np = n0 + lane; const int src = MAP == 1 ? map_in(np) : (MAP == 2 ? map_uq(np) : np);
        float v[64];
#pragma unroll
        for (int i = 0; i < 64; ++i) v[i] = src >= 0 ? W[(size_t)(ks0 + i) * N + src] : 0.f;
#pragma unroll
        for (int i = 0; i < 64; i += 2) { const float g0 = kgain ? kgain[k0 + i] : 1.f, g1 = kgain ? kgain[k0 + i + 1] : 1.f;
            *(LAS unsigned*)(tl + lane * 72 + i) = pk2(v[i] * g0, v[i + 1] * g1); }
    }
    LDS_WAIT(); asm volatile("" ::: "memory");
    bf16* orow = WT + (size_t)(n0 + lane) * K + k0;
#pragma unroll
    for (int cch = 0; cch < 8; ++cch) *(GAS v4u*)(orow + 8 * cch) = *(const LAS v4u*)(tl + lane * 72 + 8 * cch);
    LDS_WAIT(); asm volatile("" ::: "memory");
}
__device__ __forceinline__ void p0_prologue(Frame& F, size_t mods_off) {
    p0_mods(F, mods_off);
    LAS bf16* tl = (LAS bf16*)(F.lds + F.wave * 9216);
    const int gw = F.vcu * NWAVES + F.wave, NGW = F.G * NWAVES;
    constexpr int I_IN = (DM / 64) * (NP / 64), I_OUT = (DM / 64) * (DM / 64), I_UQ = (384 / 64) * (NQ / 64), I_UKV = (256 / 64) * (NKV / 64), I_L = I_IN + I_OUT + I_UQ + I_UKV;
    for (int it = gw; it < DEPTH * I_L; it += NGW) {
        const int l = it / I_L; int r = it % I_L;
        if (r < I_IN) { p0_transpose_item<1, false>(ld_in(6) + (size_t)l * DM * IN_DIM, DM, IN_DIM, WSP(bf16, WS_WIN) + (size_t)l * NP * DM, nullptr, tl, r, NP / 64, F.lane); continue; } r -= I_IN;
        if (r < I_OUT) { p0_transpose_item<0, true>(ld_in(19) + (size_t)l * DM * DM, DM, DM, WSP(bf16, WS_WOUT) + (size_t)l * DM * DM, nullptr, tl, r, DM / 64, F.lane); continue; } r -= I_OUT;
        if (r < I_UQ) { p0_transpose_item<2, false>(ld_in(14) + (size_t)l * 384 * 1152, 384, 1152, WSP(bf16, WS_WUQ) + (size_t)l * NQ * 384, ld_in(12) + l * 384, tl, r, NQ / 64, F.lane); continue; } r -= I_UQ;
        p0_transpose_item<0, false>(ld_in(15) + (size_t)l * 256 * 1536, 256, 1536, WSP(bf16, WS_WUKV) + (size_t)l * NKV * 256, ld_in(13) + l * 256, tl, r, NKV / 64, F.lane);
    }
    const int* pos = (const int*)ld_in(2);
    for (int i = (int)blockIdx.x * NTHR + F.tid; i < T * 32; i += F.G * NTHR) {
        const int t = i >> 5, f = i & 31;
        const float inv = (float)exp2(-(double)f * (13.287712379549449 / 32.0));
        const float ang = (float)pos[t] * inv;
        const double rev = (double)ang * 0.15915494309189535; const float fr = (float)(rev - floor(rev));
        WSP(float, WS_CS)[i] = __builtin_amdgcn_cosf(fr); WSP(float, WS_SN)[i] = __builtin_amdgcn_sinf(fr);
    }
}
__device__ __forceinline__ void modnorm_rows(Frame& F, const float* x, const float* g, const float* mods_l, bf16* H) {
    const int gw = F.vcu * NWAVES + F.wave, NGW = F.G * NWAVES;
    for (int t = gw; t < T; t += NGW) {
        const GAS f32x4* xr = (const GAS f32x4*)(x + (size_t)t * DM) + F.lane;
        f32x4 v[8]; float s = 0.f;
#pragma unroll
        for (int j = 0; j < 8; ++j) { v[j] = xr[64 * j]; s += (v[j][0] * v[j][0] + v[j][1] * v[j][1]) + (v[j][2] * v[j][2] + v[j][3] * v[j][3]); }
        const float rstd = __builtin_amdgcn_rsqf(wave_sum(s) * (1.f / DM) + EPS);
        const float* sh = mods_l + (size_t)(t / SEQ) * 3 * DM; const float* scl = sh + DM;
        GAS v2u* o8 = (GAS v2u*)(H + (size_t)t * DM) + F.lane;
#pragma unroll
        for (int j = 0; j < 8; ++j) { const int col = (F.lane + 64 * j) * 4;
            const f32x4 gg = *(const f32x4*)(g + col), sv = *(const f32x4*)(scl + col), hv = *(const f32x4*)(sh + col);
            const f32x4 r = v[j] * rstd * gg * (sv + 1.f) + hv;
            v2u w; w.x = pk2(r[0], r[1]); w.y = pk2(r[2], r[3]); o8[64 * j] = w; }
    }
}
__device__ __forceinline__ void finalnorm_rows(Frame& F, float* x, const float* g) {
    const int gw = F.vcu * NWAVES + F.wave, NGW = F.G * NWAVES;
    for (int t = gw; t < T; t += NGW) {
        GAS f32x4* xr = (GAS f32x4*)(x + (size_t)t * DM) + F.lane;
        f32x4 v[8]; float s = 0.f;
#pragma unroll
        for (int j = 0; j < 8; ++j) { v[j] = xr[64 * j]; s += (v[j][0] * v[j][0] + v[j][1] * v[j][1]) + (v[j][2] * v[j][2] + v[j][3] * v[j][3]); }
        const float rstd = __builtin_amdgcn_rsqf(wave_sum(s) * (1.f / DM) + EPS);
#pragma unroll
        for (int j = 0; j < 8; ++j) { const f32x4 gg = *(const f32x4*)(g + (F.lane + 64 * j) * 4); xr[64 * j] = v[j] * rstd * gg; }
    }
}
__device__ __forceinline__ void unpack8(const v4u w, float* f) { f[0] = bflo(w.x); f[1] = bfhi(w.x); f[2] = bflo(w.y); f[3] = bfhi(w.y); f[4] = bflo(w.z); f[5] = bfhi(w.z); f[6] = bflo(w.w); f[7] = bfhi(w.w); }
__device__ __forceinline__ void conv_rows(Frame& F, int l) {
    const int gw = F.vcu * NWAVES + F.wave, NGW = F.G * NWAVES;
    const bf16* P = WSP(bf16, WS_PROJ); bf16* Y = WSP(bf16, WS_HY);
    const float* cw = ld_in(17) + l * 3 * 512; const float* cg = ld_in(18) + l * 512;
    const int ch = F.lane * 8;
    for (int t = gw; t < T; t += NGW) {
        const int s = t % SEQ; const bf16* p = P + (size_t)t * NP;
        float u[3][8];
#pragma unroll
        for (int d = 0; d < 3; ++d) { const int ss = s + d - 1;
            if (ss >= 0 && ss < SEQ) { const bf16* q = p + (long)(d - 1) * NP; float a[8], b[8]; unpack8(*(const v4u*)(q + C_CC + ch), a); unpack8(*(const v4u*)(q + C_CX + ch), b);
#pragma unroll
                for (int e = 0; e < 8; ++e) u[d][e] = a[e] * b[e]; }
            else {
#pragma unroll
                for (int e = 0; e < 8; ++e) u[d][e] = 0.f; } }
        float cb[8], sz[8], pre[8]; unpack8(*(const v4u*)(p + C_CB + ch), cb); unpack8(*(const v4u*)(p + C_Z + 1536 + ch), sz);
        float ssq = 0.f;
#pragma unroll
        for (int e = 0; e < 8; ++e) { pre[e] = cb[e] * (u[0][e] * cw[ch + e] + u[1][e] * cw[512 + ch + e] + u[2][e] * cw[1024 + ch + e]); ssq += pre[e] * pre[e]; }
        const float rstd = __builtin_amdgcn_rsqf(wave_sum(ssq) * (1.f / 512.f) + EPS);
        float r[8];
#pragma unroll
        for (int e = 0; e < 8; ++e) r[e] = pre[e] * rstd * cg[ch + e] * sz[e];
        v4u w; w.x = pk2(r[0], r[1]); w.y = pk2(r[2], r[3]); w.z = pk2(r[4], r[5]); w.w = pk2(r[6], r[7]);
        *(v4u*)(Y + (size_t)t * DM + 1536 + ch) = w;
    }
}
__device__ __forceinline__ void mlaout_rows(Frame& F, int l) {
    const int gw = F.vcu * NWAVES + F.wave, NGW = F.G * NWAVES;
    const bf16* P = WSP(bf16, WS_PROJ); bf16* Y = WSP(bf16, WS_HY); const float* O = WSP(float, WS_OMLA); const float* g = ld_in(16) + l * 768;
    for (int t = gw; t < T; t += NGW) {
        f32x4 v[3]; float s = 0.f;
#pragma unroll
        for (int j = 0; j < 3; ++j) { v[j] = *(const f32x4*)(O + (size_t)t * 768 + (F.lane + 64 * j) * 4); s += (v[j][0] * v[j][0] + v[j][1] * v[j][1]) + (v[j][2] * v[j][2] + v[j][3] * v[j][3]); }
        const float rstd = __builtin_amdgcn_rsqf(wave_sum(s) * (1.f / 768.f) + EPS);
#pragma unroll
        for (int j = 0; j < 3; ++j) { const int col = (F.lane + 64 * j) * 4; const f32x4 gg = *(const f32x4*)(g + col);
            const v2u zw = *(const v2u*)(P + (size_t)t * NP + C_Z + 768 + col);
            const f32x4 r = v[j] * rstd * gg; v2u w; w.x = pk2(r[0] * bflo(zw.x), r[1] * bfhi(zw.x)); w.y = pk2(r[2] * bflo(zw.y), r[3] * bfhi(zw.y));
            *(v2u*)(Y + (size_t)t * DM + col) = w; }
    }
}

template <int KS> __device__ __forceinline__ f32x16 tile_mm(const LAS bf16* A, const LAS bf16* Bt, int r, int hh, f32x16 acc) {
#pragma unroll
    for (int s = 0; s < KS; ++s) {
        const bf16x8 a = *(const LAS bf16x8*)(A + r * 72 + 16 * s + 8 * hh), b = *(const LAS bf16x8*)(Bt + r * 72 + 16 * s + 8 * hh);
        acc = __builtin_amdgcn_mfma_f32_32x32x16_bf16(a, b, acc, 0, 0, 0);
    }
    return acc;
}
__device__ __forceinline__ float logsig16(float a) { return (fminf(a, 0.f) - __logf(1.f + __expf(-fabsf(a)))) * (1.f / 16.f); }
__device__ __forceinline__ void gla_a_item(Frame& F, int l, int item) {
    const int h = item % 6, bn = item / 6, t0 = bn * 64;
    const int tid = F.tid, lane = F.lane, wave = F.wave;
    LAS unsigned char* L = F.lds;
    LAS bf16* QB = (LAS bf16*)(L);
    LAS bf16* KB = (LAS bf16*)(L + 9216);
    LAS bf16* Mm = (LAS bf16*)(L);
    LAS bf16* VT = (LAS bf16*)(L + 18432);
    LAS float* LR = (LAS float*)(L + 36864);
    LAS float* WG = (LAS float*)(L + 36864 + 8192);
    LAS float* BG = (LAS float*)(L + 36864 + 16384);
    LAS bf16* KDT = (LAS bf16*)(L + 36864);
    LAS float* LA = (LAS float*)(L + 55296);
    LAS float* SEGT = (LAS float*)(L + 88576);
    LAS bf16* QF = (LAS bf16*)(L + 90624);
    LAS bf16* KF = (LAS bf16*)(L + 90624 + 18432);
    const bf16* P = WSP(bf16, WS_PROJ) + (size_t)t0 * NP;
    { const int r = tid >> 3, c8 = (tid & 7) * 8;
      *(LAS v4u*)(QB + r * 72 + c8) = *(const v4u*)(P + (size_t)r * NP + C_GQ + h * 64 + c8);
      *(LAS v4u*)(KB + r * 72 + c8) = *(const v4u*)(P + (size_t)r * NP + C_GK + h * 64 + c8); }
#pragma unroll
    for (int i = 0; i < 2; ++i) { const int idx = tid + i * 512, r = idx >> 4, c8 = (idx & 15) * 8;
        const v4u raw = *(const v4u*)(P + (size_t)r * NP + C_GV + h * 128 + c8);
        VT[(c8 + 0) * 72 + r] = (unsigned short)(raw.x & 0xffffu); VT[(c8 + 1) * 72 + r] = (unsigned short)(raw.x >> 16);
        VT[(c8 + 2) * 72 + r] = (unsigned short)(raw.y & 0xffffu); VT[(c8 + 3) * 72 + r] = (unsigned short)(raw.y >> 16);
        VT[(c8 + 4) * 72 + r] = (unsigned short)(raw.z & 0xffffu); VT[(c8 + 5) * 72 + r] = (unsigned short)(raw.z >> 16);
        VT[(c8 + 6) * 72 + r] = (unsigned short)(raw.w & 0xffffu); VT[(c8 + 7) * 72 + r] = (unsigned short)(raw.w >> 16); }
    if (tid < 256) { const int r = tid >> 2, c8 = (tid & 3) * 8; float f[8]; unpack8(*(const v4u*)(P + (size_t)r * NP + C_LR + c8), f);
#pragma unroll
        for (int e = 0; e < 8; ++e) LR[r * 32 + c8 + e] = f[e]; }
    { const int dir = tid >> 8, r = (tid >> 4) & 15, c4 = (tid & 15) * 4; const float* wgf_ = ld_in(7); const float* wgb_ = ld_in(9); const float* wsrc = (dir ? wgb_ : wgf_) + (size_t)l * 16 * 384 + r * 384 + h * 64 + c4;
      *(LAS f32x4*)(WG + (dir * 16 + r) * 64 + c4) = *(const f32x4*)wsrc; }
    if (tid < 128) { const int dir = tid >> 6, dk = tid & 63; const float* bgf_ = ld_in(8); const float* bgb_ = ld_in(10); BG[dir * 64 + dk] = (dir ? bgb_ : bgf_)[l * 384 + h * 64 + dk]; }
    LDS_WAIT(); __syncthreads();
    { const int tok = tid >> 3, dkg = (tid & 7) * 8;
#pragma unroll
      for (int dir = 0; dir < 2; ++dir) { float a[8];
#pragma unroll
        for (int e = 0; e < 8; ++e) a[e] = BG[dir * 64 + dkg + e];
#pragma unroll
        for (int r = 0; r < 16; ++r) { const float x = LR[tok * 32 + dir * 16 + r];
#pragma unroll
            for (int e = 0; e < 8; ++e) a[e] += x * WG[(dir * 16 + r) * 64 + dkg + e]; }
#pragma unroll
        for (int e = 0; e < 8; ++e) LA[(dir * 64 + tok) * 65 + dkg + e] = logsig16(a[e]); } }
    LDS_WAIT(); __syncthreads();
    const int cdir = (tid >> 6) & 1, cdk = tid & 63, seg = tid >> 7;
    float pb[16];
#pragma unroll
    for (int i = 0; i < 16; ++i) pb[i] = LA[(cdir * 64 + seg * 16 + i) * 65 + cdk];
    if (cdir == 0) {
#pragma unroll
        for (int i = 1; i < 16; ++i) pb[i] += pb[i - 1];
    } else {
#pragma unroll
        for (int i = 14; i >= 0; --i) pb[i] += pb[i + 1];
    }
    SEGT[(cdir * 4 + seg) * 64 + cdk] = cdir == 0 ? pb[15] : pb[0];
    LDS_WAIT(); __syncthreads();
    { float offv = 0.f, tot = 0.f;
#pragma unroll
      for (int s2 = 0; s2 < 4; ++s2) { const float sv = SEGT[(cdir * 4 + s2) * 64 + cdk]; tot += sv; if (cdir == 0 ? (s2 < seg) : (s2 > seg)) offv += sv; }
      bf16* QD = WSP(bf16, WS_QDEC) + (size_t)cdir * T * 384 + (size_t)t0 * 384 + h * 64 + cdk;
      unsigned kd[8];
#pragma unroll
      for (int i = 0; i < 16; ++i) { const int tok = seg * 16 + i; const float bv = pb[i] + offv;
          const float q = bf2f(QB[tok * 72 + cdk]), k = bf2f(KB[tok * 72 + cdk]);
          const unsigned short qd = (unsigned short)f2bf(q * 0.125f * __expf(bv)), ki = (unsigned short)f2bf(k * __expf(-bv)), kdv = (unsigned short)f2bf(k * __expf(tot - bv));
          QF[(cdir * 64 + tok) * 72 + cdk] = qd; KF[(cdir * 64 + tok) * 72 + cdk] = ki; QD[(size_t)tok * 384] = qd;
          if (i & 1) kd[i >> 1] |= (unsigned)kdv << 16; else kd[i >> 1] = kdv;
          if ((i & 3) == 3) __builtin_amdgcn_sched_barrier(0); }
      *(LAS v4u*)(KDT + (cdir * 64 + cdk) * 72 + seg * 16) = (v4u){kd[0], kd[1], kd[2], kd[3]};
      *(LAS v4u*)(KDT + (cdir * 64 + cdk) * 72 + seg * 16 + 8) = (v4u){kd[4], kd[5], kd[6], kd[7]};
      if (seg == 0) WSP(float, WS_DECAY)[((size_t)item * 2 + cdir) * 64 + cdk] = __expf(tot); }
    LDS_WAIT(); __syncthreads();
    const int r = lane & 31, hh = lane >> 5;
    if (wave < 4) {
        const int pb2 = wave >> 1, jb = wave & 1; f32x16 sf = {}, sb = {};
        if (pb2 >= jb) sf = tile_mm<4>(QF + (0 * 64 + pb2 * 32) * 72, KF + (0 * 64 + jb * 32) * 72, r, hh, sf);
        if (pb2 <= jb) sb = tile_mm<4>(QF + (1 * 64 + pb2 * 32) * 72, KF + (1 * 64 + jb * 32) * 72, r, hh, sb);
#pragma unroll
        for (int reg = 0; reg < 16; ++reg) { const int p = (reg & 3) + 8 * (reg >> 2) + 4 * hh; float v;
            if (pb2 > jb) v = sf[reg]; else if (pb2 < jb) v = sb[reg]; else v = (r <= p) ? sf[reg] : sb[reg];
            Mm[(pb2 * 32 + p) * 72 + jb * 32 + r] = (unsigned short)f2bf(v); }
    } else {
        const int dvb = wave - 4; float* KV = WSP(float, WS_KVC) + (size_t)item * 2 * 8192;
#pragma unroll
        for (int dir = 0; dir < 2; ++dir)
#pragma unroll
            for (int dkb = 0; dkb < 2; ++dkb) { f32x16 a = {}; a = tile_mm<4>(VT + (dvb * 32) * 72, KDT + (dir * 64 + dkb * 32) * 72, r, hh, a);
#pragma unroll
                for (int reg = 0; reg < 16; ++reg) { const int dv = dvb * 32 + (reg & 3) + 8 * (reg >> 2) + 4 * hh; KV[(size_t)dir * 8192 + dv * 64 + dkb * 32 + r] = a[reg]; } }
    }
    LDS_WAIT(); __syncthreads();
    { const int pb2 = wave >> 2, dvb = wave & 3; f32x16 a = {}; a = tile_mm<4>(Mm + (pb2 * 32) * 72, VT + (dvb * 32) * 72, r, hh, a);
      float* OI = WSP(float, WS_OINTRA) + (size_t)(t0 + pb2 * 32) * 768 + h * 128 + dvb * 32 + r;
#pragma unroll
      for (int reg = 0; reg < 16; ++reg) { const int p = (reg & 3) + 8 * (reg >> 2) + 4 * hh; OI[(size_t)p * 768] = a[reg]; } }
    __syncthreads();
}
__device__ __forceinline__ void gla_scan_witem(Frame& F, int item) {
    const int slice = item & 31, dir = (item >> 5) & 1, bh = item >> 6, b = bh / 6, h = bh % 6;
    const int e = slice * 256 + F.lane * 4, dk = e & 63;
    const float* KV = WSP(float, WS_KVC); const float* DC = WSP(float, WS_DECAY); bf16* ST = WSP(bf16, WS_ST);
    f32x4 st = {0.f, 0.f, 0.f, 0.f};
#pragma unroll 8
    for (int i = 0; i < 32; ++i) { const int n = dir ? 31 - i : i; const size_t it = (size_t)((b * 32 + n) * 6 + h) * 2 + dir;
        const f32x4 kv = *(const f32x4*)(KV + it * 8192 + e), dc = *(const f32x4*)(DC + it * 64 + dk);
        v2u w; w.x = pk2(st[0], st[1]); w.y = pk2(st[2], st[3]); *(v2u*)(ST + it * 8192 + e) = w;
        st = dc * st + kv; }
}
__device__ __forceinline__ void gla_c_task(Frame& F, int l, int task) {
    const int item = task >> 1, half = task & 1, h = item % 6, bn = item / 6, tk0 = bn * 64 + half * 32;
    const int r = F.lane & 31, hh = F.lane >> 5;
    const bf16* QD = WSP(bf16, WS_QDEC); const bf16* ST = WSP(bf16, WS_ST) + (size_t)item * 2 * 8192;
    bf16x8 af[2][4];
#pragma unroll
    for (int dir = 0; dir < 2; ++dir)
#pragma unroll
        for (int s = 0; s < 4; ++s) af[dir][s] = *(const bf16x8*)(QD + (size_t)dir * T * 384 + (size_t)(tk0 + r) * 384 + h * 64 + 16 * s + 8 * hh);
    f32x16 acc[4];
#pragma unroll
    for (int dvb = 0; dvb < 4; ++dvb) { acc[dvb] = f32x16{};
#pragma unroll
        for (int dir = 0; dir < 2; ++dir)
#pragma unroll
            for (int s = 0; s < 4; ++s) { const bf16x8 bfr = *(const bf16x8*)(ST + (size_t)dir * 8192 + (dvb * 32 + r) * 64 + 16 * s + 8 * hh);
                acc[dvb] = __builtin_amdgcn_mfma_f32_32x32x16_bf16(af[dir][s], bfr, acc[dvb], 0, 0, 0); } }
    const float* OI = WSP(float, WS_OINTRA); const bf16* P = WSP(bf16, WS_PROJ); bf16* Y = WSP(bf16, WS_HY); const float* g = ld_in(11) + l * 128;
    float gg[4];
#pragma unroll
    for (int dvb = 0; dvb < 4; ++dvb) gg[dvb] = g[dvb * 32 + r];
#pragma unroll
    for (int reg = 0; reg < 16; ++reg) { const int p = (reg & 3) + 8 * (reg >> 2) + 4 * hh; const size_t t = (size_t)(tk0 + p);
        float v[4], ss = 0.f;
#pragma unroll
        for (int dvb = 0; dvb < 4; ++dvb) { v[dvb] = acc[dvb][reg] + OI[t * 768 + h * 128 + dvb * 32 + r]; ss += v[dvb] * v[dvb]; }
        ss += __shfl_xor(ss, 1); ss += __shfl_xor(ss, 2); ss += __shfl_xor(ss, 4); ss += __shfl_xor(ss, 8); ss += __shfl_xor(ss, 16);
        const float rstd = __builtin_amdgcn_rsqf(ss * (1.f / 128.f) + EPS);
#pragma unroll
        for (int dvb = 0; dvb < 4; ++dvb) { const int col = h * 128 + dvb * 32 + r; const float sz = bf2f(P[t * NP + C_Z + col]);
            Y[t * DM + 768 + col] = (unsigned short)f2bf(v[dvb] * rstd * gg[dvb] * sz); } }
}
#define XB_TMO      128
#define XB_XCNT(j)  (256  + 64 * (j))
#define XB_XSUB(j)  (1280 + 64 * (j))
#define XB_XGEN(j)  (2304 + 64 * (j))
#define XB_TOP      3328
#define XB_TOPGEN   3392
#define XCD_BAR_WORDS 3456
#define XB_SPIN_CAP (1u << 18)
__device__ __forceinline__ unsigned xb_ld(unsigned* p)              { return __hip_atomic_load(p, __ATOMIC_RELAXED, __HIP_MEMORY_SCOPE_AGENT); }
__device__ __forceinline__ unsigned xb_add(unsigned* p, unsigned v) { return __hip_atomic_fetch_add(p, v, __ATOMIC_RELAXED, __HIP_MEMORY_SCOPE_AGENT); }
__device__ __forceinline__ unsigned xb_xcc_id() { return (unsigned)__builtin_amdgcn_s_getreg((3 << 11) | 20) & 0xFu; }
#define XB_SPIN(cond, bar) do { unsigned _sp = 0; while (cond) { __builtin_amdgcn_s_sleep(1); \
    if ((++_sp & 255u) == 0u) { if (xb_ld(&(bar)[XB_TMO])) break; if (_sp > XB_SPIN_CAP) { atomicAdd(&(bar)[XB_TMO], 1u); break; } } } } while (0)
struct XcdBarrier { unsigned* bar; unsigned x; volatile LAS unsigned* st; };
__device__ __forceinline__ XcdBarrier xcd_barrier_post(unsigned* bar, volatile LAS unsigned* st) {
    XcdBarrier b; b.bar = bar; b.x = xb_xcc_id(); b.st = st;
    if (threadIdx.x == 0) (void)xb_add(&bar[XB_XCNT(b.x)], 1u);
    return b;
}
__device__ __forceinline__ void xcd_barrier_complete(unsigned* bar, unsigned x, unsigned& nloc, unsigned& nx) {
    const unsigned G = gridDim.x * gridDim.y * gridDim.z;
    unsigned sum, cnt, mine, sp = 0u;
    for (;;) {
        sum = 0u; cnt = 0u; mine = 0u;
#pragma unroll
        for (unsigned j = 0; j < 16; ++j) { const unsigned c = xb_ld(&bar[XB_XCNT(j)]); sum += c; cnt += (c > 0u) ? 1u : 0u; mine = (j == x) ? c : mine; }
        if (sum == G) break;
        __builtin_amdgcn_s_sleep(1);
        if ((++sp & 255u) == 0u) { if (xb_ld(&bar[XB_TMO])) break; if (sp > XB_SPIN_CAP) { atomicAdd(&bar[XB_TMO], 1u); break; } }
    }
    nloc = mine > 0u ? mine : 1u; nx = cnt > 0u ? cnt : 1u;
}
__device__ __forceinline__ void xcd_barrier(const XcdBarrier& b) {
    asm volatile("s_waitcnt vmcnt(0)" ::: "memory");
    __syncthreads();
    if (threadIdx.x == 0) {
        unsigned* bar = b.bar;
        __builtin_amdgcn_s_waitcnt(0);
        unsigned nloc = b.st[0], nx = b.st[1];
        if (nloc == 0u) { xcd_barrier_complete(bar, b.x, nloc, nx); b.st[0] = nloc; b.st[1] = nx; }
        const unsigned old = xb_add(&bar[XB_XSUB(b.x)], 1u);
        const unsigned gen = old / nloc;
        if (old + 1u == (gen + 1u) * nloc) {
            __builtin_amdgcn_fence(__ATOMIC_RELEASE, "agent");
            asm volatile("s_waitcnt vmcnt(0)" ::: "memory");
            const unsigned og = xb_add(&bar[XB_TOP], 1u);
            const unsigned tg = og / nx;
            if (og + 1u == (tg + 1u) * nx) xb_add(&bar[XB_TOPGEN], 1u);
            else XB_SPIN(xb_ld(&bar[XB_TOPGEN]) == tg, bar);
            __builtin_amdgcn_fence(__ATOMIC_ACQUIRE, "agent");
            xb_add(&bar[XB_XGEN(b.x)], 1u);
            asm volatile("s_waitcnt vmcnt(0)" ::: "memory");
        } else {
            XB_SPIN(xb_ld(&bar[XB_XGEN(b.x)]) == gen, bar);
            __builtin_amdgcn_fence(__ATOMIC_ACQUIRE, "agent");
            asm volatile("s_waitcnt vmcnt(0)" ::: "memory");
        }
    }
    __syncthreads();
}

__device__ __forceinline__ void sub_barrier(unsigned* cnt, unsigned target) {
    asm volatile("s_waitcnt vmcnt(0)" ::: "memory");
    __syncthreads();
    if (threadIdx.x == 0) {
        __builtin_amdgcn_fence(__ATOMIC_RELEASE, "agent");
        asm volatile("s_waitcnt vmcnt(0)" ::: "memory");
        (void)xb_add(cnt, 1u);
        unsigned sp = 0u; while (xb_ld(cnt) < target) { __builtin_amdgcn_s_sleep(2); if (++sp > (1u << 22)) break; }
        __builtin_amdgcn_fence(__ATOMIC_ACQUIRE, "agent");
        asm volatile("s_waitcnt vmcnt(0)" ::: "memory");
    }
    __syncthreads();
}

struct Args { const float* in[21]; float* out; unsigned char* ws; int ph_lo, ph_hi; };
constexpr int N_PHASES = 2 + 6 * DEPTH;
__global__ void __launch_bounds__(NTHR, 2) mega_fwd(Args args) {
    extern __shared__ __attribute__((aligned(16))) unsigned char lds[];
    Frame F;
    F.lds = (LAS unsigned char*)lds; F.ldsg = (char*)lds;
    F.tid = threadIdx.x; F.lane = F.tid & 63; F.wave = __builtin_amdgcn_readfirstlane(F.tid >> 6);
    F.G = gridDim.x; { const int bx = blockIdx.x; F.vcu = (F.G % 8 == 0) ? (bx % 8) * (F.G / 8) + bx / 8 : bx; }
    F.out = args.out; F.ws = args.ws;
    volatile LAS unsigned* MISC = (volatile LAS unsigned*)(F.lds + MISC_OFF);
    for (int u = F.tid; u < (LDS_BYTES - LDSCTL_OFF) / 4; u += NTHR) ((LAS unsigned*)(F.lds + LDSCTL_OFF))[u] = 0u;
    __syncthreads();
    XcdBarrier bar = xcd_barrier_post((unsigned*)(F.ws + WS_CTL) + CW_BAR, MISC + 8);
    const int lo = args.ph_lo, hi = args.ph_hi;
#ifndef MK_MASK
#define MK_MASK 0xFF
#endif
#define PHON(b) ((MK_MASK >> (b)) & 1)
#ifndef MK_REP_PH
#define MK_REP_PH -1
#endif
#define REPS(ph) for (int rep_ = 0; rep_ < ((ph) == MK_REP_PH ? 2 : 1); ++rep_)
#define REPBAR() do { if (rep_ == 0 && false) {} } while (0)
#define IN(k) (lo <= (k) && (k) < hi)
#define FRESH() do { int t_ = threadIdx.x; asm volatile("" : "+v"(t_)); F.tid = t_; F.lane = t_ & 63; F.wave = __builtin_amdgcn_readfirstlane(t_ >> 6); GAS unsigned char* w_ = (GAS unsigned char*)args.ws; asm volatile("" : "+s"(w_)); F.ws = (unsigned char*)w_; GAS float* o_ = (GAS float*)args.out; asm volatile("" : "+s"(o_)); F.out = (float*)o_; } while (0)
#define SEAM(k) do { if (IN(k) && IN((k) + 1)) xcd_barrier(bar); } while (0)
    REPS(100) { if (PHON(0) && IN(0)) { p0_prologue(F, rep_ == 0 ? WS_MODS : (size_t)(1 * MiB)); } SEAM(0); }
    REPS(101) { if (PHON(1) && IN(1)) { modnorm_rows(F, ld_in(0), ld_in(5), WSP(float, WS_MODS), WSP(bf16, WS_HY)); } SEAM(1); }
#pragma unroll 1
    for (int l = 0; l < DEPTH; ++l) {
        const int pb = 2 + 6 * l;
#define mods_l (WSP(float, WS_MODS) + (size_t)l * BATCH * 3 * DM)
        REPS(0) { if (PHON(2) && IN(pb)) {
            FRESH();
            pg8::Gemm g{WSP(bf16, WS_HY), WSP(bf16, WS_WIN) + (size_t)l * NP * DM, T, NP, DM, DM}; pg8::StaticOrder S; S.init(T, NP, F.G, (int)blockIdx.x);
            EpiIn E{WSP(bf16, WS_PROJ), WSP(float, WS_CS), WSP(float, WS_SN), WSP(float, WS_PARTQ), WSP(float, WS_PARTKV)};
            pg8::gemm_phase<EpiIn, pg8::StaticOrder, true, true>(F.lds, g, S, E);
        } SEAM(pb); }
        REPS(1) { if (PHON(3) && IN(pb + 1)) {
#ifndef MK_SUB
#define MK_SUB 0xFF
#endif
            FRESH();
            if (MK_SUB & 1) { pg8::Gemm g{WSP(bf16, WS_PROJ) + C_MKV, WSP(bf16, WS_WUKV) + (size_t)l * NKV * 256, T, NKV, 256, NP}; pg8::StaticOrder S; S.init(T, NKV, F.G, (int)blockIdx.x);
              EpiUkv E{WSP(bf16, WS_KVUP), WSP(float, WS_PARTKV)};
              pg8::gemm_phase<EpiUkv, pg8::StaticOrder, true, true>(F.lds, g, S, E); }
            FRESH();
            if (MK_SUB & 2) { pg8::Gemm g{WSP(bf16, WS_PROJ) + C_MQ, WSP(bf16, WS_WUQ) + (size_t)l * NQ * 384, T, NQ, 384, NP}; pg8::StaticOrder S; S.init(T, NQ, F.G, ((int)blockIdx.x + 64) % F.G);
              EpiUq E{WSP(bf16, WS_QUP), WSP(float, WS_CS), WSP(float, WS_SN), WSP(float, WS_PARTQ)};
              pg8::gemm_phase<EpiUq, pg8::StaticOrder, true, true>(F.lds, g, S, E); }
            __syncthreads(); FRESH();
            if (MK_SUB & 4) for (int it = (int)blockIdx.x; it < NITEM; it += F.G) gla_a_item(F, l, it);
        } SEAM(pb + 1); }
        REPS(7) { if (PHON(3) && IN(pb + 2)) {
            FRESH();
            conv_rows(F, l);
            FRESH(); { const int gw = F.vcu * NWAVES + F.wave, NGW = F.G * NWAVES; for (int it = gw; it < 1536; it += NGW) gla_scan_witem(F, it); }
        } SEAM(pb + 2); }
        REPS(2) { if (PHON(4) && IN(pb + 3)) {
            const int bx = (int)blockIdx.x; FRESH();
            const int natt = F.G > 192 ? 192 : F.G;
            if (bx < natt) {
                for (int u = bx; u < 192; u += natt) { const int bh = u >> 3, qb = u & 7, b = bh / 6, h = bh % 6; const size_t row0 = (size_t)b * SEQ, qrow = row0 + qb * 256;
                    mla::attn_unit(WSP(bf16, WS_QUP) + qrow * NQ + h * 192, WSP(bf16, WS_KVUP) + row0 * NKV + h * 256, WSP(bf16, WS_KVUP) + row0 * NKV + h * 256 + 128,
                                   WSP(bf16, WS_PROJ) + row0 * NP + C_MKR, WSP(bf16, WS_HY) + qrow * DM + h * 128, WSP(bf16, WS_PROJ) + qrow * NP + C_Z + 768 + h * 128,
                                   ld_in(16) + l * 768 + h * 128, WSP(float, WS_PARTM) + qrow * 8 + h, SEQ, F.ldsg); }
            }
            if (F.G > 192) { if (bx >= 192) { const int gw = (bx - 192) * NWAVES + F.wave, NGW = (F.G - 192) * NWAVES; for (int task = gw; task < 2 * NITEM; task += NGW) gla_c_task(F, l, task); } }
            else { FRESH(); const int gw = F.vcu * NWAVES + F.wave, NGW = F.G * NWAVES; for (int task = gw; task < 2 * NITEM; task += NGW) gla_c_task(F, l, task); }
        } SEAM(pb + 3); }
        for (int rep_ = 0; rep_ < ((MK_REP_PH == 4 && l == 0) ? 2 : 1); ++rep_) { if (PHON(6) && IN(pb + 4)) {
            FRESH();
            pg8::Gemm g{WSP(bf16, WS_HY), WSP(bf16, WS_WOUT) + (size_t)l * DM * DM, T, DM, DM, DM}; pg8::StaticOrder S; S.init(T, DM, F.G, (int)blockIdx.x);
            EpiOut E{l == 0 ? ld_in(0) : F.out, F.out, mods_l + 2 * DM, WSP(float, WS_PARTM)};
            pg8::gemm_phase<EpiOut, pg8::StaticOrder, true, true>(F.lds, g, S, E);
        } SEAM(pb + 4); }
        for (int rep_ = 0; rep_ < ((MK_REP_PH == 5 && l == 0) ? 2 : 1); ++rep_) { if (PHON(7) && IN(pb + 5)) {
            FRESH();
            if (l + 1 < DEPTH) modnorm_rows(F, F.out, ld_in(5) + (l + 1) * DM, mods_l + (size_t)BATCH * 3 * DM, WSP(bf16, WS_HY));
            else finalnorm_rows(F, F.out, ld_in(20));
        } SEAM(pb + 5); }
        if (MK_REP_PH == 6) { for (int r_ = 0; r_ < 4; ++r_) xcd_barrier(bar); }
    }
#undef mods_l
#undef IN
#undef SEAM
}

#ifndef MK_CUT
#define MK_CUT 14
#endif
#if MK_CUT < 14
__global__ void glue_proj(const bf16* P, float* proj, float* y, int row0) {
    const int t = blockIdx.x; const bf16* p = P + (size_t)(row0 + t) * NP;
    for (int c = threadIdx.x; c < NP; c += 256) { const float v = bf2f(p[c]);
        if (c < C_MKV) proj[(size_t)t * nv::PW + c] = v;
        else if (c < C_MQ) proj[(size_t)t * nv::PW + nv::O_MKV + (c - C_MKV)] = v;
        else if (c < C_MKR) proj[(size_t)t * nv::PW + nv::O_MQ + (c - C_MQ)] = v;
        else if (c < C_LR) { const int j = c - C_MKR; proj[(size_t)t * nv::PW + nv::O_MKR + (j & 1) * 32 + (j >> 1)] = v; }
        else if (c < C_LR + 32) proj[(size_t)t * nv::PW + nv::O_LR + (c - C_LR)] = v;
        else if (c < C_CB) {}
        else if (c < C_Z) proj[(size_t)t * nv::PW + nv::O_CB + (c - C_CB)] = v;
        else y[(size_t)t * DM + (c - C_Z)] = v; }
}
__global__ void glue_qkv(const bf16* Q, const bf16* KV, float* qm, float* kv, int row0) {
    const int t = blockIdx.x;
    for (int c = threadIdx.x; c < 1152; c += 256) { const float v = bf2f(Q[(size_t)(row0 + t) * NQ + c]) * (1.f / QSCALE); const int h = c / 192, d = c % 192;
        if (d < 128) qm[(size_t)t * 1152 + c] = v; else { const int j = d - 128; qm[(size_t)t * 1152 + h * 192 + 128 + (j & 1) * 32 + (j >> 1)] = v; } }
    for (int c = threadIdx.x; c < 1536; c += 256) kv[(size_t)t * 1536 + c] = bf2f(KV[(size_t)(row0 + t) * NKV + c]);
}
__global__ void glue_y(const bf16* Y, float* y, int row0) {
    const int t = blockIdx.x; for (int c = threadIdx.x; c < DM; c += 256) { const int cr = c < 768 ? c + 768 : (c < 1536 ? c - 768 : c); y[(size_t)t * DM + cr] = bf2f(Y[(size_t)(row0 + t) * DM + c]); }
}
__global__ void glue_h(const bf16* H, float* h, int row0) {
    const int t = blockIdx.x; for (int c = threadIdx.x; c < DM; c += 256) h[(size_t)t * DM + c] = bf2f(H[(size_t)(row0 + t) * DM + c]);
}

#endif
#ifndef MK_NAIVE_BASE_MIB
#define MK_NAIVE_BASE_MIB 240
#endif
extern "C" void kernel_launch(void* const* d_in, const int* in_sizes, int n_in, void* d_out, int out_size, void* d_ws, size_t ws_size, hipStream_t stream) {
    static int grid = 0;
    if (grid == 0) {
        if (n_in != 21 || out_size != T * DM || in_sizes[0] != T * DM || ws_size < WS_END) { fprintf(stderr, "kernel_launch: unexpected shapes n_in %d out %d ws %zu\n", n_in, out_size, ws_size); grid = -1; return; }
        int dev = 0, cus = 0, per_cu = 0;
        if (hipGetDevice(&dev) != hipSuccess || hipDeviceGetAttribute(&cus, hipDeviceAttributeMultiprocessorCount, dev) != hipSuccess) { grid = -1; return; }
        if (hipFuncSetAttribute((const void*)mega_fwd, hipFuncAttributeMaxDynamicSharedMemorySize, LDS_BYTES) != hipSuccess) { fprintf(stderr, "kernel_launch: hipFuncSetAttribute failed\n"); grid = -1; return; }
        if (hipOccupancyMaxActiveBlocksPerMultiprocessor(&per_cu, (const void*)mega_fwd, NTHR, LDS_BYTES) != hipSuccess || per_cu < 1) { fprintf(stderr, "kernel_launch: occupancy query says %d blocks/CU\n", per_cu); grid = -1; (void)hipGetLastError(); return; }
        grid = cus;
    }
    if (grid < 0) return;
    (void)hipMemsetAsync((char*)d_ws + WS_CTL, 0, CTL_ZERO_BYTES, stream);
    Args a{};
    for (int i = 0; i < 21; ++i) a.in[i] = (const float*)d_in[i];
    a.out = (float*)d_out; a.ws = (unsigned char*)d_ws; a.ph_lo = 0; a.ph_hi = MK_CUT < N_PHASES ? MK_CUT : N_PHASES;
    hipLaunchKernelGGL(mega_fwd, dim3(grid), dim3(NTHR), LDS_BYTES, stream, a);
#if MK_CUT < 14
    {
        char* ws = (char*)d_ws; float* out = (float*)d_out; const float* x = (const float*)d_in[0];
        const float* mods = (const float*)(ws + WS_MODS); const float* cs = (const float*)(ws + WS_CS); const float* sn = (const float*)(ws + WS_SN);
        nv::Buf B = nv::carve(ws + (size_t)MK_NAIVE_BASE_MIB * MiB);
        const int l0 = (MK_CUT - 2) / 6, ph = (MK_CUT - 2) % 6;
        for (int l = l0; l < DEPTH; ++l)
            for (int b = 0; b < BATCH; ++b) {
                const int row0 = b * SEQ; int entry = 0; const float* xin = (l == 0 ? x : out) + (size_t)row0 * DM; float* xo = out + (size_t)row0 * DM;
                if (l == l0) {
                    if (ph >= 1 && ph <= 3) { glue_proj<<<SEQ, 256, 0, stream>>>((const bf16*)(ws + WS_PROJ), B.proj, B.y, row0); entry = 1; }
                    if (ph == 2) { glue_qkv<<<SEQ, 256, 0, stream>>>((const bf16*)(ws + WS_QUP), (const bf16*)(ws + WS_KVUP), nv::sc_qm(B), nv::sc_kv(B), row0); entry = 2; }
                    if (ph == 3) { hipMemcpyAsync(nv::sc_omla(B), ws + WS_OMLA + (size_t)row0 * 768 * 4, (size_t)SEQ * 768 * 4, hipMemcpyDeviceToDevice, stream); entry = 4; }
                    if (ph == 4) { glue_y<<<SEQ, 256, 0, stream>>>((const bf16*)(ws + WS_HY), B.y, row0); entry = 3; }
                    if (ph == 5) continue;
                }
                nv::layer_batch(d_in, l, b, entry, xin, xo, mods, cs, sn, B, stream);
            }
        nv::k_rms<<<T, 256, 0, stream>>>(out, DM, DM, (const float*)d_in[20], out, DM);
    }
#endif
}
```

```cpp
#include <hip/hip_runtime.h>
#include <cstdio>
#include <cstdint>
#define MK_CUT 14
#define MK_NAIVE_BASE_MIB 240
#define MK_REP_PH -1
namespace pg8 {
#define PG8_LAS __attribute__((address_space(3)))
typedef unsigned short bf16_t;
typedef short bf16x8 __attribute__((ext_vector_type(8)));
typedef float f32x4 __attribute__((ext_vector_type(4)));
typedef unsigned u32x4 __attribute__((ext_vector_type(4)));
constexpr int BM = 256, BK = 64, HALF = 128, HTB = HALF * BK * 2, STAGE_BYTES = 8 * HTB, NXCD = 8, WGM = 8;

__host__ __device__ __forceinline__ int lds_byte(int r, int c) { const int st = (r >> 4) * 2 + (c >> 5), rr = r & 15, cc = c & 31, ob = rr * 64 + cc * 2; return st * 1024 + (ob ^ (((ob >> 9) & 1) << 5)); }
__host__ __device__ __forceinline__ void stage_rc(int b, int& R, int& C) { const int st = b / 1024, sb = b % 1024, swz = sb ^ (((sb >> 9) & 1) << 5); R = (st >> 1) * 16 + swz / 64; C = (st & 1) * 32 + (swz % 64) / 2; }
__host__ __device__ __forceinline__ int perm32(int rho) { const int n = rho >> 4, i = rho & 15; return 8 * (i >> 2) + 4 * n + (i & 3); }

struct Unit { int pm, pn; };
struct Gemm { const bf16_t* A; const bf16_t* Bt; int M, N, K, lda; };

struct StaticOrder {
    int nM, nN, nwg, G, c;
    __host__ __device__ void init(int M, int N, int G_, int c_) { nM = M / BM; nN = N / BM; nwg = nM * nN; G = G_; c = c_; }
    __host__ __device__ bool next(int i, Unit& u) const {
        const long L = (long)i * G + c; if (L >= nwg) return false;
        int wgid = (int)L; { const int q = nwg / NXCD, r = nwg % NXCD, xcd = wgid % NXCD, off = wgid / NXCD; wgid = (xcd < r ? xcd * (q + 1) : r * (q + 1) + (xcd - r) * q) + off; }
        const int nig = WGM * nN, gid = wgid / nig, fm = gid * WGM, gsz = (nM - fm) < WGM ? (nM - fm) : WGM;
        u.pm = fm + ((wgid % nig) % gsz); u.pn = (wgid % nig) / gsz; return true;
    }
    __device__ __forceinline__ void a_ready(const Unit&) const {}
    __device__ __forceinline__ void done(const Unit&) const {}
};

__device__ __forceinline__ unsigned cvt_pk_bf16(float lo, float hi) { unsigned r; asm volatile("v_cvt_pk_bf16_f32 %0, %1, %2" : "=v"(r) : "v"(lo), "v"(hi)); return r; }

template <class Epi, class Sched, bool ALIGN_EPI = false, bool SP2 = false>
__device__ __forceinline__ void gemm_phase(PG8_LAS unsigned char* lds, const Gemm g, const Sched& S, const Epi& E) {
    int tid_ = threadIdx.x; asm volatile("" : "+v"(tid_));
    const int tid = tid_, wid = __builtin_amdgcn_readfirstlane(tid >> 6), lane = tid & 63, wr = wid >> 2, wc = wid & 3, fr = lane & 15, fq = lane >> 4;
    int K_ = g.K, lda_ = g.lda; asm volatile("" : "+s"(K_), "+s"(lda_));
    const int K = K_, nt = K / BK, lda = lda_;
    unsigned voffA[2], voffB[2];
#pragma unroll
    for (int i = 0; i < 2; ++i) { int R, C; stage_rc(tid * 16 + i * 8192, R, C); const int Rb = Epi::PERM ? ((R & ~31) + perm32(R & 31)) : R;
        voffA[i] = (unsigned)(R * lda + C) * 2u; voffB[i] = (unsigned)(Rb * K + C) * 2u; }
    const size_t kstep = (size_t)(BK * 2);
    const size_t hstepA = (size_t)HALF * lda * 2, hstepB = (size_t)HALF * K * 2;
    const size_t tstepA = 2 * hstepA, tstepB = 2 * hstepB;
    const unsigned ldsw = (unsigned)wid * 1024u;
    const int aoff = lds_byte(wr * 64 + fr, fq * 8), boff = lds_byte(wc * 32 + fr, fq * 8);
#define PG8_SA(b, h) (((b) * 2 + (h)) * HTB)
#define PG8_SB(b, h) ((4 + (b) * 2 + (h)) * HTB)
#define PG8_STAGE(bufoff, gbase, voff) do { _Pragma("unroll") for (int _i = 0; _i < 2; ++_i) \
        __builtin_amdgcn_global_load_lds((const unsigned*)((const char*)(gbase) + (voff)[_i]), (PG8_LAS unsigned*)(lds + (bufoff) + ldsw + _i * 8192), 16, 0, 0); } while (0)
#define PG8_LDA(dst, b, h) do { _Pragma("unroll") for (int m = 0; m < 4; ++m) _Pragma("unroll") for (int k = 0; k < 2; ++k) dst[m][k] = *(const PG8_LAS bf16x8*)(lds + PG8_SA(b, h) + aoff + m * 2048 + k * 1024); } while (0)
#define PG8_LDB(dst, b, h) do { _Pragma("unroll") for (int n = 0; n < 2; ++n) _Pragma("unroll") for (int k = 0; k < 2; ++k) dst[n][k] = *(const PG8_LAS bf16x8*)(lds + PG8_SB(b, h) + boff + n * 2048 + k * 1024); } while (0)
#define PG8_MMA(ai, bj, At, Bt) do { __builtin_amdgcn_s_setprio(1); _Pragma("unroll") for (int m = 0; m < 4; ++m) _Pragma("unroll") for (int n = 0; n < 2; ++n) _Pragma("unroll") for (int k = 0; k < 2; ++k) \
        acc[ai][bj][m][n] = __builtin_amdgcn_mfma_f32_16x16x32_bf16(Bt[n][k], At[m][k], acc[ai][bj][m][n], 0, 0, 0); __builtin_amdgcn_s_setprio(0); } while (0)
#define PG8_WAIT_V(n) asm volatile("s_waitcnt vmcnt(" #n ")" ::: "memory")
#define PG8_WAIT_L(n) asm volatile("s_waitcnt lgkmcnt(" #n ")" ::: "memory")
#define PG8_BAR __builtin_amdgcn_s_barrier()
#define PG8_SCHED __builtin_amdgcn_sched_barrier(0)
    Unit cur, nxt; int ui = 0;
    if (!S.next(0, cur)) return;
    f32x4 acc[2][2][4][2];
#pragma unroll
    for (int a = 0; a < 2; ++a)
#pragma unroll
        for (int b = 0; b < 2; ++b)
#pragma unroll
            for (int m = 0; m < 4; ++m)
#pragma unroll
                for (int n = 0; n < 2; ++n) acc[a][b][m][n] = (f32x4){0.f, 0.f, 0.f, 0.f};
    bf16x8 At[4][2], B0[2][2], B1[2][2];
    const char* cA = (const char*)g.A + (size_t)cur.pm * tstepA; const char* cB = (const char*)g.Bt + (size_t)cur.pn * tstepB;
    S.a_ready(cur);
    if constexpr (SP2) {
        PG8_STAGE(PG8_SB(0, 0), cB, voffB); PG8_STAGE(PG8_SB(0, 1), cB + hstepB, voffB); PG8_STAGE(PG8_SA(0, 0), cA, voffA); PG8_STAGE(PG8_SA(0, 1), cA + hstepA, voffA);
        if (wr == 1) PG8_BAR;
        PG8_WAIT_V(2); PG8_BAR;
        PG8_STAGE(PG8_SB(1, 0), cB + kstep, voffB); PG8_STAGE(PG8_SA(1, 0), cA + kstep, voffA); PG8_STAGE(PG8_SB(1, 1), cB + hstepB + kstep, voffB);
        PG8_WAIT_V(6); PG8_BAR;
    } else {
        PG8_STAGE(PG8_SB(0, 0), cB, voffB); PG8_STAGE(PG8_SA(0, 0), cA, voffA); PG8_STAGE(PG8_SB(0, 1), cB + hstepB, voffB); PG8_STAGE(PG8_SA(0, 1), cA + hstepA, voffA);
        if (wr == 1) PG8_BAR;
        PG8_WAIT_V(4); PG8_BAR;
        PG8_STAGE(PG8_SB(1, 0), cB + kstep, voffB); PG8_STAGE(PG8_SA(1, 0), cA + kstep, voffA); PG8_STAGE(PG8_SB(1, 1), cB + hstepB + kstep, voffB);
        PG8_WAIT_V(6); PG8_BAR;
    }
    for (;;) {
        const bool has_next = S.next(ui + 1, nxt);
        const char* nA = has_next ? (const char*)g.A + (size_t)nxt.pm * tstepA : cA; const char* nB = has_next ? (const char*)g.Bt + (size_t)nxt.pn * tstepB : cB;
        for (int t = 0; t < nt; t += 2) {
            const bool last = (t == nt - 2);
            const char* a1 = cA + (size_t)(t + 1) * kstep;
            const char* a2 = last ? nA : cA + (size_t)(t + 2) * kstep; const char* b2 = last ? nB : cB + (size_t)(t + 2) * kstep;
            const char* a3 = a2 + kstep; const char* b3 = b2 + kstep;
            if (last && has_next) S.a_ready(nxt);
            if constexpr (SP2) {
            PG8_LDB(B0, 0, 0); PG8_LDB(B1, 0, 1); PG8_SCHED; PG8_LDA(At, 0, 0); PG8_STAGE(PG8_SA(1, 1), a1 + hstepA, voffA);
            PG8_WAIT_V(8); PG8_WAIT_L(0); PG8_BAR; PG8_MMA(0, 0, At, B0); PG8_MMA(0, 1, At, B1); PG8_BAR; PG8_SCHED;
            PG8_LDA(At, 0, 1); PG8_STAGE(PG8_SB(0, 0), b2, voffB); PG8_STAGE(PG8_SB(0, 1), b2 + hstepB, voffB); PG8_STAGE(PG8_SA(0, 0), a2, voffA);
            PG8_WAIT_V(8); PG8_WAIT_L(0); PG8_BAR; PG8_MMA(1, 0, At, B0); PG8_MMA(1, 1, At, B1); PG8_BAR; PG8_SCHED;
            PG8_LDB(B0, 1, 0); PG8_LDB(B1, 1, 1); PG8_SCHED; PG8_LDA(At, 1, 0); PG8_STAGE(PG8_SA(0, 1), a2 + hstepA, voffA);
            PG8_WAIT_V(8); PG8_WAIT_L(0); PG8_BAR; PG8_MMA(0, 0, At, B0); PG8_MMA(0, 1, At, B1); PG8_BAR; PG8_SCHED;
            PG8_LDA(At, 1, 1); PG8_STAGE(PG8_SB(1, 0), b3, voffB); PG8_STAGE(PG8_SB(1, 1), b3 + hstepB, voffB); PG8_STAGE(PG8_SA(1, 0), a3, voffA);
            PG8_WAIT_V(8); PG8_WAIT_L(0); PG8_BAR; PG8_MMA(1, 0, At, B0); PG8_MMA(1, 1, At, B1); PG8_BAR; PG8_SCHED;
            if constexpr (Epi::HOOK_T > 0) { if (t + 2 == Epi::HOOK_T) E.hook(acc, cur, wr, wc, fr, fq); }
            } else {
            PG8_LDB(B0, 0, 0); PG8_SCHED; PG8_LDA(At, 0, 0); PG8_STAGE(PG8_SA(1, 1), a1 + hstepA, voffA);
            PG8_WAIT_L(8); PG8_BAR; PG8_WAIT_L(0); PG8_MMA(0, 0, At, B0); PG8_BAR; PG8_SCHED;
            PG8_LDB(B1, 0, 1); PG8_STAGE(PG8_SB(0, 0), b2, voffB);
            PG8_BAR; PG8_WAIT_L(0); PG8_MMA(0, 1, At, B1); PG8_BAR;
            PG8_LDA(At, 0, 1); PG8_STAGE(PG8_SA(0, 0), a2, voffA);
            PG8_BAR; PG8_WAIT_L(0); PG8_MMA(1, 0, At, B0); PG8_BAR; PG8_SCHED;
            PG8_STAGE(PG8_SB(0, 1), b2 + hstepB, voffB);
            PG8_WAIT_V(6); PG8_BAR; PG8_MMA(1, 1, At, B1); PG8_BAR;
            PG8_LDB(B0, 1, 0); PG8_SCHED; PG8_LDA(At, 1, 0); PG8_STAGE(PG8_SA(0, 1), a2 + hstepA, voffA);
            PG8_WAIT_L(8); PG8_BAR; PG8_WAIT_L(0); PG8_MMA(0, 0, At, B0); PG8_BAR; PG8_SCHED;
            PG8_LDB(B1, 1, 1); PG8_STAGE(PG8_SB(1, 0), b3, voffB);
            PG8_BAR; PG8_WAIT_L(0); PG8_MMA(0, 1, At, B1); PG8_BAR;
            PG8_LDA(At, 1, 1); PG8_STAGE(PG8_SA(1, 0), a3, voffA);
            PG8_BAR; PG8_WAIT_L(0); PG8_MMA(1, 0, At, B0); PG8_BAR; PG8_SCHED;
            PG8_STAGE(PG8_SB(1, 1), b3 + hstepB, voffB);
            PG8_WAIT_V(6); PG8_BAR; PG8_MMA(1, 1, At, B1); PG8_BAR;
            }
        }
        if constexpr (ALIGN_EPI) { if (wr == 0) PG8_BAR; }
        E(acc, cur, wr, wc, fr, fq); S.done(cur);
        if (!has_next) break;
#pragma unroll
        for (int a = 0; a < 2; ++a)
#pragma unroll
            for (int b = 0; b < 2; ++b)
#pragma unroll
                for (int m = 0; m < 4; ++m)
#pragma unroll
                    for (int n = 0; n < 2; ++n) acc[a][b][m][n] = (f32x4){0.f, 0.f, 0.f, 0.f};
        cur = nxt; cA = nA; cB = nB; ++ui;
        if constexpr (ALIGN_EPI) { if (wr == 1) PG8_BAR; }
    }
    PG8_WAIT_V(0);
    if constexpr (!ALIGN_EPI) { if (wr == 0) PG8_BAR; }
    PG8_BAR;
#undef PG8_SA
#undef PG8_SB
#undef PG8_STAGE
#undef PG8_LDA
#undef PG8_LDB
#undef PG8_MMA
#undef PG8_WAIT_V
#undef PG8_WAIT_L
#undef PG8_BAR
#undef PG8_SCHED
}
}
#define GAS __attribute__((address_space(1)))
#define LAS __attribute__((address_space(3)))
typedef unsigned short bf16;
typedef unsigned v4u __attribute__((ext_vector_type(4)));
typedef unsigned v2u __attribute__((ext_vector_type(2)));
typedef float f32x4 __attribute__((ext_vector_type(4)));
typedef float f32x16 __attribute__((ext_vector_type(16)));
typedef short bf16x8 __attribute__((ext_vector_type(8)));
typedef short s16x4 __attribute__((ext_vector_type(4)));
typedef GAS unsigned gu32;

constexpr int NWAVES = 8, NTHR = 512;
constexpr int BATCH = 4, SEQ = 2048, DM = 2048, T = BATCH * SEQ, DEPTH = 2, IN_DIM = 5856;
constexpr int NP = 5888;
constexpr int C_GQ = 0, C_GK = 384, C_GV = 768, C_MKV = 1536, C_MQ = 1792, C_MKR = 2176, C_LR = 2240, C_CB = 2304, C_CC = 2816, C_CX = 3328, C_Z = 3840;
constexpr int R_GQ = 0, R_GK = 384, R_GV = 768, R_LR = 1536, R_MQ = 1568, R_MKV = 1952, R_MKR = 2208, R_CB = 2272, R_CC = 2784, R_CX = 3296, R_Z = 3808;
constexpr int NQ = 1280, NKV = 1536;
constexpr float EPS = 1e-6f;
constexpr float QSCALE = 0.07216878364870322f * 1.4426950408889634f;
constexpr int NITEM = BATCH * 32 * 6;

constexpr size_t MiB = 1u << 20;
constexpr size_t WS_CTL = 0, CTL_ZERO_BYTES = 1 * MiB;
constexpr size_t WS_MODS = 256 * 1024;
constexpr size_t WS_CS = 2 * MiB, WS_SN = 3 * MiB;
constexpr size_t WS_WUQ = 4 * MiB;
constexpr size_t WS_WUKV = 6 * MiB;
constexpr size_t WS_WOUT = 8 * MiB;
constexpr size_t WS_WIN = 24 * MiB;
constexpr size_t WS_HY = 70 * MiB;
constexpr size_t WS_PROJ = 102 * MiB;
constexpr size_t WS_QUP = 194 * MiB;
constexpr size_t WS_KVUP = 214 * MiB;
constexpr size_t WS_OMLA = 238 * MiB;
constexpr size_t WS_OINTRA = 262 * MiB;
constexpr size_t WS_KVC = 286 * MiB;
constexpr size_t WS_ST = 334 * MiB;
constexpr size_t WS_QDEC = 358 * MiB;
constexpr size_t WS_DECAY = 370 * MiB;
constexpr size_t WS_PARTQ = 371 * MiB;
constexpr size_t WS_PARTKV = 371 * MiB + 512 * 1024;
constexpr size_t WS_PARTM = 371 * MiB + 768 * 1024;
constexpr size_t WS_END = 372 * MiB;
constexpr int CW_BAR = 4096;

constexpr int RING_BYTES = 131072, LDSCTL_OFF = RING_BYTES, MISC_OFF = LDSCTL_OFF + 320, LDS_BYTES = 147456;

#define LDS_WAIT() asm volatile("s_waitcnt lgkmcnt(0)" ::: "memory")
#define VM_WAIT() asm volatile("s_waitcnt vmcnt(0)" ::: "memory")
__device__ __forceinline__ unsigned f2bf(float f) { unsigned u = __builtin_bit_cast(unsigned, f); return (u + 0x7fffu + ((u >> 16) & 1u)) >> 16; }
__device__ __forceinline__ unsigned pk2(float lo, float hi) { return pg8::cvt_pk_bf16(lo, hi); }
__device__ __forceinline__ float bf2f(unsigned short h) { return __builtin_bit_cast(float, (unsigned)h << 16); }
__device__ __forceinline__ float bflo(unsigned w) { return __builtin_bit_cast(float, w << 16); }
__device__ __forceinline__ float bfhi(unsigned w) { return __builtin_bit_cast(float, w & 0xffff0000u); }
__device__ __forceinline__ float silu_fast(float v) { return v * __builtin_amdgcn_rcpf(1.f + __expf(-v)); }
__device__ __forceinline__ float wave_sum(float v) {
#pragma unroll
    for (int o = 1; o < 64; o <<= 1) v += __shfl_xor(v, o);
    return v;
}

__device__ __forceinline__ int map_in(int n) {
    if (n < C_MKV) return n;
    if (n < C_MQ) return R_MKV + (n - C_MKV);
    if (n < C_MKR) return R_MQ + (n - C_MQ);
    if (n < C_LR) { const int j = n - C_MKR; return R_MKR + (j & 1) * 32 + (j >> 1); }
    if (n < C_LR + 32) return R_LR + (n - C_LR);
    if (n < C_CB) return -1;
    if (n < C_Z) return R_CB + (n - C_CB);
    return R_Z + (n - C_Z);
}
__device__ __forceinline__ int map_uq(int n) {
    if (n >= 1152) return -1;
    const int h = n / 192, d = n % 192;
    if (d < 128) return n;
    const int j = d - 128; return h * 192 + 128 + (j & 1) * 32 + (j >> 1);
}

struct EpiIn {
    static constexpr bool PERM = true; static constexpr int HOOK_T = 0;
    bf16* O; const float* cs; const float* sn; float* partq; float* partkv;
    __device__ __forceinline__ void operator()(const f32x4 (&acc)[2][2][4][2], const pg8::Unit& u, int wr, int wc, int fr, int fq) const {
        const int pn = u.pn, row0 = u.pm * 256 + wr * 64 + fr, col0 = pn * 256 + wc * 32 + 8 * fq;
        const bool stat = (pn >= 6 && pn <= 8);
#pragma unroll
        for (int ai = 0; ai < 2; ++ai)
#pragma unroll
            for (int m = 0; m < 4; ++m) {
                const int row = row0 + ai * 128 + m * 16; bf16* rowp = O + (size_t)row * NP + col0; float ss = 0.f;
#pragma unroll
                for (int bj = 0; bj < 2; ++bj) {
                    f32x4 v0 = acc[ai][bj][m][0], v1 = acc[ai][bj][m][1]; const int c = col0 + bj * 128;
                    if (pn >= 15) {
#pragma unroll
                        for (int e = 0; e < 4; ++e) { v0[e] = silu_fast(v0[e]); v1[e] = silu_fast(v1[e]); }
                    } else if (pn == 8 && bj == 1 && c < C_LR) {
                        const int i0 = (c - C_MKR) >> 1; const f32x4 cc = *(const f32x4*)(cs + (size_t)row * 32 + i0), sv = *(const f32x4*)(sn + (size_t)row * 32 + i0);
                        f32x4 a0, a1;
                        a0[0] = v0[0] * cc[0] - v0[1] * sv[0]; a0[1] = v0[1] * cc[0] + v0[0] * sv[0]; a0[2] = v0[2] * cc[1] - v0[3] * sv[1]; a0[3] = v0[3] * cc[1] + v0[2] * sv[1];
                        a1[0] = v1[0] * cc[2] - v1[1] * sv[2]; a1[1] = v1[1] * cc[2] + v1[0] * sv[2]; a1[2] = v1[2] * cc[3] - v1[3] * sv[3]; a1[3] = v1[3] * cc[3] + v1[2] * sv[3];
                        v0 = a0; v1 = a1;
                    }
                    if (stat && (pn != 8 || bj == 0)) ss += (v0[0] * v0[0] + v0[1] * v0[1]) + (v0[2] * v0[2] + v0[3] * v0[3]) + (v1[0] * v1[0] + v1[1] * v1[1]) + (v1[2] * v1[2] + v1[3] * v1[3]);
                    v4u w; w.x = pk2(v0[0], v0[1]); w.y = pk2(v0[2], v0[3]); w.z = pk2(v1[0], v1[1]); w.w = pk2(v1[2], v1[3]);
                    *(v4u*)(rowp + bj * 128) = w;
                }
                asm volatile("" ::: "memory");
                if (stat) { ss += __shfl_xor(ss, 16); ss += __shfl_xor(ss, 32);
                    if (fq == 0) { if (pn == 6) partkv[(size_t)row * 4 + wc] = ss; else partq[(size_t)row * 8 + (pn - 7) * 4 + wc] = ss; } }
            }
    }
};
struct EpiUq {
    static constexpr bool PERM = true; static constexpr int HOOK_T = 0;
    bf16* O; const float* cs; const float* sn; const float* partq;
    __device__ __forceinline__ void operator()(const f32x4 (&acc)[2][2][4][2], const pg8::Unit& u, int wr, int wc, int fr, int fq) const {
        const int row0 = u.pm * 256 + wr * 64 + fr, col0 = u.pn * 256 + wc * 32 + 8 * fq;
#pragma unroll
        for (int ai = 0; ai < 2; ++ai)
#pragma unroll
            for (int m = 0; m < 4; ++m) {
                const int row = row0 + ai * 128 + m * 16; bf16* rowp = O + (size_t)row * NQ + col0;
                const f32x4 p0 = *(const f32x4*)(partq + (size_t)row * 8), p1 = *(const f32x4*)(partq + (size_t)row * 8 + 4);
                const float rs = __builtin_amdgcn_rsqf(((p0[0] + p0[1]) + (p0[2] + p0[3]) + (p1[0] + p1[1]) + (p1[2] + p1[3])) * (1.f / 384.f) + EPS) * QSCALE;
#pragma unroll
                for (int bj = 0; bj < 2; ++bj) {
                    const int c = col0 + bj * 128; if (c >= 1152) continue;
                    f32x4 v0 = acc[ai][bj][m][0] * rs, v1 = acc[ai][bj][m][1] * rs; const int d = c % 192;
                    if (d >= 128) {
                        const int i0 = (d - 128) >> 1; const f32x4 cc = *(const f32x4*)(cs + (size_t)row * 32 + i0), sv = *(const f32x4*)(sn + (size_t)row * 32 + i0);
                        f32x4 a0, a1;
                        a0[0] = v0[0] * cc[0] - v0[1] * sv[0]; a0[1] = v0[1] * cc[0] + v0[0] * sv[0]; a0[2] = v0[2] * cc[1] - v0[3] * sv[1]; a0[3] = v0[3] * cc[1] + v0[2] * sv[1];
                        a1[0] = v1[0] * cc[2] - v1[1] * sv[2]; a1[1] = v1[1] * cc[2] + v1[0] * sv[2]; a1[2] = v1[2] * cc[3] - v1[3] * sv[3]; a1[3] = v1[3] * cc[3] + v1[2] * sv[3];
                        v0 = a0; v1 = a1;
                    }
                    v4u w; w.x = pk2(v0[0], v0[1]); w.y = pk2(v0[2], v0[3]); w.z = pk2(v1[0], v1[1]); w.w = pk2(v1[2], v1[3]);
                    *(v4u*)(rowp + bj * 128) = w;
                }
                asm volatile("" ::: "memory");
            }
    }
};
struct EpiUkv {
    static constexpr bool PERM = true; static constexpr int HOOK_T = 0;
    bf16* O; const float* partkv;
    __device__ __forceinline__ void operator()(const f32x4 (&acc)[2][2][4][2], const pg8::Unit& u, int wr, int wc, int fr, int fq) const {
        const int row0 = u.pm * 256 + wr * 64 + fr, col0 = u.pn * 256 + wc * 32 + 8 * fq;
#pragma unroll
        for (int ai = 0; ai < 2; ++ai)
#pragma unroll
            for (int m = 0; m < 4; ++m) {
                const int row = row0 + ai * 128 + m * 16; bf16* rowp = O + (size_t)row * NKV + col0;
                const f32x4 p0 = *(const f32x4*)(partkv + (size_t)row * 4);
                const float rs = __builtin_amdgcn_rsqf(((p0[0] + p0[1]) + (p0[2] + p0[3])) * (1.f / 256.f) + EPS);
#pragma unroll
                for (int bj = 0; bj < 2; ++bj) {
                    const f32x4 v0 = acc[ai][bj][m][0] * rs, v1 = acc[ai][bj][m][1] * rs;
                    v4u w; w.x = pk2(v0[0], v0[1]); w.y = pk2(v0[2], v0[3]); w.z = pk2(v1[0], v1[1]); w.w = pk2(v1[2], v1[3]);
                    *(v4u*)(rowp + bj * 128) = w;
                }
                asm volatile("" ::: "memory");
            }
    }
};
struct EpiOut {
    static constexpr bool PERM = false; static constexpr int HOOK_T = 12;
    const float* xin; float* out; const float* gate;
    const float* partm;
    __device__ __forceinline__ void hook(f32x4 (&acc)[2][2][4][2], const pg8::Unit& u, int wr, int wc, int fr, int fq) const {
        const int row0 = u.pm * 256 + wr * 64 + fr;
#pragma unroll
        for (int ai = 0; ai < 2; ++ai)
#pragma unroll
            for (int m = 0; m < 4; ++m) { const float* p = partm + (size_t)(row0 + ai * 128 + m * 16) * 8; const f32x4 p0 = *(const f32x4*)p; const float p4 = p[4], p5 = p[5];
                const float rs = __builtin_amdgcn_rsqf(((p0[0] + p0[1]) + (p0[2] + p0[3]) + (p4 + p5)) * (1.f / 768.f) + EPS);
#pragma unroll
                for (int bj = 0; bj < 2; ++bj)
#pragma unroll
                    for (int n = 0; n < 2; ++n) acc[ai][bj][m][n] *= rs; }
    }
    __device__ __forceinline__ void operator()(const f32x4 (&acc)[2][2][4][2], const pg8::Unit& u, int wr, int wc, int fr, int fq) const {
        const int row0 = u.pm * 256 + wr * 64 + fr, col0 = u.pn * 256 + wc * 32 + 4 * fq; const float* gb = gate + (size_t)(u.pm >> 3) * 3 * DM;
        f32x4 gv[2][2];
#pragma unroll
        for (int bj = 0; bj < 2; ++bj)
#pragma unroll
            for (int n = 0; n < 2; ++n) gv[bj][n] = *(const f32x4*)(gb + col0 + bj * 128 + n * 16);
#pragma unroll
        for (int ai = 0; ai < 2; ++ai)
#pragma unroll
            for (int m = 0; m < 4; ++m) {
                const size_t off = (size_t)(row0 + ai * 128 + m * 16) * DM + col0;
#pragma unroll
                for (int bj = 0; bj < 2; ++bj)
#pragma unroll
                    for (int n = 0; n < 2; ++n) { const f32x4 xv = *(const f32x4*)(xin + off + bj * 128 + n * 16); *(f32x4*)(out + off + bj * 128 + n * 16) = xv + gv[bj][n] * acc[ai][bj][m][n]; }
                asm volatile("" ::: "memory");
            }
    }
};

__device__ __forceinline__ void unpack8(const v4u w, float* f) { f[0] = bflo(w.x); f[1] = bfhi(w.x); f[2] = bflo(w.y); f[3] = bfhi(w.y); f[4] = bflo(w.z); f[5] = bfhi(w.z); f[6] = bflo(w.w); f[7] = bfhi(w.w); }

__device__ __forceinline__ int stg_pos(int c, int row) { return (c & 16) | ((c ^ (row & 7) ^ ((c >> 4) << 3)) & 15); }
__device__ __forceinline__ void stage_write(LAS float* st, const f32x16* acc, int r32, int hi) {
#pragma unroll
    for (int reg = 0; reg < 16; ++reg) { const int row = (reg & 3) + 8 * (reg >> 2) + 4 * hi;
#pragma unroll
        for (int dvb = 0; dvb < 4; ++dvb) { const int col = dvb * 32 + r32; st[row * 128 + stg_pos(col >> 2, row) * 4 + (col & 3)] = acc[dvb][reg]; } }
}
__device__ __forceinline__ void stage_read(const LAS float* st, int lane, float* v) {
    const int row = lane >> 1, half = lane & 1;
#pragma unroll
    for (int j = 0; j < 16; ++j) { const f32x4 q = *(const LAS f32x4*)(st + row * 128 + stg_pos(16 * half + j, row) * 4); v[4 * j] = q[0]; v[4 * j + 1] = q[1]; v[4 * j + 2] = q[2]; v[4 * j + 3] = q[3]; }
}
__device__ __forceinline__ void gated_store64(const float* v, float rs, const float* __restrict__ g, const bf16* __restrict__ zrow, bf16* __restrict__ yrow) {
    v4u zz[8];
#pragma unroll
    for (int j = 0; j < 8; ++j) zz[j] = *(const v4u*)(zrow + 8 * j);
#pragma unroll
    for (int j = 0; j < 8; ++j) { const f32x4 g0 = *(const f32x4*)(g + 8 * j), g1 = *(const f32x4*)(g + 8 * j + 4); float z[8]; unpack8(zz[j], z);
        v4u w; w.x = pk2(v[8 * j] * rs * g0[0] * z[0], v[8 * j + 1] * rs * g0[1] * z[1]); w.y = pk2(v[8 * j + 2] * rs * g0[2] * z[2], v[8 * j + 3] * rs * g0[3] * z[3]);
        w.z = pk2(v[8 * j + 4] * rs * g1[0] * z[4], v[8 * j + 5] * rs * g1[1] * z[5]); w.w = pk2(v[8 * j + 6] * rs * g1[2] * z[6], v[8 * j + 7] * rs * g1[3] * z[7]);
        *(v4u*)(yrow + 8 * j) = w; }
}

namespace mla {
constexpr int NW = 8, QBLK = 32, KVBLK = 64;
constexpr int SHM_V = 16384, SHM_KN = 16384, SHM_KR = 8192;
constexpr int OFF_V = 0, OFF_KN = 2 * SHM_V, OFF_KR = OFF_KN + 2 * SHM_KN, OFF_WS = OFF_KR + 2 * SHM_KR, OFF_QR = OFF_WS + NW * 64 * 4, ATTN_LDS = OFF_QR + NW * 4096;
constexpr float THR = 8.f;
#define KSWZ(row, colB) ((row) * 256 + ((colB) ^ (((row) & 7) << 4)))
#define KRSWZ(row, colB) ((row) * 128 + ((colB) ^ ((((row) >> 1) & 7) << 4)))
#define SBAR() __builtin_amdgcn_sched_barrier(0)
__device__ __forceinline__ int crow(int r, int hi) { return (r & 3) + 8 * (r >> 2) + 4 * hi; }
__device__ __forceinline__ unsigned cvtpk(float lo, float hi) { unsigned r; asm volatile("v_cvt_pk_bf16_f32 %0, %1, %2" : "=v"(r) : "v"(lo), "v"(hi)); return r; }

__device__ __forceinline__ void partialSM(f32x16& p0, f32x16& p1, float& m_reg, float& mn, float& alpha) {
  float pmax = p0[0];
#pragma unroll
  for (int r = 1; r < 16; ++r) pmax = fmaxf(pmax, p0[r]);
#pragma unroll
  for (int r = 0; r < 16; ++r) pmax = fmaxf(pmax, p1[r]);
  { auto rr = __builtin_amdgcn_permlane32_swap(__float_as_uint(pmax), __float_as_uint(pmax), false, false);
    pmax = fmaxf(__uint_as_float(rr[0]), __uint_as_float(rr[1])); }
  if (__builtin_expect(__all(pmax - m_reg <= THR), 1)) { mn = m_reg; alpha = 1.f; }
  else { mn = fmaxf(m_reg, pmax); alpha = __builtin_amdgcn_exp2f(m_reg - mn); m_reg = mn; }
#pragma unroll
  for (int r = 0; r < 16; ++r) p0[r] = p0[r] - mn;
#pragma unroll
  for (int r = 0; r < 16; ++r) p1[r] = p1[r] - mn;
#pragma unroll
  for (int r = 0; r < 16; ++r) p0[r] = __builtin_amdgcn_exp2f(p0[r]);
}
__device__ __forceinline__ void finishSM(f32x16& p0, f32x16& p1, float alpha, float& l_reg, bf16x8& pa0, bf16x8& pa1, bf16x8& pa2, bf16x8& pa3) {
#pragma unroll
  for (int r = 0; r < 16; ++r) p1[r] = __builtin_amdgcn_exp2f(p1[r]);
  float ps = 0;
#pragma unroll
  for (int r = 0; r < 16; ++r) ps += p0[r];
#pragma unroll
  for (int r = 0; r < 16; ++r) ps += p1[r];
  { auto rr = __builtin_amdgcn_permlane32_swap(__float_as_uint(ps), __float_as_uint(ps), false, false);
    ps = __uint_as_float(rr[0]) + __uint_as_float(rr[1]); }
  l_reg = l_reg * alpha + ps;
#define PK4(P, BASE, OUT) do { unsigned a0 = cvtpk(P[BASE + 0], P[BASE + 1]), a1 = cvtpk(P[BASE + 2], P[BASE + 3]);   \
    unsigned b0 = cvtpk(P[BASE + 4], P[BASE + 5]), b1 = cvtpk(P[BASE + 6], P[BASE + 7]);                              \
    auto r0 = __builtin_amdgcn_permlane32_swap(a0, b0, false, false); auto r1 = __builtin_amdgcn_permlane32_swap(a1, b1, false, false); \
    v4u w = {r0[0], r1[0], r0[1], r1[1]}; OUT = *reinterpret_cast<bf16x8*>(&w); } while (0)
  PK4(p0, 0, pa0); PK4(p0, 8, pa1); PK4(p1, 0, pa2); PK4(p1, 8, pa3);
#undef PK4
}
__device__ __forceinline__ void qkt(f32x16& p0, f32x16& p1, const char* Kn, const char* Kr, const bf16x8* qr, const char* Qr, int r32, int hi) {
  p0 = f32x16{}; p1 = f32x16{};
  int tn = (hi * 16) ^ ((r32 & 7) << 4), tr = (hi * 16) ^ (((r32 >> 1) & 7) << 4);
  asm volatile("" : "+v"(tn), "+v"(tr));
  const char* knb = Kn + r32 * 256; const char* krb = Kr + r32 * 128; const char* qrb = Qr + r32 * 128;
#pragma unroll
  for (int d0 = 0; d0 < 8; ++d0) { const int off = (d0 * 32) ^ tn;
    const bf16x8 b0 = *reinterpret_cast<const bf16x8*>(knb + off);
    const bf16x8 b1 = *reinterpret_cast<const bf16x8*>(knb + off + 8192);
    p0 = __builtin_amdgcn_mfma_f32_32x32x16_bf16(b0, qr[d0], p0, 0, 0, 0);
    p1 = __builtin_amdgcn_mfma_f32_32x32x16_bf16(b1, qr[d0], p1, 0, 0, 0); }
#pragma unroll
  for (int d0 = 0; d0 < 4; ++d0) { const int off = (d0 * 32) ^ tr;
    const bf16x8 b0 = *reinterpret_cast<const bf16x8*>(krb + off);
    const bf16x8 b1 = *reinterpret_cast<const bf16x8*>(krb + off + 4096);
    const bf16x8 qv = *reinterpret_cast<const bf16x8*>(qrb + off);
    p0 = __builtin_amdgcn_mfma_f32_32x32x16_bf16(b0, qv, p0, 0, 0, 0);
    p1 = __builtin_amdgcn_mfma_f32_32x32x16_bf16(b1, qv, p1, 0, 0, 0); }
}
__device__ __forceinline__ int v_st(int k, int c) { const int kk = (k & ~0xC) | ((k & 4) << 1) | ((k & 8) >> 1); return ((kk >> 3) * 4 + (c >> 5)) * 512 + ((kk & 7) * 32 + (c & 31)) * 2; }
__device__ __forceinline__ int v_rd_base(int lane) { return ((lane & 3) << 3) | (((lane >> 2) & 3) << 6) | (((lane >> 4) & 1) << 5) | (((lane >> 5) & 1) << 8); }
constexpr int v_rd_off(int d0, int ks, int half) { return d0 * 512 + ks * 4096 + half * 2048; }
template <int OFF> __device__ __forceinline__ s16x4 tr_read(int vb) {
  s16x4 r; asm volatile("ds_read_b64_tr_b16 %0, %1 offset:%2" : "=&v"(r) : "v"(vb), "i"(OFF) : "memory"); return r;
}
template <int D0> __device__ __forceinline__ void pv_one(f32x16& od, int vb, bf16x8 pa0, bf16x8 pa1, bf16x8 pa2, bf16x8 pa3) {
  const s16x4 l0 = tr_read<v_rd_off(D0, 0, 0)>(vb), h0 = tr_read<v_rd_off(D0, 0, 1)>(vb), l1 = tr_read<v_rd_off(D0, 1, 0)>(vb), h1 = tr_read<v_rd_off(D0, 1, 1)>(vb);
  const s16x4 l2 = tr_read<v_rd_off(D0, 2, 0)>(vb), h2 = tr_read<v_rd_off(D0, 2, 1)>(vb), l3 = tr_read<v_rd_off(D0, 3, 0)>(vb), h3 = tr_read<v_rd_off(D0, 3, 1)>(vb);
  asm volatile("s_waitcnt lgkmcnt(0)" ::: "memory"); SBAR();
#define PK(L, H) (bf16x8){L[0], L[1], L[2], L[3], H[0], H[1], H[2], H[3]}
  od = __builtin_amdgcn_mfma_f32_32x32x16_bf16(pa0, PK(l0, h0), od, 0, 0, 0);
  od = __builtin_amdgcn_mfma_f32_32x32x16_bf16(pa1, PK(l1, h1), od, 0, 0, 0);
  od = __builtin_amdgcn_mfma_f32_32x32x16_bf16(pa2, PK(l2, h2), od, 0, 0, 0);
  od = __builtin_amdgcn_mfma_f32_32x32x16_bf16(pa3, PK(l3, h3), od, 0, 0, 0);
#undef PK
}
__device__ __forceinline__ void pv_d0(f32x16* o, int vb, bf16x8 pa0, bf16x8 pa1, bf16x8 pa2, bf16x8 pa3) {
  pv_one<0>(o[0], vb, pa0, pa1, pa2, pa3); pv_one<1>(o[1], vb, pa0, pa1, pa2, pa3); pv_one<2>(o[2], vb, pa0, pa1, pa2, pa3); pv_one<3>(o[3], vb, pa0, pa1, pa2, pa3);
}

__device__ __forceinline__ void attn_unit(const bf16* __restrict__ Qb, const bf16* __restrict__ Knh, const bf16* __restrict__ Vh, const bf16* __restrict__ Krh,
                                          bf16* __restrict__ Yb, const bf16* __restrict__ Zb, const float* __restrict__ gh, float* __restrict__ part, int seq, char* lds) {
  int tid_ = threadIdx.x; asm volatile("" : "+v"(tid_));
  const int tid = tid_, wid = tid >> 6, lane = tid & 63, r32 = lane & 31, hi = lane >> 5;
  char* V_lds = lds + OFF_V; char* KN_lds = lds + OFF_KN; char* KR_lds = lds + OFF_KR;
  float* ws = (float*)(lds + OFF_WS) + wid * 64; float* li_l = ws; float* al_l = ws + 32;
  float m_reg = -1e30f, l_reg = 0; f32x16 o[4] = {}; bf16x8 qr[8]; char* QR_lds = lds + OFF_QR + wid * 4096;
  const bf16* Qw = Qb + (long)(wid * QBLK + r32) * NQ + hi * 8;
#pragma unroll
  for (int d0 = 0; d0 < 8; ++d0) qr[d0] = *reinterpret_cast<const bf16x8*>(Qw + d0 * 16);
#pragma unroll
  for (int d0 = 0; d0 < 4; ++d0) *reinterpret_cast<bf16x8*>(QR_lds + KRSWZ(r32, (d0 * 16 + hi * 8) * 2)) = *reinterpret_cast<const bf16x8*>(Qw + 128 + d0 * 16);
  const int sr = tid >> 4, sc = (tid & 15) * 8, vst0 = v_st(sr, sc), vst1 = v_st(32 + sr, sc);
  const int krr = tid >> 3, krc = (tid & 7) * 8;
  const int vb0 = (int)(uintptr_t)V_lds + v_rd_base(lane);
  bf16x8 vs0, vs1, ks0, ks1, kr0;
#define SLOAD(k0) do { vs0 = *reinterpret_cast<const bf16x8*>(&Vh[(long)((k0) + sr) * NKV + sc]); vs1 = *reinterpret_cast<const bf16x8*>(&Vh[(long)((k0) + 32 + sr) * NKV + sc]); \
    ks0 = *reinterpret_cast<const bf16x8*>(&Knh[(long)((k0) + sr) * NKV + sc]); ks1 = *reinterpret_cast<const bf16x8*>(&Knh[(long)((k0) + 32 + sr) * NKV + sc]); \
    kr0 = *reinterpret_cast<const bf16x8*>(&Krh[(long)((k0) + krr) * NP + krc]); } while (0)
#define SWRITE(b) do { *(bf16x8*)(V_lds + (b) * SHM_V + vst0) = vs0; *(bf16x8*)(V_lds + (b) * SHM_V + vst1) = vs1; const int kc = sc * 2;   \
    *(bf16x8*)(KN_lds + (b) * SHM_KN + KSWZ(sr, kc)) = ks0; *(bf16x8*)(KN_lds + (b) * SHM_KN + KSWZ(32 + sr, kc)) = ks1;                       \
    *(bf16x8*)(KR_lds + (b) * SHM_KR + KRSWZ(krr, krc * 2)) = kr0; } while (0)
#define SWAIT() asm volatile("s_waitcnt vmcnt(0)" ::: "memory")
#define RESC(a) do { if (__any((a) < 1.f)) { if (hi == 0) al_l[r32] = (a); asm volatile("s_waitcnt lgkmcnt(0)" ::: "memory"); \
    _Pragma("unroll") for (int d = 0; d < 4; ++d) _Pragma("unroll") for (int r = 0; r < 16; ++r) o[d][r] *= al_l[crow(r, hi)]; } } while (0)
  f32x16 pA0, pA1, pB0, pB1; float mnA, mnB, alA, alB; bf16x8 pa0, pa1, pa2, pa3; const int NT = seq / KVBLK;
  SLOAD(0); SWAIT(); SWRITE(0); __syncthreads();
  qkt(pA0, pA1, KN_lds, KR_lds, qr, QR_lds, r32, hi); partialSM(pA0, pA1, m_reg, mnA, alA);
  SLOAD(KVBLK);
  SWAIT(); SWRITE(1); __syncthreads();
  for (int j = 1; j + 1 < NT; j += 2) {
    SBAR(); qkt(pB0, pB1, KN_lds + SHM_KN, KR_lds + SHM_KR, qr, QR_lds, r32, hi);
    finishSM(pA0, pA1, alA, l_reg, pa0, pa1, pa2, pa3); SBAR();
    SLOAD((j + 1) * KVBLK); SBAR();
    pv_d0(o, vb0, pa0, pa1, pa2, pa3); partialSM(pB0, pB1, m_reg, mnB, alB);
    __syncthreads(); SWAIT(); SWRITE(0);
    RESC(alB); __syncthreads();
    SBAR(); qkt(pA0, pA1, KN_lds, KR_lds, qr, QR_lds, r32, hi);
    finishSM(pB0, pB1, alB, l_reg, pa0, pa1, pa2, pa3); SBAR();
    SLOAD((j + 2) * KVBLK); SBAR();
    pv_d0(o, vb0 + SHM_V, pa0, pa1, pa2, pa3); partialSM(pA0, pA1, m_reg, mnA, alA);
    __syncthreads(); SWAIT(); SWRITE(1);
    RESC(alA); __syncthreads();
  }
  SBAR(); qkt(pB0, pB1, KN_lds + SHM_KN, KR_lds + SHM_KR, qr, QR_lds, r32, hi);
  finishSM(pA0, pA1, alA, l_reg, pa0, pa1, pa2, pa3); SBAR();
  pv_d0(o, vb0, pa0, pa1, pa2, pa3); partialSM(pB0, pB1, m_reg, mnB, alB);
  __syncthreads(); RESC(alB);
  finishSM(pB0, pB1, alB, l_reg, pa0, pa1, pa2, pa3); SBAR();
  pv_d0(o, vb0 + SHM_V, pa0, pa1, pa2, pa3);
  if (hi == 0) li_l[r32] = l_reg; asm volatile("s_waitcnt lgkmcnt(0)" ::: "memory");
  float rli[16];
#pragma unroll
  for (int r = 0; r < 16; ++r) rli[r] = __builtin_amdgcn_rcpf(li_l[crow(r, hi)]);
#pragma unroll
  for (int d0 = 0; d0 < 4; ++d0)
#pragma unroll
    for (int r = 0; r < 16; ++r) o[d0][r] *= rli[r];
  __syncthreads();
  { LAS float* st = (LAS float*)(LAS unsigned char*)(lds + wid * 16384);
    stage_write(st, o, r32, hi);
    asm volatile("s_waitcnt lgkmcnt(0)" ::: "memory");
    float v[64]; stage_read(st, lane, v);
    const int row = lane >> 1, half = lane & 1; const long rr = wid * QBLK + row;
    float ss = 0.f;
#pragma unroll
    for (int j = 0; j < 64; ++j) ss += v[j] * v[j];
    ss += __shfl_xor(ss, 1);
    if (half == 0) part[rr * 8] = ss;
    gated_store64(v, 1.f, gh + half * 64, Zb + rr * NP + half * 64, Yb + rr * DM + half * 64); }
  __syncthreads();
#undef SLOAD
#undef SWRITE
#undef SWAIT
#undef RESC
}
#undef SBAR
}
struct Frame {
    LAS unsigned char* lds; char* ldsg;
    int tid, lane, wave, vcu, G;
    float* out; unsigned char* ws;
};
__device__ __forceinline__ const float* ld_in(int i) {
    const __attribute__((address_space(4))) char* ka = (const __attribute__((address_space(4))) char*)__builtin_amdgcn_kernarg_segment_ptr();
    asm volatile("" : "+s"(i));
    const GAS float* p = *(const GAS float* const __attribute__((address_space(4)))*)(ka + 8 * i);
    return (const float*)p;
}
#define WSP(T_, off) ((T_*)(F.ws + (off)))

__device__ __forceinline__ void p0_mods(Frame& F, size_t mods_off) {
    LAS float* sc = (LAS float*)F.lds;
    LAS float* part = (LAS float*)(F.lds + 32768);
    const float* c = ld_in(1); const float* aw = ld_in(3); const float* ab = ld_in(4);
    for (int i = F.tid; i < BATCH * DM; i += NTHR) { const float v = c[i]; sc[i] = v / (1.f + __expf(-v)); }
    __syncthreads();
    for (int item = (int)blockIdx.x; item < 768; item += F.G) {
        const int ks = item & 15, cb = (item >> 4) % 24, l = item / 384, j0 = cb * 256, kb = ks * 128 + F.wave * 16;
        const f32x4* w = (const f32x4*)(aw + (size_t)l * DM * 3 * DM + (size_t)kb * 3 * DM + j0) + F.lane;
        f32x4 wv[16];
#pragma unroll
        for (int k = 0; k < 16; ++k) wv[k] = w[(size_t)k * (3 * DM / 4)];
        f32x4 a[4] = {};
#pragma unroll
        for (int k = 0; k < 16; ++k)
#pragma unroll
            for (int b = 0; b < 4; ++b) a[b] += wv[k] * sc[b * DM + kb + k];
#pragma unroll
        for (int b = 0; b < 4; ++b) *(LAS f32x4*)(part + (F.wave * 4 + b) * 256 + F.lane * 4) = a[b];
        __syncthreads();
        for (int o = F.tid; o < 1024; o += NTHR) { const int b = o >> 8, col = o & 255; float s = 0.f;
#pragma unroll
            for (int wv2 = 0; wv2 < 8; ++wv2) s += part[(wv2 * 4 + b) * 256 + col];
            if (ks == 0) s += ab[l * 3 * DM + j0 + col];
            atomicAdd(WSP(float, mods_off) + ((size_t)l * BATCH + b) * 3 * DM + j0 + col, s); }
        __syncthreads();
    }
}
__device__ __forceinline__ int kmap_out(int k) { return k < 768 ? k + 768 : (k < 1536 ? k - 768 : k); }
template <int MAP, bool KMAP> __device__ __forceinline__ void p0_transpose_item(const float* W, int K, int N, bf16* WT, const float* kgain, LAS bf16* tl, int item, int nblk, int lane) {
    const int kb = item / nblk, nb = item % nblk, k0 = 64 * kb, n0 = 64 * nb, ks0 = KMAP ? kmap_out(k0) : k0;
    const int nq = (lane & 15) * 4, kr = lane >> 4;
    const int s0 = MAP == 1 ? map_in(n0) : (MAP == 2 ? map_uq(n0) : n0), s63 = MAP == 1 ? map_in(n0 + 63) : (MAP == 2 ? map_uq(n0 + 63) : n0 + 63);
    const int s1 = MAP == 1 ? map_in(n0 + 1) : (MAP == 2 ? map_uq(n0 + 1) : n0 + 1);
    if (s0 >= 0 && s63 - s0 == 63 && s1 == s0 + 1) {
        f32x4 v[16];
#pragma unroll
        for (int i = 0; i < 16; ++i) v[i] = *(const f32x4*)(W + (size_t)(ks0 + 4 * i + kr) * N + s0 + nq);
#pragma unroll
        for (int i = 0; i < 16; ++i) { const int kk = 4 * i + kr; const float gsc = kgain ? kgain[k0 + kk] : 1.f;
#pragma unroll
            for (int e = 0; e < 4; ++e) tl[(nq + e) * 72 + kk] = (unsigned short)f2bf(v[i][e] * gsc); }
    } else {
        const int np = n0 + lane; const int src = MAP == 1 ? map_in(np) : (MAP == 2 ? map_uq(np) : np);
        float v[64];
#pragma unroll
        for (int i = 0; i < 64; ++i) v[i] = src >= 0 ? W[(size_t)(ks0 + i) * N + src] : 0.f;
#pragma unroll
        for (int i = 0; i < 64; i += 2) { const float g0 = kgain ? kgain[k0 + i] : 1.f, g1 = kgain ? kgain[k0 + i + 1] : 1.f;
            *(LAS unsigned*)(tl + lane * 72 + i) = pk2(v[i] * g0, v[i + 1] * g1); }
    }
    LDS_WAIT(); asm volatile("" ::: "memory");
    bf16* orow = WT + (size_t)(n0 + lane) * K + k0;
#pragma unroll
    for (int cch = 0; cch < 8; ++cch) *(GAS v4u*)(orow + 8 * cch) = *(const LAS v4u*)(tl + lane * 72 + 8 * cch);
    LDS_WAIT(); asm volatile("" ::: "memory");
}
__device__ __forceinline__ void p0_prologue(Frame& F, size_t mods_off) {
    p0_mods(F, mods_off);
    LAS bf16* tl = (LAS bf16*)(F.lds + F.wave * 9216);
    const int gw = F.vcu * NWAVES + F.wave, NGW = F.G * NWAVES;
    constexpr int I_IN = (DM / 64) * (NP / 64), I_OUT = (DM / 64) * (DM / 64), I_UQ = (384 / 64) * (NQ / 64), I_UKV = (256 / 64) * (NKV / 64), I_L = I_IN + I_OUT + I_UQ + I_UKV;
    for (int it = gw; it < DEPTH * I_L; it += NGW) {
        const int l = it / I_L; int r = it % I_L;
        if (r < I_IN) { p0_transpose_item<1, false>(ld_in(6) + (size_t)l * DM * IN_DIM, DM, IN_DIM, WSP(bf16, WS_WIN) + (size_t)l * NP * DM, nullptr, tl, r, NP / 64, F.lane); continue; } r -= I_IN;
        if (r < I_OUT) { p0_transpose_item<0, true>(ld_in(19) + (size_t)l * DM * DM, DM, DM, WSP(bf16, WS_WOUT) + (size_t)l * DM * DM, nullptr, tl, r, DM / 64, F.lane); continue; } r -= I_OUT;
        if (r < I_UQ) { p0_transpose_item<2, false>(ld_in(14) + (size_t)l * 384 * 1152, 384, 1152, WSP(bf16, WS_WUQ) + (size_t)l * NQ * 384, ld_in(12) + l * 384, tl, r, NQ / 64, F.lane); continue; } r -= I_UQ;
        p0_transpose_item<0, false>(ld_in(15) + (size_t)l * 256 * 1536, 256, 1536, WSP(bf16, WS_WUKV) + (size_t)l * NKV * 256, ld_in(13) + l * 256, tl, r, NKV / 64, F.lane);
    }
    const int* pos = (const int*)ld_in(2);
    for (int i = (int)blockIdx.x * NTHR + F.tid; i < T * 32; i += F.G * NTHR) {
        const int t = i >> 5, f = i & 31;
        const float inv = (float)exp2(-(double)f * (13.287712379549449 / 32.0));
        const float ang = (float)pos[t] * inv;
        const double rev = (double)ang * 0.15915494309189535; const float fr = (float)(rev - floor(rev));
        WSP(float, WS_CS)[i] = __builtin_amdgcn_cosf(fr); WSP(float, WS_SN)[i] = __builtin_amdgcn_sinf(fr);
    }
}
__device__ __forceinline__ void modnorm_rows(Frame& F, const float* x, const float* g, const float* mods_l, bf16* H) {
    const int gw = F.vcu * NWAVES + F.wave, NGW = F.G * NWAVES;
    for (int t = gw; t < T; t += NGW) {
        const GAS f32x4* xr = (const GAS f32x4*)(x + (size_t)t * DM) + F.lane;
        f32x4 v[8]; float s = 0.f;
#pragma unroll
        for (int j = 0; j < 8; ++j) { v[j] = xr[64 * j]; s += (v[j][0] * v[j][0] + v[j][1] * v[j][1]) + (v[j][2] * v[j][2] + v[j][3] * v[j][3]); }
        const float rstd = __builtin_amdgcn_rsqf(wave_sum(s) * (1.f / DM) + EPS);
        const float* sh = mods_l + (size_t)(t / SEQ) * 3 * DM; const float* scl = sh + DM;
        GAS v2u* o8 = (GAS v2u*)(H + (size_t)t * DM) + F.lane;
#pragma unroll
        for (int j = 0; j < 8; ++j) { const int col = (F.lane + 64 * j) * 4;
            const f32x4 gg = *(const f32x4*)(g + col), sv = *(const f32x4*)(scl + col), hv = *(const f32x4*)(sh + col);
            const f32x4 r = v[j] * rstd * gg * (sv + 1.f) + hv;
            v2u w; w.x = pk2(r[0], r[1]); w.y = pk2(r[2], r[3]); o8[64 * j] = w; }
    }
}
__device__ __forceinline__ void finalnorm_rows(Frame& F, float* x, const float* g) {
    const int gw = F.vcu * NWAVES + F.wave, NGW = F.G * NWAVES;
    for (int t = gw; t < T; t += NGW) {
        GAS f32x4* xr = (GAS f32x4*)(x + (size_t)t * DM) + F.lane;
        f32x4 v[8]; float s = 0.f;
#pragma unroll
        for (int j = 0; j < 8; ++j) { v[j] = xr[64 * j]; s += (v[j][0] * v[j][0] + v[j][1] * v[j][1]) + (v[j][2] * v[j][2] + v[j][3] * v[j][3]); }
        const float rstd = __builtin_amdgcn_rsqf(wave_sum(s) * (1.f / DM) + EPS);
#pragma unroll
        for (int j = 0; j < 8; ++j) { const f32x4 gg = *(const f32x4*)(g + (F.lane + 64 * j) * 4); xr[64 * j] = v[j] * rstd * gg; }
    }
}
__device__ __forceinline__ void conv_rows(Frame& F, int l) {
    const int gw = F.vcu * NWAVES + F.wave, NGW = F.G * NWAVES;
    const bf16* P = WSP(bf16, WS_PROJ); bf16* Y = WSP(bf16, WS_HY);
    const float* cw = ld_in(17) + l * 3 * 512; const float* cg = ld_in(18) + l * 512;
    const int ch = F.lane * 8;
    for (int t = gw; t < T; t += NGW) {
        const int s = t % SEQ; const bf16* p = P + (size_t)t * NP;
        float u[3][8];
#pragma unroll
        for (int d = 0; d < 3; ++d) { const int ss = s + d - 1;
            if (ss >= 0 && ss < SEQ) { const bf16* q = p + (long)(d - 1) * NP; float a[8], b[8]; unpack8(*(const v4u*)(q + C_CC + ch), a); unpack8(*(const v4u*)(q + C_CX + ch), b);
#pragma unroll
                for (int e = 0; e < 8; ++e) u[d][e] = a[e] * b[e]; }
            else {
#pragma unroll
                for (int e = 0; e < 8; ++e) u[d][e] = 0.f; } }
        float cb[8], sz[8], pre[8]; unpack8(*(const v4u*)(p + C_CB + ch), cb); unpack8(*(const v4u*)(p + C_Z + 1536 + ch), sz);
        float ssq = 0.f;
#pragma unroll
        for (int e = 0; e < 8; ++e) { pre[e] = cb[e] * (u[0][e] * cw[ch + e] + u[1][e] * cw[512 + ch + e] + u[2][e] * cw[1024 + ch + e]); ssq += pre[e] * pre[e]; }
        const float rstd = __builtin_amdgcn_rsqf(wave_sum(ssq) * (1.f / 512.f) + EPS);
        float r[8];
#pragma unroll
        for (int e = 0; e < 8; ++e) r[e] = pre[e] * rstd * cg[ch + e] * sz[e];
        v4u w; w.x = pk2(r[0], r[1]); w.y = pk2(r[2], r[3]); w.z = pk2(r[4], r[5]); w.w = pk2(r[6], r[7]);
        *(v4u*)(Y + (size_t)t * DM + 1536 + ch) = w;
    }
}
__device__ __forceinline__ void mlaout_rows(Frame& F, int l) {
    const int gw = F.vcu * NWAVES + F.wave, NGW = F.G * NWAVES;
    const bf16* P = WSP(bf16, WS_PROJ); bf16* Y = WSP(bf16, WS_HY); const float* O = WSP(float, WS_OMLA); const float* g = ld_in(16) + l * 768;
    for (int t = gw; t < T; t += NGW) {
        f32x4 v[3]; float s = 0.f;
#pragma unroll
        for (int j = 0; j < 3; ++j) { v[j] = *(const f32x4*)(O + (size_t)t * 768 + (F.lane + 64 * j) * 4); s += (v[j][0] * v[j][0] + v[j][1] * v[j][1]) + (v[j][2] * v[j][2] + v[j][3] * v[j][3]); }
        const float rstd = __builtin_amdgcn_rsqf(wave_sum(s) * (1.f / 768.f) + EPS);
#pragma unroll
        for (int j = 0; j < 3; ++j) { const int col = (F.lane + 64 * j) * 4; const f32x4 gg = *(const f32x4*)(g + col);
            const v2u zw = *(const v2u*)(P + (size_t)t * NP + C_Z + 768 + col);
            const f32x4 r = v[j] * rstd * gg; v2u w; w.x = pk2(r[0] * bflo(zw.x), r[1] * bfhi(zw.x)); w.y = pk2(r[2] * bflo(zw.y), r[3] * bfhi(zw.y));
            *(v2u*)(Y + (size_t)t * DM + col) = w; }
    }
}


template <int KS> __device__ __forceinline__ f32x16 tile_mm(const LAS bf16* A, const LAS bf16* Bt, int r, int hh, f32x16 acc) {
#pragma unroll
    for (int s = 0; s < KS; ++s) {
        const bf16x8 a = *(const LAS bf16x8*)(A + r * 72 + 16 * s + 8 * hh), b = *(const LAS bf16x8*)(Bt + r * 72 + 16 * s + 8 * hh);
        acc = __builtin_amdgcn_mfma_f32_32x32x16_bf16(a, b, acc, 0, 0, 0);
    }
    return acc;
}
__device__ __forceinline__ float logsig16(float a) { return (fminf(a, 0.f) - __logf(1.f + __expf(-fabsf(a)))) * (1.f / 16.f); }
__device__ __forceinline__ void gla_a_item(Frame& F, int l, int item) {
    const int h = item % 6, bn = item / 6, t0 = bn * 64;
    const int tid = F.tid, lane = F.lane, wave = F.wave;
    LAS unsigned char* L = F.lds;
    LAS bf16* QB = (LAS bf16*)(L);
    LAS bf16* KB = (LAS bf16*)(L + 9216);
    LAS bf16* Mm = (LAS bf16*)(L);
    LAS bf16* VT = (LAS bf16*)(L + 18432);
    LAS float* LR = (LAS float*)(L + 36864);
    LAS float* WG = (LAS float*)(L + 36864 + 8192);
    LAS float* BG = (LAS float*)(L + 36864 + 16384);
    LAS bf16* KDT = (LAS bf16*)(L + 36864);
    LAS float* LA = (LAS float*)(L + 55296);
    LAS float* SEGT = (LAS float*)(L + 88576);
    LAS bf16* QF = (LAS bf16*)(L + 90624);
    LAS bf16* KF = (LAS bf16*)(L + 90624 + 18432);
    const bf16* P = WSP(bf16, WS_PROJ) + (size_t)t0 * NP;
    { const int r = tid >> 3, c8 = (tid & 7) * 8;
      *(LAS v4u*)(QB + r * 72 + c8) = *(const v4u*)(P + (size_t)r * NP + C_GQ + h * 64 + c8);
      *(LAS v4u*)(KB + r * 72 + c8) = *(const v4u*)(P + (size_t)r * NP + C_GK + h * 64 + c8); }
#pragma unroll
    for (int i = 0; i < 2; ++i) { const int idx = tid + i * 512, r = idx >> 4, c8 = (idx & 15) * 8;
        const v4u raw = *(const v4u*)(P + (size_t)r * NP + C_GV + h * 128 + c8);
        VT[(c8 + 0) * 72 + r] = (unsigned short)(raw.x & 0xffffu); VT[(c8 + 1) * 72 + r] = (unsigned short)(raw.x >> 16);
        VT[(c8 + 2) * 72 + r] = (unsigned short)(raw.y & 0xffffu); VT[(c8 + 3) * 72 + r] = (unsigned short)(raw.y >> 16);
        VT[(c8 + 4) * 72 + r] = (unsigned short)(raw.z & 0xffffu); VT[(c8 + 5) * 72 + r] = (unsigned short)(raw.z >> 16);
        VT[(c8 + 6) * 72 + r] = (unsigned short)(raw.w & 0xffffu); VT[(c8 + 7) * 72 + r] = (unsigned short)(raw.w >> 16); }
    if (tid < 256) { const int r = tid >> 2, c8 = (tid & 3) * 8; float f[8]; unpack8(*(const v4u*)(P + (size_t)r * NP + C_LR + c8), f);
#pragma unroll
        for (int e = 0; e < 8; ++e) LR[r * 32 + c8 + e] = f[e]; }
    { const int dir = tid >> 8, r = (tid >> 4) & 15, c4 = (tid & 15) * 4; const float* wgf_ = ld_in(7); const float* wgb_ = ld_in(9); const float* wsrc = (dir ? wgb_ : wgf_) + (size_t)l * 16 * 384 + r * 384 + h * 64 + c4;
      *(LAS f32x4*)(WG + (dir * 16 + r) * 64 + c4) = *(const f32x4*)wsrc; }
    if (tid < 128) { const int dir = tid >> 6, dk = tid & 63; const float* bgf_ = ld_in(8); const float* bgb_ = ld_in(10); BG[dir * 64 + dk] = (dir ? bgb_ : bgf_)[l * 384 + h * 64 + dk]; }
    LDS_WAIT(); __syncthreads();
    { const int tok = tid >> 3, dkg = (tid & 7) * 8;
#pragma unroll
      for (int dir = 0; dir < 2; ++dir) { float a[8];
#pragma unroll
        for (int e = 0; e < 8; ++e) a[e] = BG[dir * 64 + dkg + e];
#pragma unroll
        for (int r = 0; r < 16; ++r) { const float x = LR[tok * 32 + dir * 16 + r];
#pragma unroll
            for (int e = 0; e < 8; ++e) a[e] += x * WG[(dir * 16 + r) * 64 + dkg + e]; }
#pragma unroll
        for (int e = 0; e < 8; ++e) LA[(dir * 64 + tok) * 65 + dkg + e] = logsig16(a[e]); } }
    LDS_WAIT(); __syncthreads();
    const int cdir = (tid >> 6) & 1, cdk = tid & 63, seg = tid >> 7;
    float pb[16];
#pragma unroll
    for (int i = 0; i < 16; ++i) pb[i] = LA[(cdir * 64 + seg * 16 + i) * 65 + cdk];
    if (cdir == 0) {
#pragma unroll
        for (int i = 1; i < 16; ++i) pb[i] += pb[i - 1];
    } else {
#pragma unroll
        for (int i = 14; i >= 0; --i) pb[i] += pb[i + 1];
    }
    SEGT[(cdir * 4 + seg) * 64 + cdk] = cdir == 0 ? pb[15] : pb[0];
    LDS_WAIT(); __syncthreads();
    { float offv = 0.f, tot = 0.f;
#pragma unroll
      for (int s2 = 0; s2 < 4; ++s2) { const float sv = SEGT[(cdir * 4 + s2) * 64 + cdk]; tot += sv; if (cdir == 0 ? (s2 < seg) : (s2 > seg)) offv += sv; }
      bf16* QD = WSP(bf16, WS_QDEC) + (size_t)cdir * T * 384 + (size_t)t0 * 384 + h * 64 + cdk;
      unsigned kd[8];
#pragma unroll
      for (int i = 0; i < 16; ++i) { const int tok = seg * 16 + i; const float bv = pb[i] + offv;
          const float q = bf2f(QB[tok * 72 + cdk]), k = bf2f(KB[tok * 72 + cdk]);
          const unsigned short qd = (unsigned short)f2bf(q * 0.125f * __expf(bv)), ki = (unsigned short)f2bf(k * __expf(-bv)), kdv = (unsigned short)f2bf(k * __expf(tot - bv));
          QF[(cdir * 64 + tok) * 72 + cdk] = qd; KF[(cdir * 64 + tok) * 72 + cdk] = ki; QD[(size_t)tok * 384] = qd;
          if (i & 1) kd[i >> 1] |= (unsigned)kdv << 16; else kd[i >> 1] = kdv;
          if ((i & 3) == 3) __builtin_amdgcn_sched_barrier(0); }
      *(LAS v4u*)(KDT + (cdir * 64 + cdk) * 72 + seg * 16) = (v4u){kd[0], kd[1], kd[2], kd[3]};
      *(LAS v4u*)(KDT + (cdir * 64 + cdk) * 72 + seg * 16 + 8) = (v4u){kd[4], kd[5], kd[6], kd[7]};
      if (seg == 0) WSP(float, WS_DECAY)[((size_t)item * 2 + cdir) * 64 + cdk] = __expf(tot); }
    LDS_WAIT(); __syncthreads();
    const int r = lane & 31, hh = lane >> 5;
    if (wave < 4) {
        const int pb2 = wave >> 1, jb = wave & 1; f32x16 sf = {}, sb = {};
        if (pb2 >= jb) sf = tile_mm<4>(QF + (0 * 64 + pb2 * 32) * 72, KF + (0 * 64 + jb * 32) * 72, r, hh, sf);
        if (pb2 <= jb) sb = tile_mm<4>(QF + (1 * 64 + pb2 * 32) * 72, KF + (1 * 64 + jb * 32) * 72, r, hh, sb);
#pragma unroll
        for (int reg = 0; reg < 16; ++reg) { const int p = (reg & 3) + 8 * (reg >> 2) + 4 * hh; float v;
            if (pb2 > jb) v = sf[reg]; else if (pb2 < jb) v = sb[reg]; else v = (r <= p) ? sf[reg] : sb[reg];
            Mm[(pb2 * 32 + p) * 72 + jb * 32 + r] = (unsigned short)f2bf(v); }
    } else {
        const int dvb = wave - 4; float* KV = WSP(float, WS_KVC) + (size_t)item * 2 * 8192;
#pragma unroll
        for (int dir = 0; dir < 2; ++dir)
#pragma unroll
            for (int dkb = 0; dkb < 2; ++dkb) { f32x16 a = {}; a = tile_mm<4>(VT + (dvb * 32) * 72, KDT + (dir * 64 + dkb * 32) * 72, r, hh, a);
#pragma unroll
                for (int reg = 0; reg < 16; ++reg) { const int dv = dvb * 32 + (reg & 3) + 8 * (reg >> 2) + 4 * hh; KV[(size_t)dir * 8192 + dv * 64 + dkb * 32 + r] = a[reg]; } }
    }
    LDS_WAIT(); __syncthreads();
    { const int pb2 = wave >> 2, dvb = wave & 3; f32x16 a = {}; a = tile_mm<4>(Mm + (pb2 * 32) * 72, VT + (dvb * 32) * 72, r, hh, a);
      float* OI = WSP(float, WS_OINTRA) + (size_t)(t0 + pb2 * 32) * 768 + h * 128 + dvb * 32 + r;
#pragma unroll
      for (int reg = 0; reg < 16; ++reg) { const int p = (reg & 3) + 8 * (reg >> 2) + 4 * hh; OI[(size_t)p * 768] = a[reg]; } }
    __syncthreads();
}
__device__ __forceinline__ void gla_scan_witem(Frame& F, int item) {
    const int slice = item & 31, dir = (item >> 5) & 1, bh = item >> 6, b = bh / 6, h = bh % 6;
    const int e = slice * 256 + F.lane * 4, dk = e & 63;
    const float* KV = WSP(float, WS_KVC); const float* DC = WSP(float, WS_DECAY); bf16* ST = WSP(bf16, WS_ST);
    f32x4 st = {0.f, 0.f, 0.f, 0.f};
#pragma unroll 8
    for (int i = 0; i < 32; ++i) { const int n = dir ? 31 - i : i; const size_t it = (size_t)((b * 32 + n) * 6 + h) * 2 + dir;
        const f32x4 kv = *(const f32x4*)(KV + it * 8192 + e), dc = *(const f32x4*)(DC + it * 64 + dk);
        v2u w; w.x = pk2(st[0], st[1]); w.y = pk2(st[2], st[3]); *(v2u*)(ST + it * 8192 + e) = w;
        st = dc * st + kv; }
}
__device__ __forceinline__ void gla_c_task(Frame& F, int l, int task) {
    const int item = task >> 1, half = task & 1, h = item % 6, bn = item / 6, tk0 = bn * 64 + half * 32;
    const int r = F.lane & 31, hh = F.lane >> 5;
    const bf16* QD = WSP(bf16, WS_QDEC); const bf16* ST = WSP(bf16, WS_ST) + (size_t)item * 2 * 8192;
    bf16x8 af[2][4];
#pragma unroll
    for (int dir = 0; dir < 2; ++dir)
#pragma unroll
        for (int s = 0; s < 4; ++s) af[dir][s] = *(const bf16x8*)(QD + (size_t)dir * T * 384 + (size_t)(tk0 + r) * 384 + h * 64 + 16 * s + 8 * hh);
    f32x16 acc[4];
#pragma unroll
    for (int dvb = 0; dvb < 4; ++dvb) { acc[dvb] = f32x16{};
#pragma unroll
        for (int dir = 0; dir < 2; ++dir)
#pragma unroll
            for (int s = 0; s < 4; ++s) { const bf16x8 bfr = *(const bf16x8*)(ST + (size_t)dir * 8192 + (dvb * 32 + r) * 64 + 16 * s + 8 * hh);
                acc[dvb] = __builtin_amdgcn_mfma_f32_32x32x16_bf16(af[dir][s], bfr, acc[dvb], 0, 0, 0); } }
    LAS float* st = (LAS float*)(F.lds + F.wave * 16384);
    stage_write(st, acc, r, hh);
    LDS_WAIT(); asm volatile("" ::: "memory");
    float v[64]; stage_read(st, F.lane, v);
    const int row = F.lane >> 1, hf = F.lane & 1; const size_t t = (size_t)(tk0 + row);
    const float* OI = WSP(float, WS_OINTRA) + t * 768 + h * 128 + hf * 64;
    f32x4 oi[16];
#pragma unroll
    for (int j = 0; j < 16; ++j) oi[j] = *(const f32x4*)(OI + 4 * j);
    float ss = 0.f;
#pragma unroll
    for (int j = 0; j < 16; ++j) {
#pragma unroll
        for (int e2 = 0; e2 < 4; ++e2) { v[4 * j + e2] += oi[j][e2]; ss += v[4 * j + e2] * v[4 * j + e2]; } }
    ss += __shfl_xor(ss, 1);
    const float rstd = __builtin_amdgcn_rsqf(ss * (1.f / 128.f) + EPS);
    gated_store64(v, rstd, ld_in(11) + l * 128 + hf * 64, WSP(bf16, WS_PROJ) + t * NP + C_Z + h * 128 + hf * 64, WSP(bf16, WS_HY) + t * DM + 768 + h * 128 + hf * 64);
    LDS_WAIT(); asm volatile("" ::: "memory");
}
#define XB_TMO      128
#define XB_XCNT(j)  (256  + 64 * (j))
#define XB_XSUB(j)  (1280 + 64 * (j))
#define XB_XGEN(j)  (2304 + 64 * (j))
#define XB_TOP      3328
#define XB_TOPGEN   3392
#define XCD_BAR_WORDS 3456
#define XB_SPIN_CAP (1u << 18)
__device__ __forceinline__ unsigned xb_ld(unsigned* p)              { return __hip_atomic_load(p, __ATOMIC_RELAXED, __HIP_MEMORY_SCOPE_AGENT); }
__device__ __forceinline__ unsigned xb_add(unsigned* p, unsigned v) { return __hip_atomic_fetch_add(p, v, __ATOMIC_RELAXED, __HIP_MEMORY_SCOPE_AGENT); }
__device__ __forceinline__ unsigned xb_xcc_id() { return (unsigned)__builtin_amdgcn_s_getreg((3 << 11) | 20) & 0xFu; }
#define XB_SPIN(cond, bar) do { unsigned _sp = 0; while (cond) { __builtin_amdgcn_s_sleep(1); \
    if ((++_sp & 255u) == 0u) { if (xb_ld(&(bar)[XB_TMO])) break; if (_sp > XB_SPIN_CAP) { atomicAdd(&(bar)[XB_TMO], 1u); break; } } } } while (0)
struct XcdBarrier { unsigned* bar; unsigned x; volatile LAS unsigned* st; };
__device__ __forceinline__ XcdBarrier xcd_barrier_post(unsigned* bar, volatile LAS unsigned* st) {
    XcdBarrier b; b.bar = bar; b.x = xb_xcc_id(); b.st = st;
    if (threadIdx.x == 0) (void)xb_add(&bar[XB_XCNT(b.x)], 1u);
    return b;
}
__device__ __forceinline__ void xcd_barrier_complete(unsigned* bar, unsigned x, unsigned& nloc, unsigned& nx) {
    const unsigned G = gridDim.x * gridDim.y * gridDim.z;
    unsigned sum, cnt, mine, sp = 0u;
    for (;;) {
        sum = 0u; cnt = 0u; mine = 0u;
#pragma unroll
        for (unsigned j = 0; j < 16; ++j) { const unsigned c = xb_ld(&bar[XB_XCNT(j)]); sum += c; cnt += (c > 0u) ? 1u : 0u; mine = (j == x) ? c : mine; }
        if (sum == G) break;
        __builtin_amdgcn_s_sleep(1);
        if ((++sp & 255u) == 0u) { if (xb_ld(&bar[XB_TMO])) break; if (sp > XB_SPIN_CAP) { atomicAdd(&bar[XB_TMO], 1u); break; } }
    }
    nloc = mine > 0u ? mine : 1u; nx = cnt > 0u ? cnt : 1u;
}
__device__ __forceinline__ void xcd_barrier(const XcdBarrier& b) {
    asm volatile("s_waitcnt vmcnt(0)" ::: "memory");
    __syncthreads();
    if (threadIdx.x == 0) {
        unsigned* bar = b.bar;
        __builtin_amdgcn_s_waitcnt(0);
        unsigned nloc = b.st[0], nx = b.st[1];
        if (nloc == 0u) { xcd_barrier_complete(bar, b.x, nloc, nx); b.st[0] = nloc; b.st[1] = nx; }
        const unsigned old = xb_add(&bar[XB_XSUB(b.x)], 1u);
        const unsigned gen = old / nloc;
        if (old + 1u == (gen + 1u) * nloc) {
            __builtin_amdgcn_fence(__ATOMIC_RELEASE, "agent");
            asm volatile("s_waitcnt vmcnt(0)" ::: "memory");
            const unsigned og = xb_add(&bar[XB_TOP], 1u);
            const unsigned tg = og / nx;
            if (og + 1u == (tg + 1u) * nx) xb_add(&bar[XB_TOPGEN], 1u);
            else XB_SPIN(xb_ld(&bar[XB_TOPGEN]) == tg, bar);
            __builtin_amdgcn_fence(__ATOMIC_ACQUIRE, "agent");
            xb_add(&bar[XB_XGEN(b.x)], 1u);
            asm volatile("s_waitcnt vmcnt(0)" ::: "memory");
        } else {
            XB_SPIN(xb_ld(&bar[XB_XGEN(b.x)]) == gen, bar);
            __builtin_amdgcn_fence(__ATOMIC_ACQUIRE, "agent");
            asm volatile("s_waitcnt vmcnt(0)" ::: "memory");
        }
    }
    __syncthreads();
}

__device__ __forceinline__ void sub_barrier(unsigned* cnt, unsigned target) {
    asm volatile("s_waitcnt vmcnt(0)" ::: "memory");
    __syncthreads();
    if (threadIdx.x == 0) {
        __builtin_amdgcn_fence(__ATOMIC_RELEASE, "agent");
        asm volatile("s_waitcnt vmcnt(0)" ::: "memory");
        (void)xb_add(cnt, 1u);
        unsigned sp = 0u; while (xb_ld(cnt) < target) { __builtin_amdgcn_s_sleep(2); if (++sp > (1u << 22)) break; }
        __builtin_amdgcn_fence(__ATOMIC_ACQUIRE, "agent");
        asm volatile("s_waitcnt vmcnt(0)" ::: "memory");
    }
    __syncthreads();
}

struct Args { const float* in[21]; float* out; unsigned char* ws; int ph_lo, ph_hi; };
constexpr int N_PHASES = 2 + 6 * DEPTH;
__global__ void __launch_bounds__(NTHR, 2) mega_fwd(Args args) {
    extern __shared__ __attribute__((aligned(16))) unsigned char lds[];
    Frame F;
    F.lds = (LAS unsigned char*)lds; F.ldsg = (char*)lds;
    F.tid = threadIdx.x; F.lane = F.tid & 63; F.wave = __builtin_amdgcn_readfirstlane(F.tid >> 6);
    F.G = gridDim.x; { const int bx = blockIdx.x; F.vcu = (F.G % 8 == 0) ? (bx % 8) * (F.G / 8) + bx / 8 : bx; }
    F.out = args.out; F.ws = args.ws;
    volatile LAS unsigned* MISC = (volatile LAS unsigned*)(F.lds + MISC_OFF);
    for (int u = F.tid; u < (LDS_BYTES - LDSCTL_OFF) / 4; u += NTHR) ((LAS unsigned*)(F.lds + LDSCTL_OFF))[u] = 0u;
    __syncthreads();
    XcdBarrier bar = xcd_barrier_post((unsigned*)(F.ws + WS_CTL) + CW_BAR, MISC + 8);
    const int lo = args.ph_lo, hi = args.ph_hi;
#ifndef MK_MASK
#define MK_MASK 0xFF
#endif
#define PHON(b) ((MK_MASK >> (b)) & 1)
#ifndef MK_REP_PH
#define MK_REP_PH -1
#endif
#define REPS(ph) for (int rep_ = 0; rep_ < ((ph) == MK_REP_PH ? 2 : 1); ++rep_)
#define REPBAR() do { if (rep_ == 0 && false) {} } while (0)
#define IN(k) (lo <= (k) && (k) < hi)
#define FRESH() do { int t_ = threadIdx.x; asm volatile("" : "+v"(t_)); F.tid = t_; F.lane = t_ & 63; F.wave = __builtin_amdgcn_readfirstlane(t_ >> 6); GAS unsigned char* w_ = (GAS unsigned char*)args.ws; asm volatile("" : "+s"(w_)); F.ws = (unsigned char*)w_; GAS float* o_ = (GAS float*)args.out; asm volatile("" : "+s"(o_)); F.out = (float*)o_; } while (0)
#define SEAM(k) do { if (IN(k) && IN((k) + 1)) xcd_barrier(bar); } while (0)
    REPS(100) { if (PHON(0) && IN(0)) { p0_prologue(F, rep_ == 0 ? WS_MODS : (size_t)(1 * MiB)); } SEAM(0); }
    REPS(101) { if (PHON(1) && IN(1)) { modnorm_rows(F, ld_in(0), ld_in(5), WSP(float, WS_MODS), WSP(bf16, WS_HY)); } SEAM(1); }
#pragma unroll 1
    for (int l = 0; l < DEPTH; ++l) {
        const int pb = 2 + 6 * l;
#define mods_l (WSP(float, WS_MODS) + (size_t)l * BATCH * 3 * DM)
        REPS(0) { if (PHON(2) && IN(pb)) {
            FRESH();
            pg8::Gemm g{WSP(bf16, WS_HY), WSP(bf16, WS_WIN) + (size_t)l * NP * DM, T, NP, DM, DM}; pg8::StaticOrder S; S.init(T, NP, F.G, (int)blockIdx.x);
            EpiIn E{WSP(bf16, WS_PROJ), WSP(float, WS_CS), WSP(float, WS_SN), WSP(float, WS_PARTQ), WSP(float, WS_PARTKV)};
            pg8::gemm_phase<EpiIn, pg8::StaticOrder, true, true>(F.lds, g, S, E);
        } SEAM(pb); }
        REPS(1) { if (PHON(3) && IN(pb + 1)) {
#ifndef MK_SUB
#define MK_SUB 0xFF
#endif
            FRESH();
            if (MK_SUB & 1) { pg8::Gemm g{WSP(bf16, WS_PROJ) + C_MKV, WSP(bf16, WS_WUKV) + (size_t)l * NKV * 256, T, NKV, 256, NP}; pg8::StaticOrder S; S.init(T, NKV, F.G, (int)blockIdx.x);
              EpiUkv E{WSP(bf16, WS_KVUP), WSP(float, WS_PARTKV)};
              pg8::gemm_phase<EpiUkv, pg8::StaticOrder, true, true>(F.lds, g, S, E); }
            FRESH();
            if (MK_SUB & 2) { pg8::Gemm g{WSP(bf16, WS_PROJ) + C_MQ, WSP(bf16, WS_WUQ) + (size_t)l * NQ * 384, T, NQ, 384, NP}; pg8::StaticOrder S; S.init(T, NQ, F.G, ((int)blockIdx.x + 64) % F.G);
              EpiUq E{WSP(bf16, WS_QUP), WSP(float, WS_CS), WSP(float, WS_SN), WSP(float, WS_PARTQ)};
              pg8::gemm_phase<EpiUq, pg8::StaticOrder, true, true>(F.lds, g, S, E); }
            __syncthreads(); FRESH();
            if (MK_SUB & 4) for (int it = (int)blockIdx.x; it < NITEM; it += F.G) gla_a_item(F, l, it);
        } SEAM(pb + 1); }
        REPS(7) { if (PHON(3) && IN(pb + 2)) {
            FRESH();
            conv_rows(F, l);
            FRESH(); { const int gw = F.vcu * NWAVES + F.wave, NGW = F.G * NWAVES; for (int it = gw; it < 1536; it += NGW) gla_scan_witem(F, it); }
        } SEAM(pb + 2); }
        REPS(2) { if (PHON(4) && IN(pb + 3)) {
            const int bx = (int)blockIdx.x; FRESH();
            const int natt = F.G > 192 ? 192 : F.G;
            if (bx < natt) {
                for (int u = bx; u < 192; u += natt) { const int bh = u >> 3, qb = u & 7, b = bh / 6, h = bh % 6; const size_t row0 = (size_t)b * SEQ, qrow = row0 + qb * 256;
                    mla::attn_unit(WSP(bf16, WS_QUP) + qrow * NQ + h * 192, WSP(bf16, WS_KVUP) + row0 * NKV + h * 256, WSP(bf16, WS_KVUP) + row0 * NKV + h * 256 + 128,
                                   WSP(bf16, WS_PROJ) + row0 * NP + C_MKR, WSP(bf16, WS_HY) + qrow * DM + h * 128, WSP(bf16, WS_PROJ) + qrow * NP + C_Z + 768 + h * 128,
                                   ld_in(16) + l * 768 + h * 128, WSP(float, WS_PARTM) + qrow * 8 + h, SEQ, F.ldsg); }
            }
            if (F.G > 192) { if (bx >= 192) { const int gw = (bx - 192) * NWAVES + F.wave, NGW = (F.G - 192) * NWAVES; for (int task = gw; task < 2 * NITEM; task += NGW) gla_c_task(F, l, task); } }
            else { FRESH(); const int gw = F.vcu * NWAVES + F.wave, NGW = F.G * NWAVES; for (int task = gw; task < 2 * NITEM; task += NGW) gla_c_task(F, l, task); }
        } SEAM(pb + 3); }
        for (int rep_ = 0; rep_ < ((MK_REP_PH == 4 && l == 0) ? 2 : 1); ++rep_) { if (PHON(6) && IN(pb + 4)) {
            FRESH();
            pg8::Gemm g{WSP(bf16, WS_HY), WSP(bf16, WS_WOUT) + (size_t)l * DM * DM, T, DM, DM, DM}; pg8::StaticOrder S; S.init(T, DM, F.G, (int)blockIdx.x);
            EpiOut E{l == 0 ? ld_in(0) : F.out, F.out, mods_l + 2 * DM, WSP(float, WS_PARTM)};
            pg8::gemm_phase<EpiOut, pg8::StaticOrder, true, true>(F.lds, g, S, E);
        } SEAM(pb + 4); }
        for (int rep_ = 0; rep_ < ((MK_REP_PH == 5 && l == 0) ? 2 : 1); ++rep_) { if (PHON(7) && IN(pb + 5)) {
            FRESH();
            if (l + 1 < DEPTH) modnorm_rows(F, F.out, ld_in(5) + (l + 1) * DM, mods_l + (size_t)BATCH * 3 * DM, WSP(bf16, WS_HY));
            else finalnorm_rows(F, F.out, ld_in(20));
        } SEAM(pb + 5); }
        if (MK_REP_PH == 6) { for (int r_ = 0; r_ < 4; ++r_) xcd_barrier(bar); }
    }
#undef mods_l
#undef IN
#undef SEAM
}

#ifndef MK_CUT
#define MK_CUT 14
#endif
#if MK_CUT < 14
__global__ void glue_proj(const bf16* P, float* proj, float* y, int row0) {
    const int t = blockIdx.x; const bf16* p = P + (size_t)(row0 + t) * NP;
    for (int c = threadIdx.x; c < NP; c += 256) { const float v = bf2f(p[c]);
        if (c < C_MKV) proj[(size_t)t * nv::PW + c] = v;
        else if (c < C_MQ) proj[(size_t)t * nv::PW + nv::O_MKV + (c - C_MKV)] = v;
        else if (c < C_MKR) proj[(size_t)t * nv::PW + nv::O_MQ + (c - C_MQ)] = v;
        else if (c < C_LR) { const int j = c - C_MKR; proj[(size_t)t * nv::PW + nv::O_MKR + (j & 1) * 32 + (j >> 1)] = v; }
        else if (c < C_LR + 32) proj[(size_t)t * nv::PW + nv::O_LR + (c - C_LR)] = v;
        else if (c < C_CB) {}
        else if (c < C_Z) proj[(size_t)t * nv::PW + nv::O_CB + (c - C_CB)] = v;
        else y[(size_t)t * DM + (c - C_Z)] = v; }
}
__global__ void glue_qkv(const bf16* Q, const bf16* KV, float* qm, float* kv, int row0) {
    const int t = blockIdx.x;
    for (int c = threadIdx.x; c < 1152; c += 256) { const float v = bf2f(Q[(size_t)(row0 + t) * NQ + c]) * (1.f / QSCALE); const int h = c / 192, d = c % 192;
        if (d < 128) qm[(size_t)t * 1152 + c] = v; else { const int j = d - 128; qm[(size_t)t * 1152 + h * 192 + 128 + (j & 1) * 32 + (j >> 1)] = v; } }
    for (int c = threadIdx.x; c < 1536; c += 256) kv[(size_t)t * 1536 + c] = bf2f(KV[(size_t)(row0 + t) * NKV + c]);
}
__global__ void glue_y(const bf16* Y, float* y, int row0) {
    const int t = blockIdx.x; for (int c = threadIdx.x; c < DM; c += 256) { const int cr = c < 768 ? c + 768 : (c < 1536 ? c - 768 : c); y[(size_t)t * DM + cr] = bf2f(Y[(size_t)(row0 + t) * DM + c]); }
}
__global__ void glue_h(const bf16* H, float* h, int row0) {
    const int t = blockIdx.x; for (int c = threadIdx.x; c < DM; c += 256) h[(size_t)t * DM + c] = bf2f(H[(size_t)(row0 + t) * DM + c]);
}

#endif
#ifndef MK_NAIVE_BASE_MIB
#define MK_NAIVE_BASE_MIB 240
#endif
extern "C" void kernel_launch(void* const* d_in, const int* in_sizes, int n_in, void* d_out, int out_size, void* d_ws, size_t ws_size, hipStream_t stream) {
    static int grid = 0;
    if (grid == 0) {
        if (n_in != 21 || out_size != T * DM || in_sizes[0] != T * DM || ws_size < WS_END) { fprintf(stderr, "kernel_launch: unexpected shapes n_in %d out %d ws %zu\n", n_in, out_size, ws_size); grid = -1; return; }
        int dev = 0, cus = 0, per_cu = 0;
        if (hipGetDevice(&dev) != hipSuccess || hipDeviceGetAttribute(&cus, hipDeviceAttributeMultiprocessorCount, dev) != hipSuccess) { grid = -1; return; }
        if (hipFuncSetAttribute((const void*)mega_fwd, hipFuncAttributeMaxDynamicSharedMemorySize, LDS_BYTES) != hipSuccess) { fprintf(stderr, "kernel_launch: hipFuncSetAttribute failed\n"); grid = -1; return; }
        if (hipOccupancyMaxActiveBlocksPerMultiprocessor(&per_cu, (const void*)mega_fwd, NTHR, LDS_BYTES) != hipSuccess || per_cu < 1) { fprintf(stderr, "kernel_launch: occupancy query says %d blocks/CU\n", per_cu); grid = -1; (void)hipGetLastError(); return; }
        grid = cus;
    }
    if (grid < 0) return;
    (void)hipMemsetAsync((char*)d_ws + WS_CTL, 0, CTL_ZERO_BYTES, stream);
    Args a{};
    for (int i = 0; i < 21; ++i) a.in[i] = (const float*)d_in[i];
    a.out = (float*)d_out; a.ws = (unsigned char*)d_ws; a.ph_lo = 0; a.ph_hi = MK_CUT < N_PHASES ? MK_CUT : N_PHASES;
    hipLaunchKernelGGL(mega_fwd, dim3(grid), dim3(NTHR), LDS_BYTES, stream, a);
#if MK_CUT < 14
    {
        char* ws = (char*)d_ws; float* out = (float*)d_out; const float* x = (const float*)d_in[0];
        const float* mods = (const float*)(ws + WS_MODS); const float* cs = (const float*)(ws + WS_CS); const float* sn = (const float*)(ws + WS_SN);
        nv::Buf B = nv::carve(ws + (size_t)MK_NAIVE_BASE_MIB * MiB);
        const int l0 = (MK_CUT - 2) / 6, ph = (MK_CUT - 2) % 6;
        for (int l = l0; l < DEPTH; ++l)
            for (int b = 0; b < BATCH; ++b) {
                const int row0 = b * SEQ; int entry = 0; const float* xin = (l == 0 ? x : out) + (size_t)row0 * DM; float* xo = out + (size_t)row0 * DM;
                if (l == l0) {
                    if (ph >= 1 && ph <= 3) { glue_proj<<<SEQ, 256, 0, stream>>>((const bf16*)(ws + WS_PROJ), B.proj, B.y, row0); entry = 1; }
                    if (ph == 2) { glue_qkv<<<SEQ, 256, 0, stream>>>((const bf16*)(ws + WS_QUP), (const bf16*)(ws + WS_KVUP), nv::sc_qm(B), nv::sc_kv(B), row0); entry = 2; }
                    if (ph == 3) { hipMemcpyAsync(nv::sc_omla(B), ws + WS_OMLA + (size_t)row0 * 768 * 4, (size_t)SEQ * 768 * 4, hipMemcpyDeviceToDevice, stream); entry = 4; }
                    if (ph == 4) { glue_y<<<SEQ, 256, 0, stream>>>((const bf16*)(ws + WS_HY), B.y, row0); entry = 3; }
                    if (ph == 5) continue;
                }
                nv::layer_batch(d_in, l, b, entry, xin, xo, mods, cs, sn, B, stream);
            }
        nv::k_rms<<<T, 256, 0, stream>>>(out, DM, DM, (const float*)d_in[20], out, DM);
    }
#endif
}
```

```cpp
#include <hip/hip_runtime.h>
#include <cstdio>
#include <cstdint>
#define MK_CUT 14
#define MK_NAIVE_BASE_MIB 240
#define MK_REP_PH -1
namespace pg8 {
#define PG8_LAS __attribute__((address_space(3)))
typedef unsigned short bf16_t;
typedef short bf16x8 __attribute__((ext_vector_type(8)));
typedef float f32x4 __attribute__((ext_vector_type(4)));
typedef unsigned u32x4 __attribute__((ext_vector_type(4)));
constexpr int BM = 256, BK = 64, HALF = 128, HTB = HALF * BK * 2, STAGE_BYTES = 8 * HTB, NXCD = 8, WGM = 8;

__host__ __device__ __forceinline__ int lds_byte(int r, int c) { const int st = (r >> 4) * 2 + (c >> 5), rr = r & 15, cc = c & 31, ob = rr * 64 + cc * 2; return st * 1024 + (ob ^ (((ob >> 9) & 1) << 5)); }
__host__ __device__ __forceinline__ void stage_rc(int b, int& R, int& C) { const int st = b / 1024, sb = b % 1024, swz = sb ^ (((sb >> 9) & 1) << 5); R = (st >> 1) * 16 + swz / 64; C = (st & 1) * 32 + (swz % 64) / 2; }
__host__ __device__ __forceinline__ int perm32(int rho) { const int n = rho >> 4, i = rho & 15; return 8 * (i >> 2) + 4 * n + (i & 3); }

struct Unit { int pm, pn; };
struct Gemm { const bf16_t* A; const bf16_t* Bt; int M, N, K, lda; };

struct StaticOrder {
    int nM, nN, nwg, G, c;
    __host__ __device__ void init(int M, int N, int G_, int c_) { nM = M / BM; nN = N / BM; nwg = nM * nN; G = G_; c = c_; }
    __host__ __device__ bool next(int i, Unit& u) const {
        const long L = (long)i * G + c; if (L >= nwg) return false;
        int wgid = (int)L; { const int q = nwg / NXCD, r = nwg % NXCD, xcd = wgid % NXCD, off = wgid / NXCD; wgid = (xcd < r ? xcd * (q + 1) : r * (q + 1) + (xcd - r) * q) + off; }
        const int nig = WGM * nN, gid = wgid / nig, fm = gid * WGM, gsz = (nM - fm) < WGM ? (nM - fm) : WGM;
        u.pm = fm + ((wgid % nig) % gsz); u.pn = (wgid % nig) / gsz; return true;
    }
    __device__ __forceinline__ void a_ready(const Unit&) const {}
    __device__ __forceinline__ void done(const Unit&) const {}
};

__device__ __forceinline__ unsigned cvt_pk_bf16(float lo, float hi) { unsigned r; asm volatile("v_cvt_pk_bf16_f32 %0, %1, %2" : "=v"(r) : "v"(lo), "v"(hi)); return r; }

template <class Epi, class Sched, bool ALIGN_EPI = false, bool SP2 = false>
__device__ __forceinline__ void gemm_phase(PG8_LAS unsigned char* lds, const Gemm g, const Sched& S, const Epi& E) {
    int tid_ = threadIdx.x; asm volatile("" : "+v"(tid_));
    const int tid = tid_, wid = __builtin_amdgcn_readfirstlane(tid >> 6), lane = tid & 63, wr = wid >> 2, wc = wid & 3, fr = lane & 15, fq = lane >> 4;
    int K_ = g.K, lda_ = g.lda; asm volatile("" : "+s"(K_), "+s"(lda_));
    const int K = K_, nt = K / BK, lda = lda_;
    unsigned voffA[2], voffB[2];
#pragma unroll
    for (int i = 0; i < 2; ++i) { int R, C; stage_rc(tid * 16 + i * 8192, R, C); const int Rb = Epi::PERM ? ((R & ~31) + perm32(R & 31)) : R;
        voffA[i] = (unsigned)(R * lda + C) * 2u; voffB[i] = (unsigned)(Rb * K + C) * 2u; }
    const size_t kstep = (size_t)(BK * 2);
    const size_t hstepA = (size_t)HALF * lda * 2, hstepB = (size_t)HALF * K * 2;
    const size_t tstepA = 2 * hstepA, tstepB = 2 * hstepB;
    const unsigned ldsw = (unsigned)wid * 1024u;
    const int aoff = lds_byte(wr * 64 + fr, fq * 8), boff = lds_byte(wc * 32 + fr, fq * 8);
#define PG8_SA(b, h) (((b) * 2 + (h)) * HTB)
#define PG8_SB(b, h) ((4 + (b) * 2 + (h)) * HTB)
#define PG8_STAGE(bufoff, gbase, voff) do { _Pragma("unroll") for (int _i = 0; _i < 2; ++_i) \
        __builtin_amdgcn_global_load_lds((const unsigned*)((const char*)(gbase) + (voff)[_i]), (PG8_LAS unsigned*)(lds + (bufoff) + ldsw + _i * 8192), 16, 0, 0); } while (0)
#define PG8_LDA(dst, b, h) do { _Pragma("unroll") for (int m = 0; m < 4; ++m) _Pragma("unroll") for (int k = 0; k < 2; ++k) dst[m][k] = *(const PG8_LAS bf16x8*)(lds + PG8_SA(b, h) + aoff + m * 2048 + k * 1024); } while (0)
#define PG8_LDB(dst, b, h) do { _Pragma("unroll") for (int n = 0; n < 2; ++n) _Pragma("unroll") for (int k = 0; k < 2; ++k) dst[n][k] = *(const PG8_LAS bf16x8*)(lds + PG8_SB(b, h) + boff + n * 2048 + k * 1024); } while (0)
#define PG8_MMA(ai, bj, At, Bt) do { __builtin_amdgcn_s_setprio(1); _Pragma("unroll") for (int m = 0; m < 4; ++m) _Pragma("unroll") for (int n = 0; n < 2; ++n) _Pragma("unroll") for (int k = 0; k < 2; ++k) \
        acc[ai][bj][m][n] = __builtin_amdgcn_mfma_f32_16x16x32_bf16(Bt[n][k], At[m][k], acc[ai][bj][m][n], 0, 0, 0); __builtin_amdgcn_s_setprio(0); } while (0)
#define PG8_WAIT_V(n) asm volatile("s_waitcnt vmcnt(" #n ")" ::: "memory")
#define PG8_WAIT_L(n) asm volatile("s_waitcnt lgkmcnt(" #n ")" ::: "memory")
#define PG8_BAR __builtin_amdgcn_s_barrier()
#define PG8_SCHED __builtin_amdgcn_sched_barrier(0)
    Unit cur, nxt; int ui = 0;
    if (!S.next(0, cur)) return;
    f32x4 acc[2][2][4][2];
#pragma unroll
    for (int a = 0; a < 2; ++a)
#pragma unroll
        for (int b = 0; b < 2; ++b)
#pragma unroll
            for (int m = 0; m < 4; ++m)
#pragma unroll
                for (int n = 0; n < 2; ++n) acc[a][b][m][n] = (f32x4){0.f, 0.f, 0.f, 0.f};
    bf16x8 At[4][2], B0[2][2], B1[2][2];
    const char* cA = (const char*)g.A + (size_t)cur.pm * tstepA; const char* cB = (const char*)g.Bt + (size_t)cur.pn * tstepB;
    S.a_ready(cur);
    if constexpr (SP2) {
        PG8_STAGE(PG8_SB(0, 0), cB, voffB); PG8_STAGE(PG8_SB(0, 1), cB + hstepB, voffB); PG8_STAGE(PG8_SA(0, 0), cA, voffA); PG8_STAGE(PG8_SA(0, 1), cA + hstepA, voffA);
        if (wr == 1) PG8_BAR;
        PG8_WAIT_V(2); PG8_BAR;
        PG8_STAGE(PG8_SB(1, 0), cB + kstep, voffB); PG8_STAGE(PG8_SA(1, 0), cA + kstep, voffA); PG8_STAGE(PG8_SB(1, 1), cB + hstepB + kstep, voffB);
        PG8_WAIT_V(6); PG8_BAR;
    } else {
        PG8_STAGE(PG8_SB(0, 0), cB, voffB); PG8_STAGE(PG8_SA(0, 0), cA, voffA); PG8_STAGE(PG8_SB(0, 1), cB + hstepB, voffB); PG8_STAGE(PG8_SA(0, 1), cA + hstepA, voffA);
        if (wr == 1) PG8_BAR;
        PG8_WAIT_V(4); PG8_BAR;
        PG8_STAGE(PG8_SB(1, 0), cB + kstep, voffB); PG8_STAGE(PG8_SA(1, 0), cA + kstep, voffA); PG8_STAGE(PG8_SB(1, 1), cB + hstepB + kstep, voffB);
        PG8_WAIT_V(6); PG8_BAR;
    }
    for (;;) {
        const bool has_next = S.next(ui + 1, nxt);
        const char* nA = has_next ? (const char*)g.A + (size_t)nxt.pm * tstepA : cA; const char* nB = has_next ? (const char*)g.Bt + (size_t)nxt.pn * tstepB : cB;
        for (int t = 0; t < nt; t += 2) {
            const bool last = (t == nt - 2);
            const char* a1 = cA + (size_t)(t + 1) * kstep;
            const char* a2 = last ? nA : cA + (size_t)(t + 2) * kstep; const char* b2 = last ? nB : cB + (size_t)(t + 2) * kstep;
            const char* a3 = a2 + kstep; const char* b3 = b2 + kstep;
            if (last && has_next) S.a_ready(nxt);
            if constexpr (SP2) {
            PG8_LDB(B0, 0, 0); PG8_LDB(B1, 0, 1); PG8_SCHED; PG8_LDA(At, 0, 0); PG8_STAGE(PG8_SA(1, 1), a1 + hstepA, voffA);
            PG8_WAIT_V(8); PG8_WAIT_L(0); PG8_BAR; PG8_MMA(0, 0, At, B0); PG8_MMA(0, 1, At, B1); PG8_BAR; PG8_SCHED;
            PG8_LDA(At, 0, 1); PG8_STAGE(PG8_SB(0, 0), b2, voffB); PG8_STAGE(PG8_SB(0, 1), b2 + hstepB, voffB); PG8_STAGE(PG8_SA(0, 0), a2, voffA);
            PG8_WAIT_V(8); PG8_WAIT_L(0); PG8_BAR; PG8_MMA(1, 0, At, B0); PG8_MMA(1, 1, At, B1); PG8_BAR; PG8_SCHED;
            PG8_LDB(B0, 1, 0); PG8_LDB(B1, 1, 1); PG8_SCHED; PG8_LDA(At, 1, 0); PG8_STAGE(PG8_SA(0, 1), a2 + hstepA, voffA);
            PG8_WAIT_V(8); PG8_WAIT_L(0); PG8_BAR; PG8_MMA(0, 0, At, B0); PG8_MMA(0, 1, At, B1); PG8_BAR; PG8_SCHED;
            PG8_LDA(At, 1, 1); PG8_STAGE(PG8_SB(1, 0), b3, voffB); PG8_STAGE(PG8_SB(1, 1), b3 + hstepB, voffB); PG8_STAGE(PG8_SA(1, 0), a3, voffA);
            PG8_WAIT_V(8); PG8_WAIT_L(0); PG8_BAR; PG8_MMA(1, 0, At, B0); PG8_MMA(1, 1, At, B1); PG8_BAR; PG8_SCHED;
            if constexpr (Epi::HOOK_T > 0) { if (t + 2 == Epi::HOOK_T) E.hook(acc, cur, wr, wc, fr, fq); }
            } else {
            PG8_LDB(B0, 0, 0); PG8_SCHED; PG8_LDA(At, 0, 0); PG8_STAGE(PG8_SA(1, 1), a1 + hstepA, voffA);
            PG8_WAIT_L(8); PG8_BAR; PG8_WAIT_L(0); PG8_MMA(0, 0, At, B0); PG8_BAR; PG8_SCHED;
            PG8_LDB(B1, 0, 1); PG8_STAGE(PG8_SB(0, 0), b2, voffB);
            PG8_BAR; PG8_WAIT_L(0); PG8_MMA(0, 1, At, B1); PG8_BAR;
            PG8_LDA(At, 0, 1); PG8_STAGE(PG8_SA(0, 0), a2, voffA);
            PG8_BAR; PG8_WAIT_L(0); PG8_MMA(1, 0, At, B0); PG8_BAR; PG8_SCHED;
            PG8_STAGE(PG8_SB(0, 1), b2 + hstepB, voffB);
            PG8_WAIT_V(6); PG8_BAR; PG8_MMA(1, 1, At, B1); PG8_BAR;
            PG8_LDB(B0, 1, 0); PG8_SCHED; PG8_LDA(At, 1, 0); PG8_STAGE(PG8_SA(0, 1), a2 + hstepA, voffA);
            PG8_WAIT_L(8); PG8_BAR; PG8_WAIT_L(0); PG8_MMA(0, 0, At, B0); PG8_BAR; PG8_SCHED;
            PG8_LDB(B1, 1, 1); PG8_STAGE(PG8_SB(1, 0), b3, voffB);
            PG8_BAR; PG8_WAIT_L(0); PG8_MMA(0, 1, At, B1); PG8_BAR;
            PG8_LDA(At, 1, 1); PG8_STAGE(PG8_SA(1, 0), a3, voffA);
            PG8_BAR; PG8_WAIT_L(0); PG8_MMA(1, 0, At, B0); PG8_BAR; PG8_SCHED;
            PG8_STAGE(PG8_SB(1, 1), b3 + hstepB, voffB);
            PG8_WAIT_V(6); PG8_BAR; PG8_MMA(1, 1, At, B1); PG8_BAR;
            }
        }
        if constexpr (ALIGN_EPI) { if (wr == 0) PG8_BAR; }
        E(acc, cur, wr, wc, fr, fq); S.done(cur);
        if (!has_next) break;
#pragma unroll
        for (int a = 0; a < 2; ++a)
#pragma unroll
            for (int b = 0; b < 2; ++b)
#pragma unroll
                for (int m = 0; m < 4; ++m)
#pragma unroll
                    for (int n = 0; n < 2; ++n) acc[a][b][m][n] = (f32x4){0.f, 0.f, 0.f, 0.f};
        cur = nxt; cA = nA; cB = nB; ++ui;
        if constexpr (ALIGN_EPI) { if (wr == 1) PG8_BAR; }
    }
    PG8_WAIT_V(0);
    if constexpr (!ALIGN_EPI) { if (wr == 0) PG8_BAR; }
    PG8_BAR;
#undef PG8_SA
#undef PG8_SB
#undef PG8_STAGE
#undef PG8_LDA
#undef PG8_LDB
#undef PG8_MMA
#undef PG8_WAIT_V
#undef PG8_WAIT_L
#undef PG8_BAR
#undef PG8_SCHED
}
}
#define GAS __attribute__((address_space(1)))
#define LAS __attribute__((address_space(3)))
typedef unsigned short bf16;
typedef unsigned v4u __attribute__((ext_vector_type(4)));
typedef unsigned v2u __attribute__((ext_vector_type(2)));
typedef float f32x4 __attribute__((ext_vector_type(4)));
typedef float f32x16 __attribute__((ext_vector_type(16)));
typedef short bf16x8 __attribute__((ext_vector_type(8)));
typedef short s16x4 __attribute__((ext_vector_type(4)));
typedef GAS unsigned gu32;

constexpr int NWAVES = 8, NTHR = 512;
constexpr int BATCH = 4, SEQ = 2048, DM = 2048, T = BATCH * SEQ, DEPTH = 2, IN_DIM = 5856;
constexpr int NP = 5888;
constexpr int C_GQ = 0, C_GK = 384, C_GV = 768, C_MKV = 1536, C_MQ = 1792, C_MKR = 2176, C_LR = 2240, C_CB = 2304, C_CC = 2816, C_CX = 3328, C_Z = 3840;
constexpr int R_GQ = 0, R_GK = 384, R_GV = 768, R_LR = 1536, R_MQ = 1568, R_MKV = 1952, R_MKR = 2208, R_CB = 2272, R_CC = 2784, R_CX = 3296, R_Z = 3808;
constexpr int NQ = 1280, NKV = 1536;
constexpr float EPS = 1e-6f;
constexpr float QSCALE = 0.07216878364870322f * 1.4426950408889634f;
constexpr int NITEM = BATCH * 32 * 6;

constexpr size_t MiB = 1u << 20;
constexpr size_t WS_CTL = 0, CTL_ZERO_BYTES = 1 * MiB;
constexpr size_t WS_MODS = 256 * 1024;
constexpr size_t WS_CS = 2 * MiB, WS_SN = 3 * MiB;
constexpr size_t WS_WUQ = 4 * MiB;
constexpr size_t WS_WUKV = 6 * MiB;
constexpr size_t WS_WOUT = 8 * MiB;
constexpr size_t WS_WIN = 24 * MiB;
constexpr size_t WS_HY = 70 * MiB;
constexpr size_t WS_PROJ = 102 * MiB;
constexpr size_t WS_QUP = 194 * MiB;
constexpr size_t WS_KVUP = 214 * MiB;
constexpr size_t WS_OMLA = 238 * MiB;
constexpr size_t WS_OINTRA = 262 * MiB;
constexpr size_t WS_KVC = 286 * MiB;
constexpr size_t WS_ST = 334 * MiB;
constexpr size_t WS_QDEC = 358 * MiB;
constexpr size_t WS_DECAY = 370 * MiB;
constexpr size_t WS_PARTQ = 371 * MiB;
constexpr size_t WS_PARTKV = 371 * MiB + 512 * 1024;
constexpr size_t WS_PARTM = 371 * MiB + 768 * 1024;
constexpr size_t WS_END = 372 * MiB;
constexpr int CW_BAR = 4096;

constexpr int RING_BYTES = 131072, LDSCTL_OFF = RING_BYTES, MISC_OFF = LDSCTL_OFF + 320, LDS_BYTES = 147456;

#define LDS_WAIT() asm volatile("s_waitcnt lgkmcnt(0)" ::: "memory")
#define VM_WAIT() asm volatile("s_waitcnt vmcnt(0)" ::: "memory")
__device__ __forceinline__ unsigned f2bf(float f) { unsigned u = __builtin_bit_cast(unsigned, f); return (u + 0x7fffu + ((u >> 16) & 1u)) >> 16; }
__device__ __forceinline__ unsigned pk2(float lo, float hi) { return pg8::cvt_pk_bf16(lo, hi); }
__device__ __forceinline__ float bf2f(unsigned short h) { return __builtin_bit_cast(float, (unsigned)h << 16); }
__device__ __forceinline__ float bflo(unsigned w) { return __builtin_bit_cast(float, w << 16); }
__device__ __forceinline__ float bfhi(unsigned w) { return __builtin_bit_cast(float, w & 0xffff0000u); }
__device__ __forceinline__ float silu_fast(float v) { return v * __builtin_amdgcn_rcpf(1.f + __expf(-v)); }
__device__ __forceinline__ float wave_sum(float v) {
#pragma unroll
    for (int o = 1; o < 64; o <<= 1) v += __shfl_xor(v, o);
    return v;
}

__device__ __forceinline__ int map_in(int n) {
    if (n < C_MKV) return n;
    if (n < C_MQ) return R_MKV + (n - C_MKV);
    if (n < C_MKR) return R_MQ + (n - C_MQ);
    if (n < C_LR) { const int j = n - C_MKR; return R_MKR + (j & 1) * 32 + (j >> 1); }
    if (n < C_LR + 32) return R_LR + (n - C_LR);
    if (n < C_CB) return -1;
    if (n < C_Z) return R_CB + (n - C_CB);
    return R_Z + (n - C_Z);
}
__device__ __forceinline__ int map_uq(int n) {
    if (n >= 1152) return -1;
    const int h = n / 192, d = n % 192;
    if (d < 128) return n;
    const int j = d - 128; return h * 192 + 128 + (j & 1) * 32 + (j >> 1);
}

struct EpiIn {
    static constexpr bool PERM = true; static constexpr int HOOK_T = 0;
    bf16* O; const float* cs; const float* sn; float* partq; float* partkv;
    __device__ __forceinline__ void operator()(const f32x4 (&acc)[2][2][4][2], const pg8::Unit& u, int wr, int wc, int fr, int fq) const {
        const int pn = u.pn, row0 = u.pm * 256 + wr * 64 + fr, col0 = pn * 256 + wc * 32 + 8 * fq;
        const bool stat = (pn >= 6 && pn <= 8);
#pragma unroll
        for (int ai = 0; ai < 2; ++ai)
#pragma unroll
            for (int m = 0; m < 4; ++m) {
                const int row = row0 + ai * 128 + m * 16; bf16* rowp = O + (size_t)row * NP + col0; float ss = 0.f;
#pragma unroll
                for (int bj = 0; bj < 2; ++bj) {
                    f32x4 v0 = acc[ai][bj][m][0], v1 = acc[ai][bj][m][1]; const int c = col0 + bj * 128;
                    if (pn >= 15) {
#pragma unroll
                        for (int e = 0; e < 4; ++e) { v0[e] = silu_fast(v0[e]); v1[e] = silu_fast(v1[e]); }
                    } else if (pn == 8 && bj == 1 && c < C_LR) {
                        const int i0 = (c - C_MKR) >> 1; const f32x4 cc = *(const f32x4*)(cs + (size_t)row * 32 + i0), sv = *(const f32x4*)(sn + (size_t)row * 32 + i0);
                        f32x4 a0, a1;
                        a0[0] = v0[0] * cc[0] - v0[1] * sv[0]; a0[1] = v0[1] * cc[0] + v0[0] * sv[0]; a0[2] = v0[2] * cc[1] - v0[3] * sv[1]; a0[3] = v0[3] * cc[1] + v0[2] * sv[1];
                        a1[0] = v1[0] * cc[2] - v1[1] * sv[2]; a1[1] = v1[1] * cc[2] + v1[0] * sv[2]; a1[2] = v1[2] * cc[3] - v1[3] * sv[3]; a1[3] = v1[3] * cc[3] + v1[2] * sv[3];
                        v0 = a0; v1 = a1;
                    }
                    if (stat && (pn != 8 || bj == 0)) ss += (v0[0] * v0[0] + v0[1] * v0[1]) + (v0[2] * v0[2] + v0[3] * v0[3]) + (v1[0] * v1[0] + v1[1] * v1[1]) + (v1[2] * v1[2] + v1[3] * v1[3]);
                    v4u w; w.x = pk2(v0[0], v0[1]); w.y = pk2(v0[2], v0[3]); w.z = pk2(v1[0], v1[1]); w.w = pk2(v1[2], v1[3]);
                    *(v4u*)(rowp + bj * 128) = w;
                }
                asm volatile("" ::: "memory");
                if (stat) { ss += __shfl_xor(ss, 16); ss += __shfl_xor(ss, 32);
                    if (fq == 0) { if (pn == 6) partkv[(size_t)row * 4 + wc] = ss; else partq[(size_t)row * 8 + (pn - 7) * 4 + wc] = ss; } }
            }
    }
};
struct EpiUq {
    static constexpr bool PERM = true; static constexpr int HOOK_T = 0;
    bf16* O; const float* cs; const float* sn; const float* partq;
    __device__ __forceinline__ void operator()(const f32x4 (&acc)[2][2][4][2], const pg8::Unit& u, int wr, int wc, int fr, int fq) const {
        const int row0 = u.pm * 256 + wr * 64 + fr, col0 = u.pn * 256 + wc * 32 + 8 * fq;
        float rs[2][4];
#pragma unroll
        for (int ai = 0; ai < 2; ++ai) {
#pragma unroll
            for (int m = 0; m < 4; ++m) { const int row = row0 + ai * 128 + m * 16;
                const f32x4 p0 = *(const f32x4*)(partq + (size_t)row * 8), p1 = *(const f32x4*)(partq + (size_t)row * 8 + 4);
                rs[ai][m] = __builtin_amdgcn_rsqf(((p0[0] + p0[1]) + (p0[2] + p0[3]) + (p1[0] + p1[1]) + (p1[2] + p1[3])) * (1.f / 384.f) + EPS) * QSCALE; }
#pragma unroll
            for (int m = 0; m < 4; ++m) {
                const int row = row0 + ai * 128 + m * 16; bf16* rowp = O + (size_t)row * NQ + col0;
#pragma unroll
                for (int bj = 0; bj < 2; ++bj) {
                    const int c = col0 + bj * 128; if (c >= 1152) continue;
                    f32x4 v0 = acc[ai][bj][m][0] * rs[ai][m], v1 = acc[ai][bj][m][1] * rs[ai][m]; const int d = c % 192;
                    if (d >= 128) {
                        const int i0 = (d - 128) >> 1; const f32x4 cc = *(const f32x4*)(cs + (size_t)row * 32 + i0), sv = *(const f32x4*)(sn + (size_t)row * 32 + i0);
                        f32x4 a0, a1;
                        a0[0] = v0[0] * cc[0] - v0[1] * sv[0]; a0[1] = v0[1] * cc[0] + v0[0] * sv[0]; a0[2] = v0[2] * cc[1] - v0[3] * sv[1]; a0[3] = v0[3] * cc[1] + v0[2] * sv[1];
                        a1[0] = v1[0] * cc[2] - v1[1] * sv[2]; a1[1] = v1[1] * cc[2] + v1[0] * sv[2]; a1[2] = v1[2] * cc[3] - v1[3] * sv[3]; a1[3] = v1[3] * cc[3] + v1[2] * sv[3];
                        v0 = a0; v1 = a1;
                    }
                    v4u w; w.x = pk2(v0[0], v0[1]); w.y = pk2(v0[2], v0[3]); w.z = pk2(v1[0], v1[1]); w.w = pk2(v1[2], v1[3]);
                    *(v4u*)(rowp + bj * 128) = w;
                }
                asm volatile("" ::: "memory");
            }
        }
    }
};
struct EpiUkv {
    static constexpr bool PERM = true; static constexpr int HOOK_T = 0;
    bf16* O; const float* partkv;
    __device__ __forceinline__ void operator()(const f32x4 (&acc)[2][2][4][2], const pg8::Unit& u, int wr, int wc, int fr, int fq) const {
        const int row0 = u.pm * 256 + wr * 64 + fr, col0 = u.pn * 256 + wc * 32 + 8 * fq;
        float rs[2][4];
#pragma unroll
        for (int ai = 0; ai < 2; ++ai)
#pragma unroll
            for (int m = 0; m < 4; ++m) { const f32x4 p0 = *(const f32x4*)(partkv + (size_t)(row0 + ai * 128 + m * 16) * 4);
                rs[ai][m] = __builtin_amdgcn_rsqf(((p0[0] + p0[1]) + (p0[2] + p0[3])) * (1.f / 256.f) + EPS); }
#pragma unroll
        for (int ai = 0; ai < 2; ++ai)
#pragma unroll
            for (int m = 0; m < 4; ++m) {
                const int row = row0 + ai * 128 + m * 16; bf16* rowp = O + (size_t)row * NKV + col0;
#pragma unroll
                for (int bj = 0; bj < 2; ++bj) {
                    const f32x4 v0 = acc[ai][bj][m][0] * rs[ai][m], v1 = acc[ai][bj][m][1] * rs[ai][m];
                    v4u w; w.x = pk2(v0[0], v0[1]); w.y = pk2(v0[2], v0[3]); w.z = pk2(v1[0], v1[1]); w.w = pk2(v1[2], v1[3]);
                    *(v4u*)(rowp + bj * 128) = w;
                }
            }
    }
};
struct EpiOut {
    static constexpr bool PERM = false; static constexpr int HOOK_T = 12;
    const float* xin; float* out; const float* gate;
    const float* partm;
    __device__ __forceinline__ void hook(f32x4 (&acc)[2][2][4][2], const pg8::Unit& u, int wr, int wc, int fr, int fq) const {
        const int row0 = u.pm * 256 + wr * 64 + fr;
        float rs[2][4];
#pragma unroll
        for (int ai = 0; ai < 2; ++ai)
#pragma unroll
            for (int m = 0; m < 4; ++m) { const float* p = partm + (size_t)(row0 + ai * 128 + m * 16) * 8; const f32x4 p0 = *(const f32x4*)p; const float p4 = p[4], p5 = p[5];
                rs[ai][m] = __builtin_amdgcn_rsqf(((p0[0] + p0[1]) + (p0[2] + p0[3]) + (p4 + p5)) * (1.f / 768.f) + EPS); }
#pragma unroll
        for (int ai = 0; ai < 2; ++ai)
#pragma unroll
            for (int m = 0; m < 4; ++m)
#pragma unroll
                for (int bj = 0; bj < 2; ++bj)
#pragma unroll
                    for (int n = 0; n < 2; ++n) acc[ai][bj][m][n] *= rs[ai][m];
    }
    __device__ __forceinline__ void operator()(const f32x4 (&acc)[2][2][4][2], const pg8::Unit& u, int wr, int wc, int fr, int fq) const {
        const int row0 = u.pm * 256 + wr * 64 + fr, col0 = u.pn * 256 + wc * 32 + 4 * fq; const float* gb = gate + (size_t)(u.pm >> 3) * 3 * DM;
        f32x4 gv[2][2];
#pragma unroll
        for (int bj = 0; bj < 2; ++bj)
#pragma unroll
            for (int n = 0; n < 2; ++n) gv[bj][n] = *(const f32x4*)(gb + col0 + bj * 128 + n * 16);
        f32x4 xv[2][2][2][2];
#define EO_LOAD(slot, g) do { _Pragma("unroll") for (int q = 0; q < 2; ++q) { const size_t off = (size_t)(row0 + ((g) >> 1) * 128 + (((g) & 1) * 2 + q) * 16) * DM + col0; \
            _Pragma("unroll") for (int bj = 0; bj < 2; ++bj) _Pragma("unroll") for (int n = 0; n < 2; ++n) xv[slot][q][bj][n] = *(const f32x4*)(xin + off + bj * 128 + n * 16); } } while (0)
#define EO_STORE(slot, g) do { _Pragma("unroll") for (int q = 0; q < 2; ++q) { const int ai = (g) >> 1, m = ((g) & 1) * 2 + q; const size_t off = (size_t)(row0 + ai * 128 + m * 16) * DM + col0; \
            _Pragma("unroll") for (int bj = 0; bj < 2; ++bj) _Pragma("unroll") for (int n = 0; n < 2; ++n) *(f32x4*)(out + off + bj * 128 + n * 16) = xv[slot][q][bj][n] + gv[bj][n] * acc[ai][bj][m][n]; } } while (0)
        EO_LOAD(0, 0); EO_LOAD(1, 1); EO_STORE(0, 0); EO_LOAD(0, 2); EO_STORE(1, 1); EO_LOAD(1, 3); EO_STORE(0, 2); EO_STORE(1, 3);
#undef EO_LOAD
#undef EO_STORE
    }
};

__device__ __forceinline__ void unpack8(const v4u w, float* f) { f[0] = bflo(w.x); f[1] = bfhi(w.x); f[2] = bflo(w.y); f[3] = bfhi(w.y); f[4] = bflo(w.z); f[5] = bfhi(w.z); f[6] = bflo(w.w); f[7] = bfhi(w.w); }

__device__ __forceinline__ int stg_pos(int c, int row) { return (c & 16) | ((c ^ (row & 7) ^ ((c >> 4) << 3)) & 15); }
__device__ __forceinline__ void stage_write(LAS float* st, const f32x16* acc, int r32, int hi) {
#pragma unroll
    for (int reg = 0; reg < 16; ++reg) { const int row = (reg & 3) + 8 * (reg >> 2) + 4 * hi;
#pragma unroll
        for (int dvb = 0; dvb < 4; ++dvb) { const int col = dvb * 32 + r32; st[row * 128 + stg_pos(col >> 2, row) * 4 + (col & 3)] = acc[dvb][reg]; } }
}
__device__ __forceinline__ void stage_read(const LAS float* st, int lane, float* v) {
    const int row = lane >> 1, half = lane & 1;
#pragma unroll
    for (int j = 0; j < 16; ++j) { const f32x4 q = *(const LAS f32x4*)(st + row * 128 + stg_pos(16 * half + j, row) * 4); v[4 * j] = q[0]; v[4 * j + 1] = q[1]; v[4 * j + 2] = q[2]; v[4 * j + 3] = q[3]; }
}
__device__ __forceinline__ void gated_store64(const float* v, float rs, const float* __restrict__ g, const bf16* __restrict__ zrow, bf16* __restrict__ yrow) {
    v4u zz[8];
#pragma unroll
    for (int j = 0; j < 8; ++j) zz[j] = *(const v4u*)(zrow + 8 * j);
#pragma unroll
    for (int j = 0; j < 8; ++j) { const f32x4 g0 = *(const f32x4*)(g + 8 * j), g1 = *(const f32x4*)(g + 8 * j + 4); float z[8]; unpack8(zz[j], z);
        v4u w; w.x = pk2(v[8 * j] * rs * g0[0] * z[0], v[8 * j + 1] * rs * g0[1] * z[1]); w.y = pk2(v[8 * j + 2] * rs * g0[2] * z[2], v[8 * j + 3] * rs * g0[3] * z[3]);
        w.z = pk2(v[8 * j + 4] * rs * g1[0] * z[4], v[8 * j + 5] * rs * g1[1] * z[5]); w.w = pk2(v[8 * j + 6] * rs * g1[2] * z[6], v[8 * j + 7] * rs * g1[3] * z[7]);
        *(v4u*)(yrow + 8 * j) = w; }
}

namespace mla {
constexpr int NW = 8, QBLK = 32, KVBLK = 64;
constexpr int SHM_V = 16384, SHM_KN = 16384, SHM_KR = 8192;
constexpr int OFF_V = 0, OFF_KN = 2 * SHM_V, OFF_KR = OFF_KN + 2 * SHM_KN, OFF_WS = OFF_KR + 2 * SHM_KR, OFF_QR = OFF_WS + NW * 64 * 4, ATTN_LDS = OFF_QR + NW * 4096;
constexpr float THR = 8.f;
#define KSWZ(row, colB) ((row) * 256 + ((colB) ^ (((row) & 7) << 4)))
#define KRSWZ(row, colB) ((row) * 128 + ((colB) ^ ((((row) >> 1) & 7) << 4)))
#define SBAR() __builtin_amdgcn_sched_barrier(0)
__device__ __forceinline__ int crow(int r, int hi) { return (r & 3) + 8 * (r >> 2) + 4 * hi; }
__device__ __forceinline__ unsigned cvtpk(float lo, float hi) { unsigned r; asm volatile("v_cvt_pk_bf16_f32 %0, %1, %2" : "=v"(r) : "v"(lo), "v"(hi)); return r; }

__device__ __forceinline__ void partialSM(f32x16& p0, f32x16& p1, float& m_reg, float& mn, float& alpha) {
  float pmax = p0[0];
#pragma unroll
  for (int r = 1; r < 16; ++r) pmax = fmaxf(pmax, p0[r]);
#pragma unroll
  for (int r = 0; r < 16; ++r) pmax = fmaxf(pmax, p1[r]);
  { auto rr = __builtin_amdgcn_permlane32_swap(__float_as_uint(pmax), __float_as_uint(pmax), false, false);
    pmax = fmaxf(__uint_as_float(rr[0]), __uint_as_float(rr[1])); }
  if (__builtin_expect(__all(pmax - m_reg <= THR), 1)) { mn = m_reg; alpha = 1.f; }
  else { mn = fmaxf(m_reg, pmax); alpha = __builtin_amdgcn_exp2f(m_reg - mn); m_reg = mn; }
#pragma unroll
  for (int r = 0; r < 16; ++r) p0[r] = p0[r] - mn;
#pragma unroll
  for (int r = 0; r < 16; ++r) p1[r] = p1[r] - mn;
#pragma unroll
  for (int r = 0; r < 16; ++r) p0[r] = __builtin_amdgcn_exp2f(p0[r]);
}
__device__ __forceinline__ void finishSM(f32x16& p0, f32x16& p1, float alpha, float& l_reg, bf16x8& pa0, bf16x8& pa1, bf16x8& pa2, bf16x8& pa3) {
#pragma unroll
  for (int r = 0; r < 16; ++r) p1[r] = __builtin_amdgcn_exp2f(p1[r]);
  float ps = 0;
#pragma unroll
  for (int r = 0; r < 16; ++r) ps += p0[r];
#pragma unroll
  for (int r = 0; r < 16; ++r) ps += p1[r];
  { auto rr = __builtin_amdgcn_permlane32_swap(__float_as_uint(ps), __float_as_uint(ps), false, false);
    ps = __uint_as_float(rr[0]) + __uint_as_float(rr[1]); }
  l_reg = l_reg * alpha + ps;
#define PK4(P, BASE, OUT) do { unsigned a0 = cvtpk(P[BASE + 0], P[BASE + 1]), a1 = cvtpk(P[BASE + 2], P[BASE + 3]);   \
    unsigned b0 = cvtpk(P[BASE + 4], P[BASE + 5]), b1 = cvtpk(P[BASE + 6], P[BASE + 7]);                              \
    auto r0 = __builtin_amdgcn_permlane32_swap(a0, b0, false, false); auto r1 = __builtin_amdgcn_permlane32_swap(a1, b1, false, false); \
    v4u w = {r0[0], r1[0], r0[1], r1[1]}; OUT = *reinterpret_cast<bf16x8*>(&w); } while (0)
  PK4(p0, 0, pa0); PK4(p0, 8, pa1); PK4(p1, 0, pa2); PK4(p1, 8, pa3);
#undef PK4
}
__device__ __forceinline__ void qkt(f32x16& p0, f32x16& p1, const char* Kn, const char* Kr, const bf16x8* qr, const char* Qr, int r32, int hi) {
  p0 = f32x16{}; p1 = f32x16{};
  int tn = (hi * 16) ^ ((r32 & 7) << 4), tr = (hi * 16) ^ (((r32 >> 1) & 7) << 4);
  asm volatile("" : "+v"(tn), "+v"(tr));
  const char* knb = Kn + r32 * 256; const char* krb = Kr + r32 * 128; const char* qrb = Qr + r32 * 128;
#pragma unroll
  for (int d0 = 0; d0 < 8; ++d0) { const int off = (d0 * 32) ^ tn;
    const bf16x8 b0 = *reinterpret_cast<const bf16x8*>(knb + off);
    const bf16x8 b1 = *reinterpret_cast<const bf16x8*>(knb + off + 8192);
    p0 = __builtin_amdgcn_mfma_f32_32x32x16_bf16(b0, qr[d0], p0, 0, 0, 0);
    p1 = __builtin_amdgcn_mfma_f32_32x32x16_bf16(b1, qr[d0], p1, 0, 0, 0); }
#pragma unroll
  for (int d0 = 0; d0 < 4; ++d0) { const int off = (d0 * 32) ^ tr;
    const bf16x8 b0 = *reinterpret_cast<const bf16x8*>(krb + off);
    const bf16x8 b1 = *reinterpret_cast<const bf16x8*>(krb + off + 4096);
    const bf16x8 qv = *reinterpret_cast<const bf16x8*>(qrb + off);
    p0 = __builtin_amdgcn_mfma_f32_32x32x16_bf16(b0, qv, p0, 0, 0, 0);
    p1 = __builtin_amdgcn_mfma_f32_32x32x16_bf16(b1, qv, p1, 0, 0, 0); }
}
__device__ __forceinline__ int v_st(int k, int c) { const int kk = (k & ~0xC) | ((k & 4) << 1) | ((k & 8) >> 1); return ((kk >> 3) * 4 + (c >> 5)) * 512 + ((kk & 7) * 32 + (c & 31)) * 2; }
__device__ __forceinline__ int v_rd_base(int lane) { return ((lane & 3) << 3) | (((lane >> 2) & 3) << 6) | (((lane >> 4) & 1) << 5) | (((lane >> 5) & 1) << 8); }
constexpr int v_rd_off(int d0, int ks, int half) { return d0 * 512 + ks * 4096 + half * 2048; }
template <int OFF> __device__ __forceinline__ s16x4 tr_read(int vb) {
  s16x4 r; asm volatile("ds_read_b64_tr_b16 %0, %1 offset:%2" : "=&v"(r) : "v"(vb), "i"(OFF) : "memory"); return r;
}
template <int D0> __device__ __forceinline__ void pv_one(f32x16& od, int vb, bf16x8 pa0, bf16x8 pa1, bf16x8 pa2, bf16x8 pa3) {
  const s16x4 l0 = tr_read<v_rd_off(D0, 0, 0)>(vb), h0 = tr_read<v_rd_off(D0, 0, 1)>(vb), l1 = tr_read<v_rd_off(D0, 1, 0)>(vb), h1 = tr_read<v_rd_off(D0, 1, 1)>(vb);
  const s16x4 l2 = tr_read<v_rd_off(D0, 2, 0)>(vb), h2 = tr_read<v_rd_off(D0, 2, 1)>(vb), l3 = tr_read<v_rd_off(D0, 3, 0)>(vb), h3 = tr_read<v_rd_off(D0, 3, 1)>(vb);
  asm volatile("s_waitcnt lgkmcnt(0)" ::: "memory"); SBAR();
#define PK(L, H) (bf16x8){L[0], L[1], L[2], L[3], H[0], H[1], H[2], H[3]}
  od = __builtin_amdgcn_mfma_f32_32x32x16_bf16(pa0, PK(l0, h0), od, 0, 0, 0);
  od = __builtin_amdgcn_mfma_f32_32x32x16_bf16(pa1, PK(l1, h1), od, 0, 0, 0);
  od = __builtin_amdgcn_mfma_f32_32x32x16_bf16(pa2, PK(l2, h2), od, 0, 0, 0);
  od = __builtin_amdgcn_mfma_f32_32x32x16_bf16(pa3, PK(l3, h3), od, 0, 0, 0);
#undef PK
}
__device__ __forceinline__ void pv_d0(f32x16* o, int vb, bf16x8 pa0, bf16x8 pa1, bf16x8 pa2, bf16x8 pa3) {
  pv_one<0>(o[0], vb, pa0, pa1, pa2, pa3); pv_one<1>(o[1], vb, pa0, pa1, pa2, pa3); pv_one<2>(o[2], vb, pa0, pa1, pa2, pa3); pv_one<3>(o[3], vb, pa0, pa1, pa2, pa3);
}

__device__ __forceinline__ void attn_unit(const bf16* __restrict__ Qb, const bf16* __restrict__ Knh, const bf16* __restrict__ Vh, const bf16* __restrict__ Krh,
                                          bf16* __restrict__ Yb, const bf16* __restrict__ Zb, const float* __restrict__ gh, float* __restrict__ part, int seq, char* lds) {
  int tid_ = threadIdx.x; asm volatile("" : "+v"(tid_));
  const int tid = tid_, wid = tid >> 6, lane = tid & 63, r32 = lane & 31, hi = lane >> 5;
  char* V_lds = lds + OFF_V; char* KN_lds = lds + OFF_KN; char* KR_lds = lds + OFF_KR;
  float* ws = (float*)(lds + OFF_WS) + wid * 64; float* li_l = ws; float* al_l = ws + 32;
  float m_reg = -1e30f, l_reg = 0; f32x16 o[4] = {}; bf16x8 qr[8]; char* QR_lds = lds + OFF_QR + wid * 4096;
  const bf16* Qw = Qb + (long)(wid * QBLK + r32) * NQ + hi * 8;
#pragma unroll
  for (int d0 = 0; d0 < 8; ++d0) qr[d0] = *reinterpret_cast<const bf16x8*>(Qw + d0 * 16);
#pragma unroll
  for (int d0 = 0; d0 < 4; ++d0) *reinterpret_cast<bf16x8*>(QR_lds + KRSWZ(r32, (d0 * 16 + hi * 8) * 2)) = *reinterpret_cast<const bf16x8*>(Qw + 128 + d0 * 16);
  const int sr = tid >> 4, sc = (tid & 15) * 8, vst0 = v_st(sr, sc), vst1 = v_st(32 + sr, sc);
  const int krr = tid >> 3, krc = (tid & 7) * 8;
  const int vb0 = (int)(uintptr_t)V_lds + v_rd_base(lane);
  bf16x8 vs0, vs1, ks0, ks1, kr0;
#define SLOAD(k0) do { vs0 = *reinterpret_cast<const bf16x8*>(&Vh[(long)((k0) + sr) * NKV + sc]); vs1 = *reinterpret_cast<const bf16x8*>(&Vh[(long)((k0) + 32 + sr) * NKV + sc]); \
    ks0 = *reinterpret_cast<const bf16x8*>(&Knh[(long)((k0) + sr) * NKV + sc]); ks1 = *reinterpret_cast<const bf16x8*>(&Knh[(long)((k0) + 32 + sr) * NKV + sc]); \
    kr0 = *reinterpret_cast<const bf16x8*>(&Krh[(long)((k0) + krr) * NP + krc]); } while (0)
#define SWRITE(b) do { *(bf16x8*)(V_lds + (b) * SHM_V + vst0) = vs0; *(bf16x8*)(V_lds + (b) * SHM_V + vst1) = vs1; const int kc = sc * 2;   \
    *(bf16x8*)(KN_lds + (b) * SHM_KN + KSWZ(sr, kc)) = ks0; *(bf16x8*)(KN_lds + (b) * SHM_KN + KSWZ(32 + sr, kc)) = ks1;                       \
    *(bf16x8*)(KR_lds + (b) * SHM_KR + KRSWZ(krr, krc * 2)) = kr0; } while (0)
#define SWAIT() asm volatile("s_waitcnt vmcnt(0)" ::: "memory")
#define RESC(a) do { if (__any((a) < 1.f)) { if (hi == 0) al_l[r32] = (a); asm volatile("s_waitcnt lgkmcnt(0)" ::: "memory"); \
    _Pragma("unroll") for (int d = 0; d < 4; ++d) _Pragma("unroll") for (int r = 0; r < 16; ++r) o[d][r] *= al_l[crow(r, hi)]; } } while (0)
  f32x16 pA0, pA1, pB0, pB1; float mnA, mnB, alA, alB; bf16x8 pa0, pa1, pa2, pa3; const int NT = seq / KVBLK;
  SLOAD(0); SWAIT(); SWRITE(0); __syncthreads();
  qkt(pA0, pA1, KN_lds, KR_lds, qr, QR_lds, r32, hi); partialSM(pA0, pA1, m_reg, mnA, alA);
  SLOAD(KVBLK);
  SWAIT(); SWRITE(1); __syncthreads();
  for (int j = 1; j + 1 < NT; j += 2) {
    SBAR(); qkt(pB0, pB1, KN_lds + SHM_KN, KR_lds + SHM_KR, qr, QR_lds, r32, hi);
    finishSM(pA0, pA1, alA, l_reg, pa0, pa1, pa2, pa3); SBAR();
    SLOAD((j + 1) * KVBLK); SBAR();
    pv_d0(o, vb0, pa0, pa1, pa2, pa3); partialSM(pB0, pB1, m_reg, mnB, alB);
    __syncthreads(); SWAIT(); SWRITE(0);
    RESC(alB); __syncthreads();
    SBAR(); qkt(pA0, pA1, KN_lds, KR_lds, qr, QR_lds, r32, hi);
    finishSM(pB0, pB1, alB, l_reg, pa0, pa1, pa2, pa3); SBAR();
    SLOAD((j + 2) * KVBLK); SBAR();
    pv_d0(o, vb0 + SHM_V, pa0, pa1, pa2, pa3); partialSM(pA0, pA1, m_reg, mnA, alA);
    __syncthreads(); SWAIT(); SWRITE(1);
    RESC(alA); __syncthreads();
  }
  SBAR(); qkt(pB0, pB1, KN_lds + SHM_KN, KR_lds + SHM_KR, qr, QR_lds, r32, hi);
  finishSM(pA0, pA1, alA, l_reg, pa0, pa1, pa2, pa3); SBAR();
  pv_d0(o, vb0, pa0, pa1, pa2, pa3); partialSM(pB0, pB1, m_reg, mnB, alB);
  __syncthreads(); RESC(alB);
  finishSM(pB0, pB1, alB, l_reg, pa0, pa1, pa2, pa3); SBAR();
  pv_d0(o, vb0 + SHM_V, pa0, pa1, pa2, pa3);
  if (hi == 0) li_l[r32] = l_reg; asm volatile("s_waitcnt lgkmcnt(0)" ::: "memory");
  float rli[16];
#pragma unroll
  for (int r = 0; r < 16; ++r) rli[r] = __builtin_amdgcn_rcpf(li_l[crow(r, hi)]);
#pragma unroll
  for (int d0 = 0; d0 < 4; ++d0)
#pragma unroll
    for (int r = 0; r < 16; ++r) o[d0][r] *= rli[r];
  __syncthreads();
  { LAS float* st = (LAS float*)(LAS unsigned char*)(lds + wid * 16384);
    stage_write(st, o, r32, hi);
    asm volatile("s_waitcnt lgkmcnt(0)" ::: "memory");
    float v[64]; stage_read(st, lane, v);
    const int row = lane >> 1, half = lane & 1; const long rr = wid * QBLK + row;
    float ss = 0.f;
#pragma unroll
    for (int j = 0; j < 64; ++j) ss += v[j] * v[j];
    ss += __shfl_xor(ss, 1);
    if (half == 0) part[rr * 8] = ss;
    gated_store64(v, 1.f, gh + half * 64, Zb + rr * NP + half * 64, Yb + rr * DM + half * 64); }
  __syncthreads();
#undef SLOAD
#undef SWRITE
#undef SWAIT
#undef RESC
}
#undef SBAR
}
struct Frame {
    LAS unsigned char* lds; char* ldsg;
    int tid, lane, wave, vcu, G;
    float* out; unsigned char* ws;
};
__device__ __forceinline__ const float* ld_in(int i) {
    const __attribute__((address_space(4))) char* ka = (const __attribute__((address_space(4))) char*)__builtin_amdgcn_kernarg_segment_ptr();
    asm volatile("" : "+s"(i));
    const GAS float* p = *(const GAS float* const __attribute__((address_space(4)))*)(ka + 8 * i);
    return (const float*)p;
}
#define WSP(T_, off) ((T_*)(F.ws + (off)))

__device__ __forceinline__ void p0_mods(Frame& F, size_t mods_off) {
    LAS float* sc = (LAS float*)F.lds;
    LAS float* part = (LAS float*)(F.lds + 32768);
    const float* c = ld_in(1); const float* aw = ld_in(3); const float* ab = ld_in(4);
    for (int i = F.tid; i < BATCH * DM; i += NTHR) { const float v = c[i]; sc[i] = v / (1.f + __expf(-v)); }
    __syncthreads();
    for (int item = (int)blockIdx.x; item < 768; item += F.G) {
        const int ks = item & 15, cb = (item >> 4) % 24, l = item / 384, j0 = cb * 256, kb = ks * 128 + F.wave * 16;
        const f32x4* w = (const f32x4*)(aw + (size_t)l * DM * 3 * DM + (size_t)kb * 3 * DM + j0) + F.lane;
        f32x4 wv[16];
#pragma unroll
        for (int k = 0; k < 16; ++k) wv[k] = w[(size_t)k * (3 * DM / 4)];
        f32x4 a[4] = {};
#pragma unroll
        for (int k = 0; k < 16; ++k)
#pragma unroll
            for (int b = 0; b < 4; ++b) a[b] += wv[k] * sc[b * DM + kb + k];
#pragma unroll
        for (int b = 0; b < 4; ++b) *(LAS f32x4*)(part + (F.wave * 4 + b) * 256 + F.lane * 4) = a[b];
        __syncthreads();
        for (int o = F.tid; o < 1024; o += NTHR) { const int b = o >> 8, col = o & 255; float s = 0.f;
#pragma unroll
            for (int wv2 = 0; wv2 < 8; ++wv2) s += part[(wv2 * 4 + b) * 256 + col];
            if (ks == 0) s += ab[l * 3 * DM + j0 + col];
            atomicAdd(WSP(float, mods_off) + ((size_t)l * BATCH + b) * 3 * DM + j0 + col, s); }
        __syncthreads();
    }
}
__device__ __forceinline__ int kmap_out(int k) { return k < 768 ? k + 768 : (k < 1536 ? k - 768 : k); }
template <int MAP, bool KMAP> __device__ __forceinline__ void p0_transpose_item(const float* W, int K, int N, bf16* WT, const float* kgain, LAS bf16* tl, int item, int nblk, int lane) {
    const int kb = item / nblk, nb = item % nblk, k0 = 64 * kb, n0 = 64 * nb, ks0 = KMAP ? kmap_out(k0) : k0;
    const int nq = (lane & 15) * 4, kr = lane >> 4;
    const int s0 = MAP == 1 ? map_in(n0) : (MAP == 2 ? map_uq(n0) : n0), s63 = MAP == 1 ? map_in(n0 + 63) : (MAP == 2 ? map_uq(n0 + 63) : n0 + 63);
    const int s1 = MAP == 1 ? map_in(n0 + 1) : (MAP == 2 ? map_uq(n0 + 1) : n0 + 1);
    if (s0 >= 0 && s63 - s0 == 63 && s1 == s0 + 1) {
        f32x4 v[16];
#pragma unroll
        for (int i = 0; i < 16; ++i) v[i] = *(const f32x4*)(W + (size_t)(ks0 + 4 * i + kr) * N + s0 + nq);
#pragma unroll
        for (int i = 0; i < 16; ++i) { const int kk = 4 * i + kr; const float gsc = kgain ? kgain[k0 + kk] : 1.f;
#pragma unroll
            for (int e = 0; e < 4; ++e) tl[(nq + e) * 72 + kk] = (unsigned short)f2bf(v[i][e] * gsc); }
    } else {
        const int np = n0 + lane; const int src = MAP == 1 ? map_in(np) : (MAP == 2 ? map_uq(np) : np);
        float v[64];
#pragma unroll
        for (int i = 0; i < 64; ++i) v[i] = src >= 0 ? W[(size_t)(ks0 + i) * N + src] : 0.f;
#pragma unroll
        for (int i = 0; i < 64; i += 2) { const float g0 = kgain ? kgain[k0 + i] : 1.f, g1 = kgain ? kgain[k0 + i + 1] : 1.f;
            *(LAS unsigned*)(tl + lane * 72 + i) = pk2(v[i] * g0, v[i + 1] * g1); }
    }
    LDS_WAIT(); asm volatile("" ::: "memory");
    bf16* orow = WT + (size_t)(n0 + lane) * K + k0;
#pragma unroll
    for (int cch = 0; cch < 8; ++cch) *(GAS v4u*)(orow + 8 * cch) = *(const LAS v4u*)(tl + lane * 72 + 8 * cch);
    LDS_WAIT(); asm volatile("" ::: "memory");
}
__device__ __forceinline__ void p0_prologue(Frame& F, size_t mods_off) {
    p0_mods(F, mods_off);
    LAS bf16* tl = (LAS bf16*)(F.lds + F.wave * 9216);
    const int gw = F.vcu * NWAVES + F.wave, NGW = F.G * NWAVES;
    constexpr int I_IN = (DM / 64) * (NP / 64), I_OUT = (DM / 64) * (DM / 64), I_UQ = (384 / 64) * (NQ / 64), I_UKV = (256 / 64) * (NKV / 64), I_L = I_IN + I_OUT + I_UQ + I_UKV;
    for (int it = gw; it < DEPTH * I_L; it += NGW) {
        const int l = it / I_L; int r = it % I_L;
        if (r < I_IN) { p0_transpose_item<1, false>(ld_in(6) + (size_t)l * DM * IN_DIM, DM, IN_DIM, WSP(bf16, WS_WIN) + (size_t)l * NP * DM, nullptr, tl, r, NP / 64, F.lane); continue; } r -= I_IN;
        if (r < I_OUT) { p0_transpose_item<0, true>(ld_in(19) + (size_t)l * DM * DM, DM, DM, WSP(bf16, WS_WOUT) + (size_t)l * DM * DM, nullptr, tl, r, DM / 64, F.lane); continue; } r -= I_OUT;
        if (r < I_UQ) { p0_transpose_item<2, false>(ld_in(14) + (size_t)l * 384 * 1152, 384, 1152, WSP(bf16, WS_WUQ) + (size_t)l * NQ * 384, ld_in(12) + l * 384, tl, r, NQ / 64, F.lane); continue; } r -= I_UQ;
        p0_transpose_item<0, false>(ld_in(15) + (size_t)l * 256 * 1536, 256, 1536, WSP(bf16, WS_WUKV) + (size_t)l * NKV * 256, ld_in(13) + l * 256, tl, r, NKV / 64, F.lane);
    }
    const int* pos = (const int*)ld_in(2);
    for (int i = (int)blockIdx.x * NTHR + F.tid; i < T * 32; i += F.G * NTHR) {
        const int t = i >> 5, f = i & 31;
        const float inv = (float)exp2(-(double)f * (13.287712379549449 / 32.0));
        const float ang = (float)pos[t] * inv;
        const double rev = (double)ang * 0.15915494309189535; const float fr = (float)(rev - floor(rev));
        WSP(float, WS_CS)[i] = __builtin_amdgcn_cosf(fr); WSP(float, WS_SN)[i] = __builtin_amdgcn_sinf(fr);
    }
}
__device__ __forceinline__ void modnorm_rows(Frame& F, const float* x, const float* g, const float* mods_l, bf16* H) {
    const int gw = F.vcu * NWAVES + F.wave, NGW = F.G * NWAVES;
    for (int t = gw; t < T; t += NGW) {
        const GAS f32x4* xr = (const GAS f32x4*)(x + (size_t)t * DM) + F.lane;
        f32x4 v[8]; float s = 0.f;
#pragma unroll
        for (int j = 0; j < 8; ++j) { v[j] = xr[64 * j]; s += (v[j][0] * v[j][0] + v[j][1] * v[j][1]) + (v[j][2] * v[j][2] + v[j][3] * v[j][3]); }
        const float rstd = __builtin_amdgcn_rsqf(wave_sum(s) * (1.f / DM) + EPS);
        const float* sh = mods_l + (size_t)(t / SEQ) * 3 * DM; const float* scl = sh + DM;
        GAS v2u* o8 = (GAS v2u*)(H + (size_t)t * DM) + F.lane;
#pragma unroll
        for (int j = 0; j < 8; ++j) { const int col = (F.lane + 64 * j) * 4;
            const f32x4 gg = *(const f32x4*)(g + col), sv = *(const f32x4*)(scl + col), hv = *(const f32x4*)(sh + col);
            const f32x4 r = v[j] * rstd * gg * (sv + 1.f) + hv;
            v2u w; w.x = pk2(r[0], r[1]); w.y = pk2(r[2], r[3]); o8[64 * j] = w; }
    }
}
__device__ __forceinline__ void finalnorm_rows(Frame& F, float* x, const float* g) {
    const int gw = F.vcu * NWAVES + F.wave, NGW = F.G * NWAVES;
    for (int t = gw; t < T; t += NGW) {
        GAS f32x4* xr = (GAS f32x4*)(x + (size_t)t * DM) + F.lane;
        f32x4 v[8]; float s = 0.f;
#pragma unroll
        for (int j = 0; j < 8; ++j) { v[j] = xr[64 * j]; s += (v[j][0] * v[j][0] + v[j][1] * v[j][1]) + (v[j][2] * v[j][2] + v[j][3] * v[j][3]); }
        const float rstd = __builtin_amdgcn_rsqf(wave_sum(s) * (1.f / DM) + EPS);
#pragma unroll
        for (int j = 0; j < 8; ++j) { const f32x4 gg = *(const f32x4*)(g + (F.lane + 64 * j) * 4); xr[64 * j] = v[j] * rstd * gg; }
    }
}
__device__ __forceinline__ void conv_rows(Frame& F, int l) {
    const int gw = F.vcu * NWAVES + F.wave, NGW = F.G * NWAVES;
    const bf16* P = WSP(bf16, WS_PROJ); bf16* Y = WSP(bf16, WS_HY);
    const float* cw = ld_in(17) + l * 3 * 512; const float* cg = ld_in(18) + l * 512;
    const int ch = F.lane * 8;
    for (int t = gw; t < T; t += NGW) {
        const int s = t % SEQ; const bf16* p = P + (size_t)t * NP;
        float u[3][8];
#pragma unroll
        for (int d = 0; d < 3; ++d) { const int ss = s + d - 1;
            if (ss >= 0 && ss < SEQ) { const bf16* q = p + (long)(d - 1) * NP; float a[8], b[8]; unpack8(*(const v4u*)(q + C_CC + ch), a); unpack8(*(const v4u*)(q + C_CX + ch), b);
#pragma unroll
                for (int e = 0; e < 8; ++e) u[d][e] = a[e] * b[e]; }
            else {
#pragma unroll
                for (int e = 0; e < 8; ++e) u[d][e] = 0.f; } }
        float cb[8], sz[8], pre[8]; unpack8(*(const v4u*)(p + C_CB + ch), cb); unpack8(*(const v4u*)(p + C_Z + 1536 + ch), sz);
        float ssq = 0.f;
#pragma unroll
        for (int e = 0; e < 8; ++e) { pre[e] = cb[e] * (u[0][e] * cw[ch + e] + u[1][e] * cw[512 + ch + e] + u[2][e] * cw[1024 + ch + e]); ssq += pre[e] * pre[e]; }
        const float rstd = __builtin_amdgcn_rsqf(wave_sum(ssq) * (1.f / 512.f) + EPS);
        float r[8];
#pragma unroll
        for (int e = 0; e < 8; ++e) r[e] = pre[e] * rstd * cg[ch + e] * sz[e];
        v4u w; w.x = pk2(r[0], r[1]); w.y = pk2(r[2], r[3]); w.z = pk2(r[4], r[5]); w.w = pk2(r[6], r[7]);
        *(v4u*)(Y + (size_t)t * DM + 1536 + ch) = w;
    }
}
__device__ __forceinline__ void mlaout_rows(Frame& F, int l) {
    const int gw = F.vcu * NWAVES + F.wave, NGW = F.G * NWAVES;
    const bf16* P = WSP(bf16, WS_PROJ); bf16* Y = WSP(bf16, WS_HY); const float* O = WSP(float, WS_OMLA); const float* g = ld_in(16) + l * 768;
    for (int t = gw; t < T; t += NGW) {
        f32x4 v[3]; float s = 0.f;
#pragma unroll
        for (int j = 0; j < 3; ++j) { v[j] = *(const f32x4*)(O + (size_t)t * 768 + (F.lane + 64 * j) * 4); s += (v[j][0] * v[j][0] + v[j][1] * v[j][1]) + (v[j][2] * v[j][2] + v[j][3] * v[j][3]); }
        const float rstd = __builtin_amdgcn_rsqf(wave_sum(s) * (1.f / 768.f) + EPS);
#pragma unroll
        for (int j = 0; j < 3; ++j) { const int col = (F.lane + 64 * j) * 4; const f32x4 gg = *(const f32x4*)(g + col);
            const v2u zw = *(const v2u*)(P + (size_t)t * NP + C_Z + 768 + col);
            const f32x4 r = v[j] * rstd * gg; v2u w; w.x = pk2(r[0] * bflo(zw.x), r[1] * bfhi(zw.x)); w.y = pk2(r[2] * bflo(zw.y), r[3] * bfhi(zw.y));
            *(v2u*)(Y + (size_t)t * DM + col) = w; }
    }
}


template <int KS> __device__ __forceinline__ f32x16 tile_mm(const LAS bf16* A, const LAS bf16* Bt, int r, int hh, f32x16 acc) {
#pragma unroll
    for (int s = 0; s < KS; ++s) {
        const bf16x8 a = *(const LAS bf16x8*)(A + r * 72 + 16 * s + 8 * hh), b = *(const LAS bf16x8*)(Bt + r * 72 + 16 * s + 8 * hh);
        acc = __builtin_amdgcn_mfma_f32_32x32x16_bf16(a, b, acc, 0, 0, 0);
    }
    return acc;
}
__device__ __forceinline__ float logsig16(float a) { return (fminf(a, 0.f) - __logf(1.f + __expf(-fabsf(a)))) * (1.f / 16.f); }
__device__ __forceinline__ void gla_a_item(Frame& F, int l, int item) {
    const int h = item % 6, bn = item / 6, t0 = bn * 64;
    const int tid = F.tid, lane = F.lane, wave = F.wave;
    LAS unsigned char* L = F.lds;
    LAS bf16* QB = (LAS bf16*)(L);
    LAS bf16* KB = (LAS bf16*)(L + 9216);
    LAS bf16* Mm = (LAS bf16*)(L);
    LAS bf16* VT = (LAS bf16*)(L + 18432);
    LAS float* LR = (LAS float*)(L + 36864);
    LAS float* WG = (LAS float*)(L + 36864 + 8192);
    LAS float* BG = (LAS float*)(L + 36864 + 16384);
    LAS bf16* KDT = (LAS bf16*)(L + 36864);
    LAS float* LA = (LAS float*)(L + 55296);
    LAS float* SEGT = (LAS float*)(L + 88576);
    LAS bf16* QF = (LAS bf16*)(L + 90624);
    LAS bf16* KF = (LAS bf16*)(L + 90624 + 18432);
    const bf16* P = WSP(bf16, WS_PROJ) + (size_t)t0 * NP;
    { const int r = tid >> 3, c8 = (tid & 7) * 8;
      *(LAS v4u*)(QB + r * 72 + c8) = *(const v4u*)(P + (size_t)r * NP + C_GQ + h * 64 + c8);
      *(LAS v4u*)(KB + r * 72 + c8) = *(const v4u*)(P + (size_t)r * NP + C_GK + h * 64 + c8); }
#pragma unroll
    for (int i = 0; i < 2; ++i) { const int idx = tid + i * 512, r = idx >> 4, c8 = (idx & 15) * 8;
        const v4u raw = *(const v4u*)(P + (size_t)r * NP + C_GV + h * 128 + c8);
        VT[(c8 + 0) * 72 + r] = (unsigned short)(raw.x & 0xffffu); VT[(c8 + 1) * 72 + r] = (unsigned short)(raw.x >> 16);
        VT[(c8 + 2) * 72 + r] = (unsigned short)(raw.y & 0xffffu); VT[(c8 + 3) * 72 + r] = (unsigned short)(raw.y >> 16);
        VT[(c8 + 4) * 72 + r] = (unsigned short)(raw.z & 0xffffu); VT[(c8 + 5) * 72 + r] = (unsigned short)(raw.z >> 16);
        VT[(c8 + 6) * 72 + r] = (unsigned short)(raw.w & 0xffffu); VT[(c8 + 7) * 72 + r] = (unsigned short)(raw.w >> 16); }
    if (tid < 256) { const int r = tid >> 2, c8 = (tid & 3) * 8; float f[8]; unpack8(*(const v4u*)(P + (size_t)r * NP + C_LR + c8), f);
#pragma unroll
        for (int e = 0; e < 8; ++e) LR[r * 32 + c8 + e] = f[e]; }
    { const int dir = tid >> 8, r = (tid >> 4) & 15, c4 = (tid & 15) * 4; const float* wgf_ = ld_in(7); const float* wgb_ = ld_in(9); const float* wsrc = (dir ? wgb_ : wgf_) + (size_t)l * 16 * 384 + r * 384 + h * 64 + c4;
      *(LAS f32x4*)(WG + (dir * 16 + r) * 64 + c4) = *(const f32x4*)wsrc; }
    if (tid < 128) { const int dir = tid >> 6, dk = tid & 63; const float* bgf_ = ld_in(8); const float* bgb_ = ld_in(10); BG[dir * 64 + dk] = (dir ? bgb_ : bgf_)[l * 384 + h * 64 + dk]; }
    LDS_WAIT(); __syncthreads();
    { const int tok = tid >> 3, dkg = (tid & 7) * 8;
#pragma unroll
      for (int dir = 0; dir < 2; ++dir) { float a[8];
#pragma unroll
        for (int e = 0; e < 8; ++e) a[e] = BG[dir * 64 + dkg + e];
#pragma unroll
        for (int r = 0; r < 16; ++r) { const float x = LR[tok * 32 + dir * 16 + r];
#pragma unroll
            for (int e = 0; e < 8; ++e) a[e] += x * WG[(dir * 16 + r) * 64 + dkg + e]; }
#pragma unroll
        for (int e = 0; e < 8; ++e) LA[(dir * 64 + tok) * 65 + dkg + e] = logsig16(a[e]); } }
    LDS_WAIT(); __syncthreads();
    const int cdir = (tid >> 6) & 1, cdk = tid & 63, seg = tid >> 7;
    float pb[16];
#pragma unroll
    for (int i = 0; i < 16; ++i) pb[i] = LA[(cdir * 64 + seg * 16 + i) * 65 + cdk];
    if (cdir == 0) {
#pragma unroll
        for (int i = 1; i < 16; ++i) pb[i] += pb[i - 1];
    } else {
#pragma unroll
        for (int i = 14; i >= 0; --i) pb[i] += pb[i + 1];
    }
    SEGT[(cdir * 4 + seg) * 64 + cdk] = cdir == 0 ? pb[15] : pb[0];
    LDS_WAIT(); __syncthreads();
    { float offv = 0.f, tot = 0.f;
#pragma unroll
      for (int s2 = 0; s2 < 4; ++s2) { const float sv = SEGT[(cdir * 4 + s2) * 64 + cdk]; tot += sv; if (cdir == 0 ? (s2 < seg) : (s2 > seg)) offv += sv; }
      bf16* QD = WSP(bf16, WS_QDEC) + (size_t)cdir * T * 384 + (size_t)t0 * 384 + h * 64 + cdk;
      unsigned kd[8];
#pragma unroll
      for (int i = 0; i < 16; ++i) { const int tok = seg * 16 + i; const float bv = pb[i] + offv;
          const float q = bf2f(QB[tok * 72 + cdk]), k = bf2f(KB[tok * 72 + cdk]);
          const unsigned short qd = (unsigned short)f2bf(q * 0.125f * __expf(bv)), ki = (unsigned short)f2bf(k * __expf(-bv)), kdv = (unsigned short)f2bf(k * __expf(tot - bv));
          QF[(cdir * 64 + tok) * 72 + cdk] = qd; KF[(cdir * 64 + tok) * 72 + cdk] = ki; QD[(size_t)tok * 384] = qd;
          if (i & 1) kd[i >> 1] |= (unsigned)kdv << 16; else kd[i >> 1] = kdv;
          if ((i & 3) == 3) __builtin_amdgcn_sched_barrier(0); }
      *(LAS v4u*)(KDT + (cdir * 64 + cdk) * 72 + seg * 16) = (v4u){kd[0], kd[1], kd[2], kd[3]};
      *(LAS v4u*)(KDT + (cdir * 64 + cdk) * 72 + seg * 16 + 8) = (v4u){kd[4], kd[5], kd[6], kd[7]};
      if (seg == 0) WSP(float, WS_DECAY)[((size_t)item * 2 + cdir) * 64 + cdk] = __expf(tot); }
    LDS_WAIT(); __syncthreads();
    const int r = lane & 31, hh = lane >> 5;
    if (wave < 4) {
        const int pb2 = wave >> 1, jb = wave & 1; f32x16 sf = {}, sb = {};
        if (pb2 >= jb) sf = tile_mm<4>(QF + (0 * 64 + pb2 * 32) * 72, KF + (0 * 64 + jb * 32) * 72, r, hh, sf);
        if (pb2 <= jb) sb = tile_mm<4>(QF + (1 * 64 + pb2 * 32) * 72, KF + (1 * 64 + jb * 32) * 72, r, hh, sb);
#pragma unroll
        for (int reg = 0; reg < 16; ++reg) { const int p = (reg & 3) + 8 * (reg >> 2) + 4 * hh; float v;
            if (pb2 > jb) v = sf[reg]; else if (pb2 < jb) v = sb[reg]; else v = (r <= p) ? sf[reg] : sb[reg];
            Mm[(pb2 * 32 + p) * 72 + jb * 32 + r] = (unsigned short)f2bf(v); }
    } else {
        const int dvb = wave - 4; float* KV = WSP(float, WS_KVC) + (size_t)item * 2 * 8192;
#pragma unroll
        for (int dir = 0; dir < 2; ++dir)
#pragma unroll
            for (int dkb = 0; dkb < 2; ++dkb) { f32x16 a = {}; a = tile_mm<4>(VT + (dvb * 32) * 72, KDT + (dir * 64 + dkb * 32) * 72, r, hh, a);
#pragma unroll
                for (int reg = 0; reg < 16; ++reg) { const int dv = dvb * 32 + (reg & 3) + 8 * (reg >> 2) + 4 * hh; KV[(size_t)dir * 8192 + dv * 64 + dkb * 32 + r] = a[reg]; } }
    }
    LDS_WAIT(); __syncthreads();
    { const int pb2 = wave >> 2, dvb = wave & 3; f32x16 a = {}; a = tile_mm<4>(Mm + (pb2 * 32) * 72, VT + (dvb * 32) * 72, r, hh, a);
      float* OI = WSP(float, WS_OINTRA) + (size_t)(t0 + pb2 * 32) * 768 + h * 128 + dvb * 32 + r;
#pragma unroll
      for (int reg = 0; reg < 16; ++reg) { const int p = (reg & 3) + 8 * (reg >> 2) + 4 * hh; OI[(size_t)p * 768] = a[reg]; } }
    __syncthreads();
}
__device__ __forceinline__ void gla_scan_witem(Frame& F, int item) {
    const int slice = item & 31, dir = (item >> 5) & 1, bh = item >> 6, b = bh / 6, h = bh % 6;
    const int e = slice * 256 + F.lane * 4, dk = e & 63;
    const float* KV = WSP(float, WS_KVC); const float* DC = WSP(float, WS_DECAY); bf16* ST = WSP(bf16, WS_ST);
    f32x4 st = {0.f, 0.f, 0.f, 0.f};
#pragma unroll 8
    for (int i = 0; i < 32; ++i) { const int n = dir ? 31 - i : i; const size_t it = (size_t)((b * 32 + n) * 6 + h) * 2 + dir;
        const f32x4 kv = *(const f32x4*)(KV + it * 8192 + e), dc = *(const f32x4*)(DC + it * 64 + dk);
        v2u w; w.x = pk2(st[0], st[1]); w.y = pk2(st[2], st[3]); *(v2u*)(ST + it * 8192 + e) = w;
        st = dc * st + kv; }
}
__device__ __forceinline__ void gla_c_task(Frame& F, int l, int task) {
    const int item = task >> 1, half = task & 1, h = item % 6, bn = item / 6, tk0 = bn * 64 + half * 32;
    const int r = F.lane & 31, hh = F.lane >> 5;
    const bf16* QD = WSP(bf16, WS_QDEC); const bf16* ST = WSP(bf16, WS_ST) + (size_t)item * 2 * 8192;
    bf16x8 af[2][4];
#pragma unroll
    for (int dir = 0; dir < 2; ++dir)
#pragma unroll
        for (int s = 0; s < 4; ++s) af[dir][s] = *(const bf16x8*)(QD + (size_t)dir * T * 384 + (size_t)(tk0 + r) * 384 + h * 64 + 16 * s + 8 * hh);
    f32x16 acc[4];
#pragma unroll
    for (int dvb = 0; dvb < 4; ++dvb) { acc[dvb] = f32x16{};
#pragma unroll
        for (int dir = 0; dir < 2; ++dir)
#pragma unroll
            for (int s = 0; s < 4; ++s) { const bf16x8 bfr = *(const bf16x8*)(ST + (size_t)dir * 8192 + (dvb * 32 + r) * 64 + 16 * s + 8 * hh);
                acc[dvb] = __builtin_amdgcn_mfma_f32_32x32x16_bf16(af[dir][s], bfr, acc[dvb], 0, 0, 0); } }
    LAS float* st = (LAS float*)(F.lds + F.wave * 16384);
    stage_write(st, acc, r, hh);
    LDS_WAIT(); asm volatile("" ::: "memory");
    float v[64]; stage_read(st, F.lane, v);
    const int row = F.lane >> 1, hf = F.lane & 1; const size_t t = (size_t)(tk0 + row);
    const float* OI = WSP(float, WS_OINTRA) + t * 768 + h * 128 + hf * 64;
    f32x4 oi[16];
#pragma unroll
    for (int j = 0; j < 16; ++j) oi[j] = *(const f32x4*)(OI + 4 * j);
    float ss = 0.f;
#pragma unroll
    for (int j = 0; j < 16; ++j) {
#pragma unroll
        for (int e2 = 0; e2 < 4; ++e2) { v[4 * j + e2] += oi[j][e2]; ss += v[4 * j + e2] * v[4 * j + e2]; } }
    ss += __shfl_xor(ss, 1);
    const float rstd = __builtin_amdgcn_rsqf(ss * (1.f / 128.f) + EPS);
    gated_store64(v, rstd, ld_in(11) + l * 128 + hf * 64, WSP(bf16, WS_PROJ) + t * NP + C_Z + h * 128 + hf * 64, WSP(bf16, WS_HY) + t * DM + 768 + h * 128 + hf * 64);
    LDS_WAIT(); asm volatile("" ::: "memory");
}
#define XB_TMO      128
#define XB_XCNT(j)  (256  + 64 * (j))
#define XB_XSUB(j)  (1280 + 64 * (j))
#define XB_XGEN(j)  (2304 + 64 * (j))
#define XB_TOP      3328
#define XB_TOPGEN   3392
#define XCD_BAR_WORDS 3456
#define XB_SPIN_CAP (1u << 18)
__device__ __forceinline__ unsigned xb_ld(unsigned* p)              { return __hip_atomic_load(p, __ATOMIC_RELAXED, __HIP_MEMORY_SCOPE_AGENT); }
__device__ __forceinline__ unsigned xb_add(unsigned* p, unsigned v) { return __hip_atomic_fetch_add(p, v, __ATOMIC_RELAXED, __HIP_MEMORY_SCOPE_AGENT); }
__device__ __forceinline__ unsigned xb_xcc_id() { return (unsigned)__builtin_amdgcn_s_getreg((3 << 11) | 20) & 0xFu; }
#define XB_SPIN(cond, bar) do { unsigned _sp = 0; while (cond) { __builtin_amdgcn_s_sleep(1); \
    if ((++_sp & 255u) == 0u) { if (xb_ld(&(bar)[XB_TMO])) break; if (_sp > XB_SPIN_CAP) { atomicAdd(&(bar)[XB_TMO], 1u); break; } } } } while (0)
struct XcdBarrier { unsigned* bar; unsigned x; volatile LAS unsigned* st; };
__device__ __forceinline__ XcdBarrier xcd_barrier_post(unsigned* bar, volatile LAS unsigned* st) {
    XcdBarrier b; b.bar = bar; b.x = xb_xcc_id(); b.st = st;
    if (threadIdx.x == 0) (void)xb_add(&bar[XB_XCNT(b.x)], 1u);
    return b;
}
__device__ __forceinline__ void xcd_barrier_complete(unsigned* bar, unsigned x, unsigned& nloc, unsigned& nx) {
    const unsigned G = gridDim.x * gridDim.y * gridDim.z;
    unsigned sum, cnt, mine, sp = 0u;
    for (;;) {
        sum = 0u; cnt = 0u; mine = 0u;
#pragma unroll
        for (unsigned j = 0; j < 16; ++j) { const unsigned c = xb_ld(&bar[XB_XCNT(j)]); sum += c; cnt += (c > 0u) ? 1u : 0u; mine = (j == x) ? c : mine; }
        if (sum == G) break;
        __builtin_amdgcn_s_sleep(1);
        if ((++sp & 255u) == 0u) { if (xb_ld(&bar[XB_TMO])) break; if (sp > XB_SPIN_CAP) { atomicAdd(&bar[XB_TMO], 1u); break; } }
    }
    nloc = mine > 0u ? mine : 1u; nx = cnt > 0u ? cnt : 1u;
}
__device__ __forceinline__ void xcd_barrier(const XcdBarrier& b) {
    asm volatile("s_waitcnt vmcnt(0)" ::: "memory");
    __syncthreads();
    if (threadIdx.x == 0) {
        unsigned* bar = b.bar;
        __builtin_amdgcn_s_waitcnt(0);
        unsigned nloc = b.st[0], nx = b.st[1];
        if (nloc == 0u) { xcd_barrier_complete(bar, b.x, nloc, nx); b.st[0] = nloc; b.st[1] = nx; }
        const unsigned old = xb_add(&bar[XB_XSUB(b.x)], 1u);
        const unsigned gen = old / nloc;
        if (old + 1u == (gen + 1u) * nloc) {
            __builtin_amdgcn_fence(__ATOMIC_RELEASE, "agent");
            asm volatile("s_waitcnt vmcnt(0)" ::: "memory");
            const unsigned og = xb_add(&bar[XB_TOP], 1u);
            const unsigned tg = og / nx;
            if (og + 1u == (tg + 1u) * nx) xb_add(&bar[XB_TOPGEN], 1u);
            else XB_SPIN(xb_ld(&bar[XB_TOPGEN]) == tg, bar);
            __builtin_amdgcn_fence(__ATOMIC_ACQUIRE, "agent");
            xb_add(&bar[XB_XGEN(b.x)], 1u);
            asm volatile("s_waitcnt vmcnt(0)" ::: "memory");
        } else {
            XB_SPIN(xb_ld(&bar[XB_XGEN(b.x)]) == gen, bar);
            __builtin_amdgcn_fence(__ATOMIC_ACQUIRE, "agent");
            asm volatile("s_waitcnt vmcnt(0)" ::: "memory");
        }
    }
    __syncthreads();
}

__device__ __forceinline__ void sub_barrier(unsigned* cnt, unsigned target) {
    asm volatile("s_waitcnt vmcnt(0)" ::: "memory");
    __syncthreads();
    if (threadIdx.x == 0) {
        __builtin_amdgcn_fence(__ATOMIC_RELEASE, "agent");
        asm volatile("s_waitcnt vmcnt(0)" ::: "memory");
        (void)xb_add(cnt, 1u);
        unsigned sp = 0u; while (xb_ld(cnt) < target) { __builtin_amdgcn_s_sleep(2); if (++sp > (1u << 22)) break; }
        __builtin_amdgcn_fence(__ATOMIC_ACQUIRE, "agent");
        asm volatile("s_waitcnt vmcnt(0)" ::: "memory");
    }
    __syncthreads();
}

struct Args { const float* in[21]; float* out; unsigned char* ws; int ph_lo, ph_hi; };
constexpr int N_PHASES = 2 + 6 * DEPTH;
__global__ void __launch_bounds__(NTHR, 2) mega_fwd(Args args) {
    extern __shared__ __attribute__((aligned(16))) unsigned char lds[];
    Frame F;
    F.lds = (LAS unsigned char*)lds; F.ldsg = (char*)lds;
    F.tid = threadIdx.x; F.lane = F.tid & 63; F.wave = __builtin_amdgcn_readfirstlane(F.tid >> 6);
    F.G = gridDim.x; { const int bx = blockIdx.x; F.vcu = (F.G % 8 == 0) ? (bx % 8) * (F.G / 8) + bx / 8 : bx; }
    F.out = args.out; F.ws = args.ws;
    volatile LAS unsigned* MISC = (volatile LAS unsigned*)(F.lds + MISC_OFF);
    for (int u = F.tid; u < (LDS_BYTES - LDSCTL_OFF) / 4; u += NTHR) ((LAS unsigned*)(F.lds + LDSCTL_OFF))[u] = 0u;
    __syncthreads();
    XcdBarrier bar = xcd_barrier_post((unsigned*)(F.ws + WS_CTL) + CW_BAR, MISC + 8);
    const int lo = args.ph_lo, hi = args.ph_hi;
#ifndef MK_MASK
#define MK_MASK 0xFF
#endif
#define PHON(b) ((MK_MASK >> (b)) & 1)
#ifndef MK_REP_PH
#define MK_REP_PH -1
#endif
#define REPS(ph) for (int rep_ = 0; rep_ < ((ph) == MK_REP_PH ? 2 : 1); ++rep_)
#define REPBAR() do { if (rep_ == 0 && false) {} } while (0)
#define IN(k) (lo <= (k) && (k) < hi)
#define FRESH() do { int t_ = threadIdx.x; asm volatile("" : "+v"(t_)); F.tid = t_; F.lane = t_ & 63; F.wave = __builtin_amdgcn_readfirstlane(t_ >> 6); GAS unsigned char* w_ = (GAS unsigned char*)args.ws; asm volatile("" : "+s"(w_)); F.ws = (unsigned char*)w_; GAS float* o_ = (GAS float*)args.out; asm volatile("" : "+s"(o_)); F.out = (float*)o_; } while (0)
#define SEAM(k) do { if (IN(k) && IN((k) + 1)) xcd_barrier(bar); } while (0)
    REPS(100) { if (PHON(0) && IN(0)) { p0_prologue(F, rep_ == 0 ? WS_MODS : (size_t)(1 * MiB)); } SEAM(0); }
    REPS(101) { if (PHON(1) && IN(1)) { modnorm_rows(F, ld_in(0), ld_in(5), WSP(float, WS_MODS), WSP(bf16, WS_HY)); } SEAM(1); }
#pragma unroll 1
    for (int l = 0; l < DEPTH; ++l) {
        const int pb = 2 + 6 * l;
#define mods_l (WSP(float, WS_MODS) + (size_t)l * BATCH * 3 * DM)
        REPS(0) { if (PHON(2) && IN(pb)) {
            FRESH();
            pg8::Gemm g{WSP(bf16, WS_HY), WSP(bf16, WS_WIN) + (size_t)l * NP * DM, T, NP, DM, DM}; pg8::StaticOrder S; S.init(T, NP, F.G, (int)blockIdx.x);
            EpiIn E{WSP(bf16, WS_PROJ), WSP(float, WS_CS), WSP(float, WS_SN), WSP(float, WS_PARTQ), WSP(float, WS_PARTKV)};
            pg8::gemm_phase<EpiIn, pg8::StaticOrder, true, true>(F.lds, g, S, E);
        } SEAM(pb); }
        REPS(1) { if (PHON(3) && IN(pb + 1)) {
#ifndef MK_SUB
#define MK_SUB 0xFF
#endif
            FRESH();
            if (MK_SUB & 1) { pg8::Gemm g{WSP(bf16, WS_PROJ) + C_MKV, WSP(bf16, WS_WUKV) + (size_t)l * NKV * 256, T, NKV, 256, NP}; pg8::StaticOrder S; S.init(T, NKV, F.G, (int)blockIdx.x);
              EpiUkv E{WSP(bf16, WS_KVUP), WSP(float, WS_PARTKV)};
              pg8::gemm_phase<EpiUkv, pg8::StaticOrder, true, true>(F.lds, g, S, E); }
            FRESH();
            if (MK_SUB & 2) { pg8::Gemm g{WSP(bf16, WS_PROJ) + C_MQ, WSP(bf16, WS_WUQ) + (size_t)l * NQ * 384, T, NQ, 384, NP}; pg8::StaticOrder S; S.init(T, NQ, F.G, ((int)blockIdx.x + 64) % F.G);
              EpiUq E{WSP(bf16, WS_QUP), WSP(float, WS_CS), WSP(float, WS_SN), WSP(float, WS_PARTQ)};
              pg8::gemm_phase<EpiUq, pg8::StaticOrder, true, true>(F.lds, g, S, E); }
            __syncthreads(); FRESH();
            if (MK_SUB & 4) for (int it = (int)blockIdx.x; it < NITEM; it += F.G) gla_a_item(F, l, it);
        } SEAM(pb + 1); }
        REPS(7) { if (PHON(3) && IN(pb + 2)) {
            FRESH();
            conv_rows(F, l);
            FRESH(); { const int gw = F.vcu * NWAVES + F.wave, NGW = F.G * NWAVES; for (int it = gw; it < 1536; it += NGW) gla_scan_witem(F, it); }
        } SEAM(pb + 2); }
        REPS(2) { if (PHON(4) && IN(pb + 3)) {
            const int bx = (int)blockIdx.x; FRESH();
            const int natt = F.G > 192 ? 192 : F.G;
            if (bx < natt) {
                for (int u = bx; u < 192; u += natt) { const int bh = u >> 3, qb = u & 7, b = bh / 6, h = bh % 6; const size_t row0 = (size_t)b * SEQ, qrow = row0 + qb * 256;
                    mla::attn_unit(WSP(bf16, WS_QUP) + qrow * NQ + h * 192, WSP(bf16, WS_KVUP) + row0 * NKV + h * 256, WSP(bf16, WS_KVUP) + row0 * NKV + h * 256 + 128,
                                   WSP(bf16, WS_PROJ) + row0 * NP + C_MKR, WSP(bf16, WS_HY) + qrow * DM + h * 128, WSP(bf16, WS_PROJ) + qrow * NP + C_Z + 768 + h * 128,
                                   ld_in(16) + l * 768 + h * 128, WSP(float, WS_PARTM) + qrow * 8 + h, SEQ, F.ldsg); }
            }
            if (F.G > 192) { if (bx >= 192) { const int gw = (bx - 192) * NWAVES + F.wave, NGW = (F.G - 192) * NWAVES; for (int task = gw; task < 2 * NITEM; task += NGW) gla_c_task(F, l, task); } }
            else { FRESH(); const int gw = F.vcu * NWAVES + F.wave, NGW = F.G * NWAVES; for (int task = gw; task < 2 * NITEM; task += NGW) gla_c_task(F, l, task); }
        } SEAM(pb + 3); }
        for (int rep_ = 0; rep_ < ((MK_REP_PH == 4 && l == 0) ? 2 : 1); ++rep_) { if (PHON(6) && IN(pb + 4)) {
            FRESH();
            pg8::Gemm g{WSP(bf16, WS_HY), WSP(bf16, WS_WOUT) + (size_t)l * DM * DM, T, DM, DM, DM}; pg8::StaticOrder S; S.init(T, DM, F.G, (int)blockIdx.x);
            EpiOut E{l == 0 ? ld_in(0) : F.out, F.out, mods_l + 2 * DM, WSP(float, WS_PARTM)};
            pg8::gemm_phase<EpiOut, pg8::StaticOrder, true, true>(F.lds, g, S, E);
        } SEAM(pb + 4); }
        for (int rep_ = 0; rep_ < ((MK_REP_PH == 5 && l == 0) ? 2 : 1); ++rep_) { if (PHON(7) && IN(pb + 5)) {
            FRESH();
            if (l + 1 < DEPTH) modnorm_rows(F, F.out, ld_in(5) + (l + 1) * DM, mods_l + (size_t)BATCH * 3 * DM, WSP(bf16, WS_HY));
            else finalnorm_rows(F, F.out, ld_in(20));
        } SEAM(pb + 5); }
        if (MK_REP_PH == 6) { for (int r_ = 0; r_ < 4; ++r_) xcd_barrier(bar); }
    }
#undef mods_l
#undef IN
#undef SEAM
}

#ifndef MK_CUT
#define MK_CUT 14
#endif
#if MK_CUT < 14
__global__ void glue_proj(const bf16* P, float* proj, float* y, int row0) {
    const int t = blockIdx.x; const bf16* p = P + (size_t)(row0 + t) * NP;
    for (int c = threadIdx.x; c < NP; c += 256) { const float v = bf2f(p[c]);
        if (c < C_MKV) proj[(size_t)t * nv::PW + c] = v;
        else if (c < C_MQ) proj[(size_t)t * nv::PW + nv::O_MKV + (c - C_MKV)] = v;
        else if (c < C_MKR) proj[(size_t)t * nv::PW + nv::O_MQ + (c - C_MQ)] = v;
        else if (c < C_LR) { const int j = c - C_MKR; proj[(size_t)t * nv::PW + nv::O_MKR + (j & 1) * 32 + (j >> 1)] = v; }
        else if (c < C_LR + 32) proj[(size_t)t * nv::PW + nv::O_LR + (c - C_LR)] = v;
        else if (c < C_CB) {}
        else if (c < C_Z) proj[(size_t)t * nv::PW + nv::O_CB + (c - C_CB)] = v;
        else y[(size_t)t * DM + (c - C_Z)] = v; }
}
__global__ void glue_qkv(const bf16* Q, const bf16* KV, float* qm, float* kv, int row0) {
    const int t = blockIdx.x;
    for (int c = threadIdx.x; c < 1152; c += 256) { const float v = bf2f(Q[(size_t)(row0 + t) * NQ + c]) * (1.f / QSCALE); const int h = c / 192, d = c % 192;
        if (d < 128) qm[(size_t)t * 1152 + c] = v; else { const int j = d - 128; qm[(size_t)t * 1152 + h * 192 + 128 + (j & 1) * 32 + (j >> 1)] = v; } }
    for (int c = threadIdx.x; c < 1536; c += 256) kv[(size_t)t * 1536 + c] = bf2f(KV[(size_t)(row0 + t) * NKV + c]);
}
__global__ void glue_y(const bf16* Y, float* y, int row0) {
    const int t = blockIdx.x; for (int c = threadIdx.x; c < DM; c += 256) { const int cr = c < 768 ? c + 768 : (c < 1536 ? c - 768 : c); y[(size_t)t * DM + cr] = bf2f(Y[(size_t)(row0 + t) * DM + c]); }
}
__global__ void glue_h(const bf16* H, float* h, int row0) {
    const int t = blockIdx.x; for (int c = threadIdx.x; c < DM; c += 256) h[(size_t)t * DM + c] = bf2f(H[(size_t)(row0 + t) * DM + c]);
}

#endif
#ifndef MK_NAIVE_BASE_MIB
#define MK_NAIVE_BASE_MIB 240
#endif
extern "C" void kernel_launch(void* const* d_in, const int* in_sizes, int n_in, void* d_out, int out_size, void* d_ws, size_t ws_size, hipStream_t stream) {
    static int grid = 0;
    if (grid == 0) {
        if (n_in != 21 || out_size != T * DM || in_sizes[0] != T * DM || ws_size < WS_END) { fprintf(stderr, "kernel_launch: unexpected shapes n_in %d out %d ws %zu\n", n_in, out_size, ws_size); grid = -1; return; }
        int dev = 0, cus = 0, per_cu = 0;
        if (hipGetDevice(&dev) != hipSuccess || hipDeviceGetAttribute(&cus, hipDeviceAttributeMultiprocessorCount, dev) != hipSuccess) { grid = -1; return; }
        if (hipFuncSetAttribute((const void*)mega_fwd, hipFuncAttributeMaxDynamicSharedMemorySize, LDS_BYTES) != hipSuccess) { fprintf(stderr, "kernel_launch: hipFuncSetAttribute failed\n"); grid = -1; return; }
        if (hipOccupancyMaxActiveBlocksPerMultiprocessor(&per_cu, (const void*)mega_fwd, NTHR, LDS_BYTES) != hipSuccess || per_cu < 1) { fprintf(stderr, "kernel_launch: occupancy query says %d blocks/CU\n", per_cu); grid = -1; (void)hipGetLastError(); return; }
        grid = cus;
    }
    if (grid < 0) return;
    (void)hipMemsetAsync((char*)d_ws + WS_CTL, 0, CTL_ZERO_BYTES, stream);
    Args a{};
    for (int i = 0; i < 21; ++i) a.in[i] = (const float*)d_in[i];
    a.out = (float*)d_out; a.ws = (unsigned char*)d_ws; a.ph_lo = 0; a.ph_hi = MK_CUT < N_PHASES ? MK_CUT : N_PHASES;
    hipLaunchKernelGGL(mega_fwd, dim3(grid), dim3(NTHR), LDS_BYTES, stream, a);
#if MK_CUT < 14
    {
        char* ws = (char*)d_ws; float* out = (float*)d_out; const float* x = (const float*)d_in[0];
        const float* mods = (const float*)(ws + WS_MODS); const float* cs = (const float*)(ws + WS_CS); const float* sn = (const float*)(ws + WS_SN);
        nv::Buf B = nv::carve(ws + (size_t)MK_NAIVE_BASE_MIB * MiB);
        const int l0 = (MK_CUT - 2) / 6, ph = (MK_CUT - 2) % 6;
        for (int l = l0; l < DEPTH; ++l)
            for (int b = 0; b < BATCH; ++b) {
                const int row0 = b * SEQ; int entry = 0; const float* xin = (l == 0 ? x : out) + (size_t)row0 * DM; float* xo = out + (size_t)row0 * DM;
                if (l == l0) {
                    if (ph >= 1 && ph <= 3) { glue_proj<<<SEQ, 256, 0, stream>>>((const bf16*)(ws + WS_PROJ), B.proj, B.y, row0); entry = 1; }
                    if (ph == 2) { glue_qkv<<<SEQ, 256, 0, stream>>>((const bf16*)(ws + WS_QUP), (const bf16*)(ws + WS_KVUP), nv::sc_qm(B), nv::sc_kv(B), row0); entry = 2; }
                    if (ph == 3) { hipMemcpyAsync(nv::sc_omla(B), ws + WS_OMLA + (size_t)row0 * 768 * 4, (size_t)SEQ * 768 * 4, hipMemcpyDeviceToDevice, stream); entry = 4; }
                    if (ph == 4) { glue_y<<<SEQ, 256, 0, stream>>>((const bf16*)(ws + WS_HY), B.y, row0); entry = 3; }
                    if (ph == 5) continue;
                }
                nv::layer_batch(d_in, l, b, entry, xin, xo, mods, cs, sn, B, stream);
            }
        nv::k_rms<<<T, 256, 0, stream>>>(out, DM, DM, (const float*)d_in[20], out, DM);
    }
#endif
}
```

```cpp
#include <hip/hip_runtime.h>
#include <cstdio>
#include <cstdint>
#define MK_CUT 14
#define MK_NAIVE_BASE_MIB 240
#define MK_REP_PH -1
namespace pg8 {
#define PG8_LAS __attribute__((address_space(3)))
typedef unsigned short bf16_t;
typedef short bf16x8 __attribute__((ext_vector_type(8)));
typedef float f32x4 __attribute__((ext_vector_type(4)));
typedef unsigned u32x4 __attribute__((ext_vector_type(4)));
constexpr int BM = 256, BK = 64, HALF = 128, HTB = HALF * BK * 2, STAGE_BYTES = 8 * HTB, NXCD = 8, WGM = 8;

__host__ __device__ __forceinline__ int lds_byte(int r, int c) { const int st = (r >> 4) * 2 + (c >> 5), rr = r & 15, cc = c & 31, ob = rr * 64 + cc * 2; return st * 1024 + (ob ^ (((ob >> 9) & 1) << 5)); }
__host__ __device__ __forceinline__ void stage_rc(int b, int& R, int& C) { const int st = b / 1024, sb = b % 1024, swz = sb ^ (((sb >> 9) & 1) << 5); R = (st >> 1) * 16 + swz / 64; C = (st & 1) * 32 + (swz % 64) / 2; }
__host__ __device__ __forceinline__ int perm32(int rho) { const int n = rho >> 4, i = rho & 15; return 8 * (i >> 2) + 4 * n + (i & 3); }

struct Unit { int pm, pn; };
struct Gemm { const bf16_t* A; const bf16_t* Bt; int M, N, K, lda; };

struct StaticOrder {
    int nM, nN, nwg, G, c;
    __host__ __device__ void init(int M, int N, int G_, int c_) { nM = M / BM; nN = N / BM; nwg = nM * nN; G = G_; c = c_; }
    __host__ __device__ bool next(int i, Unit& u) const {
        const long L = (long)i * G + c; if (L >= nwg) return false;
        int wgid = (int)L; { const int q = nwg / NXCD, r = nwg % NXCD, xcd = wgid % NXCD, off = wgid / NXCD; wgid = (xcd < r ? xcd * (q + 1) : r * (q + 1) + (xcd - r) * q) + off; }
        const int nig = WGM * nN, gid = wgid / nig, fm = gid * WGM, gsz = (nM - fm) < WGM ? (nM - fm) : WGM;
        u.pm = fm + ((wgid % nig) % gsz); u.pn = (wgid % nig) / gsz; return true;
    }
    __device__ __forceinline__ void a_ready(const Unit&) const {}
    __device__ __forceinline__ void done(const Unit&) const {}
};

__device__ __forceinline__ unsigned cvt_pk_bf16(float lo, float hi) { unsigned r; asm volatile("v_cvt_pk_bf16_f32 %0, %1, %2" : "=v"(r) : "v"(lo), "v"(hi)); return r; }

template <class Epi, class Sched, bool ALIGN_EPI = false, bool SP2 = false>
__device__ __forceinline__ void gemm_phase(PG8_LAS unsigned char* lds, const Gemm g, const Sched& S, const Epi& E) {
    int tid_ = threadIdx.x; asm volatile("" : "+v"(tid_));
    const int tid = tid_, wid = __builtin_amdgcn_readfirstlane(tid >> 6), lane = tid & 63, wr = wid >> 2, wc = wid & 3, fr = lane & 15, fq = lane >> 4;
    int K_ = g.K, lda_ = g.lda; asm volatile("" : "+s"(K_), "+s"(lda_));
    const int K = K_, nt = K / BK, lda = lda_;
    unsigned voffA[2], voffB[2];
#pragma unroll
    for (int i = 0; i < 2; ++i) { int R, C; stage_rc(tid * 16 + i * 8192, R, C); const int Rb = Epi::PERM ? ((R & ~31) + perm32(R & 31)) : R;
        voffA[i] = (unsigned)(R * lda + C) * 2u; voffB[i] = (unsigned)(Rb * K + C) * 2u; }
    const size_t kstep = (size_t)(BK * 2);
    const size_t hstepA = (size_t)HALF * lda * 2, hstepB = (size_t)HALF * K * 2;
    const size_t tstepA = 2 * hstepA, tstepB = 2 * hstepB;
    const unsigned ldsw = (unsigned)wid * 1024u;
    const int aoff = lds_byte(wr * 64 + fr, fq * 8), boff = lds_byte(wc * 32 + fr, fq * 8);
#define PG8_SA(b, h) (((b) * 2 + (h)) * HTB)
#define PG8_SB(b, h) ((4 + (b) * 2 + (h)) * HTB)
#define PG8_STAGE(bufoff, gbase, voff) do { _Pragma("unroll") for (int _i = 0; _i < 2; ++_i) \
        __builtin_amdgcn_global_load_lds((const unsigned*)((const char*)(gbase) + (voff)[_i]), (PG8_LAS unsigned*)(lds + (bufoff) + ldsw + _i * 8192), 16, 0, 0); } while (0)
#define PG8_LDA(dst, b, h) do { _Pragma("unroll") for (int m = 0; m < 4; ++m) _Pragma("unroll") for (int k = 0; k < 2; ++k) dst[m][k] = *(const PG8_LAS bf16x8*)(lds + PG8_SA(b, h) + aoff + m * 2048 + k * 1024); } while (0)
#define PG8_LDB(dst, b, h) do { _Pragma("unroll") for (int n = 0; n < 2; ++n) _Pragma("unroll") for (int k = 0; k < 2; ++k) dst[n][k] = *(const PG8_LAS bf16x8*)(lds + PG8_SB(b, h) + boff + n * 2048 + k * 1024); } while (0)
#define PG8_MMA(ai, bj, At, Bt) do { __builtin_amdgcn_s_setprio(1); _Pragma("unroll") for (int m = 0; m < 4; ++m) _Pragma("unroll") for (int n = 0; n < 2; ++n) _Pragma("unroll") for (int k = 0; k < 2; ++k) \
        acc[ai][bj][m][n] = __builtin_amdgcn_mfma_f32_16x16x32_bf16(Bt[n][k], At[m][k], acc[ai][bj][m][n], 0, 0, 0); __builtin_amdgcn_s_setprio(0); } while (0)
#define PG8_WAIT_V(n) asm volatile("s_waitcnt vmcnt(" #n ")" ::: "memory")
#define PG8_WAIT_L(n) asm volatile("s_waitcnt lgkmcnt(" #n ")" ::: "memory")
#define PG8_BAR __builtin_amdgcn_s_barrier()
#define PG8_SCHED __builtin_amdgcn_sched_barrier(0)
    Unit cur, nxt; int ui = 0;
    if (!S.next(0, cur)) return;
    f32x4 acc[2][2][4][2];
#pragma unroll
    for (int a = 0; a < 2; ++a)
#pragma unroll
        for (int b = 0; b < 2; ++b)
#pragma unroll
            for (int m = 0; m < 4; ++m)
#pragma unroll
                for (int n = 0; n < 2; ++n) acc[a][b][m][n] = (f32x4){0.f, 0.f, 0.f, 0.f};
    bf16x8 At[4][2], B0[2][2], B1[2][2];
    const char* cA = (const char*)g.A + (size_t)cur.pm * tstepA; const char* cB = (const char*)g.Bt + (size_t)cur.pn * tstepB;
    S.a_ready(cur);
    if constexpr (SP2) {
        PG8_STAGE(PG8_SB(0, 0), cB, voffB); PG8_STAGE(PG8_SB(0, 1), cB + hstepB, voffB); PG8_STAGE(PG8_SA(0, 0), cA, voffA); PG8_STAGE(PG8_SA(0, 1), cA + hstepA, voffA);
        if (wr == 1) PG8_BAR;
        PG8_WAIT_V(2); PG8_BAR;
        PG8_STAGE(PG8_SB(1, 0), cB + kstep, voffB); PG8_STAGE(PG8_SA(1, 0), cA + kstep, voffA); PG8_STAGE(PG8_SB(1, 1), cB + hstepB + kstep, voffB);
        PG8_WAIT_V(6); PG8_BAR;
    } else {
        PG8_STAGE(PG8_SB(0, 0), cB, voffB); PG8_STAGE(PG8_SA(0, 0), cA, voffA); PG8_STAGE(PG8_SB(0, 1), cB + hstepB, voffB); PG8_STAGE(PG8_SA(0, 1), cA + hstepA, voffA);
        if (wr == 1) PG8_BAR;
        PG8_WAIT_V(4); PG8_BAR;
        PG8_STAGE(PG8_SB(1, 0), cB + kstep, voffB); PG8_STAGE(PG8_SA(1, 0), cA + kstep, voffA); PG8_STAGE(PG8_SB(1, 1), cB + hstepB + kstep, voffB);
        PG8_WAIT_V(6); PG8_BAR;
    }
    for (;;) {
        const bool has_next = S.next(ui + 1, nxt);
        const char* nA = has_next ? (const char*)g.A + (size_t)nxt.pm * tstepA : cA; const char* nB = has_next ? (const char*)g.Bt + (size_t)nxt.pn * tstepB : cB;
        for (int t = 0; t < nt; t += 2) {
            const bool last = (t == nt - 2);
            const char* a1 = cA + (size_t)(t + 1) * kstep;
            const char* a2 = last ? nA : cA + (size_t)(t + 2) * kstep; const char* b2 = last ? nB : cB + (size_t)(t + 2) * kstep;
            const char* a3 = a2 + kstep; const char* b3 = b2 + kstep;
            if (last && has_next) S.a_ready(nxt);
            if constexpr (SP2) {
            PG8_LDB(B0, 0, 0); PG8_LDB(B1, 0, 1); PG8_SCHED; PG8_LDA(At, 0, 0); PG8_STAGE(PG8_SA(1, 1), a1 + hstepA, voffA);
            PG8_WAIT_V(8); PG8_WAIT_L(0); PG8_BAR; PG8_MMA(0, 0, At, B0); PG8_MMA(0, 1, At, B1); PG8_BAR; PG8_SCHED;
            PG8_LDA(At, 0, 1); PG8_STAGE(PG8_SB(0, 0), b2, voffB); PG8_STAGE(PG8_SB(0, 1), b2 + hstepB, voffB); PG8_STAGE(PG8_SA(0, 0), a2, voffA);
            PG8_WAIT_V(8); PG8_WAIT_L(0); PG8_BAR; PG8_MMA(1, 0, At, B0); PG8_MMA(1, 1, At, B1); PG8_BAR; PG8_SCHED;
            PG8_LDB(B0, 1, 0); PG8_LDB(B1, 1, 1); PG8_SCHED; PG8_LDA(At, 1, 0); PG8_STAGE(PG8_SA(0, 1), a2 + hstepA, voffA);
            PG8_WAIT_V(8); PG8_WAIT_L(0); PG8_BAR; PG8_MMA(0, 0, At, B0); PG8_MMA(0, 1, At, B1); PG8_BAR; PG8_SCHED;
            PG8_LDA(At, 1, 1); PG8_STAGE(PG8_SB(1, 0), b3, voffB); PG8_STAGE(PG8_SB(1, 1), b3 + hstepB, voffB); PG8_STAGE(PG8_SA(1, 0), a3, voffA);
            PG8_WAIT_V(8); PG8_WAIT_L(0); PG8_BAR; PG8_MMA(1, 0, At, B0); PG8_MMA(1, 1, At, B1); PG8_BAR; PG8_SCHED;
            if constexpr (Epi::HOOK_T > 0) { if (t + 2 == Epi::HOOK_T) E.hook(acc, cur, wr, wc, fr, fq); }
            } else {
            PG8_LDB(B0, 0, 0); PG8_SCHED; PG8_LDA(At, 0, 0); PG8_STAGE(PG8_SA(1, 1), a1 + hstepA, voffA);
            PG8_WAIT_L(8); PG8_BAR; PG8_WAIT_L(0); PG8_MMA(0, 0, At, B0); PG8_BAR; PG8_SCHED;
            PG8_LDB(B1, 0, 1); PG8_STAGE(PG8_SB(0, 0), b2, voffB);
            PG8_BAR; PG8_WAIT_L(0); PG8_MMA(0, 1, At, B1); PG8_BAR;
            PG8_LDA(At, 0, 1); PG8_STAGE(PG8_SA(0, 0), a2, voffA);
            PG8_BAR; PG8_WAIT_L(0); PG8_MMA(1, 0, At, B0); PG8_BAR; PG8_SCHED;
            PG8_STAGE(PG8_SB(0, 1), b2 + hstepB, voffB);
            PG8_WAIT_V(6); PG8_BAR; PG8_MMA(1, 1, At, B1); PG8_BAR;
            PG8_LDB(B0, 1, 0); PG8_SCHED; PG8_LDA(At, 1, 0); PG8_STAGE(PG8_SA(0, 1), a2 + hstepA, voffA);
            PG8_WAIT_L(8); PG8_BAR; PG8_WAIT_L(0); PG8_MMA(0, 0, At, B0); PG8_BAR; PG8_SCHED;
            PG8_LDB(B1, 1, 1); PG8_STAGE(PG8_SB(1, 0), b3, voffB);
            PG8_BAR; PG8_WAIT_L(0); PG8_MMA(0, 1, At, B1); PG8_BAR;
            PG8_LDA(At, 1, 1); PG8_STAGE(PG8_SA(1, 0), a3, voffA);
            PG8_BAR; PG8_WAIT_L(0); PG8_MMA(1, 0, At, B0); PG8_BAR; PG8_SCHED;
            PG8_STAGE(PG8_SB(1, 1), b3 + hstepB, voffB);
            PG8_WAIT_V(6); PG8_BAR; PG8_MMA(1, 1, At, B1); PG8_BAR;
            }
        }
        if constexpr (ALIGN_EPI) { if (wr == 0) PG8_BAR; }
        if constexpr (!Epi::AFTER_DRAIN) { E(acc, cur, wr, wc, fr, fq); S.done(cur); }
        if (!has_next) break;
#pragma unroll
        for (int a = 0; a < 2; ++a)
#pragma unroll
            for (int b = 0; b < 2; ++b)
#pragma unroll
                for (int m = 0; m < 4; ++m)
#pragma unroll
                    for (int n = 0; n < 2; ++n) acc[a][b][m][n] = (f32x4){0.f, 0.f, 0.f, 0.f};
        cur = nxt; cA = nA; cB = nB; ++ui;
        if constexpr (ALIGN_EPI) { if (wr == 1) PG8_BAR; }
    }
    PG8_WAIT_V(0);
    if constexpr (!ALIGN_EPI) { if (wr == 0) PG8_BAR; }
    PG8_BAR;
    if constexpr (Epi::AFTER_DRAIN) { E.fused(acc, cur, wr, wc, fr, fq, lds, wid, lane); S.done(cur); }
#undef PG8_SA
#undef PG8_SB
#undef PG8_STAGE
#undef PG8_LDA
#undef PG8_LDB
#undef PG8_MMA
#undef PG8_WAIT_V
#undef PG8_WAIT_L
#undef PG8_BAR
#undef PG8_SCHED
}
}
#define GAS __attribute__((address_space(1)))
#define LAS __attribute__((address_space(3)))
typedef unsigned short bf16;
typedef unsigned v4u __attribute__((ext_vector_type(4)));
typedef unsigned v2u __attribute__((ext_vector_type(2)));
typedef float f32x4 __attribute__((ext_vector_type(4)));
typedef float f32x16 __attribute__((ext_vector_type(16)));
typedef short bf16x8 __attribute__((ext_vector_type(8)));
typedef short s16x4 __attribute__((ext_vector_type(4)));
typedef GAS unsigned gu32;

constexpr int NWAVES = 8, NTHR = 512;
constexpr int BATCH = 4, SEQ = 2048, DM = 2048, T = BATCH * SEQ, DEPTH = 2, IN_DIM = 5856;
constexpr int NP = 5888;
constexpr int C_GQ = 0, C_GK = 384, C_GV = 768, C_MKV = 1536, C_MQ = 1792, C_MKR = 2176, C_LR = 2240, C_CB = 2304, C_CC = 2816, C_CX = 3328, C_Z = 3840;
constexpr int R_GQ = 0, R_GK = 384, R_GV = 768, R_LR = 1536, R_MQ = 1568, R_MKV = 1952, R_MKR = 2208, R_CB = 2272, R_CC = 2784, R_CX = 3296, R_Z = 3808;
constexpr int NQ = 1280, NKV = 1536;
constexpr float EPS = 1e-6f;
constexpr float QSCALE = 0.07216878364870322f * 1.4426950408889634f;
constexpr int NITEM = BATCH * 32 * 6;

constexpr size_t MiB = 1u << 20;
constexpr size_t WS_CTL = 0, CTL_ZERO_BYTES = 1 * MiB;
constexpr size_t WS_MODS = 256 * 1024;
constexpr size_t WS_CS = 2 * MiB, WS_SN = 3 * MiB;
constexpr size_t WS_WUQ = 4 * MiB;
constexpr size_t WS_WUKV = 6 * MiB;
constexpr size_t WS_WOUT = 8 * MiB;
constexpr size_t WS_WIN = 24 * MiB;
constexpr size_t WS_HY = 70 * MiB;
constexpr size_t WS_PROJ = 102 * MiB;
constexpr size_t WS_QUP = 194 * MiB;
constexpr size_t WS_KVUP = 214 * MiB;
constexpr size_t WS_OMLA = 238 * MiB;
constexpr size_t WS_OINTRA = 262 * MiB;
constexpr size_t WS_KVC = 286 * MiB;
constexpr size_t WS_ST = 334 * MiB;
constexpr size_t WS_QDEC = 358 * MiB;
constexpr size_t WS_DECAY = 370 * MiB;
constexpr size_t WS_PARTQ = 371 * MiB;
constexpr size_t WS_PARTKV = 371 * MiB + 512 * 1024;
constexpr size_t WS_PARTM = 371 * MiB + 768 * 1024;
constexpr size_t WS_XS = 1 * MiB;
constexpr int CW_PANEL = 8192;
constexpr size_t WS_END = 372 * MiB;
constexpr int CW_BAR = 4096;

constexpr int RING_BYTES = 131072, LDSCTL_OFF = RING_BYTES, MISC_OFF = LDSCTL_OFF + 320, LDS_BYTES = 147456;

#define LDS_WAIT() asm volatile("s_waitcnt lgkmcnt(0)" ::: "memory")
#define VM_WAIT() asm volatile("s_waitcnt vmcnt(0)" ::: "memory")
__device__ __forceinline__ unsigned f2bf(float f) { unsigned u = __builtin_bit_cast(unsigned, f); return (u + 0x7fffu + ((u >> 16) & 1u)) >> 16; }
__device__ __forceinline__ unsigned pk2(float lo, float hi) { return pg8::cvt_pk_bf16(lo, hi); }
__device__ __forceinline__ float bf2f(unsigned short h) { return __builtin_bit_cast(float, (unsigned)h << 16); }
__device__ __forceinline__ float bflo(unsigned w) { return __builtin_bit_cast(float, w << 16); }
__device__ __forceinline__ float bfhi(unsigned w) { return __builtin_bit_cast(float, w & 0xffff0000u); }
__device__ __forceinline__ float silu_fast(float v) { return v * __builtin_amdgcn_rcpf(1.f + __expf(-v)); }
__device__ __forceinline__ float wave_sum(float v) {
#pragma unroll
    for (int o = 1; o < 64; o <<= 1) v += __shfl_xor(v, o);
    return v;
}

__device__ __forceinline__ int map_in(int n) {
    if (n < C_MKV) return n;
    if (n < C_MQ) return R_MKV + (n - C_MKV);
    if (n < C_MKR) return R_MQ + (n - C_MQ);
    if (n < C_LR) { const int j = n - C_MKR; return R_MKR + (j & 1) * 32 + (j >> 1); }
    if (n < C_LR + 32) return R_LR + (n - C_LR);
    if (n < C_CB) return -1;
    if (n < C_Z) return R_CB + (n - C_CB);
    return R_Z + (n - C_Z);
}
__device__ __forceinline__ int map_uq(int n) {
    if (n >= 1152) return -1;
    const int h = n / 192, d = n % 192;
    if (d < 128) return n;
    const int j = d - 128; return h * 192 + 128 + (j & 1) * 32 + (j >> 1);
}

struct EpiIn {
    static constexpr bool PERM = true, AFTER_DRAIN = false; static constexpr int HOOK_T = 0;
    bf16* O; const float* cs; const float* sn; float* partq; float* partkv;
    __device__ __forceinline__ void operator()(const f32x4 (&acc)[2][2][4][2], const pg8::Unit& u, int wr, int wc, int fr, int fq) const {
        const int pn = u.pn, row0 = u.pm * 256 + wr * 64 + fr, col0 = pn * 256 + wc * 32 + 8 * fq;
        const bool stat = (pn >= 6 && pn <= 8);
#pragma unroll
        for (int ai = 0; ai < 2; ++ai)
#pragma unroll
            for (int m = 0; m < 4; ++m) {
                const int row = row0 + ai * 128 + m * 16; bf16* rowp = O + (size_t)row * NP + col0; float ss = 0.f;
#pragma unroll
                for (int bj = 0; bj < 2; ++bj) {
                    f32x4 v0 = acc[ai][bj][m][0], v1 = acc[ai][bj][m][1]; const int c = col0 + bj * 128;
                    if (pn >= 15) {
#pragma unroll
                        for (int e = 0; e < 4; ++e) { v0[e] = silu_fast(v0[e]); v1[e] = silu_fast(v1[e]); }
                    } else if (pn == 8 && bj == 1 && c < C_LR) {
                        const int i0 = (c - C_MKR) >> 1; const f32x4 cc = *(const f32x4*)(cs + (size_t)row * 32 + i0), sv = *(const f32x4*)(sn + (size_t)row * 32 + i0);
                        f32x4 a0, a1;
                        a0[0] = v0[0] * cc[0] - v0[1] * sv[0]; a0[1] = v0[1] * cc[0] + v0[0] * sv[0]; a0[2] = v0[2] * cc[1] - v0[3] * sv[1]; a0[3] = v0[3] * cc[1] + v0[2] * sv[1];
                        a1[0] = v1[0] * cc[2] - v1[1] * sv[2]; a1[1] = v1[1] * cc[2] + v1[0] * sv[2]; a1[2] = v1[2] * cc[3] - v1[3] * sv[3]; a1[3] = v1[3] * cc[3] + v1[2] * sv[3];
                        v0 = a0; v1 = a1;
                    }
                    if (stat && (pn != 8 || bj == 0)) ss += (v0[0] * v0[0] + v0[1] * v0[1]) + (v0[2] * v0[2] + v0[3] * v0[3]) + (v1[0] * v1[0] + v1[1] * v1[1]) + (v1[2] * v1[2] + v1[3] * v1[3]);
                    v4u w; w.x = pk2(v0[0], v0[1]); w.y = pk2(v0[2], v0[3]); w.z = pk2(v1[0], v1[1]); w.w = pk2(v1[2], v1[3]);
                    *(v4u*)(rowp + bj * 128) = w;
                }
                asm volatile("" ::: "memory");
                if (stat) { ss += __shfl_xor(ss, 16); ss += __shfl_xor(ss, 32);
                    if (fq == 0) { if (pn == 6) partkv[(size_t)row * 4 + wc] = ss; else partq[(size_t)row * 8 + (pn - 7) * 4 + wc] = ss; } }
            }
    }
};
struct EpiUq {
    static constexpr bool PERM = true, AFTER_DRAIN = false; static constexpr int HOOK_T = 0;
    bf16* O; const float* cs; const float* sn; const float* partq;
    __device__ __forceinline__ void operator()(const f32x4 (&acc)[2][2][4][2], const pg8::Unit& u, int wr, int wc, int fr, int fq) const {
        const int row0 = u.pm * 256 + wr * 64 + fr, col0 = u.pn * 256 + wc * 32 + 8 * fq;
        float rs[2][4];
#pragma unroll
        for (int ai = 0; ai < 2; ++ai) {
#pragma unroll
            for (int m = 0; m < 4; ++m) { const int row = row0 + ai * 128 + m * 16;
                const f32x4 p0 = *(const f32x4*)(partq + (size_t)row * 8), p1 = *(const f32x4*)(partq + (size_t)row * 8 + 4);
                rs[ai][m] = __builtin_amdgcn_rsqf(((p0[0] + p0[1]) + (p0[2] + p0[3]) + (p1[0] + p1[1]) + (p1[2] + p1[3])) * (1.f / 384.f) + EPS) * QSCALE; }
#pragma unroll
            for (int m = 0; m < 4; ++m) {
                const int row = row0 + ai * 128 + m * 16; bf16* rowp = O + (size_t)row * NQ + col0;
#pragma unroll
                for (int bj = 0; bj < 2; ++bj) {
                    const int c = col0 + bj * 128; if (c >= 1152) continue;
                    f32x4 v0 = acc[ai][bj][m][0] * rs[ai][m], v1 = acc[ai][bj][m][1] * rs[ai][m]; const int d = c % 192;
                    if (d >= 128) {
                        const int i0 = (d - 128) >> 1; const f32x4 cc = *(const f32x4*)(cs + (size_t)row * 32 + i0), sv = *(const f32x4*)(sn + (size_t)row * 32 + i0);
                        f32x4 a0, a1;
                        a0[0] = v0[0] * cc[0] - v0[1] * sv[0]; a0[1] = v0[1] * cc[0] + v0[0] * sv[0]; a0[2] = v0[2] * cc[1] - v0[3] * sv[1]; a0[3] = v0[3] * cc[1] + v0[2] * sv[1];
                        a1[0] = v1[0] * cc[2] - v1[1] * sv[2]; a1[1] = v1[1] * cc[2] + v1[0] * sv[2]; a1[2] = v1[2] * cc[3] - v1[3] * sv[3]; a1[3] = v1[3] * cc[3] + v1[2] * sv[3];
                        v0 = a0; v1 = a1;
                    }
                    v4u w; w.x = pk2(v0[0], v0[1]); w.y = pk2(v0[2], v0[3]); w.z = pk2(v1[0], v1[1]); w.w = pk2(v1[2], v1[3]);
                    *(v4u*)(rowp + bj * 128) = w;
                }
                asm volatile("" ::: "memory");
            }
        }
    }
};
struct EpiUkv {
    static constexpr bool PERM = true, AFTER_DRAIN = false; static constexpr int HOOK_T = 0;
    bf16* O; const float* partkv;
    __device__ __forceinline__ void operator()(const f32x4 (&acc)[2][2][4][2], const pg8::Unit& u, int wr, int wc, int fr, int fq) const {
        const int row0 = u.pm * 256 + wr * 64 + fr, col0 = u.pn * 256 + wc * 32 + 8 * fq;
        float rs[2][4];
#pragma unroll
        for (int ai = 0; ai < 2; ++ai)
#pragma unroll
            for (int m = 0; m < 4; ++m) { const f32x4 p0 = *(const f32x4*)(partkv + (size_t)(row0 + ai * 128 + m * 16) * 4);
                rs[ai][m] = __builtin_amdgcn_rsqf(((p0[0] + p0[1]) + (p0[2] + p0[3])) * (1.f / 256.f) + EPS); }
#pragma unroll
        for (int ai = 0; ai < 2; ++ai)
#pragma unroll
            for (int m = 0; m < 4; ++m) {
                const int row = row0 + ai * 128 + m * 16; bf16* rowp = O + (size_t)row * NKV + col0;
#pragma unroll
                for (int bj = 0; bj < 2; ++bj) {
                    const f32x4 v0 = acc[ai][bj][m][0] * rs[ai][m], v1 = acc[ai][bj][m][1] * rs[ai][m];
                    v4u w; w.x = pk2(v0[0], v0[1]); w.y = pk2(v0[2], v0[3]); w.z = pk2(v1[0], v1[1]); w.w = pk2(v1[2], v1[3]);
                    *(v4u*)(rowp + bj * 128) = w;
                }
            }
    }
};
struct EpiOut {
    static constexpr bool PERM = false, AFTER_DRAIN = false; static constexpr int HOOK_T = 12;
    const float* xin; float* out; const float* gate;
    const float* partm;
    __device__ __forceinline__ void hook(f32x4 (&acc)[2][2][4][2], const pg8::Unit& u, int wr, int wc, int fr, int fq) const {
        const int row0 = u.pm * 256 + wr * 64 + fr;
        float rs[2][4];
#pragma unroll
        for (int ai = 0; ai < 2; ++ai)
#pragma unroll
            for (int m = 0; m < 4; ++m) { const float* p = partm + (size_t)(row0 + ai * 128 + m * 16) * 8; const f32x4 p0 = *(const f32x4*)p; const float p4 = p[4], p5 = p[5];
                rs[ai][m] = __builtin_amdgcn_rsqf(((p0[0] + p0[1]) + (p0[2] + p0[3]) + (p4 + p5)) * (1.f / 768.f) + EPS); }
#pragma unroll
        for (int ai = 0; ai < 2; ++ai)
#pragma unroll
            for (int m = 0; m < 4; ++m)
#pragma unroll
                for (int bj = 0; bj < 2; ++bj)
#pragma unroll
                    for (int n = 0; n < 2; ++n) acc[ai][bj][m][n] *= rs[ai][m];
    }
    __device__ __forceinline__ void operator()(const f32x4 (&acc)[2][2][4][2], const pg8::Unit& u, int wr, int wc, int fr, int fq) const {
        const int row0 = u.pm * 256 + wr * 64 + fr, col0 = u.pn * 256 + wc * 32 + 4 * fq; const float* gb = gate + (size_t)(u.pm >> 3) * 3 * DM;
        f32x4 gv[2][2];
#pragma unroll
        for (int bj = 0; bj < 2; ++bj)
#pragma unroll
            for (int n = 0; n < 2; ++n) gv[bj][n] = *(const f32x4*)(gb + col0 + bj * 128 + n * 16);
        f32x4 xv[2][2][2][2];
#define EO_LOAD(slot, g) do { _Pragma("unroll") for (int q = 0; q < 2; ++q) { const size_t off = (size_t)(row0 + ((g) >> 1) * 128 + (((g) & 1) * 2 + q) * 16) * DM + col0; \
            _Pragma("unroll") for (int bj = 0; bj < 2; ++bj) _Pragma("unroll") for (int n = 0; n < 2; ++n) xv[slot][q][bj][n] = *(const f32x4*)(xin + off + bj * 128 + n * 16); } } while (0)
#define EO_STORE(slot, g) do { _Pragma("unroll") for (int q = 0; q < 2; ++q) { const int ai = (g) >> 1, m = ((g) & 1) * 2 + q; const size_t off = (size_t)(row0 + ai * 128 + m * 16) * DM + col0; \
            _Pragma("unroll") for (int bj = 0; bj < 2; ++bj) _Pragma("unroll") for (int n = 0; n < 2; ++n) *(f32x4*)(out + off + bj * 128 + n * 16) = xv[slot][q][bj][n] + gv[bj][n] * acc[ai][bj][m][n]; } } while (0)
        EO_LOAD(0, 0); EO_LOAD(1, 1); EO_STORE(0, 0); EO_LOAD(0, 2); EO_STORE(1, 1); EO_LOAD(1, 3); EO_STORE(0, 2); EO_STORE(1, 3);
#undef EO_LOAD
#undef EO_STORE
    }
};

struct EpiOutNorm {
    static constexpr bool PERM = false, AFTER_DRAIN = true; static constexpr int HOOK_T = 12;
    const float* xin; float* out; const float* gate; const float* partm;
    bf16* H; const float* g; const float* mods_next;
    float* xs; unsigned* cnt; unsigned target; int last;
    __device__ __forceinline__ void hook(f32x4 (&acc)[2][2][4][2], const pg8::Unit& u, int wr, int wc, int fr, int fq) const {
        const int row0 = u.pm * 256 + wr * 64 + fr;
        float rs[2][4];
#pragma unroll
        for (int ai = 0; ai < 2; ++ai)
#pragma unroll
            for (int m = 0; m < 4; ++m) { const float* p = partm + (size_t)(row0 + ai * 128 + m * 16) * 8; const f32x4 p0 = *(const f32x4*)p; const float p4 = p[4], p5 = p[5];
                rs[ai][m] = __builtin_amdgcn_rsqf(((p0[0] + p0[1]) + (p0[2] + p0[3]) + (p4 + p5)) * (1.f / 768.f) + EPS); }
#pragma unroll
        for (int ai = 0; ai < 2; ++ai)
#pragma unroll
            for (int m = 0; m < 4; ++m)
#pragma unroll
                for (int bj = 0; bj < 2; ++bj)
#pragma unroll
                    for (int n = 0; n < 2; ++n) acc[ai][bj][m][n] *= rs[ai][m];
    }
    __device__ __forceinline__ void fused(f32x4 (&acc)[2][2][4][2], const pg8::Unit& u, int wr, int wc, int fr, int fq, LAS unsigned char* lds, int wid, int lane) const {
        const int row0 = u.pm * 256 + wr * 64 + fr, col0 = u.pn * 256 + wc * 32 + 4 * fq, b = u.pm >> 3; const float* gb = gate + (size_t)b * 3 * DM;
        LAS float* P = (LAS float*)lds;
        LAS float* S = (LAS float*)(lds + 4096);
        f32x4 gv[2][2];
#pragma unroll
        for (int bj = 0; bj < 2; ++bj)
#pragma unroll
            for (int n = 0; n < 2; ++n) gv[bj][n] = *(const f32x4*)(gb + col0 + bj * 128 + n * 16);
        f32x4 xv[2][2][2][2];
#define EO_LOAD(slot, g_) do { _Pragma("unroll") for (int q = 0; q < 2; ++q) { const size_t off = (size_t)(row0 + ((g_) >> 1) * 128 + (((g_) & 1) * 2 + q) * 16) * DM + col0; \
            _Pragma("unroll") for (int bj = 0; bj < 2; ++bj) _Pragma("unroll") for (int n = 0; n < 2; ++n) xv[slot][q][bj][n] = *(const f32x4*)(xin + off + bj * 128 + n * 16); } } while (0)
#define EO_ADD(slot, g_) do { _Pragma("unroll") for (int q = 0; q < 2; ++q) { const int ai = (g_) >> 1, m = ((g_) & 1) * 2 + q; const size_t off = (size_t)(row0 + ai * 128 + m * 16) * DM + col0; \
            _Pragma("unroll") for (int bj = 0; bj < 2; ++bj) _Pragma("unroll") for (int n = 0; n < 2; ++n) { acc[ai][bj][m][n] = xv[slot][q][bj][n] + gv[bj][n] * acc[ai][bj][m][n]; \
                if (!last) *(f32x4*)(out + off + bj * 128 + n * 16) = acc[ai][bj][m][n]; } } } while (0)
        EO_LOAD(0, 0); EO_LOAD(1, 1); EO_ADD(0, 0); EO_LOAD(0, 2); EO_ADD(1, 1); EO_LOAD(1, 3); EO_ADD(0, 2); EO_ADD(1, 3);
#undef EO_LOAD
#undef EO_ADD
#pragma unroll
        for (int ai = 0; ai < 2; ++ai)
#pragma unroll
            for (int m = 0; m < 4; ++m) { float ss = 0.f;
#pragma unroll
                for (int bj = 0; bj < 2; ++bj)
#pragma unroll
                    for (int n = 0; n < 2; ++n) { const f32x4 x = acc[ai][bj][m][n]; ss += (x[0] * x[0] + x[1] * x[1]) + (x[2] * x[2] + x[3] * x[3]); }
                ss += __shfl_xor(ss, 16); ss += __shfl_xor(ss, 32);
                if (fq == 0) P[(ai * 128 + wr * 64 + m * 16 + fr) * 4 + wc] = ss; }
        asm volatile("s_waitcnt lgkmcnt(0)" ::: "memory"); __builtin_amdgcn_s_barrier(); asm volatile("" ::: "memory");
        const int tid = wid * 64 + lane;
        if (tid < 256) { const f32x4 p = *(const LAS f32x4*)(P + tid * 4);
            __hip_atomic_store(xs + (size_t)(u.pm * 256 + tid) * 8 + u.pn, (p[0] + p[1]) + (p[2] + p[3]), __ATOMIC_RELAXED, __HIP_MEMORY_SCOPE_AGENT);
            asm volatile("s_waitcnt vmcnt(0)" ::: "memory");
            if (lane == 0) __hip_atomic_fetch_add(cnt + 64 * u.pm, 1u, __ATOMIC_RELAXED, __HIP_MEMORY_SCOPE_AGENT); }
        if (wid == 0) { unsigned sp = 0u;
            while ((unsigned)__builtin_amdgcn_readfirstlane(__hip_atomic_load(cnt + 64 * u.pm, __ATOMIC_RELAXED, __HIP_MEMORY_SCOPE_AGENT)) < target) { __builtin_amdgcn_s_sleep(2); if (++sp > (1u << 22)) break; }
            __builtin_amdgcn_fence(__ATOMIC_ACQUIRE, "agent"); }
        asm volatile("s_waitcnt vmcnt(0) lgkmcnt(0)" ::: "memory"); __builtin_amdgcn_s_barrier(); asm volatile("" ::: "memory");
        if (tid < 256) { const float* sl = xs + (size_t)(u.pm * 256 + tid) * 8; float s = 0.f;
#pragma unroll
            for (int t = 0; t < 8; ++t) s += __hip_atomic_load(sl + t, __ATOMIC_RELAXED, __HIP_MEMORY_SCOPE_AGENT);
            S[tid] = __builtin_amdgcn_rsqf(s * (1.f / DM) + EPS); }
        asm volatile("s_waitcnt lgkmcnt(0)" ::: "memory"); __builtin_amdgcn_s_barrier(); asm volatile("" ::: "memory");
        f32x4 mul[2][2], add[2][2];
#pragma unroll
        for (int bj = 0; bj < 2; ++bj)
#pragma unroll
            for (int n = 0; n < 2; ++n) { const int c = col0 + bj * 128 + n * 16; const f32x4 gg = *(const f32x4*)(g + c);
                if (last) { mul[bj][n] = gg; add[bj][n] = (f32x4){0.f, 0.f, 0.f, 0.f}; }
                else { const float* mn = mods_next + (size_t)b * 3 * DM; mul[bj][n] = gg * (*(const f32x4*)(mn + DM + c) + 1.f); add[bj][n] = *(const f32x4*)(mn + c); } }
#pragma unroll
        for (int ai = 0; ai < 2; ++ai)
#pragma unroll
            for (int m = 0; m < 4; ++m) { const int rl = ai * 128 + wr * 64 + m * 16 + fr; const float rstd = S[rl]; const size_t off = (size_t)(u.pm * 256 + rl) * DM + col0;
#pragma unroll
                for (int bj = 0; bj < 2; ++bj)
#pragma unroll
                    for (int n = 0; n < 2; ++n) { const f32x4 r = acc[ai][bj][m][n] * rstd * mul[bj][n] + add[bj][n];
                        if (last) *(f32x4*)(out + off + bj * 128 + n * 16) = r;
                        else { v2u w; w.x = pk2(r[0], r[1]); w.y = pk2(r[2], r[3]); *(v2u*)(H + off + bj * 128 + n * 16) = w; } } }
    }
};

__device__ __forceinline__ void unpack8(const v4u w, float* f) { f[0] = bflo(w.x); f[1] = bfhi(w.x); f[2] = bflo(w.y); f[3] = bfhi(w.y); f[4] = bflo(w.z); f[5] = bfhi(w.z); f[6] = bflo(w.w); f[7] = bfhi(w.w); }

__device__ __forceinline__ int stg_pos(int c, int row) { return (c & 16) | ((c ^ (row & 7) ^ ((c >> 4) << 3)) & 15); }
__device__ __forceinline__ void stage_write(LAS float* st, const f32x16* acc, int r32, int hi) {
#pragma unroll
    for (int reg = 0; reg < 16; ++reg) { const int row = (reg & 3) + 8 * (reg >> 2) + 4 * hi;
#pragma unroll
        for (int dvb = 0; dvb < 4; ++dvb) { const int col = dvb * 32 + r32; st[row * 128 + stg_pos(col >> 2, row) * 4 + (col & 3)] = acc[dvb][reg]; } }
}
__device__ __forceinline__ void stage_read(const LAS float* st, int lane, float* v) {
    const int row = lane >> 1, half = lane & 1;
#pragma unroll
    for (int j = 0; j < 16; ++j) { const f32x4 q = *(const LAS f32x4*)(st + row * 128 + stg_pos(16 * half + j, row) * 4); v[4 * j] = q[0]; v[4 * j + 1] = q[1]; v[4 * j + 2] = q[2]; v[4 * j + 3] = q[3]; }
}
__device__ __forceinline__ void gated_store64(const float* v, float rs, const float* __restrict__ g, const bf16* __restrict__ zrow, bf16* __restrict__ yrow) {
    v4u zz[8];
#pragma unroll
    for (int j = 0; j < 8; ++j) zz[j] = *(const v4u*)(zrow + 8 * j);
#pragma unroll
    for (int j = 0; j < 8; ++j) { const f32x4 g0 = *(const f32x4*)(g + 8 * j), g1 = *(const f32x4*)(g + 8 * j + 4); float z[8]; unpack8(zz[j], z);
        v4u w; w.x = pk2(v[8 * j] * rs * g0[0] * z[0], v[8 * j + 1] * rs * g0[1] * z[1]); w.y = pk2(v[8 * j + 2] * rs * g0[2] * z[2], v[8 * j + 3] * rs * g0[3] * z[3]);
        w.z = pk2(v[8 * j + 4] * rs * g1[0] * z[4], v[8 * j + 5] * rs * g1[1] * z[5]); w.w = pk2(v[8 * j + 6] * rs * g1[2] * z[6], v[8 * j + 7] * rs * g1[3] * z[7]);
        *(v4u*)(yrow + 8 * j) = w; }
}

namespace mla {
constexpr int NW = 8, QBLK = 32, KVBLK = 64;
constexpr int SHM_V = 16384, SHM_KN = 16384, SHM_KR = 8192;
constexpr int OFF_V = 0, OFF_KN = 2 * SHM_V, OFF_KR = OFF_KN + 2 * SHM_KN, OFF_WS = OFF_KR + 2 * SHM_KR, OFF_QR = OFF_WS + NW * 64 * 4, ATTN_LDS = OFF_QR + NW * 4096;
constexpr float THR = 8.f;
#define KSWZ(row, colB) ((row) * 256 + ((colB) ^ (((row) & 7) << 4)))
#define KRSWZ(row, colB) ((row) * 128 + ((colB) ^ ((((row) >> 1) & 7) << 4)))
#define SBAR() __builtin_amdgcn_sched_barrier(0)
__device__ __forceinline__ int crow(int r, int hi) { return (r & 3) + 8 * (r >> 2) + 4 * hi; }
__device__ __forceinline__ unsigned cvtpk(float lo, float hi) { unsigned r; asm volatile("v_cvt_pk_bf16_f32 %0, %1, %2" : "=v"(r) : "v"(lo), "v"(hi)); return r; }

__device__ __forceinline__ void partialSM(f32x16& p0, f32x16& p1, float& m_reg, float& mn, float& alpha) {
  float pmax = p0[0];
#pragma unroll
  for (int r = 1; r < 16; ++r) pmax = fmaxf(pmax, p0[r]);
#pragma unroll
  for (int r = 0; r < 16; ++r) pmax = fmaxf(pmax, p1[r]);
  { auto rr = __builtin_amdgcn_permlane32_swap(__float_as_uint(pmax), __float_as_uint(pmax), false, false);
    pmax = fmaxf(__uint_as_float(rr[0]), __uint_as_float(rr[1])); }
  if (__builtin_expect(__all(pmax - m_reg <= THR), 1)) { mn = m_reg; alpha = 1.f; }
  else { mn = fmaxf(m_reg, pmax); alpha = __builtin_amdgcn_exp2f(m_reg - mn); m_reg = mn; }
#pragma unroll
  for (int r = 0; r < 16; ++r) p0[r] = p0[r] - mn;
#pragma unroll
  for (int r = 0; r < 16; ++r) p1[r] = p1[r] - mn;
#pragma unroll
  for (int r = 0; r < 16; ++r) p0[r] = __builtin_amdgcn_exp2f(p0[r]);
}
__device__ __forceinline__ void finishSM(f32x16& p0, f32x16& p1, float alpha, float& l_reg, bf16x8& pa0, bf16x8& pa1, bf16x8& pa2, bf16x8& pa3) {
#pragma unroll
  for (int r = 0; r < 16; ++r) p1[r] = __builtin_amdgcn_exp2f(p1[r]);
  float ps = 0;
#pragma unroll
  for (int r = 0; r < 16; ++r) ps += p0[r];
#pragma unroll
  for (int r = 0; r < 16; ++r) ps += p1[r];
  { auto rr = __builtin_amdgcn_permlane32_swap(__float_as_uint(ps), __float_as_uint(ps), false, false);
    ps = __uint_as_float(rr[0]) + __uint_as_float(rr[1]); }
  l_reg = l_reg * alpha + ps;
#define PK4(P, BASE, OUT) do { unsigned a0 = cvtpk(P[BASE + 0], P[BASE + 1]), a1 = cvtpk(P[BASE + 2], P[BASE + 3]);   \
    unsigned b0 = cvtpk(P[BASE + 4], P[BASE + 5]), b1 = cvtpk(P[BASE + 6], P[BASE + 7]);                              \
    auto r0 = __builtin_amdgcn_permlane32_swap(a0, b0, false, false); auto r1 = __builtin_amdgcn_permlane32_swap(a1, b1, false, false); \
    v4u w = {r0[0], r1[0], r0[1], r1[1]}; OUT = *reinterpret_cast<bf16x8*>(&w); } while (0)
  PK4(p0, 0, pa0); PK4(p0, 8, pa1); PK4(p1, 0, pa2); PK4(p1, 8, pa3);
#undef PK4
}
__device__ __forceinline__ void qkt(f32x16& p0, f32x16& p1, const char* Kn, const char* Kr, const bf16x8* qr, const char* Qr, int r32, int hi) {
  p0 = f32x16{}; p1 = f32x16{};
  int tn = (hi * 16) ^ ((r32 & 7) << 4), tr = (hi * 16) ^ (((r32 >> 1) & 7) << 4);
  asm volatile("" : "+v"(tn), "+v"(tr));
  const char* knb = Kn + r32 * 256; const char* krb = Kr + r32 * 128; const char* qrb = Qr + r32 * 128;
#pragma unroll
  for (int d0 = 0; d0 < 8; ++d0) { const int off = (d0 * 32) ^ tn;
    const bf16x8 b0 = *reinterpret_cast<const bf16x8*>(knb + off);
    const bf16x8 b1 = *reinterpret_cast<const bf16x8*>(knb + off + 8192);
    p0 = __builtin_amdgcn_mfma_f32_32x32x16_bf16(b0, qr[d0], p0, 0, 0, 0);
    p1 = __builtin_amdgcn_mfma_f32_32x32x16_bf16(b1, qr[d0], p1, 0, 0, 0); }
#pragma unroll
  for (int d0 = 0; d0 < 4; ++d0) { const int off = (d0 * 32) ^ tr;
    const bf16x8 b0 = *reinterpret_cast<const bf16x8*>(krb + off);
    const bf16x8 b1 = *reinterpret_cast<const bf16x8*>(krb + off + 4096);
    const bf16x8 qv = *reinterpret_cast<const bf16x8*>(qrb + off);
    p0 = __builtin_amdgcn_mfma_f32_32x32x16_bf16(b0, qv, p0, 0, 0, 0);
    p1 = __builtin_amdgcn_mfma_f32_32x32x16_bf16(b1, qv, p1, 0, 0, 0); }
}
__device__ __forceinline__ int v_st(int k, int c) { const int kk = (k & ~0xC) | ((k & 4) << 1) | ((k & 8) >> 1); return ((kk >> 3) * 4 + (c >> 5)) * 512 + ((kk & 7) * 32 + (c & 31)) * 2; }
__device__ __forceinline__ int v_rd_base(int lane) { return ((lane & 3) << 3) | (((lane >> 2) & 3) << 6) | (((lane >> 4) & 1) << 5) | (((lane >> 5) & 1) << 8); }
constexpr int v_rd_off(int d0, int ks, int half) { return d0 * 512 + ks * 4096 + half * 2048; }
template <int OFF> __device__ __forceinline__ s16x4 tr_read(int vb) {
  s16x4 r; asm volatile("ds_read_b64_tr_b16 %0, %1 offset:%2" : "=&v"(r) : "v"(vb), "i"(OFF) : "memory"); return r;
}
template <int D0> __device__ __forceinline__ void pv_one(f32x16& od, int vb, bf16x8 pa0, bf16x8 pa1, bf16x8 pa2, bf16x8 pa3) {
  const s16x4 l0 = tr_read<v_rd_off(D0, 0, 0)>(vb), h0 = tr_read<v_rd_off(D0, 0, 1)>(vb), l1 = tr_read<v_rd_off(D0, 1, 0)>(vb), h1 = tr_read<v_rd_off(D0, 1, 1)>(vb);
  const s16x4 l2 = tr_read<v_rd_off(D0, 2, 0)>(vb), h2 = tr_read<v_rd_off(D0, 2, 1)>(vb), l3 = tr_read<v_rd_off(D0, 3, 0)>(vb), h3 = tr_read<v_rd_off(D0, 3, 1)>(vb);
  asm volatile("s_waitcnt lgkmcnt(0)" ::: "memory"); SBAR();
#define PK(L, H) (bf16x8){L[0], L[1], L[2], L[3], H[0], H[1], H[2], H[3]}
  od = __builtin_amdgcn_mfma_f32_32x32x16_bf16(pa0, PK(l0, h0), od, 0, 0, 0);
  od = __builtin_amdgcn_mfma_f32_32x32x16_bf16(pa1, PK(l1, h1), od, 0, 0, 0);
  od = __builtin_amdgcn_mfma_f32_32x32x16_bf16(pa2, PK(l2, h2), od, 0, 0, 0);
  od = __builtin_amdgcn_mfma_f32_32x32x16_bf16(pa3, PK(l3, h3), od, 0, 0, 0);
#undef PK
}
__device__ __forceinline__ void pv_d0(f32x16* o, int vb, bf16x8 pa0, bf16x8 pa1, bf16x8 pa2, bf16x8 pa3) {
  pv_one<0>(o[0], vb, pa0, pa1, pa2, pa3); pv_one<1>(o[1], vb, pa0, pa1, pa2, pa3); pv_one<2>(o[2], vb, pa0, pa1, pa2, pa3); pv_one<3>(o[3], vb, pa0, pa1, pa2, pa3);
}

__device__ __forceinline__ void attn_unit(const bf16* __restrict__ Qb, const bf16* __restrict__ Knh, const bf16* __restrict__ Vh, const bf16* __restrict__ Krh,
                                          bf16* __restrict__ Yb, const bf16* __restrict__ Zb, const float* __restrict__ gh, float* __restrict__ part, int seq, char* lds) {
  int tid_ = threadIdx.x; asm volatile("" : "+v"(tid_));
  const int tid = tid_, wid = tid >> 6, lane = tid & 63, r32 = lane & 31, hi = lane >> 5;
  char* V_lds = lds + OFF_V; char* KN_lds = lds + OFF_KN; char* KR_lds = lds + OFF_KR;
  float* ws = (float*)(lds + OFF_WS) + wid * 64; float* li_l = ws; float* al_l = ws + 32;
  float m_reg = -1e30f, l_reg = 0; f32x16 o[4] = {}; bf16x8 qr[8]; char* QR_lds = lds + OFF_QR + wid * 4096;
  const bf16* Qw = Qb + (long)(wid * QBLK + r32) * NQ + hi * 8;
#pragma unroll
  for (int d0 = 0; d0 < 8; ++d0) qr[d0] = *reinterpret_cast<const bf16x8*>(Qw + d0 * 16);
#pragma unroll
  for (int d0 = 0; d0 < 4; ++d0) *reinterpret_cast<bf16x8*>(QR_lds + KRSWZ(r32, (d0 * 16 + hi * 8) * 2)) = *reinterpret_cast<const bf16x8*>(Qw + 128 + d0 * 16);
  const int sr = tid >> 4, sc = (tid & 15) * 8, vst0 = v_st(sr, sc), vst1 = v_st(32 + sr, sc);
  const int krr = tid >> 3, krc = (tid & 7) * 8;
  const int vb0 = (int)(uintptr_t)V_lds + v_rd_base(lane);
  bf16x8 vs0, vs1, ks0, ks1, kr0;
#define SLOAD(k0) do { vs0 = *reinterpret_cast<const bf16x8*>(&Vh[(long)((k0) + sr) * NKV + sc]); vs1 = *reinterpret_cast<const bf16x8*>(&Vh[(long)((k0) + 32 + sr) * NKV + sc]); \
    ks0 = *reinterpret_cast<const bf16x8*>(&Knh[(long)((k0) + sr) * NKV + sc]); ks1 = *reinterpret_cast<const bf16x8*>(&Knh[(long)((k0) + 32 + sr) * NKV + sc]); \
    kr0 = *reinterpret_cast<const bf16x8*>(&Krh[(long)((k0) + krr) * NP + krc]); } while (0)
#define SWRITE(b) do { *(bf16x8*)(V_lds + (b) * SHM_V + vst0) = vs0; *(bf16x8*)(V_lds + (b) * SHM_V + vst1) = vs1; const int kc = sc * 2;   \
    *(bf16x8*)(KN_lds + (b) * SHM_KN + KSWZ(sr, kc)) = ks0; *(bf16x8*)(KN_lds + (b) * SHM_KN + KSWZ(32 + sr, kc)) = ks1;                       \
    *(bf16x8*)(KR_lds + (b) * SHM_KR + KRSWZ(krr, krc * 2)) = kr0; } while (0)
#define SWAIT() asm volatile("s_waitcnt vmcnt(0)" ::: "memory")
#define RESC(a) do { if (__any((a) < 1.f)) { if (hi == 0) al_l[r32] = (a); asm volatile("s_waitcnt lgkmcnt(0)" ::: "memory"); \
    _Pragma("unroll") for (int d = 0; d < 4; ++d) _Pragma("unroll") for (int r = 0; r < 16; ++r) o[d][r] *= al_l[crow(r, hi)]; } } while (0)
  f32x16 pA0, pA1, pB0, pB1; float mnA, mnB, alA, alB; bf16x8 pa0, pa1, pa2, pa3; const int NT = seq / KVBLK;
  SLOAD(0); SWAIT(); SWRITE(0); __syncthreads();
  qkt(pA0, pA1, KN_lds, KR_lds, qr, QR_lds, r32, hi); partialSM(pA0, pA1, m_reg, mnA, alA);
  SLOAD(KVBLK);
  SWAIT(); SWRITE(1); __syncthreads();
  for (int j = 1; j + 1 < NT; j += 2) {
    SBAR(); qkt(pB0, pB1, KN_lds + SHM_KN, KR_lds + SHM_KR, qr, QR_lds, r32, hi);
    finishSM(pA0, pA1, alA, l_reg, pa0, pa1, pa2, pa3); SBAR();
    SLOAD((j + 1) * KVBLK); SBAR();
    pv_d0(o, vb0, pa0, pa1, pa2, pa3); partialSM(pB0, pB1, m_reg, mnB, alB);
    __syncthreads(); SWAIT(); SWRITE(0);
    RESC(alB); __syncthreads();
    SBAR(); qkt(pA0, pA1, KN_lds, KR_lds, qr, QR_lds, r32, hi);
    finishSM(pB0, pB1, alB, l_reg, pa0, pa1, pa2, pa3); SBAR();
    SLOAD((j + 2) * KVBLK); SBAR();
    pv_d0(o, vb0 + SHM_V, pa0, pa1, pa2, pa3); partialSM(pA0, pA1, m_reg, mnA, alA);
    __syncthreads(); SWAIT(); SWRITE(1);
    RESC(alA); __syncthreads();
  }
  SBAR(); qkt(pB0, pB1, KN_lds + SHM_KN, KR_lds + SHM_KR, qr, QR_lds, r32, hi);
  finishSM(pA0, pA1, alA, l_reg, pa0, pa1, pa2, pa3); SBAR();
  pv_d0(o, vb0, pa0, pa1, pa2, pa3); partialSM(pB0, pB1, m_reg, mnB, alB);
  __syncthreads(); RESC(alB);
  finishSM(pB0, pB1, alB, l_reg, pa0, pa1, pa2, pa3); SBAR();
  pv_d0(o, vb0 + SHM_V, pa0, pa1, pa2, pa3);
  if (hi == 0) li_l[r32] = l_reg; asm volatile("s_waitcnt lgkmcnt(0)" ::: "memory");
  float rli[16];
#pragma unroll
  for (int r = 0; r < 16; ++r) rli[r] = __builtin_amdgcn_rcpf(li_l[crow(r, hi)]);
#pragma unroll
  for (int d0 = 0; d0 < 4; ++d0)
#pragma unroll
    for (int r = 0; r < 16; ++r) o[d0][r] *= rli[r];
  __syncthreads();
  { LAS float* st = (LAS float*)(LAS unsigned char*)(lds + wid * 16384);
    stage_write(st, o, r32, hi);
    asm volatile("s_waitcnt lgkmcnt(0)" ::: "memory");
    float v[64]; stage_read(st, lane, v);
    const int row = lane >> 1, half = lane & 1; const long rr = wid * QBLK + row;
    float ss = 0.f;
#pragma unroll
    for (int j = 0; j < 64; ++j) ss += v[j] * v[j];
    ss += __shfl_xor(ss, 1);
    if (half == 0) part[rr * 8] = ss;
    gated_store64(v, 1.f, gh + half * 64, Zb + rr * NP + half * 64, Yb + rr * DM + half * 64); }
  __syncthreads();
#undef SLOAD
#undef SWRITE
#undef SWAIT
#undef RESC
}
#undef SBAR
}
struct Frame {
    LAS unsigned char* lds; char* ldsg;
    int tid, lane, wave, vcu, G;
    float* out; unsigned char* ws;
};
__device__ __forceinline__ const float* ld_in(int i) {
    const __attribute__((address_space(4))) char* ka = (const __attribute__((address_space(4))) char*)__builtin_amdgcn_kernarg_segment_ptr();
    asm volatile("" : "+s"(i));
    const GAS float* p = *(const GAS float* const __attribute__((address_space(4)))*)(ka + 8 * i);
    return (const float*)p;
}
#define WSP(T_, off) ((T_*)(F.ws + (off)))

__device__ __forceinline__ void p0_mods(Frame& F, size_t mods_off) {
    LAS float* sc = (LAS float*)F.lds;
    LAS float* part = (LAS float*)(F.lds + 32768);
    const float* c = ld_in(1); const float* aw = ld_in(3); const float* ab = ld_in(4);
    for (int i = F.tid; i < BATCH * DM; i += NTHR) { const float v = c[i]; sc[i] = v / (1.f + __expf(-v)); }
    __syncthreads();
    for (int item = (int)blockIdx.x; item < 768; item += F.G) {
        const int ks = item & 15, cb = (item >> 4) % 24, l = item / 384, j0 = cb * 256, kb = ks * 128 + F.wave * 16;
        const f32x4* w = (const f32x4*)(aw + (size_t)l * DM * 3 * DM + (size_t)kb * 3 * DM + j0) + F.lane;
        f32x4 wv[16];
#pragma unroll
        for (int k = 0; k < 16; ++k) wv[k] = w[(size_t)k * (3 * DM / 4)];
        f32x4 a[4] = {};
#pragma unroll
        for (int k = 0; k < 16; ++k)
#pragma unroll
            for (int b = 0; b < 4; ++b) a[b] += wv[k] * sc[b * DM + kb + k];
#pragma unroll
        for (int b = 0; b < 4; ++b) *(LAS f32x4*)(part + (F.wave * 4 + b) * 256 + F.lane * 4) = a[b];
        __syncthreads();
        for (int o = F.tid; o < 1024; o += NTHR) { const int b = o >> 8, col = o & 255; float s = 0.f;
#pragma unroll
            for (int wv2 = 0; wv2 < 8; ++wv2) s += part[(wv2 * 4 + b) * 256 + col];
            if (ks == 0) s += ab[l * 3 * DM + j0 + col];
            atomicAdd(WSP(float, mods_off) + ((size_t)l * BATCH + b) * 3 * DM + j0 + col, s); }
        __syncthreads();
    }
}
__device__ __forceinline__ int kmap_out(int k) { return k < 768 ? k + 768 : (k < 1536 ? k - 768 : k); }
template <int MAP, bool KMAP> __device__ __forceinline__ void p0_transpose_item(const float* W, int K, int N, bf16* WT, const float* kgain, LAS bf16* tl, int item, int nblk, int lane) {
    const int kb = item / nblk, nb = item % nblk, k0 = 64 * kb, n0 = 64 * nb, ks0 = KMAP ? kmap_out(k0) : k0;
    const int nq = (lane & 15) * 4, kr = lane >> 4;
    const int s0 = MAP == 1 ? map_in(n0) : (MAP == 2 ? map_uq(n0) : n0), s63 = MAP == 1 ? map_in(n0 + 63) : (MAP == 2 ? map_uq(n0 + 63) : n0 + 63);
    const int s1 = MAP == 1 ? map_in(n0 + 1) : (MAP == 2 ? map_uq(n0 + 1) : n0 + 1);
    if (s0 >= 0 && s63 - s0 == 63 && s1 == s0 + 1) {
        f32x4 v[16];
#pragma unroll
        for (int i = 0; i < 16; ++i) v[i] = *(const f32x4*)(W + (size_t)(ks0 + 4 * i + kr) * N + s0 + nq);
#pragma unroll
        for (int i = 0; i < 16; ++i) { const int kk = 4 * i + kr; const float gsc = kgain ? kgain[k0 + kk] : 1.f;
#pragma unroll
            for (int e = 0; e < 4; ++e) tl[(nq + e) * 72 + kk] = (unsigned short)f2bf(v[i][e] * gsc); }
    } else {
        const int np = n0 + lane; const int src = MAP == 1 ? map_in(np) : (MAP == 2 ? map_uq(np) : np);
        float v[64];
#pragma unroll
        for (int i = 0; i < 64; ++i) v[i] = src >= 0 ? W[(size_t)(ks0 + i) * N + src] : 0.f;
#pragma unroll
        for (int i = 0; i < 64; i += 2) { const float g0 = kgain ? kgain[k0 + i] : 1.f, g1 = kgain ? kgain[k0 + i + 1] : 1.f;
            *(LAS unsigned*)(tl + lane * 72 + i) = pk2(v[i] * g0, v[i + 1] * g1); }
    }
    LDS_WAIT(); asm volatile("" ::: "memory");
    bf16* orow = WT + (size_t)(n0 + lane) * K + k0;
#pragma unroll
    for (int cch = 0; cch < 8; ++cch) *(GAS v4u*)(orow + 8 * cch) = *(const LAS v4u*)(tl + lane * 72 + 8 * cch);
    LDS_WAIT(); asm volatile("" ::: "memory");
}
__device__ __forceinline__ void p0_prologue(Frame& F, size_t mods_off) {
    p0_mods(F, mods_off);
    LAS bf16* tl = (LAS bf16*)(F.lds + F.wave * 9216);
    const int gw = F.vcu * NWAVES + F.wave, NGW = F.G * NWAVES;
    constexpr int I_IN = (DM / 64) * (NP / 64), I_OUT = (DM / 64) * (DM / 64), I_UQ = (384 / 64) * (NQ / 64), I_UKV = (256 / 64) * (NKV / 64), I_L = I_IN + I_OUT + I_UQ + I_UKV;
    for (int it = gw; it < DEPTH * I_L; it += NGW) {
        const int l = it / I_L; int r = it % I_L;
        if (r < I_IN) { p0_transpose_item<1, false>(ld_in(6) + (size_t)l * DM * IN_DIM, DM, IN_DIM, WSP(bf16, WS_WIN) + (size_t)l * NP * DM, nullptr, tl, r, NP / 64, F.lane); continue; } r -= I_IN;
        if (r < I_OUT) { p0_transpose_item<0, true>(ld_in(19) + (size_t)l * DM * DM, DM, DM, WSP(bf16, WS_WOUT) + (size_t)l * DM * DM, nullptr, tl, r, DM / 64, F.lane); continue; } r -= I_OUT;
        if (r < I_UQ) { p0_transpose_item<2, false>(ld_in(14) + (size_t)l * 384 * 1152, 384, 1152, WSP(bf16, WS_WUQ) + (size_t)l * NQ * 384, ld_in(12) + l * 384, tl, r, NQ / 64, F.lane); continue; } r -= I_UQ;
        p0_transpose_item<0, false>(ld_in(15) + (size_t)l * 256 * 1536, 256, 1536, WSP(bf16, WS_WUKV) + (size_t)l * NKV * 256, ld_in(13) + l * 256, tl, r, NKV / 64, F.lane);
    }
    const int* pos = (const int*)ld_in(2);
    for (int i = (int)blockIdx.x * NTHR + F.tid; i < T * 32; i += F.G * NTHR) {
        const int t = i >> 5, f = i & 31;
        const float inv = (float)exp2(-(double)f * (13.287712379549449 / 32.0));
        const float ang = (float)pos[t] * inv;
        const double rev = (double)ang * 0.15915494309189535; const float fr = (float)(rev - floor(rev));
        WSP(float, WS_CS)[i] = __builtin_amdgcn_cosf(fr); WSP(float, WS_SN)[i] = __builtin_amdgcn_sinf(fr);
    }
}
__device__ __forceinline__ void modnorm_rows(Frame& F, const float* x, const float* g, const float* mods_l, bf16* H) {
    const int gw = F.vcu * NWAVES + F.wave, NGW = F.G * NWAVES;
    for (int t = gw; t < T; t += NGW) {
        const GAS f32x4* xr = (const GAS f32x4*)(x + (size_t)t * DM) + F.lane;
        f32x4 v[8]; float s = 0.f;
#pragma unroll
        for (int j = 0; j < 8; ++j) { v[j] = xr[64 * j]; s += (v[j][0] * v[j][0] + v[j][1] * v[j][1]) + (v[j][2] * v[j][2] + v[j][3] * v[j][3]); }
        const float rstd = __builtin_amdgcn_rsqf(wave_sum(s) * (1.f / DM) + EPS);
        const float* sh = mods_l + (size_t)(t / SEQ) * 3 * DM; const float* scl = sh + DM;
        GAS v2u* o8 = (GAS v2u*)(H + (size_t)t * DM) + F.lane;
#pragma unroll
        for (int j = 0; j < 8; ++j) { const int col = (F.lane + 64 * j) * 4;
            const f32x4 gg = *(const f32x4*)(g + col), sv = *(const f32x4*)(scl + col), hv = *(const f32x4*)(sh + col);
            const f32x4 r = v[j] * rstd * gg * (sv + 1.f) + hv;
            v2u w; w.x = pk2(r[0], r[1]); w.y = pk2(r[2], r[3]); o8[64 * j] = w; }
    }
}
__device__ __forceinline__ void finalnorm_rows(Frame& F, float* x, const float* g) {
    const int gw = F.vcu * NWAVES + F.wave, NGW = F.G * NWAVES;
    for (int t = gw; t < T; t += NGW) {
        GAS f32x4* xr = (GAS f32x4*)(x + (size_t)t * DM) + F.lane;
        f32x4 v[8]; float s = 0.f;
#pragma unroll
        for (int j = 0; j < 8; ++j) { v[j] = xr[64 * j]; s += (v[j][0] * v[j][0] + v[j][1] * v[j][1]) + (v[j][2] * v[j][2] + v[j][3] * v[j][3]); }
        const float rstd = __builtin_amdgcn_rsqf(wave_sum(s) * (1.f / DM) + EPS);
#pragma unroll
        for (int j = 0; j < 8; ++j) { const f32x4 gg = *(const f32x4*)(g + (F.lane + 64 * j) * 4); xr[64 * j] = v[j] * rstd * gg; }
    }
}
__device__ __forceinline__ void conv_rows(Frame& F, int l) {
    const int gw = F.vcu * NWAVES + F.wave, NGW = F.G * NWAVES;
    const bf16* P = WSP(bf16, WS_PROJ); bf16* Y = WSP(bf16, WS_HY);
    const float* cw = ld_in(17) + l * 3 * 512; const float* cg = ld_in(18) + l * 512;
    const int ch = F.lane * 8;
    for (int t = gw; t < T; t += NGW) {
        const int s = t % SEQ; const bf16* p = P + (size_t)t * NP;
        float u[3][8];
#pragma unroll
        for (int d = 0; d < 3; ++d) { const int ss = s + d - 1;
            if (ss >= 0 && ss < SEQ) { const bf16* q = p + (long)(d - 1) * NP; float a[8], b[8]; unpack8(*(const v4u*)(q + C_CC + ch), a); unpack8(*(const v4u*)(q + C_CX + ch), b);
#pragma unroll
                for (int e = 0; e < 8; ++e) u[d][e] = a[e] * b[e]; }
            else {
#pragma unroll
                for (int e = 0; e < 8; ++e) u[d][e] = 0.f; } }
        float cb[8], sz[8], pre[8]; unpack8(*(const v4u*)(p + C_CB + ch), cb); unpack8(*(const v4u*)(p + C_Z + 1536 + ch), sz);
        float ssq = 0.f;
#pragma unroll
        for (int e = 0; e < 8; ++e) { pre[e] = cb[e] * (u[0][e] * cw[ch + e] + u[1][e] * cw[512 + ch + e] + u[2][e] * cw[1024 + ch + e]); ssq += pre[e] * pre[e]; }
        const float rstd = __builtin_amdgcn_rsqf(wave_sum(ssq) * (1.f / 512.f) + EPS);
        float r[8];
#pragma unroll
        for (int e = 0; e < 8; ++e) r[e] = pre[e] * rstd * cg[ch + e] * sz[e];
        v4u w; w.x = pk2(r[0], r[1]); w.y = pk2(r[2], r[3]); w.z = pk2(r[4], r[5]); w.w = pk2(r[6], r[7]);
        *(v4u*)(Y + (size_t)t * DM + 1536 + ch) = w;
    }
}
__device__ __forceinline__ void mlaout_rows(Frame& F, int l) {
    const int gw = F.vcu * NWAVES + F.wave, NGW = F.G * NWAVES;
    const bf16* P = WSP(bf16, WS_PROJ); bf16* Y = WSP(bf16, WS_HY); const float* O = WSP(float, WS_OMLA); const float* g = ld_in(16) + l * 768;
    for (int t = gw; t < T; t += NGW) {
        f32x4 v[3]; float s = 0.f;
#pragma unroll
        for (int j = 0; j < 3; ++j) { v[j] = *(const f32x4*)(O + (size_t)t * 768 + (F.lane + 64 * j) * 4); s += (v[j][0] * v[j][0] + v[j][1] * v[j][1]) + (v[j][2] * v[j][2] + v[j][3] * v[j][3]); }
        const float rstd = __builtin_amdgcn_rsqf(wave_sum(s) * (1.f / 768.f) + EPS);
#pragma unroll
        for (int j = 0; j < 3; ++j) { const int col = (F.lane + 64 * j) * 4; const f32x4 gg = *(const f32x4*)(g + col);
            const v2u zw = *(const v2u*)(P + (size_t)t * NP + C_Z + 768 + col);
            const f32x4 r = v[j] * rstd * gg; v2u w; w.x = pk2(r[0] * bflo(zw.x), r[1] * bfhi(zw.x)); w.y = pk2(r[2] * bflo(zw.y), r[3] * bfhi(zw.y));
            *(v2u*)(Y + (size_t)t * DM + col) = w; }
    }
}


template <int KS> __device__ __forceinline__ f32x16 tile_mm(const LAS bf16* A, const LAS bf16* Bt, int r, int hh, f32x16 acc) {
#pragma unroll
    for (int s = 0; s < KS; ++s) {
        const bf16x8 a = *(const LAS bf16x8*)(A + r * 72 + 16 * s + 8 * hh), b = *(const LAS bf16x8*)(Bt + r * 72 + 16 * s + 8 * hh);
        acc = __builtin_amdgcn_mfma_f32_32x32x16_bf16(a, b, acc, 0, 0, 0);
    }
    return acc;
}
__device__ __forceinline__ float logsig16(float a) { return (fminf(a, 0.f) - __logf(1.f + __expf(-fabsf(a)))) * (1.f / 16.f); }
__device__ __forceinline__ void gla_a_item(Frame& F, int l, int item) {
    const int h = item % 6, bn = item / 6, t0 = bn * 64;
    const int tid = F.tid, lane = F.lane, wave = F.wave;
    LAS unsigned char* L = F.lds;
    LAS bf16* QB = (LAS bf16*)(L);
    LAS bf16* KB = (LAS bf16*)(L + 9216);
    LAS bf16* Mm = (LAS bf16*)(L);
    LAS bf16* VT = (LAS bf16*)(L + 18432);
    LAS float* LR = (LAS float*)(L + 36864);
    LAS float* WG = (LAS float*)(L + 36864 + 8192);
    LAS float* BG = (LAS float*)(L + 36864 + 16384);
    LAS bf16* KDT = (LAS bf16*)(L + 36864);
    LAS float* LA = (LAS float*)(L + 55296);
    LAS float* SEGT = (LAS float*)(L + 88576);
    LAS bf16* QF = (LAS bf16*)(L + 90624);
    LAS bf16* KF = (LAS bf16*)(L + 90624 + 18432);
    const bf16* P = WSP(bf16, WS_PROJ) + (size_t)t0 * NP;
    { const int r = tid >> 3, c8 = (tid & 7) * 8;
      *(LAS v4u*)(QB + r * 72 + c8) = *(const v4u*)(P + (size_t)r * NP + C_GQ + h * 64 + c8);
      *(LAS v4u*)(KB + r * 72 + c8) = *(const v4u*)(P + (size_t)r * NP + C_GK + h * 64 + c8); }
#pragma unroll
    for (int i = 0; i < 2; ++i) { const int idx = tid + i * 512, r = idx >> 4, c8 = (idx & 15) * 8;
        const v4u raw = *(const v4u*)(P + (size_t)r * NP + C_GV + h * 128 + c8);
        VT[(c8 + 0) * 72 + r] = (unsigned short)(raw.x & 0xffffu); VT[(c8 + 1) * 72 + r] = (unsigned short)(raw.x >> 16);
        VT[(c8 + 2) * 72 + r] = (unsigned short)(raw.y & 0xffffu); VT[(c8 + 3) * 72 + r] = (unsigned short)(raw.y >> 16);
        VT[(c8 + 4) * 72 + r] = (unsigned short)(raw.z & 0xffffu); VT[(c8 + 5) * 72 + r] = (unsigned short)(raw.z >> 16);
        VT[(c8 + 6) * 72 + r] = (unsigned short)(raw.w & 0xffffu); VT[(c8 + 7) * 72 + r] = (unsigned short)(raw.w >> 16); }
    if (tid < 256) { const int r = tid >> 2, c8 = (tid & 3) * 8; float f[8]; unpack8(*(const v4u*)(P + (size_t)r * NP + C_LR + c8), f);
#pragma unroll
        for (int e = 0; e < 8; ++e) LR[r * 32 + c8 + e] = f[e]; }
    { const int dir = tid >> 8, r = (tid >> 4) & 15, c4 = (tid & 15) * 4; const float* wgf_ = ld_in(7); const float* wgb_ = ld_in(9); const float* wsrc = (dir ? wgb_ : wgf_) + (size_t)l * 16 * 384 + r * 384 + h * 64 + c4;
      *(LAS f32x4*)(WG + (dir * 16 + r) * 64 + c4) = *(const f32x4*)wsrc; }
    if (tid < 128) { const int dir = tid >> 6, dk = tid & 63; const float* bgf_ = ld_in(8); const float* bgb_ = ld_in(10); BG[dir * 64 + dk] = (dir ? bgb_ : bgf_)[l * 384 + h * 64 + dk]; }
    LDS_WAIT(); __syncthreads();
    { const int tok = tid >> 3, dkg = (tid & 7) * 8;
#pragma unroll
      for (int dir = 0; dir < 2; ++dir) { float a[8];
#pragma unroll
        for (int e = 0; e < 8; ++e) a[e] = BG[dir * 64 + dkg + e];
#pragma unroll
        for (int r = 0; r < 16; ++r) { const float x = LR[tok * 32 + dir * 16 + r];
#pragma unroll
            for (int e = 0; e < 8; ++e) a[e] += x * WG[(dir * 16 + r) * 64 + dkg + e]; }
#pragma unroll
        for (int e = 0; e < 8; ++e) LA[(dir * 64 + tok) * 65 + dkg + e] = logsig16(a[e]); } }
    LDS_WAIT(); __syncthreads();
    const int cdir = (tid >> 6) & 1, cdk = tid & 63, seg = tid >> 7;
    float pb[16];
#pragma unroll
    for (int i = 0; i < 16; ++i) pb[i] = LA[(cdir * 64 + seg * 16 + i) * 65 + cdk];
    if (cdir == 0) {
#pragma unroll
        for (int i = 1; i < 16; ++i) pb[i] += pb[i - 1];
    } else {
#pragma unroll
        for (int i = 14; i >= 0; --i) pb[i] += pb[i + 1];
    }
    SEGT[(cdir * 4 + seg) * 64 + cdk] = cdir == 0 ? pb[15] : pb[0];
    LDS_WAIT(); __syncthreads();
    { float offv = 0.f, tot = 0.f;
#pragma unroll
      for (int s2 = 0; s2 < 4; ++s2) { const float sv = SEGT[(cdir * 4 + s2) * 64 + cdk]; tot += sv; if (cdir == 0 ? (s2 < seg) : (s2 > seg)) offv += sv; }
      bf16* QD = WSP(bf16, WS_QDEC) + (size_t)cdir * T * 384 + (size_t)t0 * 384 + h * 64 + cdk;
      unsigned kd[8];
#pragma unroll
      for (int i = 0; i < 16; ++i) { const int tok = seg * 16 + i; const float bv = pb[i] + offv;
          const float q = bf2f(QB[tok * 72 + cdk]), k = bf2f(KB[tok * 72 + cdk]);
          const unsigned short qd = (unsigned short)f2bf(q * 0.125f * __expf(bv)), ki = (unsigned short)f2bf(k * __expf(-bv)), kdv = (unsigned short)f2bf(k * __expf(tot - bv));
          QF[(cdir * 64 + tok) * 72 + cdk] = qd; KF[(cdir * 64 + tok) * 72 + cdk] = ki; QD[(size_t)tok * 384] = qd;
          if (i & 1) kd[i >> 1] |= (unsigned)kdv << 16; else kd[i >> 1] = kdv;
          if ((i & 3) == 3) __builtin_amdgcn_sched_barrier(0); }
      *(LAS v4u*)(KDT + (cdir * 64 + cdk) * 72 + seg * 16) = (v4u){kd[0], kd[1], kd[2], kd[3]};
      *(LAS v4u*)(KDT + (cdir * 64 + cdk) * 72 + seg * 16 + 8) = (v4u){kd[4], kd[5], kd[6], kd[7]};
      if (seg == 0) WSP(float, WS_DECAY)[((size_t)item * 2 + cdir) * 64 + cdk] = __expf(tot); }
    LDS_WAIT(); __syncthreads();
    const int r = lane & 31, hh = lane >> 5;
    if (wave < 4) {
        const int pb2 = wave >> 1, jb = wave & 1; f32x16 sf = {}, sb = {};
        if (pb2 >= jb) sf = tile_mm<4>(QF + (0 * 64 + pb2 * 32) * 72, KF + (0 * 64 + jb * 32) * 72, r, hh, sf);
        if (pb2 <= jb) sb = tile_mm<4>(QF + (1 * 64 + pb2 * 32) * 72, KF + (1 * 64 + jb * 32) * 72, r, hh, sb);
#pragma unroll
        for (int reg = 0; reg < 16; ++reg) { const int p = (reg & 3) + 8 * (reg >> 2) + 4 * hh; float v;
            if (pb2 > jb) v = sf[reg]; else if (pb2 < jb) v = sb[reg]; else v = (r <= p) ? sf[reg] : sb[reg];
            Mm[(pb2 * 32 + p) * 72 + jb * 32 + r] = (unsigned short)f2bf(v); }
    } else {
        const int dvb = wave - 4; float* KV = WSP(float, WS_KVC) + (size_t)item * 2 * 8192;
#pragma unroll
        for (int dir = 0; dir < 2; ++dir)
#pragma unroll
            for (int dkb = 0; dkb < 2; ++dkb) { f32x16 a = {}; a = tile_mm<4>(VT + (dvb * 32) * 72, KDT + (dir * 64 + dkb * 32) * 72, r, hh, a);
#pragma unroll
                for (int reg = 0; reg < 16; ++reg) { const int dv = dvb * 32 + (reg & 3) + 8 * (reg >> 2) + 4 * hh; KV[(size_t)dir * 8192 + dv * 64 + dkb * 32 + r] = a[reg]; } }
    }
    LDS_WAIT(); __syncthreads();
    { const int pb2 = wave >> 2, dvb = wave & 3; f32x16 a = {}; a = tile_mm<4>(Mm + (pb2 * 32) * 72, VT + (dvb * 32) * 72, r, hh, a);
      float* OI = WSP(float, WS_OINTRA) + (size_t)(t0 + pb2 * 32) * 768 + h * 128 + dvb * 32 + r;
#pragma unroll
      for (int reg = 0; reg < 16; ++reg) { const int p = (reg & 3) + 8 * (reg >> 2) + 4 * hh; OI[(size_t)p * 768] = a[reg]; } }
    __syncthreads();
}
__device__ __forceinline__ void gla_scan_witem(Frame& F, int item) {
    const int slice = item & 31, dir = (item >> 5) & 1, bh = item >> 6, b = bh / 6, h = bh % 6;
    const int e = slice * 256 + F.lane * 4, dk = e & 63;
    const float* KV = WSP(float, WS_KVC); const float* DC = WSP(float, WS_DECAY); bf16* ST = WSP(bf16, WS_ST);
    f32x4 st = {0.f, 0.f, 0.f, 0.f};
#pragma unroll 8
    for (int i = 0; i < 32; ++i) { const int n = dir ? 31 - i : i; const size_t it = (size_t)((b * 32 + n) * 6 + h) * 2 + dir;
        const f32x4 kv = *(const f32x4*)(KV + it * 8192 + e), dc = *(const f32x4*)(DC + it * 64 + dk);
        v2u w; w.x = pk2(st[0], st[1]); w.y = pk2(st[2], st[3]); *(v2u*)(ST + it * 8192 + e) = w;
        st = dc * st + kv; }
}
__device__ __forceinline__ void gla_c_task(Frame& F, int l, int task) {
    const int item = task >> 1, half = task & 1, h = item % 6, bn = item / 6, tk0 = bn * 64 + half * 32;
    const int r = F.lane & 31, hh = F.lane >> 5;
    const bf16* QD = WSP(bf16, WS_QDEC); const bf16* ST = WSP(bf16, WS_ST) + (size_t)item * 2 * 8192;
    bf16x8 af[2][4];
#pragma unroll
    for (int dir = 0; dir < 2; ++dir)
#pragma unroll
        for (int s = 0; s < 4; ++s) af[dir][s] = *(const bf16x8*)(QD + (size_t)dir * T * 384 + (size_t)(tk0 + r) * 384 + h * 64 + 16 * s + 8 * hh);
    f32x16 acc[4];
#pragma unroll
    for (int dvb = 0; dvb < 4; ++dvb) { acc[dvb] = f32x16{};
#pragma unroll
        for (int dir = 0; dir < 2; ++dir)
#pragma unroll
            for (int s = 0; s < 4; ++s) { const bf16x8 bfr = *(const bf16x8*)(ST + (size_t)dir * 8192 + (dvb * 32 + r) * 64 + 16 * s + 8 * hh);
                acc[dvb] = __builtin_amdgcn_mfma_f32_32x32x16_bf16(af[dir][s], bfr, acc[dvb], 0, 0, 0); } }
    LAS float* st = (LAS float*)(F.lds + F.wave * 16384);
    stage_write(st, acc, r, hh);
    LDS_WAIT(); asm volatile("" ::: "memory");
    float v[64]; stage_read(st, F.lane, v);
    const int row = F.lane >> 1, hf = F.lane & 1; const size_t t = (size_t)(tk0 + row);
    const float* OI = WSP(float, WS_OINTRA) + t * 768 + h * 128 + hf * 64;
    f32x4 oi[16];
#pragma unroll
    for (int j = 0; j < 16; ++j) oi[j] = *(const f32x4*)(OI + 4 * j);
    float ss = 0.f;
#pragma unroll
    for (int j = 0; j < 16; ++j) {
#pragma unroll
        for (int e2 = 0; e2 < 4; ++e2) { v[4 * j + e2] += oi[j][e2]; ss += v[4 * j + e2] * v[4 * j + e2]; } }
    ss += __shfl_xor(ss, 1);
    const float rstd = __builtin_amdgcn_rsqf(ss * (1.f / 128.f) + EPS);
    gated_store64(v, rstd, ld_in(11) + l * 128 + hf * 64, WSP(bf16, WS_PROJ) + t * NP + C_Z + h * 128 + hf * 64, WSP(bf16, WS_HY) + t * DM + 768 + h * 128 + hf * 64);
    LDS_WAIT(); asm volatile("" ::: "memory");
}
#define XB_TMO      128
#define XB_XCNT(j)  (256  + 64 * (j))
#define XB_XSUB(j)  (1280 + 64 * (j))
#define XB_XGEN(j)  (2304 + 64 * (j))
#define XB_TOP      3328
#define XB_TOPGEN   3392
#define XCD_BAR_WORDS 3456
#define XB_SPIN_CAP (1u << 18)
__device__ __forceinline__ unsigned xb_ld(unsigned* p)              { return __hip_atomic_load(p, __ATOMIC_RELAXED, __HIP_MEMORY_SCOPE_AGENT); }
__device__ __forceinline__ unsigned xb_add(unsigned* p, unsigned v) { return __hip_atomic_fetch_add(p, v, __ATOMIC_RELAXED, __HIP_MEMORY_SCOPE_AGENT); }
__device__ __forceinline__ unsigned xb_xcc_id() { return (unsigned)__builtin_amdgcn_s_getreg((3 << 11) | 20) & 0xFu; }
#define XB_SPIN(cond, bar) do { unsigned _sp = 0; while (cond) { __builtin_amdgcn_s_sleep(1); \
    if ((++_sp & 255u) == 0u) { if (xb_ld(&(bar)[XB_TMO])) break; if (_sp > XB_SPIN_CAP) { atomicAdd(&(bar)[XB_TMO], 1u); break; } } } } while (0)
struct XcdBarrier { unsigned* bar; unsigned x; volatile LAS unsigned* st; };
__device__ __forceinline__ XcdBarrier xcd_barrier_post(unsigned* bar, volatile LAS unsigned* st) {
    XcdBarrier b; b.bar = bar; b.x = xb_xcc_id(); b.st = st;
    if (threadIdx.x == 0) (void)xb_add(&bar[XB_XCNT(b.x)], 1u);
    return b;
}
__device__ __forceinline__ void xcd_barrier_complete(unsigned* bar, unsigned x, unsigned& nloc, unsigned& nx) {
    const unsigned G = gridDim.x * gridDim.y * gridDim.z;
    unsigned sum, cnt, mine, sp = 0u;
    for (;;) {
        sum = 0u; cnt = 0u; mine = 0u;
#pragma unroll
        for (unsigned j = 0; j < 16; ++j) { const unsigned c = xb_ld(&bar[XB_XCNT(j)]); sum += c; cnt += (c > 0u) ? 1u : 0u; mine = (j == x) ? c : mine; }
        if (sum == G) break;
        __builtin_amdgcn_s_sleep(1);
        if ((++sp & 255u) == 0u) { if (xb_ld(&bar[XB_TMO])) break; if (sp > XB_SPIN_CAP) { atomicAdd(&bar[XB_TMO], 1u); break; } }
    }
    nloc = mine > 0u ? mine : 1u; nx = cnt > 0u ? cnt : 1u;
}
__device__ __forceinline__ void xcd_barrier(const XcdBarrier& b) {
    asm volatile("s_waitcnt vmcnt(0)" ::: "memory");
    __syncthreads();
    if (threadIdx.x == 0) {
        unsigned* bar = b.bar;
        __builtin_amdgcn_s_waitcnt(0);
        unsigned nloc = b.st[0], nx = b.st[1];
        if (nloc == 0u) { xcd_barrier_complete(bar, b.x, nloc, nx); b.st[0] = nloc; b.st[1] = nx; }
        const unsigned old = xb_add(&bar[XB_XSUB(b.x)], 1u);
        const unsigned gen = old / nloc;
        if (old + 1u == (gen + 1u) * nloc) {
            __builtin_amdgcn_fence(__ATOMIC_RELEASE, "agent");
            asm volatile("s_waitcnt vmcnt(0)" ::: "memory");
            const unsigned og = xb_add(&bar[XB_TOP], 1u);
            const unsigned tg = og / nx;
            if (og + 1u == (tg + 1u) * nx) xb_add(&bar[XB_TOPGEN], 1u);
            else XB_SPIN(xb_ld(&bar[XB_TOPGEN]) == tg, bar);
            __builtin_amdgcn_fence(__ATOMIC_ACQUIRE, "agent");
            xb_add(&bar[XB_XGEN(b.x)], 1u);
            asm volatile("s_waitcnt vmcnt(0)" ::: "memory");
        } else {
            XB_SPIN(xb_ld(&bar[XB_XGEN(b.x)]) == gen, bar);
            __builtin_amdgcn_fence(__ATOMIC_ACQUIRE, "agent");
            asm volatile("s_waitcnt vmcnt(0)" ::: "memory");
        }
    }
    __syncthreads();
}

__device__ __forceinline__ void sub_barrier(unsigned* cnt, unsigned target) {
    asm volatile("s_waitcnt vmcnt(0)" ::: "memory");
    __syncthreads();
    if (threadIdx.x == 0) {
        __builtin_amdgcn_fence(__ATOMIC_RELEASE, "agent");
        asm volatile("s_waitcnt vmcnt(0)" ::: "memory");
        (void)xb_add(cnt, 1u);
        unsigned sp = 0u; while (xb_ld(cnt) < target) { __builtin_amdgcn_s_sleep(2); if (++sp > (1u << 22)) break; }
        __builtin_amdgcn_fence(__ATOMIC_ACQUIRE, "agent");
        asm volatile("s_waitcnt vmcnt(0)" ::: "memory");
    }
    __syncthreads();
}

struct Args { const float* in[21]; float* out; unsigned char* ws; int ph_lo, ph_hi; };
constexpr int N_PHASES = 2 + 6 * DEPTH;
__global__ void __launch_bounds__(NTHR, 2) mega_fwd(Args args) {
    extern __shared__ __attribute__((aligned(16))) unsigned char lds[];
    Frame F;
    F.lds = (LAS unsigned char*)lds; F.ldsg = (char*)lds;
    F.tid = threadIdx.x; F.lane = F.tid & 63; F.wave = __builtin_amdgcn_readfirstlane(F.tid >> 6);
    F.G = gridDim.x; { const int bx = blockIdx.x; F.vcu = (F.G % 8 == 0) ? (bx % 8) * (F.G / 8) + bx / 8 : bx; }
    F.out = args.out; F.ws = args.ws;
    volatile LAS unsigned* MISC = (volatile LAS unsigned*)(F.lds + MISC_OFF);
    for (int u = F.tid; u < (LDS_BYTES - LDSCTL_OFF) / 4; u += NTHR) ((LAS unsigned*)(F.lds + LDSCTL_OFF))[u] = 0u;
    __syncthreads();
    XcdBarrier bar = xcd_barrier_post((unsigned*)(F.ws + WS_CTL) + CW_BAR, MISC + 8);
    const int lo = args.ph_lo, hi = args.ph_hi;
#ifndef MK_MASK
#define MK_MASK 0xFF
#endif
#define PHON(b) ((MK_MASK >> (b)) & 1)
#ifndef MK_REP_PH
#define MK_REP_PH -1
#endif
#define REPS(ph) for (int rep_ = 0; rep_ < ((ph) == MK_REP_PH ? 2 : 1); ++rep_)
#define REPBAR() do { if (rep_ == 0 && false) {} } while (0)
#define IN(k) (lo <= (k) && (k) < hi)
#define FRESH() do { int t_ = threadIdx.x; asm volatile("" : "+v"(t_)); F.tid = t_; F.lane = t_ & 63; F.wave = __builtin_amdgcn_readfirstlane(t_ >> 6); GAS unsigned char* w_ = (GAS unsigned char*)args.ws; asm volatile("" : "+s"(w_)); F.ws = (unsigned char*)w_; GAS float* o_ = (GAS float*)args.out; asm volatile("" : "+s"(o_)); F.out = (float*)o_; } while (0)
#define SEAM(k) do { if (IN(k) && IN((k) + 1)) xcd_barrier(bar); } while (0)
    REPS(100) { if (PHON(0) && IN(0)) { p0_prologue(F, rep_ == 0 ? WS_MODS : (size_t)(1 * MiB)); } SEAM(0); }
    REPS(101) { if (PHON(1) && IN(1)) { modnorm_rows(F, ld_in(0), ld_in(5), WSP(float, WS_MODS), WSP(bf16, WS_HY)); } SEAM(1); }
#pragma unroll 1
    for (int l = 0; l < DEPTH; ++l) {
        const int pb = 2 + 6 * l;
#define mods_l (WSP(float, WS_MODS) + (size_t)l * BATCH * 3 * DM)
        REPS(0) { if (PHON(2) && IN(pb)) {
            FRESH();
            pg8::Gemm g{WSP(bf16, WS_HY), WSP(bf16, WS_WIN) + (size_t)l * NP * DM, T, NP, DM, DM}; pg8::StaticOrder S; S.init(T, NP, F.G, (int)blockIdx.x);
            EpiIn E{WSP(bf16, WS_PROJ), WSP(float, WS_CS), WSP(float, WS_SN), WSP(float, WS_PARTQ), WSP(float, WS_PARTKV)};
            pg8::gemm_phase<EpiIn, pg8::StaticOrder, true, true>(F.lds, g, S, E);
        } SEAM(pb); }
        REPS(1) { if (PHON(3) && IN(pb + 1)) {
#ifndef MK_SUB
#define MK_SUB 0xFF
#endif
            FRESH();
            if (MK_SUB & 1) { pg8::Gemm g{WSP(bf16, WS_PROJ) + C_MKV, WSP(bf16, WS_WUKV) + (size_t)l * NKV * 256, T, NKV, 256, NP}; pg8::StaticOrder S; S.init(T, NKV, F.G, (int)blockIdx.x);
              EpiUkv E{WSP(bf16, WS_KVUP), WSP(float, WS_PARTKV)};
              pg8::gemm_phase<EpiUkv, pg8::StaticOrder, true, true>(F.lds, g, S, E); }
            FRESH();
            if (MK_SUB & 2) { pg8::Gemm g{WSP(bf16, WS_PROJ) + C_MQ, WSP(bf16, WS_WUQ) + (size_t)l * NQ * 384, T, NQ, 384, NP}; pg8::StaticOrder S; S.init(T, NQ, F.G, ((int)blockIdx.x + 64) % F.G);
              EpiUq E{WSP(bf16, WS_QUP), WSP(float, WS_CS), WSP(float, WS_SN), WSP(float, WS_PARTQ)};
              pg8::gemm_phase<EpiUq, pg8::StaticOrder, true, true>(F.lds, g, S, E); }
            __syncthreads(); FRESH();
            if (MK_SUB & 4) for (int it = (int)blockIdx.x; it < NITEM; it += F.G) gla_a_item(F, l, it);
        } SEAM(pb + 1); }
        REPS(7) { if (PHON(3) && IN(pb + 2)) {
            FRESH();
            conv_rows(F, l);
            FRESH(); { const int gw = F.vcu * NWAVES + F.wave, NGW = F.G * NWAVES; for (int it = gw; it < 1536; it += NGW) gla_scan_witem(F, it); }
        } SEAM(pb + 2); }
        REPS(2) { if (PHON(4) && IN(pb + 3)) {
            const int bx = (int)blockIdx.x; FRESH();
            const int natt = F.G > 192 ? 192 : F.G;
            if (bx < natt) {
                for (int u = bx; u < 192; u += natt) { const int bh = u >> 3, qb = u & 7, b = bh / 6, h = bh % 6; const size_t row0 = (size_t)b * SEQ, qrow = row0 + qb * 256;
                    mla::attn_unit(WSP(bf16, WS_QUP) + qrow * NQ + h * 192, WSP(bf16, WS_KVUP) + row0 * NKV + h * 256, WSP(bf16, WS_KVUP) + row0 * NKV + h * 256 + 128,
                                   WSP(bf16, WS_PROJ) + row0 * NP + C_MKR, WSP(bf16, WS_HY) + qrow * DM + h * 128, WSP(bf16, WS_PROJ) + qrow * NP + C_Z + 768 + h * 128,
                                   ld_in(16) + l * 768 + h * 128, WSP(float, WS_PARTM) + qrow * 8 + h, SEQ, F.ldsg); }
            }
            if (F.G > 192) { if (bx >= 192) { const int gw = (bx - 192) * NWAVES + F.wave, NGW = (F.G - 192) * NWAVES; for (int task = gw; task < 2 * NITEM; task += NGW) gla_c_task(F, l, task); } }
            else { FRESH(); const int gw = F.vcu * NWAVES + F.wave, NGW = F.G * NWAVES; for (int task = gw; task < 2 * NITEM; task += NGW) gla_c_task(F, l, task); }
        } SEAM(pb + 3); }
        for (int rep_ = 0; rep_ < ((MK_REP_PH == 4 && l == 0) ? 2 : 1); ++rep_) { if (PHON(6) && IN(pb + 4)) {
            FRESH();
            pg8::Gemm g{WSP(bf16, WS_HY), WSP(bf16, WS_WOUT) + (size_t)l * DM * DM, T, DM, DM, DM}; pg8::StaticOrder S; S.init(T, DM, F.G, (int)blockIdx.x);
            if (F.G == 256 && MK_REP_PH != 4) {
                const int last = (l + 1 == DEPTH);
                EpiOutNorm E{l == 0 ? ld_in(0) : F.out, F.out, mods_l + 2 * DM, WSP(float, WS_PARTM), WSP(bf16, WS_HY), last ? ld_in(20) : ld_in(5) + (l + 1) * DM,
                             mods_l + (size_t)BATCH * 3 * DM, WSP(float, WS_XS), (unsigned*)(F.ws + WS_CTL) + CW_PANEL + 64 * 32 * l, 32u, last};
                pg8::gemm_phase<EpiOutNorm, pg8::StaticOrder, true, true>(F.lds, g, S, E);
            } else {
                EpiOut E{l == 0 ? ld_in(0) : F.out, F.out, mods_l + 2 * DM, WSP(float, WS_PARTM)};
                pg8::gemm_phase<EpiOut, pg8::StaticOrder, true, true>(F.lds, g, S, E);
            }
        } if (!(F.G == 256 && MK_REP_PH != 4 && l + 1 == DEPTH)) SEAM(pb + 4); }
        if (!(F.G == 256 && MK_REP_PH != 4)) {
        for (int rep_ = 0; rep_ < ((MK_REP_PH == 5 && l == 0) ? 2 : 1); ++rep_) { if (PHON(7) && IN(pb + 5)) {
            FRESH();
            if (l + 1 < DEPTH) modnorm_rows(F, F.out, ld_in(5) + (l + 1) * DM, mods_l + (size_t)BATCH * 3 * DM, WSP(bf16, WS_HY));
            else finalnorm_rows(F, F.out, ld_in(20));
        } SEAM(pb + 5); }
        }
        if (MK_REP_PH == 6) { for (int r_ = 0; r_ < 4; ++r_) xcd_barrier(bar); }
    }
#undef mods_l
#undef IN
#undef SEAM
}

#ifndef MK_CUT
#define MK_CUT 14
#endif
#if MK_CUT < 14
__global__ void glue_proj(const bf16* P, float* proj, float* y, int row0) {
    const int t = blockIdx.x; const bf16* p = P + (size_t)(row0 + t) * NP;
    for (int c = threadIdx.x; c < NP; c += 256) { const float v = bf2f(p[c]);
        if (c < C_MKV) proj[(size_t)t * nv::PW + c] = v;
        else if (c < C_MQ) proj[(size_t)t * nv::PW + nv::O_MKV + (c - C_MKV)] = v;
        else if (c < C_MKR) proj[(size_t)t * nv::PW + nv::O_MQ + (c - C_MQ)] = v;
        else if (c < C_LR) { const int j = c - C_MKR; proj[(size_t)t * nv::PW + nv::O_MKR + (j & 1) * 32 + (j >> 1)] = v; }
        else if (c < C_LR + 32) proj[(size_t)t * nv::PW + nv::O_LR + (c - C_LR)] = v;
        else if (c < C_CB) {}
        else if (c < C_Z) proj[(size_t)t * nv::PW + nv::O_CB + (c - C_CB)] = v;
        else y[(size_t)t * DM + (c - C_Z)] = v; }
}
__global__ void glue_qkv(const bf16* Q, const bf16* KV, float* qm, float* kv, int row0) {
    const int t = blockIdx.x;
    for (int c = threadIdx.x; c < 1152; c += 256) { const float v = bf2f(Q[(size_t)(row0 + t) * NQ + c]) * (1.f / QSCALE); const int h = c / 192, d = c % 192;
        if (d < 128) qm[(size_t)t * 1152 + c] = v; else { const int j = d - 128; qm[(size_t)t * 1152 + h * 192 + 128 + (j & 1) * 32 + (j >> 1)] = v; } }
    for (int c = threadIdx.x; c < 1536; c += 256) kv[(size_t)t * 1536 + c] = bf2f(KV[(size_t)(row0 + t) * NKV + c]);
}
__global__ void glue_y(const bf16* Y, float* y, int row0) {
    const int t = blockIdx.x; for (int c = threadIdx.x; c < DM; c += 256) { const int cr = c < 768 ? c + 768 : (c < 1536 ? c - 768 : c); y[(size_t)t * DM + cr] = bf2f(Y[(size_t)(row0 + t) * DM + c]); }
}
__global__ void glue_h(const bf16* H, float* h, int row0) {
    const int t = blockIdx.x; for (int c = threadIdx.x; c < DM; c += 256) h[(size_t)t * DM + c] = bf2f(H[(size_t)(row0 + t) * DM + c]);
}

#endif
#ifndef MK_NAIVE_BASE_MIB
#define MK_NAIVE_BASE_MIB 240
#endif
extern "C" void kernel_launch(void* const* d_in, const int* in_sizes, int n_in, void* d_out, int out_size, void* d_ws, size_t ws_size, hipStream_t stream) {
    static int grid = 0;
    if (grid == 0) {
        if (n_in != 21 || out_size != T * DM || in_sizes[0] != T * DM || ws_size < WS_END) { fprintf(stderr, "kernel_launch: unexpected shapes n_in %d out %d ws %zu\n", n_in, out_size, ws_size); grid = -1; return; }
        int dev = 0, cus = 0, per_cu = 0;
        if (hipGetDevice(&dev) != hipSuccess || hipDeviceGetAttribute(&cus, hipDeviceAttributeMultiprocessorCount, dev) != hipSuccess) { grid = -1; return; }
        if (hipFuncSetAttribute((const void*)mega_fwd, hipFuncAttributeMaxDynamicSharedMemorySize, LDS_BYTES) != hipSuccess) { fprintf(stderr, "kernel_launch: hipFuncSetAttribute failed\n"); grid = -1; return; }
        if (hipOccupancyMaxActiveBlocksPerMultiprocessor(&per_cu, (const void*)mega_fwd, NTHR, LDS_BYTES) != hipSuccess || per_cu < 1) { fprintf(stderr, "kernel_launch: occupancy query says %d blocks/CU\n", per_cu); grid = -1; (void)hipGetLastError(); return; }
        grid = cus;
    }
    if (grid < 0) return;
    (void)hipMemsetAsync((char*)d_ws + WS_CTL, 0, CTL_ZERO_BYTES, stream);
    Args a{};
    for (int i = 0; i < 21; ++i) a.in[i] = (const float*)d_in[i];
    a.out = (float*)d_out; a.ws = (unsigned char*)d_ws; a.ph_lo = 0; a.ph_hi = MK_CUT < N_PHASES ? MK_CUT : N_PHASES;
    hipLaunchKernelGGL(mega_fwd, dim3(grid), dim3(NTHR), LDS_BYTES, stream, a);
#if MK_CUT < 14
    {
        char* ws = (char*)d_ws; float* out = (float*)d_out; const float* x = (const float*)d_in[0];
        const float* mods = (const float*)(ws + WS_MODS); const float* cs = (const float*)(ws + WS_CS); const float* sn = (const float*)(ws + WS_SN);
        nv::Buf B = nv::carve(ws + (size_t)MK_NAIVE_BASE_MIB * MiB);
        const int l0 = (MK_CUT - 2) / 6, ph = (MK_CUT - 2) % 6;
        for (int l = l0; l < DEPTH; ++l)
            for (int b = 0; b < BATCH; ++b) {
                const int row0 = b * SEQ; int entry = 0; const float* xin = (l == 0 ? x : out) + (size_t)row0 * DM; float* xo = out + (size_t)row0 * DM;
                if (l == l0) {
                    if (ph >= 1 && ph <= 3) { glue_proj<<<SEQ, 256, 0, stream>>>((const bf16*)(ws + WS_PROJ), B.proj, B.y, row0); entry = 1; }
                    if (ph == 2) { glue_qkv<<<SEQ, 256, 0, stream>>>((const bf16*)(ws + WS_QUP), (const bf16*)(ws + WS_KVUP), nv::sc_qm(B), nv::sc_kv(B), row0); entry = 2; }
                    if (ph == 3) { hipMemcpyAsync(nv::sc_omla(B), ws + WS_OMLA + (size_t)row0 * 768 * 4, (size_t)SEQ * 768 * 4, hipMemcpyDeviceToDevice, stream); entry = 4; }
                    if (ph == 4) { glue_y<<<SEQ, 256, 0, stream>>>((const bf16*)(ws + WS_HY), B.y, row0); entry = 3; }
                    if (ph == 5) continue;
                }
                nv::layer_batch(d_in, l, b, entry, xin, xo, mods, cs, sn, B, stream);
            }
        nv::k_rms<<<T, 256, 0, stream>>>(out, DM, DM, (const float*)d_in[20], out, DM);
    }
#endif
}
```

```cpp
#include <hip/hip_runtime.h>
#include <cstdio>
#include <cstdint>
#define MK_CUT 14
#define MK_NAIVE_BASE_MIB 240
#define MK_REP_PH -1
namespace pg8 {
#define PG8_LAS __attribute__((address_space(3)))
typedef unsigned short bf16_t;
typedef short bf16x8 __attribute__((ext_vector_type(8)));
typedef float f32x4 __attribute__((ext_vector_type(4)));
typedef unsigned u32x4 __attribute__((ext_vector_type(4)));
constexpr int BM = 256, BK = 64, HALF = 128, HTB = HALF * BK * 2, STAGE_BYTES = 8 * HTB, NXCD = 8, WGM = 8;

__host__ __device__ __forceinline__ int lds_byte(int r, int c) { const int st = (r >> 4) * 2 + (c >> 5), rr = r & 15, cc = c & 31, ob = rr * 64 + cc * 2; return st * 1024 + (ob ^ (((ob >> 9) & 1) << 5)); }
__host__ __device__ __forceinline__ void stage_rc(int b, int& R, int& C) { const int st = b / 1024, sb = b % 1024, swz = sb ^ (((sb >> 9) & 1) << 5); R = (st >> 1) * 16 + swz / 64; C = (st & 1) * 32 + (swz % 64) / 2; }
__host__ __device__ __forceinline__ int perm32(int rho) { const int n = rho >> 4, i = rho & 15; return 8 * (i >> 2) + 4 * n + (i & 3); }

struct Unit { int pm, pn; };
struct Gemm { const bf16_t* A; const bf16_t* Bt; int M, N, K, lda; };

struct StaticOrder {
    int nM, nN, nwg, G, c;
    __host__ __device__ void init(int M, int N, int G_, int c_) { nM = M / BM; nN = N / BM; nwg = nM * nN; G = G_; c = c_; }
    __host__ __device__ bool next(int i, Unit& u) const {
        const long L = (long)i * G + c; if (L >= nwg) return false;
        int wgid = (int)L; { const int q = nwg / NXCD, r = nwg % NXCD, xcd = wgid % NXCD, off = wgid / NXCD; wgid = (xcd < r ? xcd * (q + 1) : r * (q + 1) + (xcd - r) * q) + off; }
        const int nig = WGM * nN, gid = wgid / nig, fm = gid * WGM, gsz = (nM - fm) < WGM ? (nM - fm) : WGM;
        u.pm = fm + ((wgid % nig) % gsz); u.pn = (wgid % nig) / gsz; return true;
    }
    __device__ __forceinline__ void a_ready(const Unit&) const {}
    __device__ __forceinline__ void done(const Unit&) const {}
};

__device__ __forceinline__ unsigned cvt_pk_bf16(float lo, float hi) { unsigned r; asm volatile("v_cvt_pk_bf16_f32 %0, %1, %2" : "=v"(r) : "v"(lo), "v"(hi)); return r; }

template <class Epi, class Sched, bool ALIGN_EPI = false, bool SP2 = false>
__device__ __forceinline__ void gemm_phase(PG8_LAS unsigned char* lds, const Gemm g, const Sched& S, const Epi& E) {
    int tid_ = threadIdx.x; asm volatile("" : "+v"(tid_));
    const int tid = tid_, wid = __builtin_amdgcn_readfirstlane(tid >> 6), lane = tid & 63, wr = wid >> 2, wc = wid & 3, fr = lane & 15, fq = lane >> 4;
    int K_ = g.K, lda_ = g.lda; asm volatile("" : "+s"(K_), "+s"(lda_));
    const int K = K_, nt = K / BK, lda = lda_;
    unsigned voffA[2], voffB[2];
#pragma unroll
    for (int i = 0; i < 2; ++i) { int R, C; stage_rc(tid * 16 + i * 8192, R, C); const int Rb = Epi::PERM ? ((R & ~31) + perm32(R & 31)) : R;
        voffA[i] = (unsigned)(R * lda + C) * 2u; voffB[i] = (unsigned)(Rb * K + C) * 2u; }
    const size_t kstep = (size_t)(BK * 2);
    const size_t hstepA = (size_t)HALF * lda * 2, hstepB = (size_t)HALF * K * 2;
    const size_t tstepA = 2 * hstepA, tstepB = 2 * hstepB;
    const unsigned ldsw = (unsigned)wid * 1024u;
    const int aoff = lds_byte(wr * 64 + fr, fq * 8), boff = lds_byte(wc * 32 + fr, fq * 8);
#define PG8_SA(b, h) (((b) * 2 + (h)) * HTB)
#define PG8_SB(b, h) ((4 + (b) * 2 + (h)) * HTB)
#define PG8_STAGE(bufoff, gbase, voff) do { _Pragma("unroll") for (int _i = 0; _i < 2; ++_i) \
        __builtin_amdgcn_global_load_lds((const unsigned*)((const char*)(gbase) + (voff)[_i]), (PG8_LAS unsigned*)(lds + (bufoff) + ldsw + _i * 8192), 16, 0, 0); } while (0)
#define PG8_LDA(dst, b, h) do { _Pragma("unroll") for (int m = 0; m < 4; ++m) _Pragma("unroll") for (int k = 0; k < 2; ++k) dst[m][k] = *(const PG8_LAS bf16x8*)(lds + PG8_SA(b, h) + aoff + m * 2048 + k * 1024); } while (0)
#define PG8_LDB(dst, b, h) do { _Pragma("unroll") for (int n = 0; n < 2; ++n) _Pragma("unroll") for (int k = 0; k < 2; ++k) dst[n][k] = *(const PG8_LAS bf16x8*)(lds + PG8_SB(b, h) + boff + n * 2048 + k * 1024); } while (0)
#define PG8_MMA(ai, bj, At, Bt) do { __builtin_amdgcn_s_setprio(1); _Pragma("unroll") for (int m = 0; m < 4; ++m) _Pragma("unroll") for (int n = 0; n < 2; ++n) _Pragma("unroll") for (int k = 0; k < 2; ++k) \
        acc[ai][bj][m][n] = __builtin_amdgcn_mfma_f32_16x16x32_bf16(Bt[n][k], At[m][k], acc[ai][bj][m][n], 0, 0, 0); __builtin_amdgcn_s_setprio(0); } while (0)
#define PG8_WAIT_V(n) asm volatile("s_waitcnt vmcnt(" #n ")" ::: "memory")
#define PG8_WAIT_L(n) asm volatile("s_waitcnt lgkmcnt(" #n ")" ::: "memory")
#define PG8_BAR __builtin_amdgcn_s_barrier()
#define PG8_SCHED __builtin_amdgcn_sched_barrier(0)
    Unit cur, nxt; int ui = 0;
    if (!S.next(0, cur)) return;
    f32x4 acc[2][2][4][2];
#pragma unroll
    for (int a = 0; a < 2; ++a)
#pragma unroll
        for (int b = 0; b < 2; ++b)
#pragma unroll
            for (int m = 0; m < 4; ++m)
#pragma unroll
                for (int n = 0; n < 2; ++n) acc[a][b][m][n] = (f32x4){0.f, 0.f, 0.f, 0.f};
    bf16x8 At[4][2], B0[2][2], B1[2][2];
    const char* cA = (const char*)g.A + (size_t)cur.pm * tstepA; const char* cB = (const char*)g.Bt + (size_t)cur.pn * tstepB;
    S.a_ready(cur);
    if constexpr (SP2) {
        PG8_STAGE(PG8_SB(0, 0), cB, voffB); PG8_STAGE(PG8_SB(0, 1), cB + hstepB, voffB); PG8_STAGE(PG8_SA(0, 0), cA, voffA); PG8_STAGE(PG8_SA(0, 1), cA + hstepA, voffA);
        if (wr == 1) PG8_BAR;
        PG8_WAIT_V(2); PG8_BAR;
        PG8_STAGE(PG8_SB(1, 0), cB + kstep, voffB); PG8_STAGE(PG8_SA(1, 0), cA + kstep, voffA); PG8_STAGE(PG8_SB(1, 1), cB + hstepB + kstep, voffB);
        PG8_WAIT_V(6); PG8_BAR;
    } else {
        PG8_STAGE(PG8_SB(0, 0), cB, voffB); PG8_STAGE(PG8_SA(0, 0), cA, voffA); PG8_STAGE(PG8_SB(0, 1), cB + hstepB, voffB); PG8_STAGE(PG8_SA(0, 1), cA + hstepA, voffA);
        if (wr == 1) PG8_BAR;
        PG8_WAIT_V(4); PG8_BAR;
        PG8_STAGE(PG8_SB(1, 0), cB + kstep, voffB); PG8_STAGE(PG8_SA(1, 0), cA + kstep, voffA); PG8_STAGE(PG8_SB(1, 1), cB + hstepB + kstep, voffB);
        PG8_WAIT_V(6); PG8_BAR;
    }
    for (;;) {
        const bool has_next = S.next(ui + 1, nxt);
        const char* nA = has_next ? (const char*)g.A + (size_t)nxt.pm * tstepA : cA; const char* nB = has_next ? (const char*)g.Bt + (size_t)nxt.pn * tstepB : cB;
        for (int t = 0; t < nt; t += 2) {
            const bool last = (t == nt - 2);
            const char* a1 = cA + (size_t)(t + 1) * kstep;
            const char* a2 = last ? nA : cA + (size_t)(t + 2) * kstep; const char* b2 = last ? nB : cB + (size_t)(t + 2) * kstep;
            const char* a3 = a2 + kstep; const char* b3 = b2 + kstep;
            if (last && has_next) S.a_ready(nxt);
            if constexpr (SP2) {
            PG8_LDB(B0, 0, 0); PG8_LDB(B1, 0, 1); PG8_SCHED; PG8_LDA(At, 0, 0); PG8_STAGE(PG8_SA(1, 1), a1 + hstepA, voffA);
            PG8_WAIT_V(8); PG8_WAIT_L(0); PG8_BAR; PG8_MMA(0, 0, At, B0); PG8_MMA(0, 1, At, B1); PG8_BAR; PG8_SCHED;
            PG8_LDA(At, 0, 1); PG8_STAGE(PG8_SB(0, 0), b2, voffB); PG8_STAGE(PG8_SB(0, 1), b2 + hstepB, voffB); PG8_STAGE(PG8_SA(0, 0), a2, voffA);
            PG8_WAIT_V(8); PG8_WAIT_L(0); PG8_BAR; PG8_MMA(1, 0, At, B0); PG8_MMA(1, 1, At, B1); PG8_BAR; PG8_SCHED;
            PG8_LDB(B0, 1, 0); PG8_LDB(B1, 1, 1); PG8_SCHED; PG8_LDA(At, 1, 0); PG8_STAGE(PG8_SA(0, 1), a2 + hstepA, voffA);
            PG8_WAIT_V(8); PG8_WAIT_L(0); PG8_BAR; PG8_MMA(0, 0, At, B0); PG8_MMA(0, 1, At, B1); PG8_BAR; PG8_SCHED;
            PG8_LDA(At, 1, 1); PG8_STAGE(PG8_SB(1, 0), b3, voffB); PG8_STAGE(PG8_SB(1, 1), b3 + hstepB, voffB); PG8_STAGE(PG8_SA(1, 0), a3, voffA);
            PG8_WAIT_V(8); PG8_WAIT_L(0); PG8_BAR; PG8_MMA(1, 0, At, B0); PG8_MMA(1, 1, At, B1); PG8_BAR; PG8_SCHED;
            if constexpr (Epi::HOOK_T > 0) { if (t + 2 == Epi::HOOK_T) E.hook(acc, cur, wr, wc, fr, fq); }
            } else {
            PG8_LDB(B0, 0, 0); PG8_SCHED; PG8_LDA(At, 0, 0); PG8_STAGE(PG8_SA(1, 1), a1 + hstepA, voffA);
            PG8_WAIT_L(8); PG8_BAR; PG8_WAIT_L(0); PG8_MMA(0, 0, At, B0); PG8_BAR; PG8_SCHED;
            PG8_LDB(B1, 0, 1); PG8_STAGE(PG8_SB(0, 0), b2, voffB);
            PG8_BAR; PG8_WAIT_L(0); PG8_MMA(0, 1, At, B1); PG8_BAR;
            PG8_LDA(At, 0, 1); PG8_STAGE(PG8_SA(0, 0), a2, voffA);
            PG8_BAR; PG8_WAIT_L(0); PG8_MMA(1, 0, At, B0); PG8_BAR; PG8_SCHED;
            PG8_STAGE(PG8_SB(0, 1), b2 + hstepB, voffB);
            PG8_WAIT_V(6); PG8_BAR; PG8_MMA(1, 1, At, B1); PG8_BAR;
            PG8_LDB(B0, 1, 0); PG8_SCHED; PG8_LDA(At, 1, 0); PG8_STAGE(PG8_SA(0, 1), a2 + hstepA, voffA);
            PG8_WAIT_L(8); PG8_BAR; PG8_WAIT_L(0); PG8_MMA(0, 0, At, B0); PG8_BAR; PG8_SCHED;
            PG8_LDB(B1, 1, 1); PG8_STAGE(PG8_SB(1, 0), b3, voffB);
            PG8_BAR; PG8_WAIT_L(0); PG8_MMA(0, 1, At, B1); PG8_BAR;
            PG8_LDA(At, 1, 1); PG8_STAGE(PG8_SA(1, 0), a3, voffA);
            PG8_BAR; PG8_WAIT_L(0); PG8_MMA(1, 0, At, B0); PG8_BAR; PG8_SCHED;
            PG8_STAGE(PG8_SB(1, 1), b3 + hstepB, voffB);
            PG8_WAIT_V(6); PG8_BAR; PG8_MMA(1, 1, At, B1); PG8_BAR;
            }
        }
        if constexpr (ALIGN_EPI) { if (wr == 0) PG8_BAR; }
        if constexpr (!Epi::AFTER_DRAIN) { E(acc, cur, wr, wc, fr, fq); S.done(cur); }
        if (!has_next) break;
#pragma unroll
        for (int a = 0; a < 2; ++a)
#pragma unroll
            for (int b = 0; b < 2; ++b)
#pragma unroll
                for (int m = 0; m < 4; ++m)
#pragma unroll
                    for (int n = 0; n < 2; ++n) acc[a][b][m][n] = (f32x4){0.f, 0.f, 0.f, 0.f};
        cur = nxt; cA = nA; cB = nB; ++ui;
        if constexpr (ALIGN_EPI) { if (wr == 1) PG8_BAR; }
    }
    PG8_WAIT_V(0);
    if constexpr (!ALIGN_EPI) { if (wr == 0) PG8_BAR; }
    PG8_BAR;
    if constexpr (Epi::AFTER_DRAIN) { E.fused(acc, cur, wr, wc, fr, fq, lds, wid, lane); S.done(cur); }
#undef PG8_SA
#undef PG8_SB
#undef PG8_STAGE
#undef PG8_LDA
#undef PG8_LDB
#undef PG8_MMA
#undef PG8_WAIT_V
#undef PG8_WAIT_L
#undef PG8_BAR
#undef PG8_SCHED
}
}
#define GAS __attribute__((address_space(1)))
#define LAS __attribute__((address_space(3)))
typedef unsigned short bf16;
typedef unsigned v4u __attribute__((ext_vector_type(4)));
typedef unsigned v2u __attribute__((ext_vector_type(2)));
typedef float f32x4 __attribute__((ext_vector_type(4)));
typedef float f32x16 __attribute__((ext_vector_type(16)));
typedef short bf16x8 __attribute__((ext_vector_type(8)));
typedef short s16x4 __attribute__((ext_vector_type(4)));
typedef GAS unsigned gu32;

constexpr int NWAVES = 8, NTHR = 512;
constexpr int BATCH = 4, SEQ = 2048, DM = 2048, T = BATCH * SEQ, DEPTH = 2, IN_DIM = 5856;
constexpr int NP = 5888;
constexpr int C_GQ = 0, C_GK = 384, C_GV = 768, C_MKV = 1536, C_MQ = 1792, C_MKR = 2176, C_LR = 2240, C_CB = 2304, C_CC = 2816, C_CX = 3328, C_Z = 3840;
constexpr int R_GQ = 0, R_GK = 384, R_GV = 768, R_LR = 1536, R_MQ = 1568, R_MKV = 1952, R_MKR = 2208, R_CB = 2272, R_CC = 2784, R_CX = 3296, R_Z = 3808;
constexpr int NQ = 1280, NKV = 1536;
constexpr float EPS = 1e-6f;
constexpr float QSCALE = 0.07216878364870322f * 1.4426950408889634f;
constexpr int NITEM = BATCH * 32 * 6;

constexpr size_t MiB = 1u << 20;
constexpr size_t WS_CTL = 0, CTL_ZERO_BYTES = 1 * MiB;
constexpr size_t WS_MODS = 256 * 1024;
constexpr size_t WS_CS = 2 * MiB, WS_SN = 3 * MiB;
constexpr size_t WS_WUQ = 4 * MiB;
constexpr size_t WS_WUKV = 6 * MiB;
constexpr size_t WS_WOUT = 8 * MiB;
constexpr size_t WS_WIN = 24 * MiB;
constexpr size_t WS_HY = 70 * MiB;
constexpr size_t WS_PROJ = 102 * MiB;
constexpr size_t WS_QUP = 194 * MiB;
constexpr size_t WS_KVUP = 214 * MiB;
constexpr size_t WS_OMLA = 238 * MiB;
constexpr size_t WS_OINTRA = 262 * MiB;
constexpr size_t WS_KVC = 286 * MiB;
constexpr size_t WS_ST = 334 * MiB;
constexpr size_t WS_QDEC = 358 * MiB;
constexpr size_t WS_DECAY = 370 * MiB;
constexpr size_t WS_PARTQ = 371 * MiB;
constexpr size_t WS_PARTKV = 371 * MiB + 512 * 1024;
constexpr size_t WS_PARTM = 371 * MiB + 768 * 1024;
constexpr size_t WS_XS = 1 * MiB;
constexpr int CW_PANEL = 8192;
constexpr size_t WS_END = 372 * MiB;
constexpr int CW_BAR = 4096;

constexpr int RING_BYTES = 131072, LDSCTL_OFF = RING_BYTES, MISC_OFF = LDSCTL_OFF + 320, LDS_BYTES = 147456;

#define LDS_WAIT() asm volatile("s_waitcnt lgkmcnt(0)" ::: "memory")
#define VM_WAIT() asm volatile("s_waitcnt vmcnt(0)" ::: "memory")
__device__ __forceinline__ unsigned f2bf(float f) { unsigned u = __builtin_bit_cast(unsigned, f); return (u + 0x7fffu + ((u >> 16) & 1u)) >> 16; }
__device__ __forceinline__ unsigned pk2(float lo, float hi) { return pg8::cvt_pk_bf16(lo, hi); }
__device__ __forceinline__ float bf2f(unsigned short h) { return __builtin_bit_cast(float, (unsigned)h << 16); }
__device__ __forceinline__ float bflo(unsigned w) { return __builtin_bit_cast(float, w << 16); }
__device__ __forceinline__ float bfhi(unsigned w) { return __builtin_bit_cast(float, w & 0xffff0000u); }
__device__ __forceinline__ float silu_fast(float v) { return v * __builtin_amdgcn_rcpf(1.f + __expf(-v)); }
__device__ __forceinline__ float wave_sum(float v) {
#pragma unroll
    for (int o = 1; o < 64; o <<= 1) v += __shfl_xor(v, o);
    return v;
}

__device__ __forceinline__ int map_in(int n) {
    if (n < C_MKV) return n;
    if (n < C_MQ) return R_MKV + (n - C_MKV);
    if (n < C_MKR) return R_MQ + (n - C_MQ);
    if (n < C_LR) { const int j = n - C_MKR; return R_MKR + (j & 1) * 32 + (j >> 1); }
    if (n < C_LR + 32) return R_LR + (n - C_LR);
    if (n < C_CB) return -1;
    if (n < C_Z) return R_CB + (n - C_CB);
    return R_Z + (n - C_Z);
}
__device__ __forceinline__ int map_uq(int n) {
    if (n >= 1152) return -1;
    const int h = n / 192, d = n % 192;
    if (d < 128) return n;
    const int j = d - 128; return h * 192 + 128 + (j & 1) * 32 + (j >> 1);
}

struct EpiIn {
    static constexpr bool PERM = true, AFTER_DRAIN = false; static constexpr int HOOK_T = 0;
    bf16* O; const float* cs; const float* sn; float* partq; float* partkv;
    __device__ __forceinline__ void operator()(const f32x4 (&acc)[2][2][4][2], const pg8::Unit& u, int wr, int wc, int fr, int fq) const {
        const int pn = u.pn, row0 = u.pm * 256 + wr * 64 + fr, col0 = pn * 256 + wc * 32 + 8 * fq;
        const bool stat = (pn >= 6 && pn <= 8);
#pragma unroll
        for (int ai = 0; ai < 2; ++ai)
#pragma unroll
            for (int m = 0; m < 4; ++m) {
                const int row = row0 + ai * 128 + m * 16; bf16* rowp = O + (size_t)row * NP + col0; float ss = 0.f;
#pragma unroll
                for (int bj = 0; bj < 2; ++bj) {
                    f32x4 v0 = acc[ai][bj][m][0], v1 = acc[ai][bj][m][1]; const int c = col0 + bj * 128;
                    if (pn >= 15) {
#pragma unroll
                        for (int e = 0; e < 4; ++e) { v0[e] = silu_fast(v0[e]); v1[e] = silu_fast(v1[e]); }
                    } else if (pn == 8 && bj == 1 && c < C_LR) {
                        const int i0 = (c - C_MKR) >> 1; const f32x4 cc = *(const f32x4*)(cs + (size_t)row * 32 + i0), sv = *(const f32x4*)(sn + (size_t)row * 32 + i0);
                        f32x4 a0, a1;
                        a0[0] = v0[0] * cc[0] - v0[1] * sv[0]; a0[1] = v0[1] * cc[0] + v0[0] * sv[0]; a0[2] = v0[2] * cc[1] - v0[3] * sv[1]; a0[3] = v0[3] * cc[1] + v0[2] * sv[1];
                        a1[0] = v1[0] * cc[2] - v1[1] * sv[2]; a1[1] = v1[1] * cc[2] + v1[0] * sv[2]; a1[2] = v1[2] * cc[3] - v1[3] * sv[3]; a1[3] = v1[3] * cc[3] + v1[2] * sv[3];
                        v0 = a0; v1 = a1;
                    }
                    if (stat && (pn != 8 || bj == 0)) ss += (v0[0] * v0[0] + v0[1] * v0[1]) + (v0[2] * v0[2] + v0[3] * v0[3]) + (v1[0] * v1[0] + v1[1] * v1[1]) + (v1[2] * v1[2] + v1[3] * v1[3]);
                    v4u w; w.x = pk2(v0[0], v0[1]); w.y = pk2(v0[2], v0[3]); w.z = pk2(v1[0], v1[1]); w.w = pk2(v1[2], v1[3]);
                    *(v4u*)(rowp + bj * 128) = w;
                }
                asm volatile("" ::: "memory");
                if (stat) { ss += __shfl_xor(ss, 16); ss += __shfl_xor(ss, 32);
                    if (fq == 0) { if (pn == 6) partkv[(size_t)row * 4 + wc] = ss; else partq[(size_t)row * 8 + (pn - 7) * 4 + wc] = ss; } }
            }
    }
};
struct EpiUq {
    static constexpr bool PERM = true, AFTER_DRAIN = false; static constexpr int HOOK_T = 0;
    bf16* O; const float* cs; const float* sn; const float* partq;
    __device__ __forceinline__ void operator()(const f32x4 (&acc)[2][2][4][2], const pg8::Unit& u, int wr, int wc, int fr, int fq) const {
        const int row0 = u.pm * 256 + wr * 64 + fr, col0 = u.pn * 256 + wc * 32 + 8 * fq;
        float rs[2][4];
#pragma unroll
        for (int ai = 0; ai < 2; ++ai) {
#pragma unroll
            for (int m = 0; m < 4; ++m) { const int row = row0 + ai * 128 + m * 16;
                const f32x4 p0 = *(const f32x4*)(partq + (size_t)row * 8), p1 = *(const f32x4*)(partq + (size_t)row * 8 + 4);
                rs[ai][m] = __builtin_amdgcn_rsqf(((p0[0] + p0[1]) + (p0[2] + p0[3]) + (p1[0] + p1[1]) + (p1[2] + p1[3])) * (1.f / 384.f) + EPS) * QSCALE; }
#pragma unroll
            for (int m = 0; m < 4; ++m) {
                const int row = row0 + ai * 128 + m * 16; bf16* rowp = O + (size_t)row * NQ + col0;
#pragma unroll
                for (int bj = 0; bj < 2; ++bj) {
                    const int c = col0 + bj * 128; if (c >= 1152) continue;
                    f32x4 v0 = acc[ai][bj][m][0] * rs[ai][m], v1 = acc[ai][bj][m][1] * rs[ai][m]; const int d = c % 192;
                    if (d >= 128) {
                        const int i0 = (d - 128) >> 1; const f32x4 cc = *(const f32x4*)(cs + (size_t)row * 32 + i0), sv = *(const f32x4*)(sn + (size_t)row * 32 + i0);
                        f32x4 a0, a1;
                        a0[0] = v0[0] * cc[0] - v0[1] * sv[0]; a0[1] = v0[1] * cc[0] + v0[0] * sv[0]; a0[2] = v0[2] * cc[1] - v0[3] * sv[1]; a0[3] = v0[3] * cc[1] + v0[2] * sv[1];
                        a1[0] = v1[0] * cc[2] - v1[1] * sv[2]; a1[1] = v1[1] * cc[2] + v1[0] * sv[2]; a1[2] = v1[2] * cc[3] - v1[3] * sv[3]; a1[3] = v1[3] * cc[3] + v1[2] * sv[3];
                        v0 = a0; v1 = a1;
                    }
                    v4u w; w.x = pk2(v0[0], v0[1]); w.y = pk2(v0[2], v0[3]); w.z = pk2(v1[0], v1[1]); w.w = pk2(v1[2], v1[3]);
                    *(v4u*)(rowp + bj * 128) = w;
                }
                asm volatile("" ::: "memory");
            }
        }
    }
};
struct EpiUkv {
    static constexpr bool PERM = true, AFTER_DRAIN = false; static constexpr int HOOK_T = 0;
    bf16* O; const float* partkv;
    __device__ __forceinline__ void operator()(const f32x4 (&acc)[2][2][4][2], const pg8::Unit& u, int wr, int wc, int fr, int fq) const {
        const int row0 = u.pm * 256 + wr * 64 + fr, col0 = u.pn * 256 + wc * 32 + 8 * fq;
        float rs[2][4];
#pragma unroll
        for (int ai = 0; ai < 2; ++ai)
#pragma unroll
            for (int m = 0; m < 4; ++m) { const f32x4 p0 = *(const f32x4*)(partkv + (size_t)(row0 + ai * 128 + m * 16) * 4);
                rs[ai][m] = __builtin_amdgcn_rsqf(((p0[0] + p0[1]) + (p0[2] + p0[3])) * (1.f / 256.f) + EPS); }
#pragma unroll
        for (int ai = 0; ai < 2; ++ai)
#pragma unroll
            for (int m = 0; m < 4; ++m) {
                const int row = row0 + ai * 128 + m * 16; bf16* rowp = O + (size_t)row * NKV + col0;
#pragma unroll
                for (int bj = 0; bj < 2; ++bj) {
                    const f32x4 v0 = acc[ai][bj][m][0] * rs[ai][m], v1 = acc[ai][bj][m][1] * rs[ai][m];
                    v4u w; w.x = pk2(v0[0], v0[1]); w.y = pk2(v0[2], v0[3]); w.z = pk2(v1[0], v1[1]); w.w = pk2(v1[2], v1[3]);
                    *(v4u*)(rowp + bj * 128) = w;
                }
            }
    }
};
struct EpiOut {
    static constexpr bool PERM = false, AFTER_DRAIN = false; static constexpr int HOOK_T = 12;
    const float* xin; float* out; const float* gate;
    const float* partm;
    __device__ __forceinline__ void hook(f32x4 (&acc)[2][2][4][2], const pg8::Unit& u, int wr, int wc, int fr, int fq) const {
        const int row0 = u.pm * 256 + wr * 64 + fr;
        float rs[2][4];
#pragma unroll
        for (int ai = 0; ai < 2; ++ai)
#pragma unroll
            for (int m = 0; m < 4; ++m) { const float* p = partm + (size_t)(row0 + ai * 128 + m * 16) * 8; const f32x4 p0 = *(const f32x4*)p; const float p4 = p[4], p5 = p[5];
                rs[ai][m] = __builtin_amdgcn_rsqf(((p0[0] + p0[1]) + (p0[2] + p0[3]) + (p4 + p5)) * (1.f / 768.f) + EPS); }
#pragma unroll
        for (int ai = 0; ai < 2; ++ai)
#pragma unroll
            for (int m = 0; m < 4; ++m)
#pragma unroll
                for (int bj = 0; bj < 2; ++bj)
#pragma unroll
                    for (int n = 0; n < 2; ++n) acc[ai][bj][m][n] *= rs[ai][m];
    }
    __device__ __forceinline__ void operator()(const f32x4 (&acc)[2][2][4][2], const pg8::Unit& u, int wr, int wc, int fr, int fq) const {
        const int row0 = u.pm * 256 + wr * 64 + fr, col0 = u.pn * 256 + wc * 32 + 4 * fq; const float* gb = gate + (size_t)(u.pm >> 3) * 3 * DM;
        f32x4 gv[2][2];
#pragma unroll
        for (int bj = 0; bj < 2; ++bj)
#pragma unroll
            for (int n = 0; n < 2; ++n) gv[bj][n] = *(const f32x4*)(gb + col0 + bj * 128 + n * 16);
        f32x4 xv[2][2][2][2];
#define EO_LOAD(slot, g) do { _Pragma("unroll") for (int q = 0; q < 2; ++q) { const size_t off = (size_t)(row0 + ((g) >> 1) * 128 + (((g) & 1) * 2 + q) * 16) * DM + col0; \
            _Pragma("unroll") for (int bj = 0; bj < 2; ++bj) _Pragma("unroll") for (int n = 0; n < 2; ++n) xv[slot][q][bj][n] = *(const f32x4*)(xin + off + bj * 128 + n * 16); } } while (0)
#define EO_STORE(slot, g) do { _Pragma("unroll") for (int q = 0; q < 2; ++q) { const int ai = (g) >> 1, m = ((g) & 1) * 2 + q; const size_t off = (size_t)(row0 + ai * 128 + m * 16) * DM + col0; \
            _Pragma("unroll") for (int bj = 0; bj < 2; ++bj) _Pragma("unroll") for (int n = 0; n < 2; ++n) *(f32x4*)(out + off + bj * 128 + n * 16) = xv[slot][q][bj][n] + gv[bj][n] * acc[ai][bj][m][n]; } } while (0)
        EO_LOAD(0, 0); EO_LOAD(1, 1); EO_STORE(0, 0); EO_LOAD(0, 2); EO_STORE(1, 1); EO_LOAD(1, 3); EO_STORE(0, 2); EO_STORE(1, 3);
#undef EO_LOAD
#undef EO_STORE
    }
};

struct EpiOutNorm {
    static constexpr bool PERM = false, AFTER_DRAIN = true; static constexpr int HOOK_T = 12;
    const float* xin; float* out; const float* gate; const float* partm;
    bf16* H; const float* g; const float* mods_next;
    float* xs; unsigned* cnt; unsigned target; int last;
    __device__ __forceinline__ void hook(f32x4 (&acc)[2][2][4][2], const pg8::Unit& u, int wr, int wc, int fr, int fq) const {
        const int row0 = u.pm * 256 + wr * 64 + fr;
        float rs[2][4];
#pragma unroll
        for (int ai = 0; ai < 2; ++ai)
#pragma unroll
            for (int m = 0; m < 4; ++m) { const float* p = partm + (size_t)(row0 + ai * 128 + m * 16) * 8; const f32x4 p0 = *(const f32x4*)p; const float p4 = p[4], p5 = p[5];
                rs[ai][m] = __builtin_amdgcn_rsqf(((p0[0] + p0[1]) + (p0[2] + p0[3]) + (p4 + p5)) * (1.f / 768.f) + EPS); }
#pragma unroll
        for (int ai = 0; ai < 2; ++ai)
#pragma unroll
            for (int m = 0; m < 4; ++m)
#pragma unroll
                for (int bj = 0; bj < 2; ++bj)
#pragma unroll
                    for (int n = 0; n < 2; ++n) acc[ai][bj][m][n] *= rs[ai][m];
    }
    __device__ __forceinline__ void fused(f32x4 (&acc)[2][2][4][2], const pg8::Unit& u, int wr, int wc, int fr, int fq, LAS unsigned char* lds, int wid, int lane) const {
        const int row0 = u.pm * 256 + wr * 64 + fr, col0 = u.pn * 256 + wc * 32 + 4 * fq, b = u.pm >> 3; const float* gb = gate + (size_t)b * 3 * DM;
        LAS float* P = (LAS float*)lds;
        LAS float* S = (LAS float*)(lds + 4096);
        f32x4 gv[2][2];
#pragma unroll
        for (int bj = 0; bj < 2; ++bj)
#pragma unroll
            for (int n = 0; n < 2; ++n) gv[bj][n] = *(const f32x4*)(gb + col0 + bj * 128 + n * 16);
        f32x4 xv[2][2][2][2];
#define EO_LOAD(slot, g_) do { _Pragma("unroll") for (int q = 0; q < 2; ++q) { const size_t off = (size_t)(row0 + ((g_) >> 1) * 128 + (((g_) & 1) * 2 + q) * 16) * DM + col0; \
            _Pragma("unroll") for (int bj = 0; bj < 2; ++bj) _Pragma("unroll") for (int n = 0; n < 2; ++n) xv[slot][q][bj][n] = *(const f32x4*)(xin + off + bj * 128 + n * 16); } } while (0)
#define EO_ADD(slot, g_) do { _Pragma("unroll") for (int q = 0; q < 2; ++q) { const int ai = (g_) >> 1, m = ((g_) & 1) * 2 + q; const size_t off = (size_t)(row0 + ai * 128 + m * 16) * DM + col0; \
            _Pragma("unroll") for (int bj = 0; bj < 2; ++bj) _Pragma("unroll") for (int n = 0; n < 2; ++n) { acc[ai][bj][m][n] = xv[slot][q][bj][n] + gv[bj][n] * acc[ai][bj][m][n]; \
                if (!last) *(f32x4*)(out + off + bj * 128 + n * 16) = acc[ai][bj][m][n]; } } } while (0)
        EO_LOAD(0, 0); EO_LOAD(1, 1); EO_ADD(0, 0); EO_LOAD(0, 2); EO_ADD(1, 1); EO_LOAD(1, 3); EO_ADD(0, 2); EO_ADD(1, 3);
#undef EO_LOAD
#undef EO_ADD
#pragma unroll
        for (int ai = 0; ai < 2; ++ai)
#pragma unroll
            for (int m = 0; m < 4; ++m) { float ss = 0.f;
#pragma unroll
                for (int bj = 0; bj < 2; ++bj)
#pragma unroll
                    for (int n = 0; n < 2; ++n) { const f32x4 x = acc[ai][bj][m][n]; ss += (x[0] * x[0] + x[1] * x[1]) + (x[2] * x[2] + x[3] * x[3]); }
                ss += __shfl_xor(ss, 16); ss += __shfl_xor(ss, 32);
                if (fq == 0) P[(ai * 128 + wr * 64 + m * 16 + fr) * 4 + wc] = ss; }
        asm volatile("s_waitcnt lgkmcnt(0)" ::: "memory"); __builtin_amdgcn_s_barrier(); asm volatile("" ::: "memory");
        const int tid = wid * 64 + lane;
        if (tid < 256) { const f32x4 p = *(const LAS f32x4*)(P + tid * 4);
            __hip_atomic_store(xs + (size_t)(u.pm * 256 + tid) * 8 + u.pn, (p[0] + p[1]) + (p[2] + p[3]), __ATOMIC_RELAXED, __HIP_MEMORY_SCOPE_AGENT);
            asm volatile("s_waitcnt vmcnt(0)" ::: "memory");
            if (lane == 0) __hip_atomic_fetch_add(cnt + 64 * u.pm, 1u, __ATOMIC_RELAXED, __HIP_MEMORY_SCOPE_AGENT); }
        if (wid == 0) { unsigned sp = 0u;
            while ((unsigned)__builtin_amdgcn_readfirstlane(__hip_atomic_load(cnt + 64 * u.pm, __ATOMIC_RELAXED, __HIP_MEMORY_SCOPE_AGENT)) < target) { __builtin_amdgcn_s_sleep(2); if (++sp > (1u << 22)) break; }
            __builtin_amdgcn_fence(__ATOMIC_ACQUIRE, "agent"); }
        asm volatile("s_waitcnt vmcnt(0) lgkmcnt(0)" ::: "memory"); __builtin_amdgcn_s_barrier(); asm volatile("" ::: "memory");
        if (tid < 256) { const float* sl = xs + (size_t)(u.pm * 256 + tid) * 8; float s = 0.f;
#pragma unroll
            for (int t = 0; t < 8; ++t) s += __hip_atomic_load(sl + t, __ATOMIC_RELAXED, __HIP_MEMORY_SCOPE_AGENT);
            S[tid] = __builtin_amdgcn_rsqf(s * (1.f / DM) + EPS); }
        asm volatile("s_waitcnt lgkmcnt(0)" ::: "memory"); __builtin_amdgcn_s_barrier(); asm volatile("" ::: "memory");
        f32x4 mul[2][2], add[2][2];
#pragma unroll
        for (int bj = 0; bj < 2; ++bj)
#pragma unroll
            for (int n = 0; n < 2; ++n) { const int c = col0 + bj * 128 + n * 16; const f32x4 gg = *(const f32x4*)(g + c);
                if (last) { mul[bj][n] = gg; add[bj][n] = (f32x4){0.f, 0.f, 0.f, 0.f}; }
                else { const float* mn = mods_next + (size_t)b * 3 * DM; mul[bj][n] = gg * (*(const f32x4*)(mn + DM + c) + 1.f); add[bj][n] = *(const f32x4*)(mn + c); } }
#pragma unroll
        for (int ai = 0; ai < 2; ++ai)
#pragma unroll
            for (int m = 0; m < 4; ++m) { const int rl = ai * 128 + wr * 64 + m * 16 + fr; const float rstd = S[rl]; const size_t off = (size_t)(u.pm * 256 + rl) * DM + col0;
#pragma unroll
                for (int bj = 0; bj < 2; ++bj)
#pragma unroll
                    for (int n = 0; n < 2; ++n) { const f32x4 r = acc[ai][bj][m][n] * rstd * mul[bj][n] + add[bj][n];
                        if (last) *(f32x4*)(out + off + bj * 128 + n * 16) = r;
                        else { v2u w; w.x = pk2(r[0], r[1]); w.y = pk2(r[2], r[3]); *(v2u*)(H + off + bj * 128 + n * 16) = w; } } }
    }
};

__device__ __forceinline__ void unpack8(const v4u w, float* f) { f[0] = bflo(w.x); f[1] = bfhi(w.x); f[2] = bflo(w.y); f[3] = bfhi(w.y); f[4] = bflo(w.z); f[5] = bfhi(w.z); f[6] = bflo(w.w); f[7] = bfhi(w.w); }

__device__ __forceinline__ int stg_pos(int c, int row) { return (c & 16) | ((c ^ (row & 7) ^ ((c >> 4) << 3)) & 15); }
__device__ __forceinline__ void stage_write(LAS float* st, const f32x16* acc, int r32, int hi) {
#pragma unroll
    for (int reg = 0; reg < 16; ++reg) { const int row = (reg & 3) + 8 * (reg >> 2) + 4 * hi;
#pragma unroll
        for (int dvb = 0; dvb < 4; ++dvb) { const int col = dvb * 32 + r32; st[row * 128 + stg_pos(col >> 2, row) * 4 + (col & 3)] = acc[dvb][reg]; } }
}
__device__ __forceinline__ void stage_read(const LAS float* st, int lane, float* v) {
    const int row = lane >> 1, half = lane & 1;
#pragma unroll
    for (int j = 0; j < 16; ++j) { const f32x4 q = *(const LAS f32x4*)(st + row * 128 + stg_pos(16 * half + j, row) * 4); v[4 * j] = q[0]; v[4 * j + 1] = q[1]; v[4 * j + 2] = q[2]; v[4 * j + 3] = q[3]; }
}
__device__ __forceinline__ void gated_store64(const float* v, float rs, const float* __restrict__ g, const bf16* __restrict__ zrow, bf16* __restrict__ yrow) {
    v4u zz[8];
#pragma unroll
    for (int j = 0; j < 8; ++j) zz[j] = *(const v4u*)(zrow + 8 * j);
#pragma unroll
    for (int j = 0; j < 8; ++j) { const f32x4 g0 = *(const f32x4*)(g + 8 * j), g1 = *(const f32x4*)(g + 8 * j + 4); float z[8]; unpack8(zz[j], z);
        v4u w; w.x = pk2(v[8 * j] * rs * g0[0] * z[0], v[8 * j + 1] * rs * g0[1] * z[1]); w.y = pk2(v[8 * j + 2] * rs * g0[2] * z[2], v[8 * j + 3] * rs * g0[3] * z[3]);
        w.z = pk2(v[8 * j + 4] * rs * g1[0] * z[4], v[8 * j + 5] * rs * g1[1] * z[5]); w.w = pk2(v[8 * j + 6] * rs * g1[2] * z[6], v[8 * j + 7] * rs * g1[3] * z[7]);
        *(v4u*)(yrow + 8 * j) = w; }
}

namespace mla {
constexpr int NW = 8, QBLK = 32, KVBLK = 64;
constexpr int SHM_V = 16384, SHM_KN = 16384, SHM_KR = 8192;
constexpr int OFF_V = 0, OFF_KN = 2 * SHM_V, OFF_KR = OFF_KN + 2 * SHM_KN, OFF_WS = OFF_KR + 2 * SHM_KR, OFF_QR = OFF_WS + NW * 64 * 4, ATTN_LDS = OFF_QR + NW * 4096;
constexpr float THR = 8.f;
#define KSWZ(row, colB) ((row) * 256 + ((colB) ^ (((row) & 7) << 4)))
#define KRSWZ(row, colB) ((row) * 128 + ((colB) ^ ((((row) >> 1) & 7) << 4)))
#define SBAR() __builtin_amdgcn_sched_barrier(0)
__device__ __forceinline__ int crow(int r, int hi) { return (r & 3) + 8 * (r >> 2) + 4 * hi; }
__device__ __forceinline__ unsigned cvtpk(float lo, float hi) { unsigned r; asm volatile("v_cvt_pk_bf16_f32 %0, %1, %2" : "=v"(r) : "v"(lo), "v"(hi)); return r; }

__device__ __forceinline__ void partialSM(f32x16& p0, f32x16& p1, float& m_reg, float& mn, float& alpha) {
  float pmax = p0[0];
#pragma unroll
  for (int r = 1; r < 16; ++r) pmax = fmaxf(pmax, p0[r]);
#pragma unroll
  for (int r = 0; r < 16; ++r) pmax = fmaxf(pmax, p1[r]);
  { auto rr = __builtin_amdgcn_permlane32_swap(__float_as_uint(pmax), __float_as_uint(pmax), false, false);
    pmax = fmaxf(__uint_as_float(rr[0]), __uint_as_float(rr[1])); }
  if (__builtin_expect(__all(pmax - m_reg <= THR), 1)) { mn = m_reg; alpha = 1.f; }
  else { mn = fmaxf(m_reg, pmax); alpha = __builtin_amdgcn_exp2f(m_reg - mn); m_reg = mn; }
#pragma unroll
  for (int r = 0; r < 16; ++r) p0[r] = p0[r] - mn;
#pragma unroll
  for (int r = 0; r < 16; ++r) p1[r] = p1[r] - mn;
#pragma unroll
  for (int r = 0; r < 16; ++r) p0[r] = __builtin_amdgcn_exp2f(p0[r]);
}
__device__ __forceinline__ void finishSM(f32x16& p0, f32x16& p1, float alpha, float& l_reg, bf16x8& pa0, bf16x8& pa1, bf16x8& pa2, bf16x8& pa3) {
#pragma unroll
  for (int r = 0; r < 16; ++r) p1[r] = __builtin_amdgcn_exp2f(p1[r]);
  float ps = 0;
#pragma unroll
  for (int r = 0; r < 16; ++r) ps += p0[r];
#pragma unroll
  for (int r = 0; r < 16; ++r) ps += p1[r];
  { auto rr = __builtin_amdgcn_permlane32_swap(__float_as_uint(ps), __float_as_uint(ps), false, false);
    ps = __uint_as_float(rr[0]) + __uint_as_float(rr[1]); }
  l_reg = l_reg * alpha + ps;
#define PK4(P, BASE, OUT) do { unsigned a0 = cvtpk(P[BASE + 0], P[BASE + 1]), a1 = cvtpk(P[BASE + 2], P[BASE + 3]);   \
    unsigned b0 = cvtpk(P[BASE + 4], P[BASE + 5]), b1 = cvtpk(P[BASE + 6], P[BASE + 7]);                              \
    auto r0 = __builtin_amdgcn_permlane32_swap(a0, b0, false, false); auto r1 = __builtin_amdgcn_permlane32_swap(a1, b1, false, false); \
    v4u w = {r0[0], r1[0], r0[1], r1[1]}; OUT = *reinterpret_cast<bf16x8*>(&w); } while (0)
  PK4(p0, 0, pa0); PK4(p0, 8, pa1); PK4(p1, 0, pa2); PK4(p1, 8, pa3);
#undef PK4
}
__device__ __forceinline__ void qkt(f32x16& p0, f32x16& p1, const char* Kn, const char* Kr, const bf16x8* qr, const char* Qr, int r32, int hi) {
  p0 = f32x16{}; p1 = f32x16{};
  int tn = (hi * 16) ^ ((r32 & 7) << 4), tr = (hi * 16) ^ (((r32 >> 1) & 7) << 4);
  asm volatile("" : "+v"(tn), "+v"(tr));
  const char* knb = Kn + r32 * 256; const char* krb = Kr + r32 * 128; const char* qrb = Qr + r32 * 128;
#pragma unroll
  for (int d0 = 0; d0 < 8; ++d0) { const int off = (d0 * 32) ^ tn;
    const bf16x8 b0 = *reinterpret_cast<const bf16x8*>(knb + off);
    const bf16x8 b1 = *reinterpret_cast<const bf16x8*>(knb + off + 8192);
    p0 = __builtin_amdgcn_mfma_f32_32x32x16_bf16(b0, qr[d0], p0, 0, 0, 0);
    p1 = __builtin_amdgcn_mfma_f32_32x32x16_bf16(b1, qr[d0], p1, 0, 0, 0); }
#pragma unroll
  for (int d0 = 0; d0 < 4; ++d0) { const int off = (d0 * 32) ^ tr;
    const bf16x8 b0 = *reinterpret_cast<const bf16x8*>(krb + off);
    const bf16x8 b1 = *reinterpret_cast<const bf16x8*>(krb + off + 4096);
    const bf16x8 qv = *reinterpret_cast<const bf16x8*>(qrb + off);
    p0 = __builtin_amdgcn_mfma_f32_32x32x16_bf16(b0, qv, p0, 0, 0, 0);
    p1 = __builtin_amdgcn_mfma_f32_32x32x16_bf16(b1, qv, p1, 0, 0, 0); }
}
__device__ __forceinline__ int v_st(int k, int c) { const int kk = (k & ~0xC) | ((k & 4) << 1) | ((k & 8) >> 1); return ((kk >> 3) * 4 + (c >> 5)) * 512 + ((kk & 7) * 32 + (c & 31)) * 2; }
__device__ __forceinline__ int v_rd_base(int lane) { return ((lane & 3) << 3) | (((lane >> 2) & 3) << 6) | (((lane >> 4) & 1) << 5) | (((lane >> 5) & 1) << 8); }
constexpr int v_rd_off(int d0, int ks, int half) { return d0 * 512 + ks * 4096 + half * 2048; }
template <int OFF> __device__ __forceinline__ s16x4 tr_read(int vb) {
  s16x4 r; asm volatile("ds_read_b64_tr_b16 %0, %1 offset:%2" : "=&v"(r) : "v"(vb), "i"(OFF) : "memory"); return r;
}
template <int D0> __device__ __forceinline__ void pv_one(f32x16& od, int vb, bf16x8 pa0, bf16x8 pa1, bf16x8 pa2, bf16x8 pa3) {
  const s16x4 l0 = tr_read<v_rd_off(D0, 0, 0)>(vb), h0 = tr_read<v_rd_off(D0, 0, 1)>(vb), l1 = tr_read<v_rd_off(D0, 1, 0)>(vb), h1 = tr_read<v_rd_off(D0, 1, 1)>(vb);
  const s16x4 l2 = tr_read<v_rd_off(D0, 2, 0)>(vb), h2 = tr_read<v_rd_off(D0, 2, 1)>(vb), l3 = tr_read<v_rd_off(D0, 3, 0)>(vb), h3 = tr_read<v_rd_off(D0, 3, 1)>(vb);
  asm volatile("s_waitcnt lgkmcnt(0)" ::: "memory"); SBAR();
#define PK(L, H) (bf16x8){L[0], L[1], L[2], L[3], H[0], H[1], H[2], H[3]}
  od = __builtin_amdgcn_mfma_f32_32x32x16_bf16(pa0, PK(l0, h0), od, 0, 0, 0);
  od = __builtin_amdgcn_mfma_f32_32x32x16_bf16(pa1, PK(l1, h1), od, 0, 0, 0);
  od = __builtin_amdgcn_mfma_f32_32x32x16_bf16(pa2, PK(l2, h2), od, 0, 0, 0);
  od = __builtin_amdgcn_mfma_f32_32x32x16_bf16(pa3, PK(l3, h3), od, 0, 0, 0);
#undef PK
}
__device__ __forceinline__ void pv_d0(f32x16* o, int vb, bf16x8 pa0, bf16x8 pa1, bf16x8 pa2, bf16x8 pa3) {
  pv_one<0>(o[0], vb, pa0, pa1, pa2, pa3); pv_one<1>(o[1], vb, pa0, pa1, pa2, pa3); pv_one<2>(o[2], vb, pa0, pa1, pa2, pa3); pv_one<3>(o[3], vb, pa0, pa1, pa2, pa3);
}

__device__ __forceinline__ void attn_unit(const bf16* __restrict__ Qb, const bf16* __restrict__ Knh, const bf16* __restrict__ Vh, const bf16* __restrict__ Krh,
                                          bf16* __restrict__ Yb, const bf16* __restrict__ Zb, const float* __restrict__ gh, float* __restrict__ part, int seq, char* lds) {
  int tid_ = threadIdx.x; asm volatile("" : "+v"(tid_));
  const int tid = tid_, wid = tid >> 6, lane = tid & 63, r32 = lane & 31, hi = lane >> 5;
  char* V_lds = lds + OFF_V; char* KN_lds = lds + OFF_KN; char* KR_lds = lds + OFF_KR;
  float* ws = (float*)(lds + OFF_WS) + wid * 64; float* li_l = ws; float* al_l = ws + 32;
  float m_reg = -1e30f, l_reg = 0; f32x16 o[4] = {}; bf16x8 qr[8]; char* QR_lds = lds + OFF_QR + wid * 4096;
  const bf16* Qw = Qb + (long)(wid * QBLK + r32) * NQ + hi * 8;
#pragma unroll
  for (int d0 = 0; d0 < 8; ++d0) qr[d0] = *reinterpret_cast<const bf16x8*>(Qw + d0 * 16);
#pragma unroll
  for (int d0 = 0; d0 < 4; ++d0) *reinterpret_cast<bf16x8*>(QR_lds + KRSWZ(r32, (d0 * 16 + hi * 8) * 2)) = *reinterpret_cast<const bf16x8*>(Qw + 128 + d0 * 16);
  const int sr = tid >> 4, sc = (tid & 15) * 8, vst0 = v_st(sr, sc), vst1 = v_st(32 + sr, sc);
  const int krr = tid >> 3, krc = (tid & 7) * 8;
  const int vb0 = (int)(uintptr_t)V_lds + v_rd_base(lane);
  bf16x8 vs0, vs1, ks0, ks1, kr0;
#define SLOAD(k0) do { vs0 = *reinterpret_cast<const bf16x8*>(&Vh[(long)((k0) + sr) * NKV + sc]); vs1 = *reinterpret_cast<const bf16x8*>(&Vh[(long)((k0) + 32 + sr) * NKV + sc]); \
    ks0 = *reinterpret_cast<const bf16x8*>(&Knh[(long)((k0) + sr) * NKV + sc]); ks1 = *reinterpret_cast<const bf16x8*>(&Knh[(long)((k0) + 32 + sr) * NKV + sc]); \
    kr0 = *reinterpret_cast<const bf16x8*>(&Krh[(long)((k0) + krr) * NP + krc]); } while (0)
#define SWRITE(b) do { *(bf16x8*)(V_lds + (b) * SHM_V + vst0) = vs0; *(bf16x8*)(V_lds + (b) * SHM_V + vst1) = vs1; const int kc = sc * 2;   \
    *(bf16x8*)(KN_lds + (b) * SHM_KN + KSWZ(sr, kc)) = ks0; *(bf16x8*)(KN_lds + (b) * SHM_KN + KSWZ(32 + sr, kc)) = ks1;                       \
    *(bf16x8*)(KR_lds + (b) * SHM_KR + KRSWZ(krr, krc * 2)) = kr0; } while (0)
#define SWAIT() asm volatile("s_waitcnt vmcnt(0)" ::: "memory")
#define RESC(a) do { if (__any((a) < 1.f)) { if (hi == 0) al_l[r32] = (a); asm volatile("s_waitcnt lgkmcnt(0)" ::: "memory"); \
    _Pragma("unroll") for (int d = 0; d < 4; ++d) _Pragma("unroll") for (int r = 0; r < 16; ++r) o[d][r] *= al_l[crow(r, hi)]; } } while (0)
  f32x16 pA0, pA1, pB0, pB1; float mnA, mnB, alA, alB; bf16x8 pa0, pa1, pa2, pa3; const int NT = seq / KVBLK;
  SLOAD(0); SWAIT(); SWRITE(0); __syncthreads();
  qkt(pA0, pA1, KN_lds, KR_lds, qr, QR_lds, r32, hi); partialSM(pA0, pA1, m_reg, mnA, alA);
  SLOAD(KVBLK);
  SWAIT(); SWRITE(1); __syncthreads();
  for (int j = 1; j + 1 < NT; j += 2) {
    SBAR(); qkt(pB0, pB1, KN_lds + SHM_KN, KR_lds + SHM_KR, qr, QR_lds, r32, hi);
    finishSM(pA0, pA1, alA, l_reg, pa0, pa1, pa2, pa3); SBAR();
    SLOAD((j + 1) * KVBLK); SBAR();
    pv_d0(o, vb0, pa0, pa1, pa2, pa3); partialSM(pB0, pB1, m_reg, mnB, alB);
    __syncthreads(); SWAIT(); SWRITE(0);
    RESC(alB); __syncthreads();
    SBAR(); qkt(pA0, pA1, KN_lds, KR_lds, qr, QR_lds, r32, hi);
    finishSM(pB0, pB1, alB, l_reg, pa0, pa1, pa2, pa3); SBAR();
    SLOAD((j + 2) * KVBLK); SBAR();
    pv_d0(o, vb0 + SHM_V, pa0, pa1, pa2, pa3); partialSM(pA0, pA1, m_reg, mnA, alA);
    __syncthreads(); SWAIT(); SWRITE(1);
    RESC(alA); __syncthreads();
  }
  SBAR(); qkt(pB0, pB1, KN_lds + SHM_KN, KR_lds + SHM_KR, qr, QR_lds, r32, hi);
  finishSM(pA0, pA1, alA, l_reg, pa0, pa1, pa2, pa3); SBAR();
  pv_d0(o, vb0, pa0, pa1, pa2, pa3); partialSM(pB0, pB1, m_reg, mnB, alB);
  __syncthreads(); RESC(alB);
  finishSM(pB0, pB1, alB, l_reg, pa0, pa1, pa2, pa3); SBAR();
  pv_d0(o, vb0 + SHM_V, pa0, pa1, pa2, pa3);
  if (hi == 0) li_l[r32] = l_reg; asm volatile("s_waitcnt lgkmcnt(0)" ::: "memory");
  float rli[16];
#pragma unroll
  for (int r = 0; r < 16; ++r) rli[r] = __builtin_amdgcn_rcpf(li_l[crow(r, hi)]);
#pragma unroll
  for (int d0 = 0; d0 < 4; ++d0)
#pragma unroll
    for (int r = 0; r < 16; ++r) o[d0][r] *= rli[r];
  __syncthreads();
  { LAS float* st = (LAS float*)(LAS unsigned char*)(lds + wid * 16384);
    stage_write(st, o, r32, hi);
    asm volatile("s_waitcnt lgkmcnt(0)" ::: "memory");
    float v[64]; stage_read(st, lane, v);
    const int row = lane >> 1, half = lane & 1; const long rr = wid * QBLK + row;
    float ss = 0.f;
#pragma unroll
    for (int j = 0; j < 64; ++j) ss += v[j] * v[j];
    ss += __shfl_xor(ss, 1);
    if (half == 0) part[rr * 8] = ss;
    gated_store64(v, 1.f, gh + half * 64, Zb + rr * NP + half * 64, Yb + rr * DM + half * 64); }
  __syncthreads();
#undef SLOAD
#undef SWRITE
#undef SWAIT
#undef RESC
}
#undef SBAR
}
struct Frame {
    LAS unsigned char* lds; char* ldsg;
    int tid, lane, wave, vcu, G;
    float* out; unsigned char* ws;
};
__device__ __forceinline__ const float* ld_in(int i) {
    const __attribute__((address_space(4))) char* ka = (const __attribute__((address_space(4))) char*)__builtin_amdgcn_kernarg_segment_ptr();
    asm volatile("" : "+s"(i));
    const GAS float* p = *(const GAS float* const __attribute__((address_space(4)))*)(ka + 8 * i);
    return (const float*)p;
}
#define WSP(T_, off) ((T_*)(F.ws + (off)))

__device__ __forceinline__ void p0_mods(Frame& F, size_t mods_off) {
    LAS float* sc = (LAS float*)F.lds;
    LAS float* part = (LAS float*)(F.lds + 32768);
    const float* c = ld_in(1); const float* aw = ld_in(3); const float* ab = ld_in(4);
    for (int i = F.tid; i < BATCH * DM; i += NTHR) { const float v = c[i]; sc[i] = v / (1.f + __expf(-v)); }
    __syncthreads();
    for (int item = (int)blockIdx.x; item < 768; item += F.G) {
        const int ks = item & 15, cb = (item >> 4) % 24, l = item / 384, j0 = cb * 256, kb = ks * 128 + F.wave * 16;
        const f32x4* w = (const f32x4*)(aw + (size_t)l * DM * 3 * DM + (size_t)kb * 3 * DM + j0) + F.lane;
        f32x4 wv[16];
#pragma unroll
        for (int k = 0; k < 16; ++k) wv[k] = w[(size_t)k * (3 * DM / 4)];
        f32x4 a[4] = {};
#pragma unroll
        for (int k = 0; k < 16; ++k)
#pragma unroll
            for (int b = 0; b < 4; ++b) a[b] += wv[k] * sc[b * DM + kb + k];
#pragma unroll
        for (int b = 0; b < 4; ++b) *(LAS f32x4*)(part + (F.wave * 4 + b) * 256 + F.lane * 4) = a[b];
        __syncthreads();
        for (int o = F.tid; o < 1024; o += NTHR) { const int b = o >> 8, col = o & 255; float s = 0.f;
#pragma unroll
            for (int wv2 = 0; wv2 < 8; ++wv2) s += part[(wv2 * 4 + b) * 256 + col];
            if (ks == 0) s += ab[l * 3 * DM + j0 + col];
            atomicAdd(WSP(float, mods_off) + ((size_t)l * BATCH + b) * 3 * DM + j0 + col, s); }
        __syncthreads();
    }
}
__device__ __forceinline__ int kmap_out(int k) { return k < 768 ? k + 768 : (k < 1536 ? k - 768 : k); }
template <int MAP, bool KMAP> __device__ __forceinline__ void p0_transpose_item(const float* W, int K, int N, bf16* WT, const float* kgain, int item, int nblk, int lane) {
    const int kb = item / nblk, nb = item % nblk, k0 = 64 * kb, n0 = 64 * nb, ks0 = KMAP ? kmap_out(k0) : k0;
    const int np = n0 + lane; const int src = MAP == 1 ? map_in(np) : (MAP == 2 ? map_uq(np) : np);
    float v[64];
#pragma unroll
    for (int i = 0; i < 64; ++i) v[i] = src >= 0 ? W[(size_t)(ks0 + i) * N + src] : 0.f;
    if (kgain) {
#pragma unroll
        for (int i = 0; i < 64; ++i) v[i] *= kgain[k0 + i];
    }
    bf16* orow = WT + (size_t)np * K + k0;
#pragma unroll
    for (int c = 0; c < 8; ++c) { v4u w; w.x = pk2(v[8 * c], v[8 * c + 1]); w.y = pk2(v[8 * c + 2], v[8 * c + 3]); w.z = pk2(v[8 * c + 4], v[8 * c + 5]); w.w = pk2(v[8 * c + 6], v[8 * c + 7]);
        *(GAS v4u*)(orow + 8 * c) = w; }
}
__device__ __forceinline__ void p0_prologue(Frame& F, size_t mods_off) {
    p0_mods(F, mods_off);
    const int gw = F.vcu * NWAVES + F.wave, NGW = F.G * NWAVES;
    constexpr int I_IN = (DM / 64) * (NP / 64), I_OUT = (DM / 64) * (DM / 64), I_UQ = (384 / 64) * (NQ / 64), I_UKV = (256 / 64) * (NKV / 64), I_L = I_IN + I_OUT + I_UQ + I_UKV;
    for (int it = gw; it < DEPTH * I_L; it += NGW) {
        const int l = it / I_L; int r = it % I_L;
        if (r < I_IN) { p0_transpose_item<1, false>(ld_in(6) + (size_t)l * DM * IN_DIM, DM, IN_DIM, WSP(bf16, WS_WIN) + (size_t)l * NP * DM, nullptr, r, NP / 64, F.lane); continue; } r -= I_IN;
        if (r < I_OUT) { p0_transpose_item<0, true>(ld_in(19) + (size_t)l * DM * DM, DM, DM, WSP(bf16, WS_WOUT) + (size_t)l * DM * DM, nullptr, r, DM / 64, F.lane); continue; } r -= I_OUT;
        if (r < I_UQ) { p0_transpose_item<2, false>(ld_in(14) + (size_t)l * 384 * 1152, 384, 1152, WSP(bf16, WS_WUQ) + (size_t)l * NQ * 384, ld_in(12) + l * 384, r, NQ / 64, F.lane); continue; } r -= I_UQ;
        p0_transpose_item<0, false>(ld_in(15) + (size_t)l * 256 * 1536, 256, 1536, WSP(bf16, WS_WUKV) + (size_t)l * NKV * 256, ld_in(13) + l * 256, r, NKV / 64, F.lane);
    }
    const int* pos = (const int*)ld_in(2);
    for (int i = (int)blockIdx.x * NTHR + F.tid; i < T * 32; i += F.G * NTHR) {
        const int t = i >> 5, f = i & 31;
        const float inv = (float)exp2(-(double)f * (13.287712379549449 / 32.0));
        const float ang = (float)pos[t] * inv;
        const double rev = (double)ang * 0.15915494309189535; const float fr = (float)(rev - floor(rev));
        WSP(float, WS_CS)[i] = __builtin_amdgcn_cosf(fr); WSP(float, WS_SN)[i] = __builtin_amdgcn_sinf(fr);
    }
}
__device__ __forceinline__ void modnorm_rows(Frame& F, const float* x, const float* g, const float* mods_l, bf16* H) {
    const int gw = F.vcu * NWAVES + F.wave, NGW = F.G * NWAVES;
    for (int t = gw; t < T; t += NGW) {
        const GAS f32x4* xr = (const GAS f32x4*)(x + (size_t)t * DM) + F.lane;
        f32x4 v[8]; float s = 0.f;
#pragma unroll
        for (int j = 0; j < 8; ++j) { v[j] = xr[64 * j]; s += (v[j][0] * v[j][0] + v[j][1] * v[j][1]) + (v[j][2] * v[j][2] + v[j][3] * v[j][3]); }
        const float rstd = __builtin_amdgcn_rsqf(wave_sum(s) * (1.f / DM) + EPS);
        const float* sh = mods_l + (size_t)(t / SEQ) * 3 * DM; const float* scl = sh + DM;
        GAS v2u* o8 = (GAS v2u*)(H + (size_t)t * DM) + F.lane;
#pragma unroll
        for (int j = 0; j < 8; ++j) { const int col = (F.lane + 64 * j) * 4;
            const f32x4 gg = *(const f32x4*)(g + col), sv = *(const f32x4*)(scl + col), hv = *(const f32x4*)(sh + col);
            const f32x4 r = v[j] * rstd * gg * (sv + 1.f) + hv;
            v2u w; w.x = pk2(r[0], r[1]); w.y = pk2(r[2], r[3]); o8[64 * j] = w; }
    }
}
__device__ __forceinline__ void finalnorm_rows(Frame& F, float* x, const float* g) {
    const int gw = F.vcu * NWAVES + F.wave, NGW = F.G * NWAVES;
    for (int t = gw; t < T; t += NGW) {
        GAS f32x4* xr = (GAS f32x4*)(x + (size_t)t * DM) + F.lane;
        f32x4 v[8]; float s = 0.f;
#pragma unroll
        for (int j = 0; j < 8; ++j) { v[j] = xr[64 * j]; s += (v[j][0] * v[j][0] + v[j][1] * v[j][1]) + (v[j][2] * v[j][2] + v[j][3] * v[j][3]); }
        const float rstd = __builtin_amdgcn_rsqf(wave_sum(s) * (1.f / DM) + EPS);
#pragma unroll
        for (int j = 0; j < 8; ++j) { const f32x4 gg = *(const f32x4*)(g + (F.lane + 64 * j) * 4); xr[64 * j] = v[j] * rstd * gg; }
    }
}
__device__ __forceinline__ void conv_rows(Frame& F, int l) {
    const int gw = F.vcu * NWAVES + F.wave, NGW = F.G * NWAVES;
    const bf16* P = WSP(bf16, WS_PROJ); bf16* Y = WSP(bf16, WS_HY);
    const float* cw = ld_in(17) + l * 3 * 512; const float* cg = ld_in(18) + l * 512;
    const int ch = F.lane * 8;
    for (int t = gw; t < T; t += NGW) {
        const int s = t % SEQ; const bf16* p = P + (size_t)t * NP;
        float u[3][8];
#pragma unroll
        for (int d = 0; d < 3; ++d) { const int ss = s + d - 1;
            if (ss >= 0 && ss < SEQ) { const bf16* q = p + (long)(d - 1) * NP; float a[8], b[8]; unpack8(*(const v4u*)(q + C_CC + ch), a); unpack8(*(const v4u*)(q + C_CX + ch), b);
#pragma unroll
                for (int e = 0; e < 8; ++e) u[d][e] = a[e] * b[e]; }
            else {
#pragma unroll
                for (int e = 0; e < 8; ++e) u[d][e] = 0.f; } }
        float cb[8], sz[8], pre[8]; unpack8(*(const v4u*)(p + C_CB + ch), cb); unpack8(*(const v4u*)(p + C_Z + 1536 + ch), sz);
        float ssq = 0.f;
#pragma unroll
        for (int e = 0; e < 8; ++e) { pre[e] = cb[e] * (u[0][e] * cw[ch + e] + u[1][e] * cw[512 + ch + e] + u[2][e] * cw[1024 + ch + e]); ssq += pre[e] * pre[e]; }
        const float rstd = __builtin_amdgcn_rsqf(wave_sum(ssq) * (1.f / 512.f) + EPS);
        float r[8];
#pragma unroll
        for (int e = 0; e < 8; ++e) r[e] = pre[e] * rstd * cg[ch + e] * sz[e];
        v4u w; w.x = pk2(r[0], r[1]); w.y = pk2(r[2], r[3]); w.z = pk2(r[4], r[5]); w.w = pk2(r[6], r[7]);
        *(v4u*)(Y + (size_t)t * DM + 1536 + ch) = w;
    }
}
__device__ __forceinline__ void mlaout_rows(Frame& F, int l) {
    const int gw = F.vcu * NWAVES + F.wave, NGW = F.G * NWAVES;
    const bf16* P = WSP(bf16, WS_PROJ); bf16* Y = WSP(bf16, WS_HY); const float* O = WSP(float, WS_OMLA); const float* g = ld_in(16) + l * 768;
    for (int t = gw; t < T; t += NGW) {
        f32x4 v[3]; float s = 0.f;
#pragma unroll
        for (int j = 0; j < 3; ++j) { v[j] = *(const f32x4*)(O + (size_t)t * 768 + (F.lane + 64 * j) * 4); s += (v[j][0] * v[j][0] + v[j][1] * v[j][1]) + (v[j][2] * v[j][2] + v[j][3] * v[j][3]); }
        const float rstd = __builtin_amdgcn_rsqf(wave_sum(s) * (1.f / 768.f) + EPS);
#pragma unroll
        for (int j = 0; j < 3; ++j) { const int col = (F.lane + 64 * j) * 4; const f32x4 gg = *(const f32x4*)(g + col);
            const v2u zw = *(const v2u*)(P + (size_t)t * NP + C_Z + 768 + col);
            const f32x4 r = v[j] * rstd * gg; v2u w; w.x = pk2(r[0] * bflo(zw.x), r[1] * bfhi(zw.x)); w.y = pk2(r[2] * bflo(zw.y), r[3] * bfhi(zw.y));
            *(v2u*)(Y + (size_t)t * DM + col) = w; }
    }
}


template <int KS> __device__ __forceinline__ f32x16 tile_mm(const LAS bf16* A, const LAS bf16* Bt, int r, int hh, f32x16 acc) {
#pragma unroll
    for (int s = 0; s < KS; ++s) {
        const bf16x8 a = *(const LAS bf16x8*)(A + r * 72 + 16 * s + 8 * hh), b = *(const LAS bf16x8*)(Bt + r * 72 + 16 * s + 8 * hh);
        acc = __builtin_amdgcn_mfma_f32_32x32x16_bf16(a, b, acc, 0, 0, 0);
    }
    return acc;
}
__device__ __forceinline__ float logsig16(float a) { return (fminf(a, 0.f) - __logf(1.f + __expf(-fabsf(a)))) * (1.f / 16.f); }
__device__ __forceinline__ void gla_a_item(Frame& F, int l, int item) {
    const int h = item % 6, bn = item / 6, t0 = bn * 64;
    const int tid = F.tid, lane = F.lane, wave = F.wave;
    LAS unsigned char* L = F.lds;
    LAS bf16* QB = (LAS bf16*)(L);
    LAS bf16* KB = (LAS bf16*)(L + 9216);
    LAS bf16* Mm = (LAS bf16*)(L);
    LAS bf16* VT = (LAS bf16*)(L + 18432);
    LAS float* LR = (LAS float*)(L + 36864);
    LAS float* WG = (LAS float*)(L + 36864 + 8192);
    LAS float* BG = (LAS float*)(L + 36864 + 16384);
    LAS bf16* KDT = (LAS bf16*)(L + 36864);
    LAS float* LA = (LAS float*)(L + 55296);
    LAS float* SEGT = (LAS float*)(L + 88576);
    LAS bf16* QF = (LAS bf16*)(L + 90624);
    LAS bf16* KF = (LAS bf16*)(L + 90624 + 18432);
    const bf16* P = WSP(bf16, WS_PROJ) + (size_t)t0 * NP;
    { const int r = tid >> 3, c8 = (tid & 7) * 8;
      *(LAS v4u*)(QB + r * 72 + c8) = *(const v4u*)(P + (size_t)r * NP + C_GQ + h * 64 + c8);
      *(LAS v4u*)(KB + r * 72 + c8) = *(const v4u*)(P + (size_t)r * NP + C_GK + h * 64 + c8); }
#pragma unroll
    for (int i = 0; i < 2; ++i) { const int idx = tid + i * 512, r = idx >> 4, c8 = (idx & 15) * 8;
        const v4u raw = *(const v4u*)(P + (size_t)r * NP + C_GV + h * 128 + c8);
        VT[(c8 + 0) * 72 + r] = (unsigned short)(raw.x & 0xffffu); VT[(c8 + 1) * 72 + r] = (unsigned short)(raw.x >> 16);
        VT[(c8 + 2) * 72 + r] = (unsigned short)(raw.y & 0xffffu); VT[(c8 + 3) * 72 + r] = (unsigned short)(raw.y >> 16);
        VT[(c8 + 4) * 72 + r] = (unsigned short)(raw.z & 0xffffu); VT[(c8 + 5) * 72 + r] = (unsigned short)(raw.z >> 16);
        VT[(c8 + 6) * 72 + r] = (unsigned short)(raw.w & 0xffffu); VT[(c8 + 7) * 72 + r] = (unsigned short)(raw.w >> 16); }
    if (tid < 256) { const int r = tid >> 2, c8 = (tid & 3) * 8; float f[8]; unpack8(*(const v4u*)(P + (size_t)r * NP + C_LR + c8), f);
#pragma unroll
        for (int e = 0; e < 8; ++e) LR[r * 32 + c8 + e] = f[e]; }
    { const int dir = tid >> 8, r = (tid >> 4) & 15, c4 = (tid & 15) * 4; const float* wgf_ = ld_in(7); const float* wgb_ = ld_in(9); const float* wsrc = (dir ? wgb_ : wgf_) + (size_t)l * 16 * 384 + r * 384 + h * 64 + c4;
      *(LAS f32x4*)(WG + (dir * 16 + r) * 64 + c4) = *(const f32x4*)wsrc; }
    if (tid < 128) { const int dir = tid >> 6, dk = tid & 63; const float* bgf_ = ld_in(8); const float* bgb_ = ld_in(10); BG[dir * 64 + dk] = (dir ? bgb_ : bgf_)[l * 384 + h * 64 + dk]; }
    LDS_WAIT(); __syncthreads();
    { const int tok = tid >> 3, dkg = (tid & 7) * 8;
#pragma unroll
      for (int dir = 0; dir < 2; ++dir) { float a[8];
#pragma unroll
        for (int e = 0; e < 8; ++e) a[e] = BG[dir * 64 + dkg + e];
#pragma unroll
        for (int r = 0; r < 16; ++r) { const float x = LR[tok * 32 + dir * 16 + r];
#pragma unroll
            for (int e = 0; e < 8; ++e) a[e] += x * WG[(dir * 16 + r) * 64 + dkg + e]; }
#pragma unroll
        for (int e = 0; e < 8; ++e) LA[(dir * 64 + tok) * 65 + dkg + e] = logsig16(a[e]); } }
    LDS_WAIT(); __syncthreads();
    const int cdir = (tid >> 6) & 1, cdk = tid & 63, seg = tid >> 7;
    float pb[16];
#pragma unroll
    for (int i = 0; i < 16; ++i) pb[i] = LA[(cdir * 64 + seg * 16 + i) * 65 + cdk];
    if (cdir == 0) {
#pragma unroll
        for (int i = 1; i < 16; ++i) pb[i] += pb[i - 1];
    } else {
#pragma unroll
        for (int i = 14; i >= 0; --i) pb[i] += pb[i + 1];
    }
    SEGT[(cdir * 4 + seg) * 64 + cdk] = cdir == 0 ? pb[15] : pb[0];
    LDS_WAIT(); __syncthreads();
    { float offv = 0.f, tot = 0.f;
#pragma unroll
      for (int s2 = 0; s2 < 4; ++s2) { const float sv = SEGT[(cdir * 4 + s2) * 64 + cdk]; tot += sv; if (cdir == 0 ? (s2 < seg) : (s2 > seg)) offv += sv; }
      bf16* QD = WSP(bf16, WS_QDEC) + (size_t)cdir * T * 384 + (size_t)t0 * 384 + h * 64 + cdk;
      unsigned kd[8];
#pragma unroll
      for (int i = 0; i < 16; ++i) { const int tok = seg * 16 + i; const float bv = pb[i] + offv;
          const float q = bf2f(QB[tok * 72 + cdk]), k = bf2f(KB[tok * 72 + cdk]);
          const unsigned short qd = (unsigned short)f2bf(q * 0.125f * __expf(bv)), ki = (unsigned short)f2bf(k * __expf(-bv)), kdv = (unsigned short)f2bf(k * __expf(tot - bv));
          QF[(cdir * 64 + tok) * 72 + cdk] = qd; KF[(cdir * 64 + tok) * 72 + cdk] = ki; QD[(size_t)tok * 384] = qd;
          if (i & 1) kd[i >> 1] |= (unsigned)kdv << 16; else kd[i >> 1] = kdv;
          if ((i & 3) == 3) __builtin_amdgcn_sched_barrier(0); }
      *(LAS v4u*)(KDT + (cdir * 64 + cdk) * 72 + seg * 16) = (v4u){kd[0], kd[1], kd[2], kd[3]};
      *(LAS v4u*)(KDT + (cdir * 64 + cdk) * 72 + seg * 16 + 8) = (v4u){kd[4], kd[5], kd[6], kd[7]};
      if (seg == 0) WSP(float, WS_DECAY)[((size_t)item * 2 + cdir) * 64 + cdk] = __expf(tot); }
    LDS_WAIT(); __syncthreads();
    const int r = lane & 31, hh = lane >> 5;
    if (wave < 4) {
        const int pb2 = wave >> 1, jb = wave & 1; f32x16 sf = {}, sb = {};
        if (pb2 >= jb) sf = tile_mm<4>(QF + (0 * 64 + pb2 * 32) * 72, KF + (0 * 64 + jb * 32) * 72, r, hh, sf);
        if (pb2 <= jb) sb = tile_mm<4>(QF + (1 * 64 + pb2 * 32) * 72, KF + (1 * 64 + jb * 32) * 72, r, hh, sb);
#pragma unroll
        for (int reg = 0; reg < 16; ++reg) { const int p = (reg & 3) + 8 * (reg >> 2) + 4 * hh; float v;
            if (pb2 > jb) v = sf[reg]; else if (pb2 < jb) v = sb[reg]; else v = (r <= p) ? sf[reg] : sb[reg];
            Mm[(pb2 * 32 + p) * 72 + jb * 32 + r] = (unsigned short)f2bf(v); }
    } else {
        const int dvb = wave - 4; float* KV = WSP(float, WS_KVC) + (size_t)item * 2 * 8192;
#pragma unroll
        for (int dir = 0; dir < 2; ++dir)
#pragma unroll
            for (int dkb = 0; dkb < 2; ++dkb) { f32x16 a = {}; a = tile_mm<4>(VT + (dvb * 32) * 72, KDT + (dir * 64 + dkb * 32) * 72, r, hh, a);
#pragma unroll
                for (int reg = 0; reg < 16; ++reg) { const int dv = dvb * 32 + (reg & 3) + 8 * (reg >> 2) + 4 * hh; KV[(size_t)dir * 8192 + dv * 64 + dkb * 32 + r] = a[reg]; } }
    }
    LDS_WAIT(); __syncthreads();
    { const int pb2 = wave >> 2, dvb = wave & 3; f32x16 a = {}; a = tile_mm<4>(Mm + (pb2 * 32) * 72, VT + (dvb * 32) * 72, r, hh, a);
      float* OI = WSP(float, WS_OINTRA) + (size_t)(t0 + pb2 * 32) * 768 + h * 128 + dvb * 32 + r;
#pragma unroll
      for (int reg = 0; reg < 16; ++reg) { const int p = (reg & 3) + 8 * (reg >> 2) + 4 * hh; OI[(size_t)p * 768] = a[reg]; } }
    __syncthreads();
}
__device__ __forceinline__ void gla_scan_witem(Frame& F, int item) {
    const int slice = item & 31, dir = (item >> 5) & 1, bh = item >> 6, b = bh / 6, h = bh % 6;
    const int e = slice * 256 + F.lane * 4, dk = e & 63;
    const float* KV = WSP(float, WS_KVC); const float* DC = WSP(float, WS_DECAY); bf16* ST = WSP(bf16, WS_ST);
    f32x4 st = {0.f, 0.f, 0.f, 0.f};
#pragma unroll 8
    for (int i = 0; i < 32; ++i) { const int n = dir ? 31 - i : i; const size_t it = (size_t)((b * 32 + n) * 6 + h) * 2 + dir;
        const f32x4 kv = *(const f32x4*)(KV + it * 8192 + e), dc = *(const f32x4*)(DC + it * 64 + dk);
        v2u w; w.x = pk2(st[0], st[1]); w.y = pk2(st[2], st[3]); *(v2u*)(ST + it * 8192 + e) = w;
        st = dc * st + kv; }
}
__device__ __forceinline__ void gla_c_task(Frame& F, int l, int task) {
    const int item = task >> 1, half = task & 1, h = item % 6, bn = item / 6, tk0 = bn * 64 + half * 32;
    const int r = F.lane & 31, hh = F.lane >> 5;
    const bf16* QD = WSP(bf16, WS_QDEC); const bf16* ST = WSP(bf16, WS_ST) + (size_t)item * 2 * 8192;
    bf16x8 af[2][4];
#pragma unroll
    for (int dir = 0; dir < 2; ++dir)
#pragma unroll
        for (int s = 0; s < 4; ++s) af[dir][s] = *(const bf16x8*)(QD + (size_t)dir * T * 384 + (size_t)(tk0 + r) * 384 + h * 64 + 16 * s + 8 * hh);
    f32x16 acc[4];
#pragma unroll
    for (int dvb = 0; dvb < 4; ++dvb) { acc[dvb] = f32x16{};
#pragma unroll
        for (int dir = 0; dir < 2; ++dir)
#pragma unroll
            for (int s = 0; s < 4; ++s) { const bf16x8 bfr = *(const bf16x8*)(ST + (size_t)dir * 8192 + (dvb * 32 + r) * 64 + 16 * s + 8 * hh);
                acc[dvb] = __builtin_amdgcn_mfma_f32_32x32x16_bf16(af[dir][s], bfr, acc[dvb], 0, 0, 0); } }
    LAS float* st = (LAS float*)(F.lds + F.wave * 16384);
    stage_write(st, acc, r, hh);
    LDS_WAIT(); asm volatile("" ::: "memory");
    float v[64]; stage_read(st, F.lane, v);
    const int row = F.lane >> 1, hf = F.lane & 1; const size_t t = (size_t)(tk0 + row);
    const float* OI = WSP(float, WS_OINTRA) + t * 768 + h * 128 + hf * 64;
    f32x4 oi[16];
#pragma unroll
    for (int j = 0; j < 16; ++j) oi[j] = *(const f32x4*)(OI + 4 * j);
    float ss = 0.f;
#pragma unroll
    for (int j = 0; j < 16; ++j) {
#pragma unroll
        for (int e2 = 0; e2 < 4; ++e2) { v[4 * j + e2] += oi[j][e2]; ss += v[4 * j + e2] * v[4 * j + e2]; } }
    ss += __shfl_xor(ss, 1);
    const float rstd = __builtin_amdgcn_rsqf(ss * (1.f / 128.f) + EPS);
    gated_store64(v, rstd, ld_in(11) + l * 128 + hf * 64, WSP(bf16, WS_PROJ) + t * NP + C_Z + h * 128 + hf * 64, WSP(bf16, WS_HY) + t * DM + 768 + h * 128 + hf * 64);
    LDS_WAIT(); asm volatile("" ::: "memory");
}
#define XB_TMO      128
#define XB_XCNT(j)  (256  + 64 * (j))
#define XB_XSUB(j)  (1280 + 64 * (j))
#define XB_XGEN(j)  (2304 + 64 * (j))
#define XB_TOP      3328
#define XB_TOPGEN   3392
#define XCD_BAR_WORDS 3456
#define XB_SPIN_CAP (1u << 18)
__device__ __forceinline__ unsigned xb_ld(unsigned* p)              { return __hip_atomic_load(p, __ATOMIC_RELAXED, __HIP_MEMORY_SCOPE_AGENT); }
__device__ __forceinline__ unsigned xb_add(unsigned* p, unsigned v) { return __hip_atomic_fetch_add(p, v, __ATOMIC_RELAXED, __HIP_MEMORY_SCOPE_AGENT); }
__device__ __forceinline__ unsigned xb_xcc_id() { return (unsigned)__builtin_amdgcn_s_getreg((3 << 11) | 20) & 0xFu; }
#define XB_SPIN(cond, bar) do { unsigned _sp = 0; while (cond) { __builtin_amdgcn_s_sleep(1); \
    if ((++_sp & 255u) == 0u) { if (xb_ld(&(bar)[XB_TMO])) break; if (_sp > XB_SPIN_CAP) { atomicAdd(&(bar)[XB_TMO], 1u); break; } } } } while (0)
struct XcdBarrier { unsigned* bar; unsigned x; volatile LAS unsigned* st; };
__device__ __forceinline__ XcdBarrier xcd_barrier_post(unsigned* bar, volatile LAS unsigned* st) {
    XcdBarrier b; b.bar = bar; b.x = xb_xcc_id(); b.st = st;
    if (threadIdx.x == 0) (void)xb_add(&bar[XB_XCNT(b.x)], 1u);
    return b;
}
__device__ __forceinline__ void xcd_barrier_complete(unsigned* bar, unsigned x, unsigned& nloc, unsigned& nx) {
    const unsigned G = gridDim.x * gridDim.y * gridDim.z;
    unsigned sum, cnt, mine, sp = 0u;
    for (;;) {
        sum = 0u; cnt = 0u; mine = 0u;
#pragma unroll
        for (unsigned j = 0; j < 16; ++j) { const unsigned c = xb_ld(&bar[XB_XCNT(j)]); sum += c; cnt += (c > 0u) ? 1u : 0u; mine = (j == x) ? c : mine; }
        if (sum == G) break;
        __builtin_amdgcn_s_sleep(1);
        if ((++sp & 255u) == 0u) { if (xb_ld(&bar[XB_TMO])) break; if (sp > XB_SPIN_CAP) { atomicAdd(&bar[XB_TMO], 1u); break; } }
    }
    nloc = mine > 0u ? mine : 1u; nx = cnt > 0u ? cnt : 1u;
}
__device__ __forceinline__ void xcd_barrier(const XcdBarrier& b) {
    asm volatile("s_waitcnt vmcnt(0)" ::: "memory");
    __syncthreads();
    if (threadIdx.x == 0) {
        unsigned* bar = b.bar;
        __builtin_amdgcn_s_waitcnt(0);
        unsigned nloc = b.st[0], nx = b.st[1];
        if (nloc == 0u) { xcd_barrier_complete(bar, b.x, nloc, nx); b.st[0] = nloc; b.st[1] = nx; }
        const unsigned old = xb_add(&bar[XB_XSUB(b.x)], 1u);
        const unsigned gen = old / nloc;
        if (old + 1u == (gen + 1u) * nloc) {
            __builtin_amdgcn_fence(__ATOMIC_RELEASE, "agent");
            asm volatile("s_waitcnt vmcnt(0)" ::: "memory");
            const unsigned og = xb_add(&bar[XB_TOP], 1u);
            const unsigned tg = og / nx;
            if (og + 1u == (tg + 1u) * nx) xb_add(&bar[XB_TOPGEN], 1u);
            else XB_SPIN(xb_ld(&bar[XB_TOPGEN]) == tg, bar);
            __builtin_amdgcn_fence(__ATOMIC_ACQUIRE, "agent");
            xb_add(&bar[XB_XGEN(b.x)], 1u);
            asm volatile("s_waitcnt vmcnt(0)" ::: "memory");
        } else {
            XB_SPIN(xb_ld(&bar[XB_XGEN(b.x)]) == gen, bar);
            __builtin_amdgcn_fence(__ATOMIC_ACQUIRE, "agent");
            asm volatile("s_waitcnt vmcnt(0)" ::: "memory");
        }
    }
    __syncthreads();
}

__device__ __forceinline__ void sub_barrier(unsigned* cnt, unsigned target) {
    asm volatile("s_waitcnt vmcnt(0)" ::: "memory");
    __syncthreads();
    if (threadIdx.x == 0) {
        __builtin_amdgcn_fence(__ATOMIC_RELEASE, "agent");
        asm volatile("s_waitcnt vmcnt(0)" ::: "memory");
        (void)xb_add(cnt, 1u);
        unsigned sp = 0u; while (xb_ld(cnt) < target) { __builtin_amdgcn_s_sleep(2); if (++sp > (1u << 22)) break; }
        __builtin_amdgcn_fence(__ATOMIC_ACQUIRE, "agent");
        asm volatile("s_waitcnt vmcnt(0)" ::: "memory");
    }
    __syncthreads();
}

struct Args { const float* in[21]; float* out; unsigned char* ws; int ph_lo, ph_hi; };
constexpr int N_PHASES = 2 + 6 * DEPTH;
__global__ void __launch_bounds__(NTHR, 2) mega_fwd(Args args) {
    extern __shared__ __attribute__((aligned(16))) unsigned char lds[];
    Frame F;
    F.lds = (LAS unsigned char*)lds; F.ldsg = (char*)lds;
    F.tid = threadIdx.x; F.lane = F.tid & 63; F.wave = __builtin_amdgcn_readfirstlane(F.tid >> 6);
    F.G = gridDim.x; { const int bx = blockIdx.x; F.vcu = (F.G % 8 == 0) ? (bx % 8) * (F.G / 8) + bx / 8 : bx; }
    F.out = args.out; F.ws = args.ws;
    volatile LAS unsigned* MISC = (volatile LAS unsigned*)(F.lds + MISC_OFF);
    for (int u = F.tid; u < (LDS_BYTES - LDSCTL_OFF) / 4; u += NTHR) ((LAS unsigned*)(F.lds + LDSCTL_OFF))[u] = 0u;
    __syncthreads();
    XcdBarrier bar = xcd_barrier_post((unsigned*)(F.ws + WS_CTL) + CW_BAR, MISC + 8);
    const int lo = args.ph_lo, hi = args.ph_hi;
#ifndef MK_MASK
#define MK_MASK 0xFF
#endif
#define PHON(b) ((MK_MASK >> (b)) & 1)
#ifndef MK_REP_PH
#define MK_REP_PH -1
#endif
#define REPS(ph) for (int rep_ = 0; rep_ < ((ph) == MK_REP_PH ? 2 : 1); ++rep_)
#define REPBAR() do { if (rep_ == 0 && false) {} } while (0)
#define IN(k) (lo <= (k) && (k) < hi)
#define FRESH() do { int t_ = threadIdx.x; asm volatile("" : "+v"(t_)); F.tid = t_; F.lane = t_ & 63; F.wave = __builtin_amdgcn_readfirstlane(t_ >> 6); GAS unsigned char* w_ = (GAS unsigned char*)args.ws; asm volatile("" : "+s"(w_)); F.ws = (unsigned char*)w_; GAS float* o_ = (GAS float*)args.out; asm volatile("" : "+s"(o_)); F.out = (float*)o_; } while (0)
#define SEAM(k) do { if (IN(k) && IN((k) + 1)) xcd_barrier(bar); } while (0)
    REPS(100) { if (PHON(0) && IN(0)) { p0_prologue(F, rep_ == 0 ? WS_MODS : (size_t)(1 * MiB)); } SEAM(0); }
    REPS(101) { if (PHON(1) && IN(1)) { modnorm_rows(F, ld_in(0), ld_in(5), WSP(float, WS_MODS), WSP(bf16, WS_HY)); } SEAM(1); }
#pragma unroll 1
    for (int l = 0; l < DEPTH; ++l) {
        const int pb = 2 + 6 * l;
#define mods_l (WSP(float, WS_MODS) + (size_t)l * BATCH * 3 * DM)
        REPS(0) { if (PHON(2) && IN(pb)) {
            FRESH();
            pg8::Gemm g{WSP(bf16, WS_HY), WSP(bf16, WS_WIN) + (size_t)l * NP * DM, T, NP, DM, DM}; pg8::StaticOrder S; S.init(T, NP, F.G, (int)blockIdx.x);
            EpiIn E{WSP(bf16, WS_PROJ), WSP(float, WS_CS), WSP(float, WS_SN), WSP(float, WS_PARTQ), WSP(float, WS_PARTKV)};
            pg8::gemm_phase<EpiIn, pg8::StaticOrder, true, true>(F.lds, g, S, E);
        } SEAM(pb); }
        REPS(1) { if (PHON(3) && IN(pb + 1)) {
#ifndef MK_SUB
#define MK_SUB 0xFF
#endif
            FRESH();
            if (MK_SUB & 1) { pg8::Gemm g{WSP(bf16, WS_PROJ) + C_MKV, WSP(bf16, WS_WUKV) + (size_t)l * NKV * 256, T, NKV, 256, NP}; pg8::StaticOrder S; S.init(T, NKV, F.G, (int)blockIdx.x);
              EpiUkv E{WSP(bf16, WS_KVUP), WSP(float, WS_PARTKV)};
              pg8::gemm_phase<EpiUkv, pg8::StaticOrder, true, true>(F.lds, g, S, E); }
            FRESH();
            if (MK_SUB & 2) { pg8::Gemm g{WSP(bf16, WS_PROJ) + C_MQ, WSP(bf16, WS_WUQ) + (size_t)l * NQ * 384, T, NQ, 384, NP}; pg8::StaticOrder S; S.init(T, NQ, F.G, ((int)blockIdx.x + 64) % F.G);
              EpiUq E{WSP(bf16, WS_QUP), WSP(float, WS_CS), WSP(float, WS_SN), WSP(float, WS_PARTQ)};
              pg8::gemm_phase<EpiUq, pg8::StaticOrder, true, true>(F.lds, g, S, E); }
            __syncthreads(); FRESH();
            if (MK_SUB & 4) for (int it = (int)blockIdx.x; it < NITEM; it += F.G) gla_a_item(F, l, it);
        } SEAM(pb + 1); }
        REPS(7) { if (PHON(3) && IN(pb + 2)) {
            FRESH();
            conv_rows(F, l);
            FRESH(); { const int gw = F.vcu * NWAVES + F.wave, NGW = F.G * NWAVES; for (int it = gw; it < 1536; it += NGW) gla_scan_witem(F, it); }
        } SEAM(pb + 2); }
        REPS(2) { if (PHON(4) && IN(pb + 3)) {
            const int bx = (int)blockIdx.x; FRESH();
            const int natt = F.G > 192 ? 192 : F.G;
            if (bx < natt) {
                for (int u = bx; u < 192; u += natt) { const int bh = u >> 3, qb = u & 7, b = bh / 6, h = bh % 6; const size_t row0 = (size_t)b * SEQ, qrow = row0 + qb * 256;
                    mla::attn_unit(WSP(bf16, WS_QUP) + qrow * NQ + h * 192, WSP(bf16, WS_KVUP) + row0 * NKV + h * 256, WSP(bf16, WS_KVUP) + row0 * NKV + h * 256 + 128,
                                   WSP(bf16, WS_PROJ) + row0 * NP + C_MKR, WSP(bf16, WS_HY) + qrow * DM + h * 128, WSP(bf16, WS_PROJ) + qrow * NP + C_Z + 768 + h * 128,
                                   ld_in(16) + l * 768 + h * 128, WSP(float, WS_PARTM) + qrow * 8 + h, SEQ, F.ldsg); }
            }
            if (F.G > 192) { if (bx >= 192) { const int gw = (bx - 192) * NWAVES + F.wave, NGW = (F.G - 192) * NWAVES; for (int rr_ = 0; rr_ < (MK_REP_PH == 8 ? 2 : 1); ++rr_) for (int task = gw; task < 2 * NITEM; task += NGW) gla_c_task(F, l, task); } }
            else { FRESH(); const int gw = F.vcu * NWAVES + F.wave, NGW = F.G * NWAVES; for (int task = gw; task < 2 * NITEM; task += NGW) gla_c_task(F, l, task); }
        } SEAM(pb + 3); }
        for (int rep_ = 0; rep_ < ((MK_REP_PH == 4 && l == 0) ? 2 : 1); ++rep_) { if (PHON(6) && IN(pb + 4)) {
            FRESH();
            pg8::Gemm g{WSP(bf16, WS_HY), WSP(bf16, WS_WOUT) + (size_t)l * DM * DM, T, DM, DM, DM}; pg8::StaticOrder S; S.init(T, DM, F.G, (int)blockIdx.x);
            if (F.G == 256 && MK_REP_PH != 4) {
                const int last = (l + 1 == DEPTH);
                EpiOutNorm E{l == 0 ? ld_in(0) : F.out, F.out, mods_l + 2 * DM, WSP(float, WS_PARTM), WSP(bf16, WS_HY), last ? ld_in(20) : ld_in(5) + (l + 1) * DM,
                             mods_l + (size_t)BATCH * 3 * DM, WSP(float, WS_XS), (unsigned*)(F.ws + WS_CTL) + CW_PANEL + 64 * 32 * l, 32u, last};
                pg8::gemm_phase<EpiOutNorm, pg8::StaticOrder, true, true>(F.lds, g, S, E);
            } else {
                EpiOut E{l == 0 ? ld_in(0) : F.out, F.out, mods_l + 2 * DM, WSP(float, WS_PARTM)};
                pg8::gemm_phase<EpiOut, pg8::StaticOrder, true, true>(F.lds, g, S, E);
            }
        } if (!(F.G == 256 && MK_REP_PH != 4 && l + 1 == DEPTH)) SEAM(pb + 4); }
        if (!(F.G == 256 && MK_REP_PH != 4)) {
        for (int rep_ = 0; rep_ < ((MK_REP_PH == 5 && l == 0) ? 2 : 1); ++rep_) { if (PHON(7) && IN(pb + 5)) {
            FRESH();
            if (l + 1 < DEPTH) modnorm_rows(F, F.out, ld_in(5) + (l + 1) * DM, mods_l + (size_t)BATCH * 3 * DM, WSP(bf16, WS_HY));
            else finalnorm_rows(F, F.out, ld_in(20));
        } SEAM(pb + 5); }
        }
        if (MK_REP_PH == 6) { for (int r_ = 0; r_ < 4; ++r_) xcd_barrier(bar); }
    }
#undef mods_l
#undef IN
#undef SEAM
}

#ifndef MK_CUT
#define MK_CUT 14
#endif
#if MK_CUT < 14
__global__ void glue_proj(const bf16* P, float* proj, float* y, int row0) {
    const int t = blockIdx.x; const bf16* p = P + (size_t)(row0 + t) * NP;
    for (int c = threadIdx.x; c < NP; c += 256) { const float v = bf2f(p[c]);
        if (c < C_MKV) proj[(size_t)t * nv::PW + c] = v;
        else if (c < C_MQ) proj[(size_t)t * nv::PW + nv::O_MKV + (c - C_MKV)] = v;
        else if (c < C_MKR) proj[(size_t)t * nv::PW + nv::O_MQ + (c - C_MQ)] = v;
        else if (c < C_LR) { const int j = c - C_MKR; proj[(size_t)t * nv::PW + nv::O_MKR + (j & 1) * 32 + (j >> 1)] = v; }
        else if (c < C_LR + 32) proj[(size_t)t * nv::PW + nv::O_LR + (c - C_LR)] = v;
        else if (c < C_CB) {}
        else if (c < C_Z) proj[(size_t)t * nv::PW + nv::O_CB + (c - C_CB)] = v;
        else y[(size_t)t * DM + (c - C_Z)] = v; }
}
__global__ void glue_qkv(const bf16* Q, const bf16* KV, float* qm, float* kv, int row0) {
    const int t = blockIdx.x;
    for (int c = threadIdx.x; c < 1152; c += 256) { const float v = bf2f(Q[(size_t)(row0 + t) * NQ + c]) * (1.f / QSCALE); const int h = c / 192, d = c % 192;
        if (d < 128) qm[(size_t)t * 1152 + c] = v; else { const int j = d - 128; qm[(size_t)t * 1152 + h * 192 + 128 + (j & 1) * 32 + (j >> 1)] = v; } }
    for (int c = threadIdx.x; c < 1536; c += 256) kv[(size_t)t * 1536 + c] = bf2f(KV[(size_t)(row0 + t) * NKV + c]);
}
__global__ void glue_y(const bf16* Y, float* y, int row0) {
    const int t = blockIdx.x; for (int c = threadIdx.x; c < DM; c += 256) { const int cr = c < 768 ? c + 768 : (c < 1536 ? c - 768 : c); y[(size_t)t * DM + cr] = bf2f(Y[(size_t)(row0 + t) * DM + c]); }
}
__global__ void glue_h(const bf16* H, float* h, int row0) {
    const int t = blockIdx.x; for (int c = threadIdx.x; c < DM; c += 256) h[(size_t)t * DM + c] = bf2f(H[(size_t)(row0 + t) * DM + c]);
}

#endif
#ifndef MK_NAIVE_BASE_MIB
#define MK_NAIVE_BASE_MIB 240
#endif
extern "C" void kernel_launch(void* const* d_in, const int* in_sizes, int n_in, void* d_out, int out_size, void* d_ws, size_t ws_size, hipStream_t stream) {
    static int grid = 0;
    if (grid == 0) {
        if (n_in != 21 || out_size != T * DM || in_sizes[0] != T * DM || ws_size < WS_END) { fprintf(stderr, "kernel_launch: unexpected shapes n_in %d out %d ws %zu\n", n_in, out_size, ws_size); grid = -1; return; }
        int dev = 0, cus = 0, per_cu = 0;
        if (hipGetDevice(&dev) != hipSuccess || hipDeviceGetAttribute(&cus, hipDeviceAttributeMultiprocessorCount, dev) != hipSuccess) { grid = -1; return; }
        if (hipFuncSetAttribute((const void*)mega_fwd, hipFuncAttributeMaxDynamicSharedMemorySize, LDS_BYTES) != hipSuccess) { fprintf(stderr, "kernel_launch: hipFuncSetAttribute failed\n"); grid = -1; return; }
        if (hipOccupancyMaxActiveBlocksPerMultiprocessor(&per_cu, (const void*)mega_fwd, NTHR, LDS_BYTES) != hipSuccess || per_cu < 1) { fprintf(stderr, "kernel_launch: occupancy query says %d blocks/CU\n", per_cu); grid = -1; (void)hipGetLastError(); return; }
        grid = cus;
    }
    if (grid < 0) return;
    (void)hipMemsetAsync((char*)d_ws + WS_CTL, 0, CTL_ZERO_BYTES, stream);
    Args a{};
    for (int i = 0; i < 21; ++i) a.in[i] = (const float*)d_in[i];
    a.out = (float*)d_out; a.ws = (unsigned char*)d_ws; a.ph_lo = 0; a.ph_hi = MK_CUT < N_PHASES ? MK_CUT : N_PHASES;
    hipLaunchKernelGGL(mega_fwd, dim3(grid), dim3(NTHR), LDS_BYTES, stream, a);
#if MK_CUT < 14
    {
        char* ws = (char*)d_ws; float* out = (float*)d_out; const float* x = (const float*)d_in[0];
        const float* mods = (const float*)(ws + WS_MODS); const float* cs = (const float*)(ws + WS_CS); const float* sn = (const float*)(ws + WS_SN);
        nv::Buf B = nv::carve(ws + (size_t)MK_NAIVE_BASE_MIB * MiB);
        const int l0 = (MK_CUT - 2) / 6, ph = (MK_CUT - 2) % 6;
        for (int l = l0; l < DEPTH; ++l)
            for (int b = 0; b < BATCH; ++b) {
                const int row0 = b * SEQ; int entry = 0; const float* xin = (l == 0 ? x : out) + (size_t)row0 * DM; float* xo = out + (size_t)row0 * DM;
                if (l == l0) {
                    if (ph >= 1 && ph <= 3) { glue_proj<<<SEQ, 256, 0, stream>>>((const bf16*)(ws + WS_PROJ), B.proj, B.y, row0); entry = 1; }
                    if (ph == 2) { glue_qkv<<<SEQ, 256, 0, stream>>>((const bf16*)(ws + WS_QUP), (const bf16*)(ws + WS_KVUP), nv::sc_qm(B), nv::sc_kv(B), row0); entry = 2; }
                    if (ph == 3) { hipMemcpyAsync(nv::sc_omla(B), ws + WS_OMLA + (size_t)row0 * 768 * 4, (size_t)SEQ * 768 * 4, hipMemcpyDeviceToDevice, stream); entry = 4; }
                    if (ph == 4) { glue_y<<<SEQ, 256, 0, stream>>>((const bf16*)(ws + WS_HY), B.y, row0); entry = 3; }
                    if (ph == 5) continue;
                }
                nv::layer_batch(d_in, l, b, entry, xin, xo, mods, cs, sn, B, stream);
            }
        nv::k_rms<<<T, 256, 0, stream>>>(out, DM, DM, (const float*)d_in[20], out, DM);
    }
#endif
}
```

```cpp
#include <hip/hip_runtime.h>
#include <cstdio>
#include <cstdint>
#define MK_CUT 14
#define MK_NAIVE_BASE_MIB 240
#define MK_REP_PH -1
namespace pg8 {
#define PG8_LAS __attribute__((address_space(3)))
typedef unsigned short bf16_t;
typedef short bf16x8 __attribute__((ext_vector_type(8)));
typedef float f32x4 __attribute__((ext_vector_type(4)));
typedef unsigned u32x4 __attribute__((ext_vector_type(4)));
constexpr int BM = 256, BK = 64, HALF = 128, HTB = HALF * BK * 2, STAGE_BYTES = 8 * HTB, NXCD = 8, WGM = 8;

__host__ __device__ __forceinline__ int lds_byte(int r, int c) { const int st = (r >> 4) * 2 + (c >> 5), rr = r & 15, cc = c & 31, ob = rr * 64 + cc * 2; return st * 1024 + (ob ^ (((ob >> 9) & 1) << 5)); }
__host__ __device__ __forceinline__ void stage_rc(int b, int& R, int& C) { const int st = b / 1024, sb = b % 1024, swz = sb ^ (((sb >> 9) & 1) << 5); R = (st >> 1) * 16 + swz / 64; C = (st & 1) * 32 + (swz % 64) / 2; }
__host__ __device__ __forceinline__ int perm32(int rho) { const int n = rho >> 4, i = rho & 15; return 8 * (i >> 2) + 4 * n + (i & 3); }

struct Unit { int pm, pn; };
struct Gemm { const bf16_t* A; const bf16_t* Bt; int M, N, K, lda; };

struct StaticOrder {
    int nM, nN, nwg, G, c;
    __host__ __device__ void init(int M, int N, int G_, int c_) { nM = M / BM; nN = N / BM; nwg = nM * nN; G = G_; c = c_; }
    __host__ __device__ __forceinline__ bool next(int i, Unit& u) const {
        const long L = (long)i * G + c; if (L >= nwg) return false;
        int wgid = (int)L; { const int q = nwg / NXCD, r = nwg % NXCD, xcd = wgid % NXCD, off = wgid / NXCD; wgid = (xcd < r ? xcd * (q + 1) : r * (q + 1) + (xcd - r) * q) + off; }
        const int nig = WGM * nN, gid = wgid / nig, fm = gid * WGM, gsz = (nM - fm) < WGM ? (nM - fm) : WGM;
        u.pm = fm + ((wgid % nig) % gsz); u.pn = (wgid % nig) / gsz; return true;
    }
    __device__ __forceinline__ void a_ready(const Unit&) const {}
    __device__ __forceinline__ void done(const Unit&) const {}
};

__device__ __forceinline__ unsigned cvt_pk_bf16(float lo, float hi) { unsigned r; asm volatile("v_cvt_pk_bf16_f32 %0, %1, %2" : "=v"(r) : "v"(lo), "v"(hi)); return r; }

template <class Epi, class Sched, bool ALIGN_EPI = false, bool SP2 = false>
__device__ __forceinline__ void gemm_phase(PG8_LAS unsigned char* lds, const Gemm g, const Sched& S, const Epi& E) {
    int tid_ = threadIdx.x; asm volatile("" : "+v"(tid_));
    const int tid = tid_, wid = __builtin_amdgcn_readfirstlane(tid >> 6), lane = tid & 63, wr = wid >> 2, wc = wid & 3, fr = lane & 15, fq = lane >> 4;
    int K_ = g.K, lda_ = g.lda; asm volatile("" : "+s"(K_), "+s"(lda_));
    const int K = K_, nt = K / BK, lda = lda_;
    unsigned voffA[2], voffB[2];
#pragma unroll
    for (int i = 0; i < 2; ++i) { int R, C; stage_rc(tid * 16 + i * 8192, R, C); const int Rb = Epi::PERM ? ((R & ~31) + perm32(R & 31)) : R;
        voffA[i] = (unsigned)(R * lda + C) * 2u; voffB[i] = (unsigned)(Rb * K + C) * 2u; }
    const size_t kstep = (size_t)(BK * 2);
    const size_t hstepA = (size_t)HALF * lda * 2, hstepB = (size_t)HALF * K * 2;
    const size_t tstepA = 2 * hstepA, tstepB = 2 * hstepB;
    const unsigned ldsw = (unsigned)wid * 1024u;
    const int aoff = lds_byte(wr * 64 + fr, fq * 8), boff = lds_byte(wc * 32 + fr, fq * 8);
#define PG8_SA(b, h) (((b) * 2 + (h)) * HTB)
#define PG8_SB(b, h) ((4 + (b) * 2 + (h)) * HTB)
#define PG8_STAGE(bufoff, gbase, voff) do { _Pragma("unroll") for (int _i = 0; _i < 2; ++_i) \
        __builtin_amdgcn_global_load_lds((const unsigned*)((const char*)(gbase) + (voff)[_i]), (PG8_LAS unsigned*)(lds + (bufoff) + ldsw + _i * 8192), 16, 0, 0); } while (0)
#define PG8_LDA(dst, b, h) do { _Pragma("unroll") for (int m = 0; m < 4; ++m) _Pragma("unroll") for (int k = 0; k < 2; ++k) dst[m][k] = *(const PG8_LAS bf16x8*)(lds + PG8_SA(b, h) + aoff + m * 2048 + k * 1024); } while (0)
#define PG8_LDB(dst, b, h) do { _Pragma("unroll") for (int n = 0; n < 2; ++n) _Pragma("unroll") for (int k = 0; k < 2; ++k) dst[n][k] = *(const PG8_LAS bf16x8*)(lds + PG8_SB(b, h) + boff + n * 2048 + k * 1024); } while (0)
#define PG8_MMA(ai, bj, At, Bt) do { __builtin_amdgcn_s_setprio(1); _Pragma("unroll") for (int m = 0; m < 4; ++m) _Pragma("unroll") for (int n = 0; n < 2; ++n) _Pragma("unroll") for (int k = 0; k < 2; ++k) \
        acc[ai][bj][m][n] = __builtin_amdgcn_mfma_f32_16x16x32_bf16(Bt[n][k], At[m][k], acc[ai][bj][m][n], 0, 0, 0); __builtin_amdgcn_s_setprio(0); } while (0)
#define PG8_WAIT_V(n) asm volatile("s_waitcnt vmcnt(" #n ")" ::: "memory")
#define PG8_WAIT_L(n) asm volatile("s_waitcnt lgkmcnt(" #n ")" ::: "memory")
#define PG8_BAR __builtin_amdgcn_s_barrier()
#define PG8_SCHED __builtin_amdgcn_sched_barrier(0)
    Unit cur, nxt; int ui = 0;
    if (!S.next(0, cur)) return;
    f32x4 acc[2][2][4][2];
#pragma unroll
    for (int a = 0; a < 2; ++a)
#pragma unroll
        for (int b = 0; b < 2; ++b)
#pragma unroll
            for (int m = 0; m < 4; ++m)
#pragma unroll
                for (int n = 0; n < 2; ++n) acc[a][b][m][n] = (f32x4){0.f, 0.f, 0.f, 0.f};
    bf16x8 At[4][2], B0[2][2], B1[2][2];
    const char* cA = (const char*)g.A + (size_t)cur.pm * tstepA; const char* cB = (const char*)g.Bt + (size_t)cur.pn * tstepB;
    S.a_ready(cur);
    if constexpr (SP2) {
        PG8_STAGE(PG8_SB(0, 0), cB, voffB); PG8_STAGE(PG8_SB(0, 1), cB + hstepB, voffB); PG8_STAGE(PG8_SA(0, 0), cA, voffA); PG8_STAGE(PG8_SA(0, 1), cA + hstepA, voffA);
        if (wr == 1) PG8_BAR;
        PG8_WAIT_V(2); PG8_BAR;
        PG8_STAGE(PG8_SB(1, 0), cB + kstep, voffB); PG8_STAGE(PG8_SA(1, 0), cA + kstep, voffA); PG8_STAGE(PG8_SB(1, 1), cB + hstepB + kstep, voffB);
        PG8_WAIT_V(6); PG8_BAR;
    } else {
        PG8_STAGE(PG8_SB(0, 0), cB, voffB); PG8_STAGE(PG8_SA(0, 0), cA, voffA); PG8_STAGE(PG8_SB(0, 1), cB + hstepB, voffB); PG8_STAGE(PG8_SA(0, 1), cA + hstepA, voffA);
        if (wr == 1) PG8_BAR;
        PG8_WAIT_V(4); PG8_BAR;
        PG8_STAGE(PG8_SB(1, 0), cB + kstep, voffB); PG8_STAGE(PG8_SA(1, 0), cA + kstep, voffA); PG8_STAGE(PG8_SB(1, 1), cB + hstepB + kstep, voffB);
        PG8_WAIT_V(6); PG8_BAR;
    }
    for (;;) {
        const bool has_next = S.next(ui + 1, nxt);
        const char* nA = has_next ? (const char*)g.A + (size_t)nxt.pm * tstepA : cA; const char* nB = has_next ? (const char*)g.Bt + (size_t)nxt.pn * tstepB : cB;
        for (int t = 0; t < nt; t += 2) {
            const bool last = (t == nt - 2);
            const char* a1 = cA + (size_t)(t + 1) * kstep;
            const char* a2 = last ? nA : cA + (size_t)(t + 2) * kstep; const char* b2 = last ? nB : cB + (size_t)(t + 2) * kstep;
            const char* a3 = a2 + kstep; const char* b3 = b2 + kstep;
            if (last && has_next) S.a_ready(nxt);
            if constexpr (SP2) {
            PG8_LDB(B0, 0, 0); PG8_LDB(B1, 0, 1); PG8_SCHED; PG8_LDA(At, 0, 0); PG8_STAGE(PG8_SA(1, 1), a1 + hstepA, voffA);
            PG8_WAIT_V(8); PG8_WAIT_L(0); PG8_BAR; PG8_MMA(0, 0, At, B0); PG8_MMA(0, 1, At, B1); PG8_BAR; PG8_SCHED;
            PG8_LDA(At, 0, 1); PG8_STAGE(PG8_SB(0, 0), b2, voffB); PG8_STAGE(PG8_SB(0, 1), b2 + hstepB, voffB); PG8_STAGE(PG8_SA(0, 0), a2, voffA);
            PG8_WAIT_V(8); PG8_WAIT_L(0); PG8_BAR; PG8_MMA(1, 0, At, B0); PG8_MMA(1, 1, At, B1); PG8_BAR; PG8_SCHED;
            PG8_LDB(B0, 1, 0); PG8_LDB(B1, 1, 1); PG8_SCHED; PG8_LDA(At, 1, 0); PG8_STAGE(PG8_SA(0, 1), a2 + hstepA, voffA);
            PG8_WAIT_V(8); PG8_WAIT_L(0); PG8_BAR; PG8_MMA(0, 0, At, B0); PG8_MMA(0, 1, At, B1); PG8_BAR; PG8_SCHED;
            PG8_LDA(At, 1, 1); PG8_STAGE(PG8_SB(1, 0), b3, voffB); PG8_STAGE(PG8_SB(1, 1), b3 + hstepB, voffB); PG8_STAGE(PG8_SA(1, 0), a3, voffA);
            PG8_WAIT_V(8); PG8_WAIT_L(0); PG8_BAR; PG8_MMA(1, 0, At, B0); PG8_MMA(1, 1, At, B1); PG8_BAR; PG8_SCHED;
            if constexpr (Epi::HOOK_T > 0) { if (t + 2 == Epi::HOOK_T) E.hook(acc, cur, wr, wc, fr, fq); }
            } else {
            PG8_LDB(B0, 0, 0); PG8_SCHED; PG8_LDA(At, 0, 0); PG8_STAGE(PG8_SA(1, 1), a1 + hstepA, voffA);
            PG8_WAIT_L(8); PG8_BAR; PG8_WAIT_L(0); PG8_MMA(0, 0, At, B0); PG8_BAR; PG8_SCHED;
            PG8_LDB(B1, 0, 1); PG8_STAGE(PG8_SB(0, 0), b2, voffB);
            PG8_BAR; PG8_WAIT_L(0); PG8_MMA(0, 1, At, B1); PG8_BAR;
            PG8_LDA(At, 0, 1); PG8_STAGE(PG8_SA(0, 0), a2, voffA);
            PG8_BAR; PG8_WAIT_L(0); PG8_MMA(1, 0, At, B0); PG8_BAR; PG8_SCHED;
            PG8_STAGE(PG8_SB(0, 1), b2 + hstepB, voffB);
            PG8_WAIT_V(6); PG8_BAR; PG8_MMA(1, 1, At, B1); PG8_BAR;
            PG8_LDB(B0, 1, 0); PG8_SCHED; PG8_LDA(At, 1, 0); PG8_STAGE(PG8_SA(0, 1), a2 + hstepA, voffA);
            PG8_WAIT_L(8); PG8_BAR; PG8_WAIT_L(0); PG8_MMA(0, 0, At, B0); PG8_BAR; PG8_SCHED;
            PG8_LDB(B1, 1, 1); PG8_STAGE(PG8_SB(1, 0), b3, voffB);
            PG8_BAR; PG8_WAIT_L(0); PG8_MMA(0, 1, At, B1); PG8_BAR;
            PG8_LDA(At, 1, 1); PG8_STAGE(PG8_SA(1, 0), a3, voffA);
            PG8_BAR; PG8_WAIT_L(0); PG8_MMA(1, 0, At, B0); PG8_BAR; PG8_SCHED;
            PG8_STAGE(PG8_SB(1, 1), b3 + hstepB, voffB);
            PG8_WAIT_V(6); PG8_BAR; PG8_MMA(1, 1, At, B1); PG8_BAR;
            }
        }
        if constexpr (ALIGN_EPI) { if (wr == 0) PG8_BAR; }
        if constexpr (!Epi::AFTER_DRAIN) { E(acc, cur, wr, wc, fr, fq); S.done(cur); }
        if (!has_next) break;
#pragma unroll
        for (int a = 0; a < 2; ++a)
#pragma unroll
            for (int b = 0; b < 2; ++b)
#pragma unroll
                for (int m = 0; m < 4; ++m)
#pragma unroll
                    for (int n = 0; n < 2; ++n) acc[a][b][m][n] = (f32x4){0.f, 0.f, 0.f, 0.f};
        cur = nxt; cA = nA; cB = nB; ++ui;
        if constexpr (ALIGN_EPI) { if (wr == 1) PG8_BAR; }
    }
    PG8_WAIT_V(0);
    if constexpr (!ALIGN_EPI) { if (wr == 0) PG8_BAR; }
    PG8_BAR;
    if constexpr (Epi::AFTER_DRAIN) { E.fused(acc, cur, wr, wc, fr, fq, lds, wid, lane); S.done(cur); }
#undef PG8_SA
#undef PG8_SB
#undef PG8_STAGE
#undef PG8_LDA
#undef PG8_LDB
#undef PG8_MMA
#undef PG8_WAIT_V
#undef PG8_WAIT_L
#undef PG8_BAR
#undef PG8_SCHED
}
}
#define GAS __attribute__((address_space(1)))
#define LAS __attribute__((address_space(3)))
typedef unsigned short bf16;
typedef unsigned v4u __attribute__((ext_vector_type(4)));
typedef unsigned v2u __attribute__((ext_vector_type(2)));
typedef float f32x4 __attribute__((ext_vector_type(4)));
typedef float f32x16 __attribute__((ext_vector_type(16)));
typedef short bf16x8 __attribute__((ext_vector_type(8)));
typedef short s16x4 __attribute__((ext_vector_type(4)));
typedef GAS unsigned gu32;

constexpr int NWAVES = 8, NTHR = 512;
constexpr int BATCH = 4, SEQ = 2048, DM = 2048, T = BATCH * SEQ, DEPTH = 2, IN_DIM = 5856;
constexpr int NP = 5888;
constexpr int C_GQ = 0, C_GK = 384, C_GV = 768, C_MKV = 1536, C_MQ = 1792, C_MKR = 2176, C_LR = 2240, C_CB = 2304, C_CC = 2816, C_CX = 3328, C_Z = 3840;
constexpr int R_GQ = 0, R_GK = 384, R_GV = 768, R_LR = 1536, R_MQ = 1568, R_MKV = 1952, R_MKR = 2208, R_CB = 2272, R_CC = 2784, R_CX = 3296, R_Z = 3808;
constexpr int NQ = 1280, NKV = 1536;
constexpr float EPS = 1e-6f;
constexpr float QSCALE = 0.07216878364870322f * 1.4426950408889634f;
constexpr int NITEM = BATCH * 32 * 6;

constexpr size_t MiB = 1u << 20;
constexpr size_t WS_CTL = 0, CTL_ZERO_BYTES = 1 * MiB;
constexpr size_t WS_MODS = 256 * 1024;
constexpr size_t WS_CS = 2 * MiB, WS_SN = 3 * MiB;
constexpr size_t WS_WUQ = 4 * MiB;
constexpr size_t WS_WUKV = 6 * MiB;
constexpr size_t WS_WOUT = 8 * MiB;
constexpr size_t WS_WIN = 24 * MiB;
constexpr size_t WS_HY = 70 * MiB;
constexpr size_t WS_PROJ = 102 * MiB;
constexpr size_t WS_QUP = 194 * MiB;
constexpr size_t WS_KVUP = 214 * MiB;
constexpr size_t WS_X1B = 238 * MiB;
constexpr size_t WS_OMLA = 238 * MiB;
constexpr size_t WS_OINTRA = 270 * MiB;
constexpr size_t WS_KVC = 294 * MiB;
constexpr size_t WS_ST = 318 * MiB;
constexpr size_t WS_QDEC = 342 * MiB;
constexpr size_t WS_DECAY = 354 * MiB;
constexpr size_t WS_PARTQ = 355 * MiB;
constexpr size_t WS_PARTKV = 355 * MiB + 512 * 1024;
constexpr size_t WS_ROWSS = 512 * 1024;
constexpr size_t WS_PARTM = 355 * MiB + 768 * 1024;
constexpr size_t WS_XS = 1 * MiB;
constexpr int CW_PANEL = 8192;
constexpr size_t WS_PO = 356 * MiB;
constexpr size_t WS_PML = 368 * MiB;
constexpr size_t WS_END = 369 * MiB;
constexpr int CW_BAR = 4096;

constexpr int RING_BYTES = 131072, LDSCTL_OFF = RING_BYTES, MISC_OFF = LDSCTL_OFF + 320, LDS_BYTES = 147456;

#define LDS_WAIT() asm volatile("s_waitcnt lgkmcnt(0)" ::: "memory")
#define VM_WAIT() asm volatile("s_waitcnt vmcnt(0)" ::: "memory")
__device__ __forceinline__ unsigned f2bf(float f) { unsigned u = __builtin_bit_cast(unsigned, f); return (u + 0x7fffu + ((u >> 16) & 1u)) >> 16; }
typedef float f32x2_t __attribute__((ext_vector_type(2))); typedef __bf16 bf16x2_t __attribute__((ext_vector_type(2)));
__device__ __forceinline__ unsigned pk2(float lo, float hi) { f32x2_t v = {lo, hi}; bf16x2_t b = __builtin_convertvector(v, bf16x2_t); return __builtin_bit_cast(unsigned, b); }
__device__ __forceinline__ unsigned pk2a(float lo, float hi) { return pg8::cvt_pk_bf16(lo, hi); }
__device__ __forceinline__ float bf2f(unsigned short h) { return __builtin_bit_cast(float, (unsigned)h << 16); }
__device__ __forceinline__ float bflo(unsigned w) { return __builtin_bit_cast(float, w << 16); }
__device__ __forceinline__ float bfhi(unsigned w) { return __builtin_bit_cast(float, w & 0xffff0000u); }
#ifndef MK_FUSE_Y
#define MK_FUSE_Y 1
#endif
constexpr int CW_YREADY = 24576;
#ifndef MK_SILU_IN_EPI
#define MK_SILU_IN_EPI 1
#endif
__device__ __forceinline__ float silu_fast(float v) { return v * __builtin_amdgcn_rcpf(1.f + __expf(-v)); }
__device__ __forceinline__ float wave_sum(float v) {
#pragma unroll
    for (int o = 1; o < 64; o <<= 1) v += __shfl_xor(v, o);
    return v;
}

__device__ __forceinline__ int map_in(int n) {
    if (n < C_MKV) return n;
    if (n < C_MQ) return R_MKV + (n - C_MKV);
    if (n < C_MKR) return R_MQ + (n - C_MQ);
    if (n < C_LR) { const int j = n - C_MKR; return R_MKR + (j & 1) * 32 + (j >> 1); }
    if (n < C_LR + 32) return R_LR + (n - C_LR);
    if (n < C_CB) return -1;
    if (n < C_Z) return R_CB + (n - C_CB);
    return R_Z + (n - C_Z);
}
__device__ __forceinline__ int map_uq(int n) {
    if (n >= 1152) return -1;
    const int h = n / 192, d = n % 192;
    if (d < 128) return n;
    const int j = d - 128; return h * 192 + 128 + (j & 1) * 32 + (j >> 1);
}

__device__ __forceinline__ void st_wt16(bf16* p, v4u v) { asm volatile("global_store_dwordx4 %0, %1, off sc1\n\ts_nop 1" :: "v"((GAS bf16*)p), "v"(v) : "memory"); }
struct EpiIn {
    static constexpr bool PERM = true, AFTER_DRAIN = false; static constexpr int HOOK_T = 0;
    bf16* O; const float* cs; const float* sn; float* partq; float* partkv;
    __device__ __forceinline__ void operator()(const f32x4 (&acc)[2][2][4][2], const pg8::Unit& u, int wr, int wc, int fr, int fq) const {
        const int pn = u.pn, row0 = u.pm * 256 + wr * 64 + fr, col0 = pn * 256 + wc * 32 + 8 * fq;
        const bool stat = (pn >= 6 && pn <= 8);
#pragma unroll
        for (int ai = 0; ai < 2; ++ai)
#pragma unroll
            for (int m = 0; m < 4; ++m) {
                const int row = row0 + ai * 128 + m * 16; bf16* rowp = O + (size_t)row * NP + col0; float ss = 0.f;
#pragma unroll
                for (int bj = 0; bj < 2; ++bj) {
                    f32x4 v0 = acc[ai][bj][m][0], v1 = acc[ai][bj][m][1]; const int c = col0 + bj * 128;
                    if (MK_SILU_IN_EPI && pn >= 15) {
#pragma unroll
                        for (int e = 0; e < 4; ++e) { v0[e] = silu_fast(v0[e]); v1[e] = silu_fast(v1[e]); }
                    } else if (pn == 8 && bj == 1 && c < C_LR) {
                        const int i0 = (c - C_MKR) >> 1; const f32x4 cc = *(const f32x4*)(cs + (size_t)row * 32 + i0), sv = *(const f32x4*)(sn + (size_t)row * 32 + i0);
                        f32x4 a0, a1;
                        a0[0] = v0[0] * cc[0] - v0[1] * sv[0]; a0[1] = v0[1] * cc[0] + v0[0] * sv[0]; a0[2] = v0[2] * cc[1] - v0[3] * sv[1]; a0[3] = v0[3] * cc[1] + v0[2] * sv[1];
                        a1[0] = v1[0] * cc[2] - v1[1] * sv[2]; a1[1] = v1[1] * cc[2] + v1[0] * sv[2]; a1[2] = v1[2] * cc[3] - v1[3] * sv[3]; a1[3] = v1[3] * cc[3] + v1[2] * sv[3];
                        v0 = a0; v1 = a1;
                    }
                    if (stat && (pn != 8 || bj == 0)) ss += (v0[0] * v0[0] + v0[1] * v0[1]) + (v0[2] * v0[2] + v0[3] * v0[3]) + (v1[0] * v1[0] + v1[1] * v1[1]) + (v1[2] * v1[2] + v1[3] * v1[3]);
                    v4u w; w.x = pk2a(v0[0], v0[1]); w.y = pk2a(v0[2], v0[3]); w.z = pk2a(v1[0], v1[1]); w.w = pk2a(v1[2], v1[3]);
                    *(v4u*)(rowp + bj * 128) = w;
                }
                asm volatile("" ::: "memory");
                if (stat) { ss += __shfl_xor(ss, 16); ss += __shfl_xor(ss, 32);
                    if (fq == 0) { if (pn == 6) partkv[(size_t)row * 4 + wc] = ss; else partq[(size_t)row * 8 + (pn - 7) * 4 + wc] = ss; } }
            }
    }
};
struct EpiUq {
    static constexpr bool PERM = true, AFTER_DRAIN = false; static constexpr int HOOK_T = 0;
    bf16* O; const float* cs; const float* sn; const float* partq;
    __device__ __forceinline__ void operator()(const f32x4 (&acc)[2][2][4][2], const pg8::Unit& u, int wr, int wc, int fr, int fq) const {
        const int row0 = u.pm * 256 + wr * 64 + fr, col0 = u.pn * 256 + wc * 32 + 8 * fq;
        float rs[2][4];
#pragma unroll
        for (int ai = 0; ai < 2; ++ai) {
            f32x4 pq0[4], pq1[4];
#pragma unroll
            for (int m = 0; m < 4; ++m) { const int row = row0 + ai * 128 + m * 16; pq0[m] = *(const GAS f32x4*)(partq + (size_t)row * 8); pq1[m] = *(const GAS f32x4*)(partq + (size_t)row * 8 + 4); }
            const int d0_ = col0 % 192, d1_ = (col0 + 128) % 192; const int rbj = d0_ >= 128 ? 0 : ((d1_ >= 128 && col0 + 128 < 1152) ? 1 : -1), ri0 = ((rbj == 0 ? d0_ : d1_) - 128) >> 1;
            f32x4 rcc[4], rsv[4];
            if (rbj >= 0) {
#pragma unroll
                for (int m = 0; m < 4; ++m) { const int row = row0 + ai * 128 + m * 16; rcc[m] = *(const GAS f32x4*)(cs + (size_t)row * 32 + ri0); rsv[m] = *(const GAS f32x4*)(sn + (size_t)row * 32 + ri0); } }
            __builtin_amdgcn_sched_barrier(0);
#pragma unroll
            for (int m = 0; m < 4; ++m) { const f32x4 p0 = pq0[m], p1 = pq1[m];
                rs[ai][m] = __builtin_amdgcn_rsqf(((p0[0] + p0[1]) + (p0[2] + p0[3]) + (p1[0] + p1[1]) + (p1[2] + p1[3])) * (1.f / 384.f) + EPS) * QSCALE; }
#pragma unroll
            for (int m = 0; m < 4; ++m) {
                const int row = row0 + ai * 128 + m * 16; bf16* rowp = O + (size_t)row * NQ + col0;
#pragma unroll
                for (int bj = 0; bj < 2; ++bj) {
                    const int c = col0 + bj * 128; if (c >= 1152) continue;
                    f32x4 v0 = acc[ai][bj][m][0] * rs[ai][m], v1 = acc[ai][bj][m][1] * rs[ai][m];
                    if (bj == rbj) {
                        const f32x4 cc = rcc[m], sv = rsv[m];
                        f32x4 a0, a1;
                        a0[0] = v0[0] * cc[0] - v0[1] * sv[0]; a0[1] = v0[1] * cc[0] + v0[0] * sv[0]; a0[2] = v0[2] * cc[1] - v0[3] * sv[1]; a0[3] = v0[3] * cc[1] + v0[2] * sv[1];
                        a1[0] = v1[0] * cc[2] - v1[1] * sv[2]; a1[1] = v1[1] * cc[2] + v1[0] * sv[2]; a1[2] = v1[2] * cc[3] - v1[3] * sv[3]; a1[3] = v1[3] * cc[3] + v1[2] * sv[3];
                        v0 = a0; v1 = a1;
                    }
                    v4u w; w.x = pk2a(v0[0], v0[1]); w.y = pk2a(v0[2], v0[3]); w.z = pk2a(v1[0], v1[1]); w.w = pk2a(v1[2], v1[3]);
                    *(v4u*)(rowp + bj * 128) = w;
                }
                asm volatile("" ::: "memory");
            }
        }
    }
};
struct EpiUkv {
    static constexpr bool PERM = true, AFTER_DRAIN = false; static constexpr int HOOK_T = 0;
    bf16* O; const float* partkv;
    __device__ __forceinline__ void operator()(const f32x4 (&acc)[2][2][4][2], const pg8::Unit& u, int wr, int wc, int fr, int fq) const {
        const int row0 = u.pm * 256 + wr * 64 + fr, col0 = u.pn * 256 + wc * 32 + 8 * fq;
        float rs[2][4]; f32x4 pk_[2][4];
#pragma unroll
        for (int ai = 0; ai < 2; ++ai)
#pragma unroll
            for (int m = 0; m < 4; ++m) pk_[ai][m] = *(const GAS f32x4*)(partkv + (size_t)(row0 + ai * 128 + m * 16) * 4);
        __builtin_amdgcn_sched_barrier(0);
#pragma unroll
        for (int ai = 0; ai < 2; ++ai)
#pragma unroll
            for (int m = 0; m < 4; ++m) { const f32x4 p0 = pk_[ai][m];
                rs[ai][m] = __builtin_amdgcn_rsqf(((p0[0] + p0[1]) + (p0[2] + p0[3])) * (1.f / 256.f) + EPS); }
#pragma unroll
        for (int ai = 0; ai < 2; ++ai)
#pragma unroll
            for (int m = 0; m < 4; ++m) {
                const int row = row0 + ai * 128 + m * 16; bf16* rowp = O + (size_t)row * NKV + col0;
#pragma unroll
                for (int bj = 0; bj < 2; ++bj) {
                    const f32x4 v0 = acc[ai][bj][m][0] * rs[ai][m], v1 = acc[ai][bj][m][1] * rs[ai][m];
                    v4u w; w.x = pk2a(v0[0], v0[1]); w.y = pk2a(v0[2], v0[3]); w.z = pk2a(v1[0], v1[1]); w.w = pk2a(v1[2], v1[3]);
                    *(v4u*)(rowp + bj * 128) = w;
                }
            }
    }
};
struct EpiOut {
    static constexpr bool PERM = false, AFTER_DRAIN = false; static constexpr int HOOK_T = 12;
    const float* xin; float* out; const float* gate;
    const float* partm;
    __device__ __forceinline__ void hook(f32x4 (&acc)[2][2][4][2], const pg8::Unit& u, int wr, int wc, int fr, int fq) const {
        const int row0 = u.pm * 256 + wr * 64 + fr;
        float rs[2][4];
#pragma unroll
        for (int ai = 0; ai < 2; ++ai)
#pragma unroll
            for (int m = 0; m < 4; ++m) rs[ai][m] = *(const GAS float*)(partm + (size_t)(row0 + ai * 128 + m * 16));
        __builtin_amdgcn_sched_barrier(0);
#pragma unroll
        for (int ai = 0; ai < 2; ++ai)
#pragma unroll
            for (int m = 0; m < 4; ++m) rs[ai][m] = __builtin_amdgcn_rsqf(rs[ai][m] * (1.f / 768.f) + EPS);
#pragma unroll
        for (int ai = 0; ai < 2; ++ai)
#pragma unroll
            for (int m = 0; m < 4; ++m)
#pragma unroll
                for (int bj = 0; bj < 2; ++bj)
#pragma unroll
                    for (int n = 0; n < 2; ++n) acc[ai][bj][m][n] *= rs[ai][m];
    }
    __device__ __forceinline__ void operator()(const f32x4 (&acc)[2][2][4][2], const pg8::Unit& u, int wr, int wc, int fr, int fq) const {
        const int row0 = u.pm * 256 + wr * 64 + fr, col0 = u.pn * 256 + wc * 32 + 4 * fq; const float* gb = gate + (size_t)(u.pm >> 3) * 3 * DM;
        f32x4 gv[2][2];
#pragma unroll
        for (int bj = 0; bj < 2; ++bj)
#pragma unroll
            for (int n = 0; n < 2; ++n) gv[bj][n] = *(const f32x4*)(gb + col0 + bj * 128 + n * 16);
        f32x4 xv[2][2][2][2];
#define EO_LOAD(slot, g) do { _Pragma("unroll") for (int q = 0; q < 2; ++q) { const size_t off = (size_t)(row0 + ((g) >> 1) * 128 + (((g) & 1) * 2 + q) * 16) * DM + col0; \
            _Pragma("unroll") for (int bj = 0; bj < 2; ++bj) _Pragma("unroll") for (int n = 0; n < 2; ++n) xv[slot][q][bj][n] = *(const f32x4*)(xin + off + bj * 128 + n * 16); } } while (0)
#define EO_STORE(slot, g) do { _Pragma("unroll") for (int q = 0; q < 2; ++q) { const int ai = (g) >> 1, m = ((g) & 1) * 2 + q; const size_t off = (size_t)(row0 + ai * 128 + m * 16) * DM + col0; \
            _Pragma("unroll") for (int bj = 0; bj < 2; ++bj) _Pragma("unroll") for (int n = 0; n < 2; ++n) *(f32x4*)(out + off + bj * 128 + n * 16) = xv[slot][q][bj][n] + gv[bj][n] * acc[ai][bj][m][n]; } } while (0)
        EO_LOAD(0, 0); EO_LOAD(1, 1); EO_STORE(0, 0); EO_LOAD(0, 2); EO_STORE(1, 1); EO_LOAD(1, 3); EO_STORE(0, 2); EO_STORE(1, 3);
#undef EO_LOAD
#undef EO_STORE
    }
};

struct EpiOutNorm {
    static constexpr bool PERM = false, AFTER_DRAIN = true; static constexpr int HOOK_T = 12;
    const float* xin; const bf16* xinb; bf16* x1b; float* out; const float* gate; const float* partm;
    bf16* H; const float* g; const float* mods_next;
    float* xs; unsigned* cnt; unsigned target; int last;
    __device__ __forceinline__ void hook(f32x4 (&acc)[2][2][4][2], const pg8::Unit& u, int wr, int wc, int fr, int fq) const {
        const int row0 = u.pm * 256 + wr * 64 + fr;
        float rs[2][4];
#pragma unroll
        for (int ai = 0; ai < 2; ++ai)
#pragma unroll
            for (int m = 0; m < 4; ++m) rs[ai][m] = *(const GAS float*)(partm + (size_t)(row0 + ai * 128 + m * 16));
        __builtin_amdgcn_sched_barrier(0);
#pragma unroll
        for (int ai = 0; ai < 2; ++ai)
#pragma unroll
            for (int m = 0; m < 4; ++m) rs[ai][m] = __builtin_amdgcn_rsqf(rs[ai][m] * (1.f / 768.f) + EPS);
#pragma unroll
        for (int ai = 0; ai < 2; ++ai)
#pragma unroll
            for (int m = 0; m < 4; ++m)
#pragma unroll
                for (int bj = 0; bj < 2; ++bj)
#pragma unroll
                    for (int n = 0; n < 2; ++n) acc[ai][bj][m][n] *= rs[ai][m];
    }
    __device__ __forceinline__ void fused(f32x4 (&acc)[2][2][4][2], const pg8::Unit& u, int wr, int wc, int fr, int fq, LAS unsigned char* lds, int wid, int lane) const {
        const int row0 = u.pm * 256 + wr * 64 + fr, col0 = u.pn * 256 + wc * 32 + 4 * fq, b = u.pm >> 3; const float* gb = gate + (size_t)b * 3 * DM;
        LAS float* P = (LAS float*)lds;
        LAS float* S = (LAS float*)(lds + 4096);
        f32x4 gv[2][2];
#pragma unroll
        for (int bj = 0; bj < 2; ++bj)
#pragma unroll
            for (int n = 0; n < 2; ++n) gv[bj][n] = *(const f32x4*)(gb + col0 + bj * 128 + n * 16);
        v4u xr[2][2][2][2];
#define EO_LOAD(slot, g_) do { _Pragma("unroll") for (int q = 0; q < 2; ++q) { const size_t off = (size_t)(row0 + ((g_) >> 1) * 128 + (((g_) & 1) * 2 + q) * 16) * DM + col0; \
            _Pragma("unroll") for (int bj = 0; bj < 2; ++bj) _Pragma("unroll") for (int n = 0; n < 2; ++n) { if (xinb) { const v2u w_ = *(const GAS v2u*)(xinb + off + bj * 128 + n * 16); xr[slot][q][bj][n] = (v4u){w_.x, w_.y, 0u, 0u}; } \
                else xr[slot][q][bj][n] = *(const GAS v4u*)(xin + off + bj * 128 + n * 16); } } } while (0)
#define EO_ADD(slot, g_) do { _Pragma("unroll") for (int q = 0; q < 2; ++q) { const int ai = (g_) >> 1, m = ((g_) & 1) * 2 + q; const size_t off = (size_t)(row0 + ai * 128 + m * 16) * DM + col0; \
            _Pragma("unroll") for (int bj = 0; bj < 2; ++bj) _Pragma("unroll") for (int n = 0; n < 2; ++n) { const v4u r_ = xr[slot][q][bj][n]; \
                f32x4 x_ = __builtin_bit_cast(f32x4, r_); if (xinb) x_ = (f32x4){bflo(r_.x), bfhi(r_.x), bflo(r_.y), bfhi(r_.y)}; \
                acc[ai][bj][m][n] = x_ + gv[bj][n] * acc[ai][bj][m][n]; \
                if (!last) { v2u w_; w_.x = pk2(acc[ai][bj][m][n][0], acc[ai][bj][m][n][1]); w_.y = pk2(acc[ai][bj][m][n][2], acc[ai][bj][m][n][3]); *(v2u*)(x1b + off + bj * 128 + n * 16) = w_; } } } } while (0)
        EO_LOAD(0, 0); EO_LOAD(1, 1); EO_ADD(0, 0); EO_LOAD(0, 2); EO_ADD(1, 1); EO_LOAD(1, 3); EO_ADD(0, 2); EO_ADD(1, 3);
#undef EO_LOAD
#undef EO_ADD
#pragma unroll
        for (int ai = 0; ai < 2; ++ai)
#pragma unroll
            for (int m = 0; m < 4; ++m) { float ss = 0.f;
#pragma unroll
                for (int bj = 0; bj < 2; ++bj)
#pragma unroll
                    for (int n = 0; n < 2; ++n) { const f32x4 x = acc[ai][bj][m][n]; ss += (x[0] * x[0] + x[1] * x[1]) + (x[2] * x[2] + x[3] * x[3]); }
                ss += __shfl_xor(ss, 16); ss += __shfl_xor(ss, 32);
                if (fq == 0) P[(ai * 128 + wr * 64 + m * 16 + fr) * 4 + wc] = ss; }
        asm volatile("s_waitcnt lgkmcnt(0)" ::: "memory"); __builtin_amdgcn_s_barrier(); asm volatile("" ::: "memory");
        const int tid = wid * 64 + lane;
        if (tid < 256) { const f32x4 p = *(const LAS f32x4*)(P + tid * 4);
            __hip_atomic_store(xs + (size_t)(u.pm * 256 + tid) * 8 + u.pn, (p[0] + p[1]) + (p[2] + p[3]), __ATOMIC_RELAXED, __HIP_MEMORY_SCOPE_AGENT);
            asm volatile("s_waitcnt vmcnt(0)" ::: "memory");
            if (lane == 0) __hip_atomic_fetch_add(cnt + 64 * u.pm, 1u, __ATOMIC_RELAXED, __HIP_MEMORY_SCOPE_AGENT); }
        if (wid == 0) { unsigned sp = 0u;
            while ((unsigned)__builtin_amdgcn_readfirstlane(__hip_atomic_load(cnt + 64 * u.pm, __ATOMIC_RELAXED, __HIP_MEMORY_SCOPE_AGENT)) < target) { __builtin_amdgcn_s_sleep(2); if (++sp > (1u << 22)) break; }
            __builtin_amdgcn_fence(__ATOMIC_ACQUIRE, "agent"); }
        asm volatile("s_waitcnt vmcnt(0) lgkmcnt(0)" ::: "memory"); __builtin_amdgcn_s_barrier(); asm volatile("" ::: "memory");
        if (tid < 256) { const GAS float* sl = (const GAS float*)(xs + (size_t)(u.pm * 256 + tid) * 8); f32x4 sa, sb;
            asm volatile("global_load_dwordx4 %0, %2, off sc1\n\tglobal_load_dwordx4 %1, %2, off offset:16 sc1\n\ts_waitcnt vmcnt(0)" : "=&v"(sa), "=&v"(sb) : "v"(sl) : "memory");
            const float s = ((sa[0] + sa[1]) + (sa[2] + sa[3])) + ((sb[0] + sb[1]) + (sb[2] + sb[3]));
            S[tid] = __builtin_amdgcn_rsqf(s * (1.f / DM) + EPS); }
        asm volatile("s_waitcnt lgkmcnt(0)" ::: "memory"); __builtin_amdgcn_s_barrier(); asm volatile("" ::: "memory");
        f32x4 mul[2][2], add[2][2];
#pragma unroll
        for (int bj = 0; bj < 2; ++bj)
#pragma unroll
            for (int n = 0; n < 2; ++n) { const int c = col0 + bj * 128 + n * 16; const f32x4 gg = *(const f32x4*)(g + c);
                if (last) { mul[bj][n] = gg; add[bj][n] = (f32x4){0.f, 0.f, 0.f, 0.f}; }
                else { const float* mn = mods_next + (size_t)b * 3 * DM; mul[bj][n] = gg * (*(const f32x4*)(mn + DM + c) + 1.f); add[bj][n] = *(const f32x4*)(mn + c); } }
#pragma unroll
        for (int ai = 0; ai < 2; ++ai)
#pragma unroll
            for (int m = 0; m < 4; ++m) { const int rl = ai * 128 + wr * 64 + m * 16 + fr; const float rstd = S[rl]; const size_t off = (size_t)(u.pm * 256 + rl) * DM + col0;
#pragma unroll
                for (int bj = 0; bj < 2; ++bj)
#pragma unroll
                    for (int n = 0; n < 2; ++n) { const f32x4 r = acc[ai][bj][m][n] * rstd * mul[bj][n] + add[bj][n];
                        if (last) *(f32x4*)(out + off + bj * 128 + n * 16) = r;
                        else { v2u w; w.x = pk2(r[0], r[1]); w.y = pk2(r[2], r[3]); *(v2u*)(H + off + bj * 128 + n * 16) = w; } } }
    }
};

__device__ __forceinline__ void unpack8(const v4u w, float* f) { f[0] = bflo(w.x); f[1] = bfhi(w.x); f[2] = bflo(w.y); f[3] = bfhi(w.y); f[4] = bflo(w.z); f[5] = bfhi(w.z); f[6] = bflo(w.w); f[7] = bfhi(w.w); }

__device__ __forceinline__ int stg_pos(int c, int row) { return (c & 16) | ((c ^ (row & 7) ^ ((c >> 4) << 3)) & 15); }
__device__ __forceinline__ void stage_write(LAS float* st, const f32x16* acc, int r32, int hi) {
#pragma unroll
    for (int reg = 0; reg < 16; ++reg) { const int row = (reg & 3) + 8 * (reg >> 2) + 4 * hi;
#pragma unroll
        for (int dvb = 0; dvb < 4; ++dvb) { const int col = dvb * 32 + r32; st[row * 128 + stg_pos(col >> 2, row) * 4 + (col & 3)] = acc[dvb][reg]; } }
}
__device__ __forceinline__ void stage_write1(LAS float* st, const f32x16& a, int dvb, int r32, int hi) {
#pragma unroll
    for (int reg = 0; reg < 16; ++reg) { const int row = (reg & 3) + 8 * (reg >> 2) + 4 * hi; const int col = dvb * 32 + r32; st[row * 128 + stg_pos(col >> 2, row) * 4 + (col & 3)] = a[reg]; }
}
__device__ __forceinline__ void stage_read(const LAS float* st, int lane, float* v) {
    const int row = lane >> 1, half = lane & 1;
#pragma unroll
    for (int j = 0; j < 16; ++j) { const f32x4 q = *(const LAS f32x4*)(st + row * 128 + stg_pos(16 * half + j, row) * 4); v[4 * j] = q[0]; v[4 * j + 1] = q[1]; v[4 * j + 2] = q[2]; v[4 * j + 3] = q[3]; }
}
__device__ __forceinline__ void gated_store64(const float* v, float rs, const float* __restrict__ g, const bf16* __restrict__ zrow, bf16* __restrict__ yrow) {
    v4u zz[8];
#pragma unroll
    for (int j = 0; j < 8; ++j) zz[j] = *(const v4u*)(zrow + 8 * j);
#pragma unroll
    for (int j = 0; j < 8; ++j) { const f32x4 g0 = *(const f32x4*)(g + 8 * j), g1 = *(const f32x4*)(g + 8 * j + 4); float z[8]; unpack8(zz[j], z);
        v4u w; w.x = pk2a(v[8 * j] * rs * g0[0] * z[0], v[8 * j + 1] * rs * g0[1] * z[1]); w.y = pk2a(v[8 * j + 2] * rs * g0[2] * z[2], v[8 * j + 3] * rs * g0[3] * z[3]);
        w.z = pk2a(v[8 * j + 4] * rs * g1[0] * z[4], v[8 * j + 5] * rs * g1[1] * z[5]); w.w = pk2a(v[8 * j + 6] * rs * g1[2] * z[6], v[8 * j + 7] * rs * g1[3] * z[7]);
        *(v4u*)(yrow + 8 * j) = w; }
}

template <bool NORM> __device__ __forceinline__ void rows_finish(const LAS float* st, int lane, const bf16* __restrict__ oi, const float* __restrict__ g, const bf16* __restrict__ z, bf16* __restrict__ y, float* __restrict__ part) {
    const int lr = lane >> 4, cl = lane & 15, c8 = cl * 8;
    const f32x4 g0 = *(const f32x4*)(g + c8), g1 = *(const f32x4*)(g + c8 + 4);
    v4u zz[8], oo[8];
#pragma unroll
    for (int it = 0; it < 8; ++it) { const int row = it * 4 + lr; zz[it] = *(const v4u*)(z + (size_t)row * NP + c8); if (NORM) oo[it] = *(const v4u*)(oi + (size_t)row * 768 + c8); }
#pragma unroll
    for (int it = 0; it < 8; ++it) { const int row = it * 4 + lr;
        const f32x4 a = *(const LAS f32x4*)(st + row * 128 + stg_pos(2 * cl, row) * 4), b = *(const LAS f32x4*)(st + row * 128 + stg_pos(2 * cl + 1, row) * 4);
        float v[8] = {a[0], a[1], a[2], a[3], b[0], b[1], b[2], b[3]};
        if (NORM) { float f[8]; unpack8(oo[it], f);
#pragma unroll
            for (int e = 0; e < 8; ++e) v[e] += f[e]; }
        float ss = 0.f;
#pragma unroll
        for (int e = 0; e < 8; ++e) ss += v[e] * v[e];
        ss += __shfl_xor(ss, 1); ss += __shfl_xor(ss, 2); ss += __shfl_xor(ss, 4); ss += __shfl_xor(ss, 8);
        float rs = 1.f;
        if (NORM) rs = __builtin_amdgcn_rsqf(ss * (1.f / 128.f) + EPS); else if (cl == 0) atomicAdd(part + row, ss);
        float zf[8]; unpack8(zz[it], zf);
        if (!MK_SILU_IN_EPI) {
#pragma unroll
            for (int e = 0; e < 8; ++e) zf[e] = silu_fast(zf[e]); }
        v4u w; w.x = pk2a(v[0] * rs * g0[0] * zf[0], v[1] * rs * g0[1] * zf[1]); w.y = pk2a(v[2] * rs * g0[2] * zf[2], v[3] * rs * g0[3] * zf[3]);
        w.z = pk2a(v[4] * rs * g1[0] * zf[4], v[5] * rs * g1[1] * zf[5]); w.w = pk2a(v[6] * rs * g1[2] * zf[6], v[7] * rs * g1[3] * zf[7]);
        if (MK_FUSE_Y) st_wt16(y + (size_t)row * DM + c8, w); else *(v4u*)(y + (size_t)row * DM + c8) = w; }
}

__device__ __forceinline__ const float* ld_in(int i);
namespace mla {
constexpr int NW = 8, QBLK = 32, KVBLK = 64;
constexpr int SHM_V = 16384, SHM_KN = 16384, SHM_KR = 8192;
constexpr int OFF_V = 0, OFF_KN = 2 * SHM_V, OFF_KR = OFF_KN + 2 * SHM_KN, OFF_WS = OFF_KR + 2 * SHM_KR, OFF_QR = OFF_WS + NW * 64 * 4, ATTN_LDS = OFF_QR + NW * 4096;
constexpr float THR = 8.f;
#define KSWZ(row, colB) ((row) * 256 + ((colB) ^ (((row) & 7) << 4)))
#define KRSWZ(row, colB) ((row) * 128 + ((colB) ^ ((((row) >> 1) & 7) << 4)))
#define SBAR() __builtin_amdgcn_sched_barrier(0)
__device__ __forceinline__ int crow(int r, int hi) { return (r & 3) + 8 * (r >> 2) + 4 * hi; }
__device__ __forceinline__ unsigned cvtpk(float lo, float hi) { unsigned r; asm volatile("v_cvt_pk_bf16_f32 %0, %1, %2" : "=v"(r) : "v"(lo), "v"(hi)); return r; }

__device__ __forceinline__ void partialSM(f32x16& p0, f32x16& p1, float& m_reg, float& mn, float& alpha) {
  float pmax = p0[0];
#pragma unroll
  for (int r = 1; r < 16; ++r) pmax = fmaxf(pmax, p0[r]);
#pragma unroll
  for (int r = 0; r < 16; ++r) pmax = fmaxf(pmax, p1[r]);
  { auto rr = __builtin_amdgcn_permlane32_swap(__float_as_uint(pmax), __float_as_uint(pmax), false, false);
    pmax = fmaxf(__uint_as_float(rr[0]), __uint_as_float(rr[1])); }
  if (__builtin_expect(__all(pmax - m_reg <= THR), 1)) { mn = m_reg; alpha = 1.f; }
  else { mn = fmaxf(m_reg, pmax); alpha = __builtin_amdgcn_exp2f(m_reg - mn); m_reg = mn; }
#pragma unroll
  for (int r = 0; r < 16; ++r) p0[r] = p0[r] - mn;
#pragma unroll
  for (int r = 0; r < 16; ++r) p1[r] = p1[r] - mn;
#pragma unroll
  for (int r = 0; r < 16; ++r) p0[r] = __builtin_amdgcn_exp2f(p0[r]);
}
__device__ __forceinline__ void finishSM(f32x16& p0, f32x16& p1, float alpha, float& l_reg, bf16x8& pa0, bf16x8& pa1, bf16x8& pa2, bf16x8& pa3) {
#pragma unroll
  for (int r = 0; r < 16; ++r) p1[r] = __builtin_amdgcn_exp2f(p1[r]);
  float ps = 0;
#pragma unroll
  for (int r = 0; r < 16; ++r) ps += p0[r];
#pragma unroll
  for (int r = 0; r < 16; ++r) ps += p1[r];
  { auto rr = __builtin_amdgcn_permlane32_swap(__float_as_uint(ps), __float_as_uint(ps), false, false);
    ps = __uint_as_float(rr[0]) + __uint_as_float(rr[1]); }
  l_reg = l_reg * alpha + ps;
#define PK4(P, BASE, OUT) do { unsigned a0 = cvtpk(P[BASE + 0], P[BASE + 1]), a1 = cvtpk(P[BASE + 2], P[BASE + 3]);   \
    unsigned b0 = cvtpk(P[BASE + 4], P[BASE + 5]), b1 = cvtpk(P[BASE + 6], P[BASE + 7]);                              \
    auto r0 = __builtin_amdgcn_permlane32_swap(a0, b0, false, false); auto r1 = __builtin_amdgcn_permlane32_swap(a1, b1, false, false); \
    v4u w = {r0[0], r1[0], r0[1], r1[1]}; OUT = *reinterpret_cast<bf16x8*>(&w); } while (0)
  PK4(p0, 0, pa0); PK4(p0, 8, pa1); PK4(p1, 0, pa2); PK4(p1, 8, pa3);
#undef PK4
}
__device__ __forceinline__ void qkt(f32x16& p0, f32x16& p1, const char* Kn, const char* Kr, const bf16x8* qr, const char* Qr, int r32, int hi) {
  p0 = f32x16{}; p1 = f32x16{};
  int tn = (hi * 16) ^ ((r32 & 7) << 4), tr = (hi * 16) ^ (((r32 >> 1) & 7) << 4);
  asm volatile("" : "+v"(tn), "+v"(tr));
  const char* knb = Kn + r32 * 256; const char* krb = Kr + r32 * 128; const char* qrb = Qr + r32 * 128;
#pragma unroll
  for (int d0 = 0; d0 < 8; ++d0) { const int off = (d0 * 32) ^ tn;
    const bf16x8 b0 = *reinterpret_cast<const bf16x8*>(knb + off);
    const bf16x8 b1 = *reinterpret_cast<const bf16x8*>(knb + off + 8192);
    p0 = __builtin_amdgcn_mfma_f32_32x32x16_bf16(b0, qr[d0], p0, 0, 0, 0);
    p1 = __builtin_amdgcn_mfma_f32_32x32x16_bf16(b1, qr[d0], p1, 0, 0, 0); }
#pragma unroll
  for (int d0 = 0; d0 < 4; ++d0) { const int off = (d0 * 32) ^ tr;
    const bf16x8 b0 = *reinterpret_cast<const bf16x8*>(krb + off);
    const bf16x8 b1 = *reinterpret_cast<const bf16x8*>(krb + off + 4096);
    const bf16x8 qv = *reinterpret_cast<const bf16x8*>(qrb + off);
    p0 = __builtin_amdgcn_mfma_f32_32x32x16_bf16(b0, qv, p0, 0, 0, 0);
    p1 = __builtin_amdgcn_mfma_f32_32x32x16_bf16(b1, qv, p1, 0, 0, 0); }
}
__device__ __forceinline__ int v_st(int k, int c) { const int kk = (k & ~0xC) | ((k & 4) << 1) | ((k & 8) >> 1); return ((kk >> 3) * 4 + (c >> 5)) * 512 + ((kk & 7) * 32 + (c & 31)) * 2; }
__device__ __forceinline__ int v_rd_base(int lane) { return ((lane & 3) << 3) | (((lane >> 2) & 3) << 6) | (((lane >> 4) & 1) << 5) | (((lane >> 5) & 1) << 8); }
constexpr int v_rd_off(int d0, int ks, int half) { return d0 * 512 + ks * 4096 + half * 2048; }
template <int OFF> __device__ __forceinline__ s16x4 tr_read(int vb) {
  s16x4 r; asm volatile("ds_read_b64_tr_b16 %0, %1 offset:%2" : "=&v"(r) : "v"(vb), "i"(OFF) : "memory"); return r;
}
template <int D0> __device__ __forceinline__ void pv_one(f32x16& od, int vb, bf16x8 pa0, bf16x8 pa1, bf16x8 pa2, bf16x8 pa3) {
  const s16x4 l0 = tr_read<v_rd_off(D0, 0, 0)>(vb), h0 = tr_read<v_rd_off(D0, 0, 1)>(vb), l1 = tr_read<v_rd_off(D0, 1, 0)>(vb), h1 = tr_read<v_rd_off(D0, 1, 1)>(vb);
  const s16x4 l2 = tr_read<v_rd_off(D0, 2, 0)>(vb), h2 = tr_read<v_rd_off(D0, 2, 1)>(vb), l3 = tr_read<v_rd_off(D0, 3, 0)>(vb), h3 = tr_read<v_rd_off(D0, 3, 1)>(vb);
  asm volatile("s_waitcnt lgkmcnt(0)" ::: "memory"); SBAR();
  __builtin_amdgcn_s_setprio(1);
#define PK(L, H) (bf16x8){L[0], L[1], L[2], L[3], H[0], H[1], H[2], H[3]}
  od = __builtin_amdgcn_mfma_f32_32x32x16_bf16(pa0, PK(l0, h0), od, 0, 0, 0);
  od = __builtin_amdgcn_mfma_f32_32x32x16_bf16(pa1, PK(l1, h1), od, 0, 0, 0);
  od = __builtin_amdgcn_mfma_f32_32x32x16_bf16(pa2, PK(l2, h2), od, 0, 0, 0);
  od = __builtin_amdgcn_mfma_f32_32x32x16_bf16(pa3, PK(l3, h3), od, 0, 0, 0);
  __builtin_amdgcn_s_setprio(0);
#undef PK
}
__device__ __forceinline__ void pv_d0(f32x16* o, int vb, bf16x8 pa0, bf16x8 pa1, bf16x8 pa2, bf16x8 pa3) {
  pv_one<0>(o[0], vb, pa0, pa1, pa2, pa3); pv_one<1>(o[1], vb, pa0, pa1, pa2, pa3); pv_one<2>(o[2], vb, pa0, pa1, pa2, pa3); pv_one<3>(o[3], vb, pa0, pa1, pa2, pa3);
}

__device__ __forceinline__ void attn_unit(const bf16* __restrict__ Qb, const bf16* __restrict__ Knh, const bf16* __restrict__ Vh, const bf16* __restrict__ Krh,
                                          bf16* __restrict__ Yb, const bf16* __restrict__ Zb, const float* __restrict__ gh, float* __restrict__ part, int seq, char* lds,
                                          int mode_u) {
  int tid_ = threadIdx.x; asm volatile("" : "+v"(tid_));
  const int tid = tid_, wid = tid >> 6, lane = tid & 63, r32 = lane & 31, hi = lane >> 5;
  char* V_lds = lds + OFF_V; char* KN_lds = lds + OFF_KN; char* KR_lds = lds + OFF_KR;
  float* ws = (float*)(lds + OFF_WS) + wid * 64; float* li_l = ws; float* al_l = ws + 32;
  float m_reg = -1e30f, l_reg = 0; f32x16 o[4] = {}; bf16x8 qr[8]; char* QR_lds = lds + OFF_QR + wid * 4096;
  const bf16* Qw = Qb + (long)(wid * QBLK + r32) * NQ + hi * 8;
#pragma unroll
  for (int d0 = 0; d0 < 8; ++d0) qr[d0] = *reinterpret_cast<const bf16x8*>(Qw + d0 * 16);
#pragma unroll
  for (int d0 = 0; d0 < 4; ++d0) *reinterpret_cast<bf16x8*>(QR_lds + KRSWZ(r32, (d0 * 16 + hi * 8) * 2)) = *reinterpret_cast<const bf16x8*>(Qw + 128 + d0 * 16);
  const int sr = tid >> 4, sc = (tid & 15) * 8, vst0 = v_st(sr, sc), vst1 = v_st(32 + sr, sc);
  const int krr = tid >> 3, krc = (tid & 7) * 8;
  const int vb0 = (int)(uintptr_t)V_lds + v_rd_base(lane);
  bf16x8 vs0, vs1, ks0, ks1, kr0;
#define SLOAD(k0) do { vs0 = *reinterpret_cast<const bf16x8*>(&Vh[(long)((k0) + sr) * NKV + sc]); vs1 = *reinterpret_cast<const bf16x8*>(&Vh[(long)((k0) + 32 + sr) * NKV + sc]); \
    ks0 = *reinterpret_cast<const bf16x8*>(&Knh[(long)((k0) + sr) * NKV + sc]); ks1 = *reinterpret_cast<const bf16x8*>(&Knh[(long)((k0) + 32 + sr) * NKV + sc]); \
    kr0 = *reinterpret_cast<const bf16x8*>(&Krh[(long)((k0) + krr) * NP + krc]); } while (0)
#define SWRITE(b) do { *(bf16x8*)(V_lds + (b) * SHM_V + vst0) = vs0; *(bf16x8*)(V_lds + (b) * SHM_V + vst1) = vs1; const int kc = sc * 2;   \
    *(bf16x8*)(KN_lds + (b) * SHM_KN + KSWZ(sr, kc)) = ks0; *(bf16x8*)(KN_lds + (b) * SHM_KN + KSWZ(32 + sr, kc)) = ks1;                       \
    *(bf16x8*)(KR_lds + (b) * SHM_KR + KRSWZ(krr, krc * 2)) = kr0; } while (0)
#define SWAIT() asm volatile("s_waitcnt vmcnt(0)" ::: "memory")
#define RESC(a) do { if (__any((a) < 1.f)) { if (hi == 0) al_l[r32] = (a); asm volatile("s_waitcnt lgkmcnt(0)" ::: "memory"); \
    _Pragma("unroll") for (int d = 0; d < 4; ++d) _Pragma("unroll") for (int r = 0; r < 16; ++r) o[d][r] *= al_l[crow(r, hi)]; } } while (0)
  f32x16 pA0, pA1, pB0, pB1; float mnA, mnB, alA, alB; bf16x8 pa0, pa1, pa2, pa3; const int NT = seq / KVBLK;
  SLOAD(0); SWAIT(); SWRITE(0); __syncthreads();
  qkt(pA0, pA1, KN_lds, KR_lds, qr, QR_lds, r32, hi); partialSM(pA0, pA1, m_reg, mnA, alA);
  SLOAD(KVBLK);
  SWAIT(); SWRITE(1); __syncthreads();
  for (int j = 1; j + 1 < NT; j += 2) {
    SBAR(); qkt(pB0, pB1, KN_lds + SHM_KN, KR_lds + SHM_KR, qr, QR_lds, r32, hi);
    finishSM(pA0, pA1, alA, l_reg, pa0, pa1, pa2, pa3); SBAR();
    SLOAD((j + 1) * KVBLK); SBAR();
    pv_d0(o, vb0, pa0, pa1, pa2, pa3); partialSM(pB0, pB1, m_reg, mnB, alB);
    __syncthreads(); SWAIT(); SWRITE(0);
    RESC(alB); __syncthreads();
    SBAR(); qkt(pA0, pA1, KN_lds, KR_lds, qr, QR_lds, r32, hi);
    finishSM(pB0, pB1, alB, l_reg, pa0, pa1, pa2, pa3); SBAR();
    SLOAD((j + 2) * KVBLK); SBAR();
    pv_d0(o, vb0 + SHM_V, pa0, pa1, pa2, pa3); partialSM(pA0, pA1, m_reg, mnA, alA);
    __syncthreads(); SWAIT(); SWRITE(1);
    RESC(alA); __syncthreads();
  }
  SBAR(); qkt(pB0, pB1, KN_lds + SHM_KN, KR_lds + SHM_KR, qr, QR_lds, r32, hi);
  finishSM(pA0, pA1, alA, l_reg, pa0, pa1, pa2, pa3); SBAR();
  pv_d0(o, vb0, pa0, pa1, pa2, pa3); partialSM(pB0, pB1, m_reg, mnB, alB);
  __syncthreads(); RESC(alB);
  finishSM(pB0, pB1, alB, l_reg, pa0, pa1, pa2, pa3); SBAR();
  pv_d0(o, vb0 + SHM_V, pa0, pa1, pa2, pa3);
  const int mu_ = __builtin_amdgcn_readfirstlane(mode_u);
  const int mode = mu_ & 15;
  unsigned long long* po = nullptr; float* pml = nullptr; unsigned* flag = nullptr;
  if (mode != 0) { unsigned char* wsb = (unsigned char*)::ld_in(22); const int un = (mu_ >> 4) & 255, fs = mu_ >> 12;
    po = (unsigned long long*)(wsb + WS_PO) + (size_t)un * 8192; pml = (float*)(wsb + WS_PML) + (size_t)un * 512; flag = (unsigned*)(wsb + WS_CTL) + 16384 + 2048 * fs + un * 8; }
  if (mode == 2) {
    unsigned long long* pw = po + (wid * 16) * 64 + lane;
#pragma unroll
    for (int d0 = 0; d0 < 4; ++d0)
#pragma unroll
      for (int q = 0; q < 4; ++q) { const unsigned long long w = (unsigned long long)pk2(o[d0][4 * q], o[d0][4 * q + 1]) | ((unsigned long long)pk2(o[d0][4 * q + 2], o[d0][4 * q + 3]) << 32);
        __hip_atomic_store(pw + (d0 * 4 + q) * 64, w, __ATOMIC_RELAXED, __HIP_MEMORY_SCOPE_AGENT); }
    if (hi == 0) { __hip_atomic_store(pml + (wid * QBLK + r32) * 2, m_reg, __ATOMIC_RELAXED, __HIP_MEMORY_SCOPE_AGENT); __hip_atomic_store(pml + (wid * QBLK + r32) * 2 + 1, l_reg, __ATOMIC_RELAXED, __HIP_MEMORY_SCOPE_AGENT); }
    asm volatile("s_waitcnt vmcnt(0)" ::: "memory");
    if (lane == 0) __hip_atomic_fetch_add(flag + wid, 1u, __ATOMIC_RELAXED, __HIP_MEMORY_SCOPE_AGENT);
    __syncthreads();
    return;
  }
  if (mode == 1) {
    { unsigned sp = 0u; while (__hip_atomic_load(flag + wid, __ATOMIC_RELAXED, __HIP_MEMORY_SCOPE_AGENT) == 0u) { __builtin_amdgcn_s_sleep(2); if (++sp > (1u << 22)) break; } }
    asm volatile("" ::: "memory");
    const unsigned long long* pw = po + (wid * 16) * 64 + lane;
    unsigned long long pq[16];
#pragma unroll
    for (int k = 0; k < 16; ++k) pq[k] = __hip_atomic_load(pw + k * 64, __ATOMIC_RELAXED, __HIP_MEMORY_SCOPE_AGENT);
    const float pm = __hip_atomic_load(pml + (wid * QBLK + r32) * 2, __ATOMIC_RELAXED, __HIP_MEMORY_SCOPE_AGENT), pl = __hip_atomic_load(pml + (wid * QBLK + r32) * 2 + 1, __ATOMIC_RELAXED, __HIP_MEMORY_SCOPE_AGENT);
    const float mt = fmaxf(m_reg, pm), fa0 = __builtin_amdgcn_exp2f(m_reg - mt), fb0 = __builtin_amdgcn_exp2f(pm - mt), inv = __builtin_amdgcn_rcpf(l_reg * fa0 + pl * fb0);
    if (hi == 0) { li_l[r32] = fa0 * inv; al_l[r32] = fb0 * inv; } asm volatile("s_waitcnt lgkmcnt(0)" ::: "memory");
    float ra[16], rb[16];
#pragma unroll
    for (int r = 0; r < 16; ++r) { ra[r] = li_l[crow(r, hi)]; rb[r] = al_l[crow(r, hi)]; }
#pragma unroll
    for (int d0 = 0; d0 < 4; ++d0)
#pragma unroll
      for (int q = 0; q < 4; ++q) { const unsigned lo = (unsigned)pq[d0 * 4 + q], hi2 = (unsigned)(pq[d0 * 4 + q] >> 32);
        o[d0][4 * q] = o[d0][4 * q] * ra[4 * q] + bflo(lo) * rb[4 * q]; o[d0][4 * q + 1] = o[d0][4 * q + 1] * ra[4 * q + 1] + bfhi(lo) * rb[4 * q + 1];
        o[d0][4 * q + 2] = o[d0][4 * q + 2] * ra[4 * q + 2] + bflo(hi2) * rb[4 * q + 2]; o[d0][4 * q + 3] = o[d0][4 * q + 3] * ra[4 * q + 3] + bfhi(hi2) * rb[4 * q + 3]; }
  } else {
  if (hi == 0) li_l[r32] = l_reg; asm volatile("s_waitcnt lgkmcnt(0)" ::: "memory");
  float rli[16];
#pragma unroll
  for (int r = 0; r < 16; ++r) rli[r] = __builtin_amdgcn_rcpf(li_l[crow(r, hi)]);
#pragma unroll
  for (int d0 = 0; d0 < 4; ++d0)
#pragma unroll
    for (int r = 0; r < 16; ++r) o[d0][r] *= rli[r];
  }
  __syncthreads();
  { LAS float* st = (LAS float*)(LAS unsigned char*)(lds + wid * 16384);
    stage_write(st, o, r32, hi);
    asm volatile("s_waitcnt lgkmcnt(0)" ::: "memory");
    rows_finish<false>(st, lane, nullptr, gh, Zb + (long)(wid * QBLK) * NP, Yb + (long)(wid * QBLK) * DM, part + wid * QBLK);
    if (MK_FUSE_Y) {
      asm volatile("s_waitcnt vmcnt(0)" ::: "memory");
      if (lane == 0) { const int un = (mu_ >> 4) & 255, fs = mu_ >> 12, pm = ((un >> 3) / 6) * 8 + (un & 7);
        (void)__hip_atomic_fetch_add((unsigned*)((unsigned char*)::ld_in(22) + WS_CTL) + CW_YREADY + 2048 * fs + 64 * pm, 1u, __ATOMIC_RELAXED, __HIP_MEMORY_SCOPE_AGENT); } } }
  __syncthreads();
#undef SLOAD
#undef SWRITE
#undef SWAIT
#undef RESC
}
#undef SBAR
}
struct Frame {
    LAS unsigned char* lds; char* ldsg;
    int tid, lane, wave, vcu, G;
    float* out; unsigned char* ws;
};
__device__ __forceinline__ const float* ld_in(int i) {
    const __attribute__((address_space(4))) char* ka = (const __attribute__((address_space(4))) char*)__builtin_amdgcn_kernarg_segment_ptr();
    asm volatile("" : "+s"(i));
    const GAS float* p = *(const GAS float* const __attribute__((address_space(4)))*)(ka + 8 * i);
    return (const float*)p;
}
#define WSP(T_, off) ((T_*)(F.ws + (off)))

__device__ __forceinline__ void p0_mods(Frame& F, size_t mods_off, int first, int step, int lo, int hi) {
    LAS float* sc = (LAS float*)F.lds;
    LAS float* part = (LAS float*)(F.lds + 32768);
    const float* c = ld_in(1); const float* aw = ld_in(3); const float* ab = ld_in(4);
    for (int i = F.tid; i < BATCH * DM; i += NTHR) { const float v = c[i]; sc[i] = v / (1.f + __expf(-v)); }
    __syncthreads();
    const int n_it = hi - lo, i0 = lo + (int)(((long)n_it * first) / step), i1 = lo + (int)(((long)n_it * (first + 1)) / step);
    f32x4 a[4] = {}; int cur = -1; bool bias = false;
#pragma unroll 1
    for (int item = i0; ; ++item) {
        const bool end = item >= i1; const int pair = end ? -1 : (item >> 4);
        if (cur >= 0 && pair != cur) {
            const int l = cur / 24, j0 = (cur % 24) * 256;
#pragma unroll
            for (int b = 0; b < 4; ++b) { *(LAS f32x4*)(part + (F.wave * 4 + b) * 256 + F.lane * 4) = a[b]; a[b] = f32x4{0.f, 0.f, 0.f, 0.f}; }
            __syncthreads();
            for (int o = F.tid; o < 1024; o += NTHR) { const int b = o >> 8, col = o & 255; float s = 0.f;
#pragma unroll
                for (int wv2 = 0; wv2 < 8; ++wv2) s += part[(wv2 * 4 + b) * 256 + col];
                if (bias) s += ab[l * 3 * DM + j0 + col];
                atomicAdd(WSP(float, mods_off) + ((size_t)l * BATCH + b) * 3 * DM + j0 + col, s); }
            __syncthreads();
            bias = false;
        }
        if (end) break;
        cur = pair;
        const int ks = item & 15, cb = pair % 24, l = pair / 24, j0 = cb * 256, kb = ks * 128 + F.wave * 16;
        if (ks == 0) bias = true;
        const f32x4* w = (const f32x4*)(aw + (size_t)l * DM * 3 * DM + (size_t)kb * 3 * DM + j0) + F.lane;
        f32x4 wv[16];
#pragma unroll
        for (int k = 0; k < 16; ++k) wv[k] = __builtin_nontemporal_load(w + (size_t)k * (3 * DM / 4));
#pragma unroll
        for (int k = 0; k < 16; ++k)
#pragma unroll
            for (int b = 0; b < 4; ++b) a[b] += wv[k] * sc[b * DM + kb + k];
    }
}
__device__ __forceinline__ int kmap_out(int k) { return k < 768 ? k + 768 : (k < 1536 ? k - 768 : k); }
template <int MAP, bool KMAP> __device__ __forceinline__ void p0_transpose_item(const float* W, int K, int N, bf16* WT, const float* kgain, int item, int nblk, int lane) {
    const int kb = item / nblk, nb = item % nblk, k0 = 64 * kb, n0 = 64 * nb, ks0 = KMAP ? kmap_out(k0) : k0;
    const int np = n0 + lane; const int src = MAP == 1 ? map_in(np) : (MAP == 2 ? map_uq(np) : np);
    float v[64];
#pragma unroll
    for (int i = 0; i < 64; ++i) v[i] = src >= 0 ? __builtin_nontemporal_load(W + (size_t)(ks0 + i) * N + src) : 0.f;
    if (kgain) {
        const unsigned gl = __builtin_bit_cast(unsigned, kgain[k0 + lane]);
#pragma unroll
        for (int i = 0; i < 64; ++i) v[i] *= __builtin_bit_cast(float, __builtin_amdgcn_readlane((int)gl, i));
    }
    bf16* orow = WT + (size_t)np * K + k0;
#pragma unroll
    for (int c = 0; c < 8; ++c) { v4u w; w.x = pk2(v[8 * c], v[8 * c + 1]); w.y = pk2(v[8 * c + 2], v[8 * c + 3]); w.z = pk2(v[8 * c + 4], v[8 * c + 5]); w.w = pk2(v[8 * c + 6], v[8 * c + 7]);
        *(GAS v4u*)(orow + 8 * c) = w; }
}
#ifndef MK_IDLE_GEMV
#define MK_IDLE_GEMV 160
#endif
#ifndef MK_SPARE_GEMV
#define MK_SPARE_GEMV 128
#endif
constexpr int I_IN = (DM / 64) * (NP / 64), I_OUT = (DM / 64) * (DM / 64), I_UQ = (384 / 64) * (NQ / 64), I_UKV = (256 / 64) * (NKV / 64), I_L = I_IN + I_OUT + I_UQ + I_UKV;
__device__ __forceinline__ void p0_transposes(Frame& F, int gw, int NGW, int lo, int hi) {
    for (int it = lo + gw; it < hi; it += NGW) {
        const int l = it / I_L; int r = it % I_L;
        if (r < I_IN) { p0_transpose_item<1, false>(ld_in(6) + (size_t)l * DM * IN_DIM, DM, IN_DIM, WSP(bf16, WS_WIN) + (size_t)l * NP * DM, nullptr, r, NP / 64, F.lane); continue; } r -= I_IN;
        if (r < I_OUT) { p0_transpose_item<0, true>(ld_in(19) + (size_t)l * DM * DM, DM, DM, WSP(bf16, WS_WOUT) + (size_t)l * DM * DM, nullptr, r, DM / 64, F.lane); continue; } r -= I_OUT;
        if (r < I_UQ) { p0_transpose_item<2, false>(ld_in(14) + (size_t)l * 384 * 1152, 384, 1152, WSP(bf16, WS_WUQ) + (size_t)l * NQ * 384, ld_in(12) + l * 384, r, NQ / 64, F.lane); continue; } r -= I_UQ;
        p0_transpose_item<0, false>(ld_in(15) + (size_t)l * 256 * 1536, 256, 1536, WSP(bf16, WS_WUKV) + (size_t)l * NKV * 256, ld_in(13) + l * 256, r, NKV / 64, F.lane);
    }
}
__device__ __forceinline__ void p0_prologue(Frame& F, size_t mods_off, bool defer, unsigned* mods_done) {
    p0_mods(F, mods_off, (int)blockIdx.x, F.G, 0, defer ? 768 - MK_IDLE_GEMV - MK_SPARE_GEMV : 768);
    if (mods_done) { asm volatile("s_waitcnt vmcnt(0)" ::: "memory"); __syncthreads(); if (F.tid == 0) (void)__hip_atomic_fetch_add(mods_done, 1u, __ATOMIC_RELAXED, __HIP_MEMORY_SCOPE_AGENT); }
    p0_transposes(F, F.vcu * NWAVES + F.wave, F.G * NWAVES, 0, DEPTH * I_L);
    const int* pos = (const int*)ld_in(2);
    for (int i = (int)blockIdx.x * NTHR + F.tid; i < T * 32; i += F.G * NTHR) {
        const int t = i >> 5, f = i & 31;
        const float inv = (float)exp2(-(double)f * (13.287712379549449 / 32.0));
        const float ang = (float)pos[t] * inv;
        const double rev = (double)ang * 0.15915494309189535; const float fr = (float)(rev - floor(rev));
        WSP(float, WS_CS)[i] = __builtin_amdgcn_cosf(fr); WSP(float, WS_SN)[i] = __builtin_amdgcn_sinf(fr);
    }
}
__device__ __forceinline__ void p0_deferred(Frame& F, size_t mods_off, int s, int ns) {
    p0_mods(F, mods_off, s, ns, 384, 768);
    p0_transposes(F, s * NWAVES + F.wave, ns * NWAVES, I_L, DEPTH * I_L);
}
__device__ __forceinline__ void modnorm_rows(Frame& F, const float* x, const float* g, const float* mods_l, bf16* H) {
    const int gw = F.vcu * NWAVES + F.wave, NGW = F.G * NWAVES;
    for (int t0 = gw; t0 < T; t0 += 2 * NGW) {
        const int t1 = t0 + NGW; const bool two = t1 < T;
        const GAS f32x4* xr0 = (const GAS f32x4*)(x + (size_t)t0 * DM) + F.lane; const GAS f32x4* xr1 = (const GAS f32x4*)(x + (size_t)(two ? t1 : t0) * DM) + F.lane;
        f32x4 v0[8], v1[8]; float s0 = 0.f, s1 = 0.f;
#pragma unroll
        for (int j = 0; j < 8; ++j) { v0[j] = __builtin_nontemporal_load(xr0 + 64 * j); v1[j] = __builtin_nontemporal_load(xr1 + 64 * j); }
#pragma unroll
        for (int j = 0; j < 8; ++j) { s0 += (v0[j][0] * v0[j][0] + v0[j][1] * v0[j][1]) + (v0[j][2] * v0[j][2] + v0[j][3] * v0[j][3]); s1 += (v1[j][0] * v1[j][0] + v1[j][1] * v1[j][1]) + (v1[j][2] * v1[j][2] + v1[j][3] * v1[j][3]); }
        const float r0 = __builtin_amdgcn_rsqf(wave_sum(s0) * (1.f / DM) + EPS), r1 = __builtin_amdgcn_rsqf(wave_sum(s1) * (1.f / DM) + EPS);
        const float* sh0 = mods_l + (size_t)(t0 / SEQ) * 3 * DM; const float* sh1 = mods_l + (size_t)((two ? t1 : t0) / SEQ) * 3 * DM;
        GAS v2u* o0 = (GAS v2u*)(H + (size_t)t0 * DM) + F.lane; GAS v2u* o1 = (GAS v2u*)(H + (size_t)t1 * DM) + F.lane;
#pragma unroll
        for (int jh = 0; jh < 8; jh += 4) {
            f32x4 gg[4], sv0[4], hv0[4], sv1[4], hv1[4];
#pragma unroll
            for (int j = 0; j < 4; ++j) { const int col = (F.lane + 64 * (jh + j)) * 4; gg[j] = *(const GAS f32x4*)(g + col);
                sv0[j] = *(const GAS f32x4*)(sh0 + DM + col); hv0[j] = *(const GAS f32x4*)(sh0 + col); sv1[j] = *(const GAS f32x4*)(sh1 + DM + col); hv1[j] = *(const GAS f32x4*)(sh1 + col); }
            __builtin_amdgcn_sched_barrier(0);
#pragma unroll
            for (int j = 0; j < 4; ++j) {
                { const f32x4 r = v0[jh + j] * r0 * gg[j] * (sv0[j] + 1.f) + hv0[j]; v2u w; w.x = pk2(r[0], r[1]); w.y = pk2(r[2], r[3]); o0[64 * (jh + j)] = w; }
                if (two) { const f32x4 r = v1[jh + j] * r1 * gg[j] * (sv1[j] + 1.f) + hv1[j]; v2u w; w.x = pk2(r[0], r[1]); w.y = pk2(r[2], r[3]); o1[64 * (jh + j)] = w; } }
        }
    }
}
__device__ __forceinline__ void finalnorm_rows(Frame& F, float* x, const float* g) {
    const int gw = F.vcu * NWAVES + F.wave, NGW = F.G * NWAVES;
    for (int t = gw; t < T; t += NGW) {
        GAS f32x4* xr = (GAS f32x4*)(x + (size_t)t * DM) + F.lane;
        f32x4 v[8]; float s = 0.f;
#pragma unroll
        for (int j = 0; j < 8; ++j) { v[j] = xr[64 * j]; s += (v[j][0] * v[j][0] + v[j][1] * v[j][1]) + (v[j][2] * v[j][2] + v[j][3] * v[j][3]); }
        const float rstd = __builtin_amdgcn_rsqf(wave_sum(s) * (1.f / DM) + EPS);
#pragma unroll
        for (int j = 0; j < 8; ++j) { const f32x4 gg = *(const f32x4*)(g + (F.lane + 64 * j) * 4); xr[64 * j] = v[j] * rstd * gg; }
    }
}
__device__ __forceinline__ void conv_rows(Frame& F, int l) {
    const int gw = F.vcu * NWAVES + F.wave, NGW = F.G * NWAVES;
    const bf16* P = WSP(bf16, WS_PROJ); bf16* Y = WSP(bf16, WS_HY);
    const float* cw = ld_in(17) + l * 3 * 512; const float* cg = ld_in(18) + l * 512;
    const int ch = F.lane * 8;
    float w0[8], w1[8], w2[8], g8[8];
#pragma unroll
    for (int e = 0; e < 8; ++e) { w0[e] = cw[ch + e]; w1[e] = cw[512 + ch + e]; w2[e] = cw[1024 + ch + e]; g8[e] = cg[ch + e]; }
    for (int t0 = 4 * gw; t0 < T; t0 += 4 * NGW) {
        const int s0 = t0 % SEQ; const bf16* p = P + (size_t)t0 * NP;
        v4u cc[6], cx[6], cbv[4], szv[4];
#pragma unroll
        for (int d = 0; d < 6; ++d) { const int ss = s0 + d - 1; const bool ok = ss >= 0 && ss < SEQ; const bf16* q = p + (long)(ok ? d - 1 : 0) * NP;
            cc[d] = *(const v4u*)(q + C_CC + ch); cx[d] = *(const v4u*)(q + C_CX + ch); }
#pragma unroll
        for (int j = 0; j < 4; ++j) { cbv[j] = *(const v4u*)(p + (size_t)j * NP + C_CB + ch); szv[j] = *(const v4u*)(p + (size_t)j * NP + C_Z + 1536 + ch); }
        float u[6][8];
#pragma unroll
        for (int d = 0; d < 6; ++d) { const int ss = s0 + d - 1; const bool ok = ss >= 0 && ss < SEQ; float a[8], b[8]; unpack8(cc[d], a); unpack8(cx[d], b);
#pragma unroll
            for (int e = 0; e < 8; ++e) u[d][e] = ok ? a[e] * b[e] : 0.f; }
#pragma unroll
        for (int j = 0; j < 4; ++j) { float cb[8], sz[8], pre[8]; unpack8(cbv[j], cb); unpack8(szv[j], sz); float ssq = 0.f;
#pragma unroll
            for (int e = 0; e < 8; ++e) { pre[e] = cb[e] * (u[j][e] * w0[e] + u[j + 1][e] * w1[e] + u[j + 2][e] * w2[e]); ssq += pre[e] * pre[e]; }
            const float rstd = __builtin_amdgcn_rsqf(wave_sum(ssq) * (1.f / 512.f) + EPS);
            float r[8];
#pragma unroll
            for (int e = 0; e < 8; ++e) r[e] = pre[e] * rstd * g8[e] * (MK_SILU_IN_EPI ? sz[e] : silu_fast(sz[e]));
            v4u w; w.x = pk2(r[0], r[1]); w.y = pk2(r[2], r[3]); w.z = pk2(r[4], r[5]); w.w = pk2(r[6], r[7]);
            *(v4u*)(Y + (size_t)(t0 + j) * DM + 1536 + ch) = w; }
    }
}
__device__ __forceinline__ void mlaout_rows(Frame& F, int l) {
    const int gw = F.vcu * NWAVES + F.wave, NGW = F.G * NWAVES;
    const bf16* P = WSP(bf16, WS_PROJ); bf16* Y = WSP(bf16, WS_HY); const float* O = WSP(float, WS_OMLA); const float* g = ld_in(16) + l * 768;
    for (int t = gw; t < T; t += NGW) {
        f32x4 v[3]; float s = 0.f;
#pragma unroll
        for (int j = 0; j < 3; ++j) { v[j] = *(const f32x4*)(O + (size_t)t * 768 + (F.lane + 64 * j) * 4); s += (v[j][0] * v[j][0] + v[j][1] * v[j][1]) + (v[j][2] * v[j][2] + v[j][3] * v[j][3]); }
        const float rstd = __builtin_amdgcn_rsqf(wave_sum(s) * (1.f / 768.f) + EPS);
#pragma unroll
        for (int j = 0; j < 3; ++j) { const int col = (F.lane + 64 * j) * 4; const f32x4 gg = *(const f32x4*)(g + col);
            const v2u zw = *(const v2u*)(P + (size_t)t * NP + C_Z + 768 + col);
            const f32x4 r = v[j] * rstd * gg; v2u w; w.x = pk2(r[0] * bflo(zw.x), r[1] * bfhi(zw.x)); w.y = pk2(r[2] * bflo(zw.y), r[3] * bfhi(zw.y));
            *(v2u*)(Y + (size_t)t * DM + col) = w; }
    }
}


template <int KS> __device__ __forceinline__ f32x16 tile_mm(const LAS bf16* A, const LAS bf16* Bt, int r, int hh, f32x16 acc) {
#pragma unroll
    for (int s = 0; s < KS; ++s) {
        const bf16x8 a = *(const LAS bf16x8*)(A + r * 72 + 16 * s + 8 * hh), b = *(const LAS bf16x8*)(Bt + r * 72 + 16 * s + 8 * hh);
        acc = __builtin_amdgcn_mfma_f32_32x32x16_bf16(a, b, acc, 0, 0, 0);
    }
    return acc;
}
__device__ __forceinline__ float logsig16(float a) { return (fminf(a, 0.f) - __logf(1.f + __expf(-fabsf(a)))) * (1.f / 16.f); }
__device__ __forceinline__ void gla_a_item(Frame& F, int l, int item) {
    const int h = item % 6, bn = item / 6, t0 = bn * 64;
    const int tid = F.tid, lane = F.lane, wave = F.wave;
    LAS unsigned char* L = F.lds;
    LAS bf16* QB = (LAS bf16*)(L);
    LAS bf16* KB = (LAS bf16*)(L + 9216);
    LAS bf16* Mm = (LAS bf16*)(L);
    LAS bf16* VT = (LAS bf16*)(L + 18432);
    LAS float* LR = (LAS float*)(L + 36864);
    LAS float* WG = (LAS float*)(L + 36864 + 8192);
    LAS float* BG = (LAS float*)(L + 36864 + 16384);
    LAS bf16* KDT = (LAS bf16*)(L + 36864);
    LAS float* LA = (LAS float*)(L + 55296);
    LAS float* SEGT = (LAS float*)(L + 88576);
    LAS bf16* QF = (LAS bf16*)(L + 90624);
    LAS bf16* KF = (LAS bf16*)(L + 90624 + 18432);
    const bf16* P = WSP(bf16, WS_PROJ) + (size_t)t0 * NP;
    LAS bf16* LRB = (LAS bf16*)(L + 36864);
    LAS bf16* WGT = (LAS bf16*)(L + 36864 + 5120);
    v4u gq_, gk_, gv0_, gv1_, glr_ = {0u, 0u, 0u, 0u}; float gw_[8] = {0.f, 0.f, 0.f, 0.f, 0.f, 0.f, 0.f, 0.f}, gb_ = 0.f;
    { const int r = tid >> 3, c8 = (tid & 7) * 8;
      gq_ = *(const GAS v4u*)(P + (size_t)r * NP + C_GQ + h * 64 + c8); gk_ = *(const GAS v4u*)(P + (size_t)r * NP + C_GK + h * 64 + c8); }
    { const int r = tid & 63, c8 = (tid >> 6) * 8;
      gv0_ = *(const GAS v4u*)(P + (size_t)r * NP + C_GV + h * 128 + c8); gv1_ = *(const GAS v4u*)(P + (size_t)r * NP + C_GV + h * 128 + c8 + 64); }
    if (tid < 256) { const int r = tid >> 2, c8 = (tid & 3) * 8; glr_ = *(const GAS v4u*)(P + (size_t)r * NP + C_LR + c8); }
    else { const int t2 = tid - 256, dir = t2 >> 7, dk = (t2 >> 1) & 63, half = t2 & 1; const float* wgf_ = ld_in(7); const float* wgb_ = ld_in(9);
        const float* wsrc = (dir ? wgb_ : wgf_) + (size_t)l * 16 * 384 + (size_t)(8 * half) * 384 + h * 64 + dk;
#pragma unroll
        for (int j = 0; j < 8; ++j) gw_[j] = wsrc[j * 384]; }
    if (tid < 128) { const int dir = tid >> 6, dk = tid & 63; const float* bgf_ = ld_in(8); const float* bgb_ = ld_in(10); gb_ = (dir ? bgb_ : bgf_)[l * 384 + h * 64 + dk]; }
    __builtin_amdgcn_sched_barrier(0);
    { const int r = tid >> 3, c8 = (tid & 7) * 8; *(LAS v4u*)(QB + r * 72 + c8) = gq_; *(LAS v4u*)(KB + r * 72 + c8) = gk_; }
#pragma unroll
    for (int i = 0; i < 2; ++i) { const int idx = tid + i * 512, r = idx & 63, c8 = (idx >> 6) * 8;
        const v4u raw = i ? gv1_ : gv0_;
        VT[(c8 + 0) * 72 + r] = (unsigned short)(raw.x & 0xffffu); VT[(c8 + 1) * 72 + r] = (unsigned short)(raw.x >> 16);
        VT[(c8 + 2) * 72 + r] = (unsigned short)(raw.y & 0xffffu); VT[(c8 + 3) * 72 + r] = (unsigned short)(raw.y >> 16);
        VT[(c8 + 4) * 72 + r] = (unsigned short)(raw.z & 0xffffu); VT[(c8 + 5) * 72 + r] = (unsigned short)(raw.z >> 16);
        VT[(c8 + 6) * 72 + r] = (unsigned short)(raw.w & 0xffffu); VT[(c8 + 7) * 72 + r] = (unsigned short)(raw.w >> 16); }
    if (tid < 256) { const int r = tid >> 2, c8 = (tid & 3) * 8; *(LAS v4u*)(LRB + r * 40 + c8) = glr_; }
    else { const int t2 = tid - 256, dir = t2 >> 7, dk = (t2 >> 1) & 63, half = t2 & 1;
        *(LAS v4u*)(WGT + (dir * 64 + dk) * 24 + half * 8) = (v4u){pk2(gw_[0], gw_[1]), pk2(gw_[2], gw_[3]), pk2(gw_[4], gw_[5]), pk2(gw_[6], gw_[7])}; }
    if (tid < 128) { const int dir = tid >> 6, dk = tid & 63; BG[dir * 64 + dk] = gb_; }
    LDS_WAIT(); __syncthreads();
    { const int r1 = lane & 31, h1 = lane >> 5, dir = wave >> 2, tb = (wave >> 1) & 1, db = wave & 1;
      const bf16x8 a = *(const LAS bf16x8*)(LRB + (tb * 32 + r1) * 40 + dir * 16 + 8 * h1), b2 = *(const LAS bf16x8*)(WGT + (dir * 64 + db * 32 + r1) * 24 + 8 * h1);
      f32x16 lg = {}; lg = __builtin_amdgcn_mfma_f32_32x32x16_bf16(a, b2, lg, 0, 0, 0);
      const float bs = BG[dir * 64 + db * 32 + r1];
#pragma unroll
      for (int reg = 0; reg < 16; ++reg) { const int tok = tb * 32 + (reg & 3) + 8 * (reg >> 2) + 4 * h1; LA[(dir * 64 + tok) * 65 + db * 32 + r1] = logsig16(lg[reg] + bs); } }
    LDS_WAIT(); __syncthreads();
    const int cdir = (tid >> 6) & 1, cdk = tid & 63, seg = tid >> 7;
    float pb[16];
#pragma unroll
    for (int i = 0; i < 16; ++i) pb[i] = LA[(cdir * 64 + seg * 16 + i) * 65 + cdk];
    if (cdir == 0) {
#pragma unroll
        for (int i = 1; i < 16; ++i) pb[i] += pb[i - 1];
    } else {
#pragma unroll
        for (int i = 14; i >= 0; --i) pb[i] += pb[i + 1];
    }
    SEGT[(cdir * 4 + seg) * 64 + cdk] = cdir == 0 ? pb[15] : pb[0];
    LDS_WAIT(); __syncthreads();
    { float offv = 0.f, tot = 0.f;
#pragma unroll
      for (int s2 = 0; s2 < 4; ++s2) { const float sv = SEGT[(cdir * 4 + s2) * 64 + cdk]; tot += sv; if (cdir == 0 ? (s2 < seg) : (s2 > seg)) offv += sv; }
      bf16* QD = WSP(bf16, WS_QDEC) + (size_t)cdir * T * 384 + (size_t)t0 * 384 + h * 64 + cdk;
      unsigned kd[8]; const float et = __expf(tot);
#pragma unroll
      for (int i = 0; i < 16; i += 2) { float kdf[2];
#pragma unroll
          for (int u = 0; u < 2; ++u) { const int tok = seg * 16 + i + u; const float bv = pb[i + u] + offv;
              const float q = bf2f(QB[tok * 72 + cdk]), k = bf2f(KB[tok * 72 + cdk]);
              const float e1 = __expf(bv), e2 = __builtin_amdgcn_rcpf(e1);
              const unsigned w = pk2(q * 0.125f * e1, k * e2);
              QF[(cdir * 64 + tok) * 72 + cdk] = (unsigned short)(w & 0xffffu); KF[(cdir * 64 + tok) * 72 + cdk] = (unsigned short)(w >> 16); QD[(size_t)tok * 384] = (unsigned short)(w & 0xffffu);
              kdf[u] = k * (et * e2); }
          kd[i >> 1] = pk2(kdf[0], kdf[1]);
          if ((i & 3) == 2) __builtin_amdgcn_sched_barrier(0); }
      *(LAS v4u*)(KDT + (cdir * 64 + cdk) * 72 + seg * 16) = (v4u){kd[0], kd[1], kd[2], kd[3]};
      *(LAS v4u*)(KDT + (cdir * 64 + cdk) * 72 + seg * 16 + 8) = (v4u){kd[4], kd[5], kd[6], kd[7]};
      if (seg == 0) WSP(float, WS_DECAY)[((size_t)item * 2 + cdir) * 64 + cdk] = et; }
    LDS_WAIT(); __syncthreads();
    const int r = lane & 31, hh = lane >> 5;
    if (wave < 4) {
        const int pb2 = wave >> 1, jb = wave & 1; f32x16 sf = {}, sb = {};
        if (pb2 >= jb) sf = tile_mm<4>(QF + (0 * 64 + pb2 * 32) * 72, KF + (0 * 64 + jb * 32) * 72, r, hh, sf);
        if (pb2 <= jb) sb = tile_mm<4>(QF + (1 * 64 + pb2 * 32) * 72, KF + (1 * 64 + jb * 32) * 72, r, hh, sb);
#pragma unroll
        for (int reg = 0; reg < 16; ++reg) { const int p = (reg & 3) + 8 * (reg >> 2) + 4 * hh; float v;
            if (pb2 > jb) v = sf[reg]; else if (pb2 < jb) v = sb[reg]; else v = (r <= p) ? sf[reg] : sb[reg];
            Mm[(pb2 * 32 + p) * 72 + jb * 32 + r] = (unsigned short)f2bf(v); }
    } else {
        const int dvb = wave - 4; bf16* KV = WSP(bf16, WS_KVC) + (size_t)item * 2 * 8192;
#pragma unroll
        for (int dir = 0; dir < 2; ++dir)
#pragma unroll
            for (int dkb = 0; dkb < 2; ++dkb) { f32x16 a = {}; a = tile_mm<4>(VT + (dvb * 32) * 72, KDT + (dir * 64 + dkb * 32) * 72, r, hh, a);
#pragma unroll
                for (int reg = 0; reg < 16; ++reg) { const int dv = dvb * 32 + (reg & 3) + 8 * (reg >> 2) + 4 * hh; KV[(size_t)dir * 8192 + dv * 64 + dkb * 32 + r] = (unsigned short)f2bf(a[reg]); } }
    }
    LDS_WAIT(); __syncthreads();
    { const int pb2 = wave >> 2, dvb = wave & 3; f32x16 a = {}; a = tile_mm<4>(Mm + (pb2 * 32) * 72, VT + (dvb * 32) * 72, r, hh, a);
      bf16* OI = WSP(bf16, WS_OINTRA) + (size_t)(t0 + pb2 * 32) * 768 + h * 128 + dvb * 32 + r;
#pragma unroll
      for (int reg = 0; reg < 16; ++reg) { const int p = (reg & 3) + 8 * (reg >> 2) + 4 * hh; OI[(size_t)p * 768] = (unsigned short)f2bf(a[reg]); } }
    __syncthreads();
}
#ifndef MK_SCAN_GS
#define MK_SCAN_GS 16
#endif
__device__ __forceinline__ void gla_scan_witem(Frame& F, int item) {
    const int slice = item & 31, dir = (item >> 5) & 1, bh = item >> 6, b = bh / 6, h = bh % 6;
    const int e = slice * 256 + F.lane * 4, dk = e & 63;
    const size_t it0 = (size_t)((b * 32 + (dir ? 31 : 0)) * 6 + h) * 2 + dir; const long stp = dir ? -12 : 12;
    const bf16* KV = WSP(bf16, WS_KVC) + it0 * 8192 + e; const float* DC = WSP(float, WS_DECAY) + it0 * 64 + dk; bf16* ST = WSP(bf16, WS_ST) + it0 * 8192 + e;
    f32x4 st = {0.f, 0.f, 0.f, 0.f};
#pragma unroll
    for (int g = 0; g < 32 / MK_SCAN_GS; ++g) {
        v2u kw[MK_SCAN_GS]; f32x4 dc[MK_SCAN_GS];
#pragma unroll
        for (int j = 0; j < MK_SCAN_GS; ++j) { const long o = (long)(g * MK_SCAN_GS + j) * stp; kw[j] = *(const GAS v2u*)(KV + o * 8192); dc[j] = *(const GAS f32x4*)(DC + o * 64); }
#pragma unroll
        for (int j = 0; j < MK_SCAN_GS; ++j) { const long o = (long)(g * MK_SCAN_GS + j) * stp;
            const f32x4 kv = {bflo(kw[j].x), bfhi(kw[j].x), bflo(kw[j].y), bfhi(kw[j].y)};
            v2u w; w.x = pk2(st[0], st[1]); w.y = pk2(st[2], st[3]); *(GAS v2u*)(ST + o * 8192) = w;
            st = dc[j] * st + kv; }
    }
}
#ifndef MK_GC_NB
#define MK_GC_NB 2
#endif
__device__ __forceinline__ void gla_c_task(Frame& F, int l, int task) {
    const int item = task >> 1, half = task & 1, h = item % 6, bn = item / 6, tk0 = bn * 64 + half * 32;
    const int r = F.lane & 31, hh = F.lane >> 5;
    const bf16* QD = WSP(bf16, WS_QDEC); const bf16* ST = WSP(bf16, WS_ST) + (size_t)item * 2 * 8192;
    bf16x8 af[2][4];
#pragma unroll
    for (int dir = 0; dir < 2; ++dir)
#pragma unroll
        for (int s = 0; s < 4; ++s) af[dir][s] = *(const bf16x8*)(QD + (size_t)dir * T * 384 + (size_t)(tk0 + r) * 384 + h * 64 + 16 * s + 8 * hh);
    LAS float* st = (LAS float*)(F.lds + F.wave * 16384);
    bf16x8 bq[MK_GC_NB][2][4];
#define GC_LOAD(i_, dvb_) do { _Pragma("unroll") for (int dir = 0; dir < 2; ++dir) _Pragma("unroll") for (int s = 0; s < 4; ++s) \
        bq[i_][dir][s] = *(const GAS bf16x8*)(ST + (size_t)dir * 8192 + ((dvb_) * 32 + r) * 64 + 16 * s + 8 * hh); } while (0)
#define GC_MMA(i_, dvb_) do { f32x16 acc = {}; _Pragma("unroll") for (int dir = 0; dir < 2; ++dir) _Pragma("unroll") for (int s = 0; s < 4; ++s) \
        acc = __builtin_amdgcn_mfma_f32_32x32x16_bf16(af[dir][s], bq[i_][dir][s], acc, 0, 0, 0); stage_write1(st, acc, dvb_, r, hh); } while (0)
#define GC_SB() __builtin_amdgcn_sched_barrier(0)
#if MK_GC_NB == 4
    GC_LOAD(0, 0); GC_LOAD(1, 1); GC_LOAD(2, 2); GC_LOAD(3, 3); GC_SB();
    GC_MMA(0, 0); GC_MMA(1, 1); GC_MMA(2, 2); GC_MMA(3, 3);
#elif MK_GC_NB == 3
    GC_LOAD(0, 0); GC_LOAD(1, 1); GC_LOAD(2, 2); GC_SB();
    GC_MMA(0, 0); GC_SB(); GC_LOAD(0, 3); GC_SB();
    GC_MMA(1, 1); GC_MMA(2, 2); GC_MMA(0, 3);
#else
    GC_LOAD(0, 0); GC_LOAD(1, 1); GC_SB();
    GC_MMA(0, 0); GC_SB(); GC_LOAD(0, 2); GC_SB();
    GC_MMA(1, 1); GC_SB(); GC_LOAD(1, 3); GC_SB();
    GC_MMA(0, 2); GC_MMA(1, 3);
#endif
#undef GC_LOAD
#undef GC_MMA
#undef GC_SB
    LDS_WAIT(); asm volatile("" ::: "memory");
    rows_finish<true>(st, F.lane, WSP(bf16, WS_OINTRA) + (size_t)tk0 * 768 + h * 128, ld_in(11) + l * 128, WSP(bf16, WS_PROJ) + (size_t)tk0 * NP + C_Z + h * 128, WSP(bf16, WS_HY) + (size_t)tk0 * DM + 768 + h * 128, nullptr);
    if (MK_FUSE_Y) { asm volatile("s_waitcnt vmcnt(0)" ::: "memory");
        if (F.lane == 0) (void)__hip_atomic_fetch_add((unsigned*)(F.ws + WS_CTL) + CW_YREADY + 2048 * (2 * l) + 64 * (tk0 >> 8), 1u, __ATOMIC_RELAXED, __HIP_MEMORY_SCOPE_AGENT); }
    LDS_WAIT(); asm volatile("" ::: "memory");
}

__device__ __forceinline__ void gla_c_round(Frame& F, int l, int base, int n) {
    const int wave = F.wave, lane = F.lane, r = lane & 31, hh = lane >> 5;
    const bool act = wave < n; const int task = base + wave, item = task >> 1, half = task & 1, h = item % 6, bn = item / 6, tk0 = bn * 64 + half * 32;
    LAS unsigned char* tile = F.lds + (wave >> 1) * 32768;
    bf16x8 af[2][4];
    if (act && task < 2 * NITEM) {
        const bf16* ST = WSP(bf16, WS_ST) + (size_t)item * 2 * 8192; const int lp = (wave & 1) * 64 + lane;
        v4u tv[16];
#pragma unroll
        for (int j = 0; j < 16; ++j) tv[j] = *(const v4u*)(ST + (size_t)(lp + 128 * j) * 8);
        const bf16* QD = WSP(bf16, WS_QDEC);
#pragma unroll
        for (int dir = 0; dir < 2; ++dir)
#pragma unroll
            for (int s = 0; s < 4; ++s) af[dir][s] = *(const bf16x8*)(QD + (size_t)dir * T * 384 + (size_t)(tk0 + r) * 384 + h * 64 + 16 * s + 8 * hh);
#pragma unroll
        for (int j = 0; j < 16; ++j) { const int q = lp + 128 * j, row = q >> 3, c = q & 7; *(LAS v4u*)(tile + row * 128 + ((c ^ (row & 7)) << 4)) = tv[j]; }
    }
    LDS_WAIT(); __syncthreads();
    f32x16 acc[4];
    if (act && task < 2 * NITEM) {
#pragma unroll
        for (int dvb = 0; dvb < 4; ++dvb) { acc[dvb] = f32x16{}; const int row = dvb * 32 + r;
#pragma unroll
            for (int dir = 0; dir < 2; ++dir)
#pragma unroll
                for (int s = 0; s < 4; ++s) { const bf16x8 bfr = *(const LAS bf16x8*)(tile + dir * 16384 + row * 128 + (((2 * s + hh) ^ (row & 7)) << 4));
                    acc[dvb] = __builtin_amdgcn_mfma_f32_32x32x16_bf16(af[dir][s], bfr, acc[dvb], 0, 0, 0); } }
    }
    LDS_WAIT(); __syncthreads();
    if (act && task < 2 * NITEM) {
        LAS float* st = (LAS float*)(F.lds + wave * 16384);
        stage_write(st, acc, r, hh);
        LDS_WAIT(); asm volatile("" ::: "memory");
        rows_finish<true>(st, lane, WSP(bf16, WS_OINTRA) + (size_t)tk0 * 768 + h * 128, ld_in(11) + l * 128, WSP(bf16, WS_PROJ) + (size_t)tk0 * NP + C_Z + h * 128, WSP(bf16, WS_HY) + (size_t)tk0 * DM + 768 + h * 128, nullptr);
    }
    LDS_WAIT(); __syncthreads();
}

__device__ __forceinline__ void gla_seq_wg(Frame& F, int l, int bh, int dir) {
    const int b = bh / 6, h = bh % 6, tid = F.tid, lane = F.lane, wave = F.wave, r = lane & 31, hh = lane >> 5;
    LAS unsigned char* L = F.lds;
    LAS bf16* QB = (LAS bf16*)(L);
    LAS bf16* KB = (LAS bf16*)(L + 9216);
    LAS bf16* VT = (LAS bf16*)(L + 18432);
    LAS bf16* QF = (LAS bf16*)(L + 36864);
    LAS bf16* KF = (LAS bf16*)(L + 46080);
    LAS bf16* KDT = (LAS bf16*)(L + 55296);
    LAS bf16* MM = (LAS bf16*)(L + 64512);
    LAS bf16* STT = (LAS bf16*)(L + 73728);
    LAS float* LR = (LAS float*)(L + 92160);
    LAS float* SEGT = (LAS float*)(L + 96256);
    LAS float* DEC = (LAS float*)(L + 98304);
    const bf16* P = WSP(bf16, WS_PROJ) + (size_t)b * SEQ * NP;
    bf16* OD = WSP(bf16, dir ? WS_OINTRA : WS_OMLA) + (size_t)b * SEQ * 768 + h * 128;
    float wgt[16]; { const float* wg = ld_in(dir ? 9 : 7) + (size_t)l * 16 * 384 + h * 64 + lane;
#pragma unroll
        for (int q = 0; q < 16; ++q) wgt[q] = wg[q * 384]; }
    const float bias = ld_in(dir ? 10 : 8)[l * 384 + h * 64 + lane];
    for (int i = tid; i < (73728 + 18432 - 64512) / 4; i += NTHR) ((LAS unsigned*)(L + 64512))[i] = 0u;
    f32x16 sacc = {};
    const int tokb = wave >> 2, dvb = wave & 3;
    v4u pq, pk, pv0, pv1, plr;
    const int qrow = tid >> 3, qc8 = (tid & 7) * 8, vtok = tid & 63, vcb = tid >> 6;
#define GS_PREFETCH(n_) do { const bf16* pc = P + (size_t)((n_) * 64) * NP; \
        pq = *(const v4u*)(pc + (size_t)qrow * NP + C_GQ + h * 64 + qc8); pk = *(const v4u*)(pc + (size_t)qrow * NP + C_GK + h * 64 + qc8); \
        pv0 = *(const v4u*)(pc + (size_t)vtok * NP + C_GV + h * 128 + vcb * 8); pv1 = *(const v4u*)(pc + (size_t)vtok * NP + C_GV + h * 128 + (vcb + 8) * 8); \
        if (tid < 128) plr = *(const v4u*)(pc + (size_t)(tid >> 1) * NP + C_LR + dir * 16 + (tid & 1) * 8); } while (0)
    GS_PREFETCH(dir ? 31 : 0);
    __syncthreads();
#pragma unroll 1
    for (int s = 0; s < 32; ++s) {
        const int n = dir ? 31 - s : s;
#ifdef GS_NOPREFETCH
        GS_PREFETCH(n);
#endif
        *(LAS v4u*)(QB + qrow * 72 + qc8) = pq; *(LAS v4u*)(KB + qrow * 72 + qc8) = pk;
        { const unsigned w0[4] = {pv0.x, pv0.y, pv0.z, pv0.w}, w1[4] = {pv1.x, pv1.y, pv1.z, pv1.w};
#pragma unroll
          for (int e = 0; e < 4; ++e) { VT[(vcb * 8 + 2 * e) * 72 + vtok] = (unsigned short)(w0[e] & 0xffffu); VT[(vcb * 8 + 2 * e + 1) * 72 + vtok] = (unsigned short)(w0[e] >> 16);
              VT[((vcb + 8) * 8 + 2 * e) * 72 + vtok] = (unsigned short)(w1[e] & 0xffffu); VT[((vcb + 8) * 8 + 2 * e + 1) * 72 + vtok] = (unsigned short)(w1[e] >> 16); } }
        if (tid < 128) { float f[8]; unpack8(plr, f);
#pragma unroll
            for (int e = 0; e < 8; ++e) LR[(tid >> 1) * 16 + (tid & 1) * 8 + e] = f[e]; }
#ifndef GS_NOPREFETCH
        if (s + 1 < 32) GS_PREFETCH(dir ? 30 - s : s + 1);
#endif
        LDS_WAIT(); __syncthreads();
        float pb8[8];
#pragma unroll
        for (int i = 0; i < 8; ++i) { const LAS float* lr = LR + (wave * 8 + i) * 16; float a = bias;
#pragma unroll
            for (int q = 0; q < 16; ++q) a += lr[q] * wgt[q];
            pb8[i] = logsig16(a); }
        if (dir == 0) {
#pragma unroll
            for (int i = 1; i < 8; ++i) pb8[i] += pb8[i - 1];
        } else {
#pragma unroll
            for (int i = 6; i >= 0; --i) pb8[i] += pb8[i + 1];
        }
        SEGT[wave * 64 + lane] = dir == 0 ? pb8[7] : pb8[0];
        LDS_WAIT(); __syncthreads();
        { float offv = 0.f, tot = 0.f;
#pragma unroll
          for (int s2 = 0; s2 < 8; ++s2) { const float sv = SEGT[s2 * 64 + lane]; tot += sv; if (dir == 0 ? (s2 < wave) : (s2 > wave)) offv += sv; }
          unsigned kd[4];
#pragma unroll
          for (int i = 0; i < 8; ++i) { const int tok = wave * 8 + i; const float bv = pb8[i] + offv;
              const float q = bf2f(QB[tok * 72 + lane]), k = bf2f(KB[tok * 72 + lane]);
              QF[tok * 72 + lane] = (unsigned short)f2bf(q * 0.125f * __expf(bv)); KF[tok * 72 + lane] = (unsigned short)f2bf(k * __expf(-bv));
              const unsigned kdv = f2bf(k * __expf(tot - bv)); if (i & 1) kd[i >> 1] |= kdv << 16; else kd[i >> 1] = kdv; }
          *(LAS v4u*)(KDT + lane * 72 + wave * 8) = (v4u){kd[0], kd[1], kd[2], kd[3]};
          if (wave == 0) DEC[lane] = __expf(tot); }
        LDS_WAIT(); __syncthreads();
        f32x16 oacc = {};
        oacc = tile_mm<4>(QF + tokb * 32 * 72, STT + dvb * 32 * 72, r, hh, oacc);
        if (wave < 3) { const int pb2 = dir == 0 ? (wave + 1) >> 1 : wave >> 1, jb = dir == 0 ? wave >> 1 : (wave + 1) >> 1;
            f32x16 sc = {}; sc = tile_mm<4>(QF + pb2 * 32 * 72, KF + jb * 32 * 72, r, hh, sc);
#pragma unroll
            for (int reg = 0; reg < 16; ++reg) { const int p = (reg & 3) + 8 * (reg >> 2) + 4 * hh; float v = sc[reg];
                if (pb2 == jb) v = (dir == 0 ? (r <= p) : (r > p)) ? v : 0.f;
                MM[(pb2 * 32 + p) * 72 + jb * 32 + r] = (unsigned short)f2bf(v); } }
        LDS_WAIT(); __syncthreads();
        oacc = tile_mm<4>(MM + tokb * 32 * 72, VT + dvb * 32 * 72, r, hh, oacc);
        { bf16* o = OD + (size_t)(n * 64 + tokb * 32) * 768 + dvb * 32 + r;
#pragma unroll
          for (int reg = 0; reg < 16; ++reg) { const int p = (reg & 3) + 8 * (reg >> 2) + 4 * hh; o[(size_t)p * 768] = (unsigned short)f2bf(oacc[reg]); } }
#pragma unroll
        for (int g4 = 0; g4 < 4; ++g4) { const f32x4 dc = *(const LAS f32x4*)(DEC + tokb * 32 + 8 * g4 + 4 * hh);
#pragma unroll
            for (int e = 0; e < 4; ++e) sacc[4 * g4 + e] *= dc[e]; }
        sacc = tile_mm<4>(KDT + tokb * 32 * 72, VT + dvb * 32 * 72, r, hh, sacc);
#pragma unroll
        for (int g4 = 0; g4 < 4; ++g4) { v2u w; w.x = pk2(sacc[4 * g4], sacc[4 * g4 + 1]); w.y = pk2(sacc[4 * g4 + 2], sacc[4 * g4 + 3]);
            *(LAS v2u*)(STT + (dvb * 32 + r) * 72 + tokb * 32 + 8 * g4 + 4 * hh) = w; }
        LDS_WAIT(); __syncthreads();
    }
#undef GS_PREFETCH
}
__device__ __forceinline__ void gla_comb_rows(Frame& F, int l) {
    const int gw = F.vcu * NWAVES + F.wave, NGW = F.G * NWAVES, sub = F.lane >> 4, c8 = (F.lane & 15) * 8;
    const bf16* OF = WSP(bf16, WS_OMLA); const bf16* OB = WSP(bf16, WS_OINTRA); const bf16* P = WSP(bf16, WS_PROJ); bf16* Y = WSP(bf16, WS_HY);
    const float* g = ld_in(11) + l * 128 + c8; const f32x4 g0 = *(const f32x4*)g, g1 = *(const f32x4*)(g + 4); const float gg[8] = {g0[0], g0[1], g0[2], g0[3], g1[0], g1[1], g1[2], g1[3]};
    for (int it = gw; it < T * 6 / 4; it += NGW) { const int pair = it * 4 + sub, t = pair / 6, h = pair % 6; const size_t o = (size_t)t * 768 + h * 128 + c8;
        float a[8], b2[8], z[8]; unpack8(*(const v4u*)(OF + o), a); unpack8(*(const v4u*)(OB + o), b2); unpack8(*(const v4u*)(P + (size_t)t * NP + C_Z + h * 128 + c8), z);
        float ss = 0.f;
#pragma unroll
        for (int e = 0; e < 8; ++e) { a[e] += b2[e]; ss += a[e] * a[e]; }
        ss += __shfl_xor(ss, 1); ss += __shfl_xor(ss, 2); ss += __shfl_xor(ss, 4); ss += __shfl_xor(ss, 8);
        const float rstd = __builtin_amdgcn_rsqf(ss * (1.f / 128.f) + EPS);
        v4u w; w.x = pk2(a[0] * rstd * gg[0] * z[0], a[1] * rstd * gg[1] * z[1]); w.y = pk2(a[2] * rstd * gg[2] * z[2], a[3] * rstd * gg[3] * z[3]);
        w.z = pk2(a[4] * rstd * gg[4] * z[4], a[5] * rstd * gg[5] * z[5]); w.w = pk2(a[6] * rstd * gg[6] * z[6], a[7] * rstd * gg[7] * z[7]);
        *(v4u*)(Y + (size_t)t * DM + 768 + h * 128 + c8) = w; }
}
#define XB_TMO      128
#define XB_XCNT(j)  (256  + 64 * (j))
#define XB_XSUB(j)  (1280 + 64 * (j))
#define XB_XGEN(j)  (2304 + 64 * (j))
#define XB_TOP      3328
#define XB_TOPGEN   3392
#define XCD_BAR_WORDS 3456
#define XB_SPIN_CAP (1u << 18)
__device__ __forceinline__ unsigned xb_ld(unsigned* p)              { return __hip_atomic_load(p, __ATOMIC_RELAXED, __HIP_MEMORY_SCOPE_AGENT); }
__device__ __forceinline__ unsigned xb_add(unsigned* p, unsigned v) { return __hip_atomic_fetch_add(p, v, __ATOMIC_RELAXED, __HIP_MEMORY_SCOPE_AGENT); }
__device__ __forceinline__ unsigned xb_xcc_id() { return (unsigned)__builtin_amdgcn_s_getreg((3 << 11) | 20) & 0xFu; }
#define XB_SPIN(cond, bar) do { unsigned _sp = 0; while (cond) { __builtin_amdgcn_s_sleep(1); \
    if ((++_sp & 255u) == 0u) { if (xb_ld(&(bar)[XB_TMO])) break; if (_sp > XB_SPIN_CAP) { atomicAdd(&(bar)[XB_TMO], 1u); break; } } } } while (0)
struct XcdBarrier { unsigned* bar; unsigned x; volatile LAS unsigned* st; };
__device__ __forceinline__ XcdBarrier xcd_barrier_post(unsigned* bar, volatile LAS unsigned* st) {
    XcdBarrier b; b.bar = bar; b.x = xb_xcc_id(); b.st = st;
    if (threadIdx.x == 0) (void)xb_add(&bar[XB_XCNT(b.x)], 1u);
    return b;
}
__device__ __forceinline__ void xcd_barrier_complete(unsigned* bar, unsigned x, unsigned& nloc, unsigned& nx) {
    const unsigned G = gridDim.x * gridDim.y * gridDim.z;
    unsigned sum, cnt, mine, sp = 0u;
    for (;;) {
        sum = 0u; cnt = 0u; mine = 0u;
        unsigned c_[16]; { const GAS unsigned* p_ = (const GAS unsigned*)&bar[XB_XCNT(0)];
            asm volatile("global_load_dword %0, %16, off sc1\n\tglobal_load_dword %1, %16, off offset:256 sc1\n\tglobal_load_dword %2, %16, off offset:512 sc1\n\tglobal_load_dword %3, %16, off offset:768 sc1\n\t"
                         "global_load_dword %4, %16, off offset:1024 sc1\n\tglobal_load_dword %5, %16, off offset:1280 sc1\n\tglobal_load_dword %6, %16, off offset:1536 sc1\n\tglobal_load_dword %7, %16, off offset:1792 sc1\n\t"
                         "global_load_dword %8, %16, off offset:2048 sc1\n\tglobal_load_dword %9, %16, off offset:2304 sc1\n\tglobal_load_dword %10, %16, off offset:2560 sc1\n\tglobal_load_dword %11, %16, off offset:2816 sc1\n\t"
                         "global_load_dword %12, %16, off offset:3072 sc1\n\tglobal_load_dword %13, %16, off offset:3328 sc1\n\tglobal_load_dword %14, %16, off offset:3584 sc1\n\tglobal_load_dword %15, %16, off offset:3840 sc1\n\ts_waitcnt vmcnt(0)"
                         : "=&v"(c_[0]), "=&v"(c_[1]), "=&v"(c_[2]), "=&v"(c_[3]), "=&v"(c_[4]), "=&v"(c_[5]), "=&v"(c_[6]), "=&v"(c_[7]), "=&v"(c_[8]), "=&v"(c_[9]), "=&v"(c_[10]), "=&v"(c_[11]), "=&v"(c_[12]), "=&v"(c_[13]), "=&v"(c_[14]), "=&v"(c_[15])
                         : "v"(p_) : "memory"); }
#pragma unroll
        for (unsigned j = 0; j < 16; ++j) { const unsigned c = c_[j]; sum += c; cnt += (c > 0u) ? 1u : 0u; mine = (j == x) ? c : mine; }
        if (sum == G) break;
        __builtin_amdgcn_s_sleep(1);
        if ((++sp & 255u) == 0u) { if (xb_ld(&bar[XB_TMO])) break; if (sp > XB_SPIN_CAP) { atomicAdd(&bar[XB_TMO], 1u); break; } }
    }
    nloc = mine > 0u ? mine : 1u; nx = cnt > 0u ? cnt : 1u;
}
__device__ __forceinline__ void xcd_barrier(const XcdBarrier& b) {
    asm volatile("s_waitcnt vmcnt(0)" ::: "memory");
    __syncthreads();
    if (threadIdx.x == 0) {
        unsigned* bar = b.bar;
        __builtin_amdgcn_s_waitcnt(0);
        unsigned nloc = b.st[0], nx = b.st[1];
        if (nloc == 0u) { xcd_barrier_complete(bar, b.x, nloc, nx); b.st[0] = nloc; b.st[1] = nx; }
        const unsigned old = xb_add(&bar[XB_XSUB(b.x)], 1u);
        const unsigned gen = old / nloc;
        if (old + 1u == (gen + 1u) * nloc) {
            __builtin_amdgcn_fence(__ATOMIC_RELEASE, "agent");
            asm volatile("s_waitcnt vmcnt(0)" ::: "memory");
            const unsigned og = xb_add(&bar[XB_TOP], 1u);
            const unsigned tg = og / nx;
            if (og + 1u == (tg + 1u) * nx) xb_add(&bar[XB_TOPGEN], 1u);
            else XB_SPIN(xb_ld(&bar[XB_TOPGEN]) == tg, bar);
            __builtin_amdgcn_fence(__ATOMIC_ACQUIRE, "agent");
            xb_add(&bar[XB_XGEN(b.x)], 1u);
            asm volatile("s_waitcnt vmcnt(0)" ::: "memory");
        } else {
            XB_SPIN(xb_ld(&bar[XB_XGEN(b.x)]) == gen, bar);
            __builtin_amdgcn_fence(__ATOMIC_ACQUIRE, "agent");
            asm volatile("s_waitcnt vmcnt(0)" ::: "memory");
        }
    }
    __syncthreads();
}

__device__ __forceinline__ void sub_barrier(unsigned* cnt, unsigned target) {
    asm volatile("s_waitcnt vmcnt(0)" ::: "memory");
    __syncthreads();
    if (threadIdx.x == 0) {
        __builtin_amdgcn_fence(__ATOMIC_RELEASE, "agent");
        asm volatile("s_waitcnt vmcnt(0)" ::: "memory");
        (void)xb_add(cnt, 1u);
        unsigned sp = 0u; while (xb_ld(cnt) < target) { __builtin_amdgcn_s_sleep(2); if (++sp > (1u << 22)) break; }
        __builtin_amdgcn_fence(__ATOMIC_ACQUIRE, "agent");
        asm volatile("s_waitcnt vmcnt(0)" ::: "memory");
    }
    __syncthreads();
}

__device__ __forceinline__ unsigned wg_fetch(unsigned* cnt, unsigned n, volatile LAS unsigned* slot) {
    __syncthreads();
    if (threadIdx.x == 0) *slot = xb_add(cnt, n);
    __syncthreads();
    return *slot;
}
__device__ __forceinline__ void wait_counter(unsigned* cnt, unsigned target) {
    if (threadIdx.x == 0) { unsigned sp = 0u; while (xb_ld(cnt) < target) { __builtin_amdgcn_s_sleep(2); if (++sp > (1u << 22)) break; }
        __builtin_amdgcn_fence(__ATOMIC_ACQUIRE, "agent"); asm volatile("s_waitcnt vmcnt(0)" ::: "memory"); }
    __syncthreads();
}

#ifndef MK_KSPLIT
#define MK_KSPLIT 1
#endif
#ifndef MK_MAIN_HELP
#define MK_MAIN_HELP 0
#endif
#ifndef MK_NT_TAIL
#define MK_NT_TAIL 0
#endif
#ifndef MK_LATE_FETCH
#define MK_LATE_FETCH 2u
#endif
struct Args { const float* in[21]; float* out; unsigned char* ws; int ph_lo, ph_hi; };
constexpr int N_PHASES = 2 + 6 * DEPTH;
__global__ void __launch_bounds__(NTHR, 2) mega_fwd(Args args) {
    extern __shared__ __attribute__((aligned(16))) unsigned char lds[];
    Frame F;
    F.lds = (LAS unsigned char*)lds; F.ldsg = (char*)lds;
    F.tid = threadIdx.x; F.lane = F.tid & 63; F.wave = __builtin_amdgcn_readfirstlane(F.tid >> 6);
    F.G = gridDim.x; { const int bx = blockIdx.x; F.vcu = (F.G % 8 == 0) ? (bx % 8) * (F.G / 8) + bx / 8 : bx; }
    F.out = args.out; F.ws = args.ws;
    volatile LAS unsigned* MISC = (volatile LAS unsigned*)(F.lds + MISC_OFF);
    for (int u = F.tid; u < (LDS_BYTES - LDSCTL_OFF) / 4; u += NTHR) ((LAS unsigned*)(F.lds + LDSCTL_OFF))[u] = 0u;
    __syncthreads();
    XcdBarrier bar = xcd_barrier_post((unsigned*)(F.ws + WS_CTL) + CW_BAR, MISC + 8);
    const int lo = args.ph_lo, hi = args.ph_hi; int nstamp = 0;
#ifndef MK_MASK
#define MK_MASK 0xFF
#endif
#define PHON(b) ((MK_MASK >> (b)) & 1)
#ifndef MK_REP_PH
#define MK_REP_PH -1
#endif
#define REPS(ph) for (int rep_ = 0; rep_ < ((ph) == MK_REP_PH ? 2 : 1); ++rep_)
#define REPBAR() do { if (rep_ == 0 && false) {} } while (0)
#define IN(k) (lo <= (k) && (k) < hi)
#define FRESH() do { int t_ = threadIdx.x; asm volatile("" : "+v"(t_)); F.tid = t_; F.lane = t_ & 63; F.wave = __builtin_amdgcn_readfirstlane(t_ >> 6); GAS unsigned char* w_ = (GAS unsigned char*)args.ws; asm volatile("" : "+s"(w_)); F.ws = (unsigned char*)w_; GAS float* o_ = (GAS float*)args.out; asm volatile("" : "+s"(o_)); F.out = (float*)o_; } while (0)
#ifndef MK_DIAG_A
#define MK_DIAG_A -1
#define MK_DIAG_B -1
#endif
#define STAMP() do { if (MK_DIAG_A >= 0 && blockIdx.x == 0 && threadIdx.x == 0) { ((unsigned long long*)(args.ws + WS_CTL + 131072))[nstamp] = __builtin_amdgcn_s_memrealtime(); } ++nstamp; } while (0)
#define SEAM(k) do { if (IN(k) && IN((k) + 1)) { xcd_barrier(bar); STAMP(); } } while (0)
    STAMP();
#ifndef MK_FUSE_P0B
#define MK_FUSE_P0B 1
#endif
    { if (PHON(0) && IN(0)) { p0_prologue(F, WS_MODS, MK_IDLE_GEMV > 0 && F.G == 256, (MK_FUSE_P0B && IN(1)) ? (unsigned*)(F.ws + WS_CTL) + 32 : (unsigned*)nullptr); } if (!(MK_FUSE_P0B && IN(0) && IN(1))) SEAM(0); }
    REPS(101) { if (PHON(1) && IN(1)) {
        if (MK_FUSE_P0B && IN(0) && rep_ == 0) { FRESH(); wait_counter((unsigned*)(F.ws + WS_CTL) + 32, (unsigned)F.G); }
        modnorm_rows(F, ld_in(0), ld_in(5), WSP(float, WS_MODS), WSP(bf16, WS_HY)); } SEAM(1); }
#pragma unroll 1
    for (int l = 0; l < DEPTH; ++l) {
        const int pb = 2 + 6 * l;
#define mods_l (WSP(float, WS_MODS) + (size_t)l * BATCH * 3 * DM)
        REPS(0) { if (PHON(2) && IN(pb)) {
            FRESH();
            pg8::Gemm g{WSP(bf16, WS_HY), WSP(bf16, WS_WIN) + (size_t)l * NP * DM, T, NP, DM, DM}; pg8::StaticOrder S; S.init(T, NP, F.G, (int)blockIdx.x);
            EpiIn E{WSP(bf16, WS_PROJ), WSP(float, WS_CS), WSP(float, WS_SN), WSP(float, WS_PARTQ), WSP(float, WS_PARTKV)};
            pg8::gemm_phase<EpiIn, pg8::StaticOrder, true, true>(F.lds, g, S, E);
            if (MK_IDLE_GEMV > 0 && F.G == 256 && l == 0 && rep_ == 0 && (int)blockIdx.x >= 224) {
                __syncthreads(); FRESH(); p0_mods(F, WS_MODS, (int)blockIdx.x - 224, 32, 768 - MK_IDLE_GEMV, 768); }
        } SEAM(pb); }
        REPS(1) { if (PHON(3) && IN(pb + 1)) {
#ifndef MK_SUB
#define MK_SUB 0xFF
#endif
            for (int rr_ = 0; rr_ < (MK_REP_PH == 9 ? 2 : 1); ++rr_) {
            FRESH();
            const bool ksplit = MK_KSPLIT && F.G == 256;
            if ((MK_SUB & 1) && (!ksplit || (int)blockIdx.x >= 160)) { pg8::Gemm g{WSP(bf16, WS_PROJ) + C_MKV, WSP(bf16, WS_WUKV) + (size_t)l * NKV * 256, T, NKV, 256, NP}; pg8::StaticOrder S; S.init(T, NKV, ksplit ? 96 : F.G, ksplit ? (int)blockIdx.x - 160 : (int)blockIdx.x);
              EpiUkv E{WSP(bf16, WS_KVUP), WSP(float, WS_PARTKV)};
              pg8::gemm_phase<EpiUkv, pg8::StaticOrder, true, true>(F.lds, g, S, E); }
            FRESH();
            if ((MK_SUB & 2) && (!ksplit || (int)blockIdx.x < 160)) { pg8::Gemm g{WSP(bf16, WS_PROJ) + C_MQ, WSP(bf16, WS_WUQ) + (size_t)l * NQ * 384, T, NQ, 384, NP}; pg8::StaticOrder S; S.init(T, NQ, ksplit ? 160 : F.G, ksplit ? (int)blockIdx.x : ((int)blockIdx.x + 64) % F.G);
              EpiUq E{WSP(bf16, WS_QUP), WSP(float, WS_CS), WSP(float, WS_SN), WSP(float, WS_PARTQ)};
              pg8::gemm_phase<EpiUq, pg8::StaticOrder, true, true>(F.lds, g, S, E); }
            __syncthreads(); }
            FRESH();
            for (int rr_ = 0; rr_ < (MK_REP_PH == 10 ? 2 : 1); ++rr_)
            if (MK_SUB & 4) {
                const int w = (int)blockIdx.x;
#pragma unroll 1
                for (int j = 0; ; ++j) { int it;
                    if (F.G == 256 && !MK_KSPLIT) it = w < 96 ? (j < 2 ? 2 * w + j : NITEM) : 192 + (w - 96) + 160 * j; else it = w + j * F.G;
                    if (it >= NITEM) break; gla_a_item(F, l, it); }
            }
            FRESH(); conv_rows(F, l);
        } SEAM(pb + 1); }
        if (F.G <= 192) { REPS(7) { if (PHON(3) && IN(pb + 2)) {
            FRESH(); { const int gw = F.vcu * NWAVES + F.wave, NGW = F.G * NWAVES; for (int it = gw; it < 1536; it += NGW) gla_scan_witem(F, it); }
        } SEAM(pb + 2); } }
        REPS(2) { if (PHON(4) && IN(pb + 3)) {
            const int bx = (int)blockIdx.x; FRESH();
            const int natt = F.G > 192 ? 192 : F.G;
            const bool split = MK_NT_TAIL > 0 && F.G == 256, spare = F.G > 192 && bx >= 192;
            unsigned* scan_done = (unsigned*)(F.ws + WS_CTL) + 64 + 64 * (l * 2 + rep_); unsigned* queue = (unsigned*)(F.ws + WS_CTL) + 1024 + 64 * (l * 2 + rep_);
            if (spare) { const int gw = (bx - 192) * NWAVES + F.wave, NGW = (F.G - 192) * NWAVES;
                for (int rr_ = 0; rr_ < (MK_REP_PH == 21 ? 2 : 1); ++rr_)
                for (int it = gw; it < 1536; it += NGW) gla_scan_witem(F, it);
                sub_barrier(scan_done, (unsigned)(F.G - 192)); }
#pragma unroll 1
            for (int pass = 0; pass < 2; ++pass) {
                if (F.G > 192 && pass == (spare ? 0 : 1) && (spare || (!split && MK_MAIN_HELP))) {
                    if (!spare) wait_counter(scan_done, (unsigned)(F.G - 192));
                    FRESH();
                    const unsigned nf = spare ? (unsigned)NWAVES : MK_LATE_FETCH;
                    for (int rr_ = 0; rr_ < (MK_REP_PH == 22 ? 2 : 1); ++rr_)
                    for (;;) { const unsigned base = wg_fetch(queue + 32 * rr_, nf, MISC + 16); if (base >= 2u * NITEM) break;
                        const int task = (int)base + F.wave; if ((unsigned)F.wave < nf && task < 2 * NITEM) gla_c_task(F, l, task); }
                    if (MK_SPARE_GEMV > 0 && MK_IDLE_GEMV > 0 && F.G == 256 && l == 0 && rep_ == 0 && spare) {
                        FRESH(); p0_mods(F, WS_MODS, bx - 192, 64, 768 - MK_IDLE_GEMV - MK_SPARE_GEMV, 768 - MK_IDLE_GEMV);
                        if (MK_FUSE_Y) { asm volatile("s_waitcnt vmcnt(0)" ::: "memory"); __syncthreads();
                            if (F.tid < 32) (void)__hip_atomic_fetch_add((unsigned*)(F.ws + WS_CTL) + CW_YREADY + 2048 * (2 * l) + 64 * F.tid, 1u, __ATOMIC_RELAXED, __HIP_MEMORY_SCOPE_AGENT); } }
                }
                if (pass == 0) {
                    FRESH();
                    const int nun = spare ? (split ? 3 : 0) : (bx < natt ? (192 - bx + natt - 1) / natt : 0);
                    for (int rr_ = 0; rr_ < ((MK_REP_PH == 20 || (MK_REP_PH == 23 && spare) || (MK_REP_PH == 24 && !spare)) ? 2 : 1); ++rr_)
#pragma unroll 1
                    for (int i = 0; i < nun; ++i) { int u, mode, kt0, nt;
                        if (spare) { const int s_ = bx - 192; u = (s_ & 7) * 24 + 3 * (s_ >> 3) + i; mode = 2; kt0 = 32 - MK_NT_TAIL; nt = MK_NT_TAIL; }
                        else { const int u0 = bx + i * natt; u = (natt == 192) ? (u0 & 7) * 24 + (u0 >> 3) : u0; mode = split ? 1 : 0; kt0 = 0; nt = split ? 32 - MK_NT_TAIL : 32; }
                        const int bh = u >> 3, qb = u & 7, b = bh / 6, h = bh % 6; const size_t row0 = (size_t)b * SEQ, qrow = row0 + qb * 256, krow = row0 + (size_t)kt0 * 64;
                        mla::attn_unit(WSP(bf16, WS_QUP) + qrow * NQ + h * 192, WSP(bf16, WS_KVUP) + krow * NKV + h * 256, WSP(bf16, WS_KVUP) + krow * NKV + h * 256 + 128,
                                       WSP(bf16, WS_PROJ) + krow * NP + C_MKR, WSP(bf16, WS_HY) + qrow * DM + h * 128, WSP(bf16, WS_PROJ) + qrow * NP + C_Z + 768 + h * 128,
                                       ld_in(16) + l * 768 + h * 128, WSP(float, WS_CTL + WS_ROWSS) + (size_t)l * T + qrow, nt * 64, F.ldsg,
                                       mode | (u << 4) | ((l * 2 + rep_) << 12)); }
                }
            }
            if (F.G <= 192) { FRESH(); const int gw = F.vcu * NWAVES + F.wave, NGW = F.G * NWAVES; for (int task = gw; task < 2 * NITEM; task += NGW) gla_c_task(F, l, task); }
        } if (!(MK_FUSE_Y && F.G == 256 && MK_REP_PH != 4 && IN(pb + 3) && IN(pb + 4))) SEAM(pb + 3); }
        for (int rep_ = 0; rep_ < ((MK_REP_PH == 4 && l == 0) ? 2 : 1); ++rep_) { if (PHON(6) && IN(pb + 4)) {
            FRESH();
            pg8::Gemm g{WSP(bf16, WS_HY), WSP(bf16, WS_WOUT) + (size_t)l * DM * DM, T, DM, DM, DM}; pg8::StaticOrder S; S.init(T, DM, F.G, (int)blockIdx.x);
            if (MK_FUSE_Y && F.G == 256 && MK_REP_PH != 4 && IN(pb + 3)) {
                pg8::Unit u0; if (S.next(0, u0)) wait_counter((unsigned*)(F.ws + WS_CTL) + CW_YREADY + 2048 * (2 * l) + 64 * u0.pm, 96u + ((MK_SPARE_GEMV > 0 && MK_IDLE_GEMV > 0 && l == 0) ? 64u : 0u)); }
            if (F.G == 256 && MK_REP_PH != 4) {
                const int last = (l + 1 == DEPTH);
                EpiOutNorm E{ld_in(0), l == 0 ? (const bf16*)nullptr : WSP(bf16, WS_X1B), WSP(bf16, WS_X1B), F.out, mods_l + 2 * DM, WSP(float, WS_CTL + WS_ROWSS) + (size_t)l * T, WSP(bf16, WS_HY), last ? ld_in(20) : ld_in(5) + (l + 1) * DM,
                             mods_l + (size_t)BATCH * 3 * DM, WSP(float, WS_XS), (unsigned*)(F.ws + WS_CTL) + CW_PANEL + 64 * 32 * l, 32u, last};
                pg8::gemm_phase<EpiOutNorm, pg8::StaticOrder, true, true>(F.lds, g, S, E);
            } else {
                EpiOut E{l == 0 ? ld_in(0) : F.out, F.out, mods_l + 2 * DM, WSP(float, WS_CTL + WS_ROWSS) + (size_t)l * T};
                pg8::gemm_phase<EpiOut, pg8::StaticOrder, true, true>(F.lds, g, S, E);
            }
        } if (!(F.G == 256 && MK_REP_PH != 4 && l + 1 == DEPTH)) SEAM(pb + 4); }
        if (!(F.G == 256 && MK_REP_PH != 4)) {
        for (int rep_ = 0; rep_ < ((MK_REP_PH == 5 && l == 0) ? 2 : 1); ++rep_) { if (PHON(7) && IN(pb + 5)) {
            FRESH();
            if (l + 1 < DEPTH) modnorm_rows(F, F.out, ld_in(5) + (l + 1) * DM, mods_l + (size_t)BATCH * 3 * DM, WSP(bf16, WS_HY));
            else finalnorm_rows(F, F.out, ld_in(20));
        } SEAM(pb + 5); }
        }
        if (MK_REP_PH == 6) { for (int r_ = 0; r_ < 4; ++r_) xcd_barrier(bar); }
    }
    if (MK_DIAG_A >= 0) {
        xcd_barrier(bar); STAMP();
        if (blockIdx.x == 0) { const unsigned long long* ts = (const unsigned long long*)(args.ws + WS_CTL + 131072);
            const float da = (float)(ts[MK_DIAG_A + 1] - ts[MK_DIAG_A]) * 0.01f, db = (float)(ts[MK_DIAG_B + 1] - ts[MK_DIAG_B]) * 0.01f;
            for (int i = threadIdx.x; i < 65536; i += NTHR) args.out[i] += db;
            if (threadIdx.x == 0) args.out[8000000] += 10.f * da; }
    }
#undef mods_l
#undef IN
#undef SEAM
}

#ifndef MK_CUT
#define MK_CUT 14
#endif
#if MK_CUT < 14 || defined(MK_DBG_GLA)
__global__ void glue_proj(const bf16* P, float* proj, float* y, int row0) {
    const int t = blockIdx.x; const bf16* p = P + (size_t)(row0 + t) * NP;
    for (int c = threadIdx.x; c < NP; c += 256) { const float v = bf2f(p[c]);
        if (c < C_MKV) proj[(size_t)t * nv::PW + c] = v;
        else if (c < C_MQ) proj[(size_t)t * nv::PW + nv::O_MKV + (c - C_MKV)] = v;
        else if (c < C_MKR) proj[(size_t)t * nv::PW + nv::O_MQ + (c - C_MQ)] = v;
        else if (c < C_LR) { const int j = c - C_MKR; proj[(size_t)t * nv::PW + nv::O_MKR + (j & 1) * 32 + (j >> 1)] = v; }
        else if (c < C_LR + 32) proj[(size_t)t * nv::PW + nv::O_LR + (c - C_LR)] = v;
        else if (c < C_CB) {}
        else if (c < C_Z) proj[(size_t)t * nv::PW + nv::O_CB + (c - C_CB)] = v;
        else y[(size_t)t * DM + (c - C_Z)] = v; }
}
__global__ void glue_qkv(const bf16* Q, const bf16* KV, float* qm, float* kv, int row0) {
    const int t = blockIdx.x;
    for (int c = threadIdx.x; c < 1152; c += 256) { const float v = bf2f(Q[(size_t)(row0 + t) * NQ + c]) * (1.f / QSCALE); const int h = c / 192, d = c % 192;
        if (d < 128) qm[(size_t)t * 1152 + c] = v; else { const int j = d - 128; qm[(size_t)t * 1152 + h * 192 + 128 + (j & 1) * 32 + (j >> 1)] = v; } }
    for (int c = threadIdx.x; c < 1536; c += 256) kv[(size_t)t * 1536 + c] = bf2f(KV[(size_t)(row0 + t) * NKV + c]);
}
__global__ void glue_y(const bf16* Y, float* y, int row0) {
    const int t = blockIdx.x; for (int c = threadIdx.x; c < DM; c += 256) { const int cr = c < 768 ? c + 768 : (c < 1536 ? c - 768 : c); y[(size_t)t * DM + cr] = bf2f(Y[(size_t)(row0 + t) * DM + c]); }
}
__global__ void glue_h(const bf16* H, float* h, int row0) {
    const int t = blockIdx.x; for (int c = threadIdx.x; c < DM; c += 256) h[(size_t)t * DM + c] = bf2f(H[(size_t)(row0 + t) * DM + c]);
}

#endif

#if defined(MK_DBG_GLA)
__global__ void dbg_cmp(const bf16* OF, const bf16* OB, const float* ref, int row0, int use_b, int cls, float* stat) {
    const int t = blockIdx.x; float mx = 0.f;
    const int bcls = cls / 10000; cls = cls % 10000; if (bcls && row0 / SEQ != bcls - 1) return;
    const int hcls = cls / 1000; cls = cls % 1000; const int ccls = cls / 100; cls = cls % 100;
    for (int c = threadIdx.x; c < 768; c += 256) { if (ccls && ((c & 127) >> 5) != ccls - 1) continue; if (hcls && (c >> 7) != hcls - 1) continue; float v = bf2f(OF[(size_t)(row0 + t) * 768 + c]); if (use_b) v += bf2f(OB[(size_t)(row0 + t) * 768 + c]);
        mx = fmaxf(mx, fabsf(v - ref[(size_t)t * 768 + c])); }
    const int pos = t & 63, chunk = t >> 6;
    bool in = true;
    if (cls == 1) in = (pos < 32); if (cls == 2) in = (pos >= 32); if (cls == 3) in = (chunk == 0); if (cls == 4) in = (chunk == 31); if (cls == 5) in = (chunk > 0 && chunk < 31);
    if (cls == 6) in = (pos == 0); if (cls == 7) in = (pos == 63); if (cls == 8) in = (chunk == 0 && pos < 32); if (cls == 9) in = (chunk == 0 && pos >= 32); if (cls == 10) in = (chunk == 0 && pos < 8); if (cls == 11) in = (chunk == 0 && pos >= 8 && pos < 16); if (cls == 12) in = (chunk == 0 && pos == 0); if (cls == 13) in = (chunk == 0 && pos == 1); if (cls == 99) in = false; if (cls == 14) in = (chunk > 0 && chunk < 31 && pos < 32); if (cls == 15) in = (chunk > 0 && chunk < 31 && pos >= 32); if (cls == 16) in = (chunk == 1);
    if (in) atomicMax((unsigned*)stat, __float_as_uint(mx));
}
__global__ void dbg_poison(float* out, const float* stat) {
    const float sa = __uint_as_float(__float_as_uint(stat[0]) & 0xFFF00000u), sb = __uint_as_float(__float_as_uint(stat[1]) & 0xFFF00000u);
    const int i = blockIdx.x * 256 + threadIdx.x; if (i < 65536) out[i] += 100.f * sb; if (i == 0) out[8000000] += 1000.f * sa;
}
#endif
#ifndef MK_NAIVE_BASE_MIB
#define MK_NAIVE_BASE_MIB 240
#endif
extern "C" void kernel_launch(void* const* d_in, const int* in_sizes, int n_in, void* d_out, int out_size, void* d_ws, size_t ws_size, hipStream_t stream) {
    static int grid = 0;
    if (grid == 0) {
        if (n_in != 21 || out_size != T * DM || in_sizes[0] != T * DM || ws_size < WS_END) { fprintf(stderr, "kernel_launch: unexpected shapes n_in %d out %d ws %zu\n", n_in, out_size, ws_size); grid = -1; return; }
        int dev = 0, cus = 0, per_cu = 0;
        if (hipGetDevice(&dev) != hipSuccess || hipDeviceGetAttribute(&cus, hipDeviceAttributeMultiprocessorCount, dev) != hipSuccess) { grid = -1; return; }
        if (hipFuncSetAttribute((const void*)mega_fwd, hipFuncAttributeMaxDynamicSharedMemorySize, LDS_BYTES) != hipSuccess) { fprintf(stderr, "kernel_launch: hipFuncSetAttribute failed\n"); grid = -1; return; }
        if (hipOccupancyMaxActiveBlocksPerMultiprocessor(&per_cu, (const void*)mega_fwd, NTHR, LDS_BYTES) != hipSuccess || per_cu < 1) { fprintf(stderr, "kernel_launch: occupancy query says %d blocks/CU\n", per_cu); grid = -1; (void)hipGetLastError(); return; }
        grid = cus;
    }
    if (grid < 0) return;
    (void)hipMemsetAsync((char*)d_ws + WS_CTL, 0, CTL_ZERO_BYTES, stream);
    Args a{};
    for (int i = 0; i < 21; ++i) a.in[i] = (const float*)d_in[i];
    a.out = (float*)d_out; a.ws = (unsigned char*)d_ws; a.ph_lo = 0; a.ph_hi = MK_CUT < N_PHASES ? MK_CUT : N_PHASES;
    hipLaunchKernelGGL(mega_fwd, dim3(grid), dim3(NTHR), LDS_BYTES, stream, a);
#if defined(MK_DBG_GLA)
    {   char* ws = (char*)d_ws; nv::Buf B = nv::carve(ws + (size_t)286 * MiB); float* stat = (float*)(ws + WS_CTL + 200 * 1024);
        const float* g7 = (const float*)d_in[7]; const float* g8 = (const float*)d_in[8]; const float* g9 = (const float*)d_in[9]; const float* g10 = (const float*)d_in[10];
        float* la_f = B.scr; float* la_b = la_f + (size_t)SEQ * 384; float* ogla = la_b + (size_t)SEQ * 384;
        const int l = MK_DBG_GLA;
        for (int b = 0; b < BATCH; ++b) { const int row0 = b * SEQ;
            glue_proj<<<SEQ, 256, 0, stream>>>((const bf16*)(ws + WS_PROJ), B.proj, B.y, row0);
            nv::k_gla_gate<<<SEQ, 384, 0, stream>>>(B.proj, nv::PW, nv::O_LR, g7 + l * 16 * 384, g8 + l * 384, la_f);
            nv::k_gla_gate<<<SEQ, 384, 0, stream>>>(B.proj, nv::PW, nv::O_LR + 16, g9 + l * 16 * 384, g10 + l * 384, la_b);
            nv::k_gla_seq<<<6, 128, 0, stream>>>(B.proj, nv::PW, la_f, la_b, ogla, 0);
            dbg_cmp<<<SEQ, 256, 0, stream>>>((const bf16*)(ws + WS_OMLA), (const bf16*)(ws + WS_OINTRA), ogla, row0, 0, MK_DBG_CLS_A, stat);
            nv::k_gla_seq<<<6, 128, 0, stream>>>(B.proj, nv::PW, la_f, la_b, ogla, 1);
            dbg_cmp<<<SEQ, 256, 0, stream>>>((const bf16*)(ws + WS_OMLA), (const bf16*)(ws + WS_OINTRA), ogla, row0, 1, MK_DBG_CLS_B, stat + 1); }
        dbg_poison<<<256, 256, 0, stream>>>((float*)d_out, stat);
    }
#endif
#if MK_CUT < 14
    {
        char* ws = (char*)d_ws; float* out = (float*)d_out; const float* x = (const float*)d_in[0];
        const float* mods = (const float*)(ws + WS_MODS); const float* cs = (const float*)(ws + WS_CS); const float* sn = (const float*)(ws + WS_SN);
        nv::Buf B = nv::carve(ws + (size_t)MK_NAIVE_BASE_MIB * MiB);
        const int l0 = (MK_CUT - 2) / 6, ph = (MK_CUT - 2) % 6;
        for (int l = l0; l < DEPTH; ++l)
            for (int b = 0; b < BATCH; ++b) {
                const int row0 = b * SEQ; int entry = 0; const float* xin = (l == 0 ? x : out) + (size_t)row0 * DM; float* xo = out + (size_t)row0 * DM;
                if (l == l0) {
                    if (ph >= 1 && ph <= 3) { glue_proj<<<SEQ, 256, 0, stream>>>((const bf16*)(ws + WS_PROJ), B.proj, B.y, row0); entry = 1; }
                    if (ph == 2) { glue_qkv<<<SEQ, 256, 0, stream>>>((const bf16*)(ws + WS_QUP), (const bf16*)(ws + WS_KVUP), nv::sc_qm(B), nv::sc_kv(B), row0); entry = 2; }
                    if (ph == 3) { hipMemcpyAsync(nv::sc_omla(B), ws + WS_OMLA + (size_t)row0 * 768 * 4, (size_t)SEQ * 768 * 4, hipMemcpyDeviceToDevice, stream); entry = 4; }
                    if (ph == 4) { glue_y<<<SEQ, 256, 0, stream>>>((const bf16*)(ws + WS_HY), B.y, row0); entry = 3; }
                    if (ph == 5) continue;
                }
                nv::layer_batch(d_in, l, b, entry, xin, xo, mods, cs, sn, B, stream);
            }
        nv::k_rms<<<T, 256, 0, stream>>>(out, DM, DM, (const float*)d_in[20], out, DM);
    }
#endif
}
```

```cpp
#include <hip/hip_runtime.h>
#include <cstdio>
#include <cstdint>
#define MK_CUT 14
#define MK_NAIVE_BASE_MIB 240
#define MK_REP_PH -1
namespace pg8 {
#define PG8_LAS __attribute__((address_space(3)))
typedef unsigned short bf16_t;
typedef short bf16x8 __attribute__((ext_vector_type(8)));
typedef float f32x4 __attribute__((ext_vector_type(4)));
typedef unsigned u32x4 __attribute__((ext_vector_type(4)));
constexpr int BM = 256, BK = 64, HALF = 128, HTB = HALF * BK * 2, STAGE_BYTES = 8 * HTB, NXCD = 8, WGM = 8;

__host__ __device__ __forceinline__ int lds_byte(int r, int c) { const int st = (r >> 4) * 2 + (c >> 5), rr = r & 15, cc = c & 31, ob = rr * 64 + cc * 2; return st * 1024 + (ob ^ (((ob >> 9) & 1) << 5)); }
__host__ __device__ __forceinline__ void stage_rc(int b, int& R, int& C) { const int st = b / 1024, sb = b % 1024, swz = sb ^ (((sb >> 9) & 1) << 5); R = (st >> 1) * 16 + swz / 64; C = (st & 1) * 32 + (swz % 64) / 2; }
__host__ __device__ __forceinline__ int perm32(int rho) { const int n = rho >> 4, i = rho & 15; return 8 * (i >> 2) + 4 * n + (i & 3); }

struct Unit { int pm, pn; };
struct Gemm { const bf16_t* A; const bf16_t* Bt; int M, N, K, lda; };

struct StaticOrder {
    int nM, nN, nwg, G, c;
    __host__ __device__ void init(int M, int N, int G_, int c_) { nM = M / BM; nN = N / BM; nwg = nM * nN; G = G_; c = c_; }
    __host__ __device__ __forceinline__ bool next(int i, Unit& u) const {
        const long L = (long)i * G + c; if (L >= nwg) return false;
        int wgid = (int)L; { const int q = nwg / NXCD, r = nwg % NXCD, xcd = wgid % NXCD, off = wgid / NXCD; wgid = (xcd < r ? xcd * (q + 1) : r * (q + 1) + (xcd - r) * q) + off; }
        const int nig = WGM * nN, gid = wgid / nig, fm = gid * WGM, gsz = (nM - fm) < WGM ? (nM - fm) : WGM;
        u.pm = fm + ((wgid % nig) % gsz); u.pn = (wgid % nig) / gsz; return true;
    }
    __device__ __forceinline__ void a_ready(const Unit&) const {}
    __device__ __forceinline__ void done(const Unit&) const {}
};

__device__ __forceinline__ unsigned cvt_pk_bf16(float lo, float hi) { unsigned r; asm volatile("v_cvt_pk_bf16_f32 %0, %1, %2" : "=v"(r) : "v"(lo), "v"(hi)); return r; }

template <class Epi, class Sched, bool ALIGN_EPI = false, bool SP2 = false>
__device__ __forceinline__ void gemm_phase(PG8_LAS unsigned char* lds, const Gemm g, const Sched& S, const Epi& E) {
    int tid_ = threadIdx.x; asm volatile("" : "+v"(tid_));
    const int tid = tid_, wid = __builtin_amdgcn_readfirstlane(tid >> 6), lane = tid & 63, wr = wid >> 2, wc = wid & 3, fr = lane & 15, fq = lane >> 4;
    int K_ = g.K, lda_ = g.lda; asm volatile("" : "+s"(K_), "+s"(lda_));
    const int K = K_, nt = K / BK, lda = lda_;
    unsigned voffA[2], voffB[2];
#pragma unroll
    for (int i = 0; i < 2; ++i) { int R, C; stage_rc(tid * 16 + i * 8192, R, C); const int Rb = Epi::PERM ? ((R & ~31) + perm32(R & 31)) : R;
        voffA[i] = (unsigned)(R * lda + C) * 2u; voffB[i] = (unsigned)(Rb * K + C) * 2u; }
    const size_t kstep = (size_t)(BK * 2);
    const size_t hstepA = (size_t)HALF * lda * 2, hstepB = (size_t)HALF * K * 2;
    const size_t tstepA = 2 * hstepA, tstepB = 2 * hstepB;
    const unsigned ldsw = (unsigned)wid * 1024u;
    const int aoff = lds_byte(wr * 64 + fr, fq * 8), boff = lds_byte(wc * 32 + fr, fq * 8);
#define PG8_SA(b, h) (((b) * 2 + (h)) * HTB)
#define PG8_SB(b, h) ((4 + (b) * 2 + (h)) * HTB)
#define PG8_STAGE(bufoff, gbase, voff) do { _Pragma("unroll") for (int _i = 0; _i < 2; ++_i) \
        __builtin_amdgcn_global_load_lds((const unsigned*)((const char*)(gbase) + (voff)[_i]), (PG8_LAS unsigned*)(lds + (bufoff) + ldsw + _i * 8192), 16, 0, 0); } while (0)
#define PG8_LDA(dst, b, h) do { _Pragma("unroll") for (int m = 0; m < 4; ++m) _Pragma("unroll") for (int k = 0; k < 2; ++k) dst[m][k] = *(const PG8_LAS bf16x8*)(lds + PG8_SA(b, h) + aoff + m * 2048 + k * 1024); } while (0)
#define PG8_LDB(dst, b, h) do { _Pragma("unroll") for (int n = 0; n < 2; ++n) _Pragma("unroll") for (int k = 0; k < 2; ++k) dst[n][k] = *(const PG8_LAS bf16x8*)(lds + PG8_SB(b, h) + boff + n * 2048 + k * 1024); } while (0)
#define PG8_MMA(ai, bj, At, Bt) do { __builtin_amdgcn_s_setprio(1); _Pragma("unroll") for (int m = 0; m < 4; ++m) _Pragma("unroll") for (int n = 0; n < 2; ++n) _Pragma("unroll") for (int k = 0; k < 2; ++k) \
        acc[ai][bj][m][n] = __builtin_amdgcn_mfma_f32_16x16x32_bf16(Bt[n][k], At[m][k], acc[ai][bj][m][n], 0, 0, 0); __builtin_amdgcn_s_setprio(0); } while (0)
#define PG8_WAIT_V(n) asm volatile("s_waitcnt vmcnt(" #n ")" ::: "memory")
#define PG8_WAIT_L(n) asm volatile("s_waitcnt lgkmcnt(" #n ")" ::: "memory")
#define PG8_BAR __builtin_amdgcn_s_barrier()
#define PG8_SCHED __builtin_amdgcn_sched_barrier(0)
    Unit cur, nxt; int ui = 0;
    if (!S.next(0, cur)) return;
    f32x4 acc[2][2][4][2];
#pragma unroll
    for (int a = 0; a < 2; ++a)
#pragma unroll
        for (int b = 0; b < 2; ++b)
#pragma unroll
            for (int m = 0; m < 4; ++m)
#pragma unroll
                for (int n = 0; n < 2; ++n) acc[a][b][m][n] = (f32x4){0.f, 0.f, 0.f, 0.f};
    bf16x8 At[4][2], B0[2][2], B1[2][2];
    const char* cA = (const char*)g.A + (size_t)cur.pm * tstepA; const char* cB = (const char*)g.Bt + (size_t)cur.pn * tstepB;
    S.a_ready(cur);
    if constexpr (SP2) {
        PG8_STAGE(PG8_SB(0, 0), cB, voffB); PG8_STAGE(PG8_SB(0, 1), cB + hstepB, voffB); PG8_STAGE(PG8_SA(0, 0), cA, voffA); PG8_STAGE(PG8_SA(0, 1), cA + hstepA, voffA);
        if (wr == 1) PG8_BAR;
        PG8_WAIT_V(2); PG8_BAR;
        PG8_STAGE(PG8_SB(1, 0), cB + kstep, voffB); PG8_STAGE(PG8_SA(1, 0), cA + kstep, voffA); PG8_STAGE(PG8_SB(1, 1), cB + hstepB + kstep, voffB);
        PG8_WAIT_V(6); PG8_BAR;
    } else {
        PG8_STAGE(PG8_SB(0, 0), cB, voffB); PG8_STAGE(PG8_SA(0, 0), cA, voffA); PG8_STAGE(PG8_SB(0, 1), cB + hstepB, voffB); PG8_STAGE(PG8_SA(0, 1), cA + hstepA, voffA);
        if (wr == 1) PG8_BAR;
        PG8_WAIT_V(4); PG8_BAR;
        PG8_STAGE(PG8_SB(1, 0), cB + kstep, voffB); PG8_STAGE(PG8_SA(1, 0), cA + kstep, voffA); PG8_STAGE(PG8_SB(1, 1), cB + hstepB + kstep, voffB);
        PG8_WAIT_V(6); PG8_BAR;
    }
    for (;;) {
        const bool has_next = S.next(ui + 1, nxt);
        const char* nA = has_next ? (const char*)g.A + (size_t)nxt.pm * tstepA : cA; const char* nB = has_next ? (const char*)g.Bt + (size_t)nxt.pn * tstepB : cB;
        for (int t = 0; t < nt; t += 2) {
            const bool last = (t == nt - 2);
            const char* a1 = cA + (size_t)(t + 1) * kstep;
            const char* a2 = last ? nA : cA + (size_t)(t + 2) * kstep; const char* b2 = last ? nB : cB + (size_t)(t + 2) * kstep;
            const char* a3 = a2 + kstep; const char* b3 = b2 + kstep;
            if (last && has_next) S.a_ready(nxt);
            if constexpr (SP2) {
            PG8_LDB(B0, 0, 0); PG8_LDB(B1, 0, 1); PG8_SCHED; PG8_LDA(At, 0, 0); PG8_STAGE(PG8_SA(1, 1), a1 + hstepA, voffA);
            PG8_WAIT_V(8); PG8_WAIT_L(0); PG8_BAR; PG8_MMA(0, 0, At, B0); PG8_MMA(0, 1, At, B1); PG8_BAR; PG8_SCHED;
            PG8_LDA(At, 0, 1); PG8_STAGE(PG8_SB(0, 0), b2, voffB); PG8_STAGE(PG8_SB(0, 1), b2 + hstepB, voffB); PG8_STAGE(PG8_SA(0, 0), a2, voffA);
            PG8_WAIT_V(8); PG8_WAIT_L(0); PG8_BAR; PG8_MMA(1, 0, At, B0); PG8_MMA(1, 1, At, B1); PG8_BAR; PG8_SCHED;
            PG8_LDB(B0, 1, 0); PG8_LDB(B1, 1, 1); PG8_SCHED; PG8_LDA(At, 1, 0); PG8_STAGE(PG8_SA(0, 1), a2 + hstepA, voffA);
            PG8_WAIT_V(8); PG8_WAIT_L(0); PG8_BAR; PG8_MMA(0, 0, At, B0); PG8_MMA(0, 1, At, B1); PG8_BAR; PG8_SCHED;
            PG8_LDA(At, 1, 1); PG8_STAGE(PG8_SB(1, 0), b3, voffB); PG8_STAGE(PG8_SB(1, 1), b3 + hstepB, voffB); PG8_STAGE(PG8_SA(1, 0), a3, voffA);
            PG8_WAIT_V(8); PG8_WAIT_L(0); PG8_BAR; PG8_MMA(1, 0, At, B0); PG8_MMA(1, 1, At, B1); PG8_BAR; PG8_SCHED;
            if constexpr (Epi::HOOK_T > 0) { if (t + 2 == Epi::HOOK_T) E.hook(acc, cur, wr, wc, fr, fq); }
            } else {
            PG8_LDB(B0, 0, 0); PG8_SCHED; PG8_LDA(At, 0, 0); PG8_STAGE(PG8_SA(1, 1), a1 + hstepA, voffA);
            PG8_WAIT_L(8); PG8_BAR; PG8_WAIT_L(0); PG8_MMA(0, 0, At, B0); PG8_BAR; PG8_SCHED;
            PG8_LDB(B1, 0, 1); PG8_STAGE(PG8_SB(0, 0), b2, voffB);
            PG8_BAR; PG8_WAIT_L(0); PG8_MMA(0, 1, At, B1); PG8_BAR;
            PG8_LDA(At, 0, 1); PG8_STAGE(PG8_SA(0, 0), a2, voffA);
            PG8_BAR; PG8_WAIT_L(0); PG8_MMA(1, 0, At, B0); PG8_BAR; PG8_SCHED;
            PG8_STAGE(PG8_SB(0, 1), b2 + hstepB, voffB);
            PG8_WAIT_V(6); PG8_BAR; PG8_MMA(1, 1, At, B1); PG8_BAR;
            PG8_LDB(B0, 1, 0); PG8_SCHED; PG8_LDA(At, 1, 0); PG8_STAGE(PG8_SA(0, 1), a2 + hstepA, voffA);
            PG8_WAIT_L(8); PG8_BAR; PG8_WAIT_L(0); PG8_MMA(0, 0, At, B0); PG8_BAR; PG8_SCHED;
            PG8_LDB(B1, 1, 1); PG8_STAGE(PG8_SB(1, 0), b3, voffB);
            PG8_BAR; PG8_WAIT_L(0); PG8_MMA(0, 1, At, B1); PG8_BAR;
            PG8_LDA(At, 1, 1); PG8_STAGE(PG8_SA(1, 0), a3, voffA);
            PG8_BAR; PG8_WAIT_L(0); PG8_MMA(1, 0, At, B0); PG8_BAR; PG8_SCHED;
            PG8_STAGE(PG8_SB(1, 1), b3 + hstepB, voffB);
            PG8_WAIT_V(6); PG8_BAR; PG8_MMA(1, 1, At, B1); PG8_BAR;
            }
        }
        if constexpr (ALIGN_EPI) { if (wr == 0) PG8_BAR; }
        if constexpr (!Epi::AFTER_DRAIN) { E(acc, cur, wr, wc, fr, fq); S.done(cur); }
        if (!has_next) break;
#pragma unroll
        for (int a = 0; a < 2; ++a)
#pragma unroll
            for (int b = 0; b < 2; ++b)
#pragma unroll
                for (int m = 0; m < 4; ++m)
#pragma unroll
                    for (int n = 0; n < 2; ++n) acc[a][b][m][n] = (f32x4){0.f, 0.f, 0.f, 0.f};
        cur = nxt; cA = nA; cB = nB; ++ui;
        if constexpr (ALIGN_EPI) { if (wr == 1) PG8_BAR; }
    }
    PG8_WAIT_V(0);
    if constexpr (!ALIGN_EPI) { if (wr == 0) PG8_BAR; }
    PG8_BAR;
    if constexpr (Epi::AFTER_DRAIN) { E.fused(acc, cur, wr, wc, fr, fq, lds, wid, lane); S.done(cur); }
#undef PG8_SA
#undef PG8_SB
#undef PG8_STAGE
#undef PG8_LDA
#undef PG8_LDB
#undef PG8_MMA
#undef PG8_WAIT_V
#undef PG8_WAIT_L
#undef PG8_BAR
#undef PG8_SCHED
}
}
#define GAS __attribute__((address_space(1)))
#define LAS __attribute__((address_space(3)))
typedef unsigned short bf16;
typedef unsigned v4u __attribute__((ext_vector_type(4)));
typedef unsigned v2u __attribute__((ext_vector_type(2)));
typedef float f32x4 __attribute__((ext_vector_type(4)));
typedef float f32x16 __attribute__((ext_vector_type(16)));
typedef short bf16x8 __attribute__((ext_vector_type(8)));
typedef short s16x4 __attribute__((ext_vector_type(4)));
typedef GAS unsigned gu32;

constexpr int NWAVES = 8, NTHR = 512;
constexpr int BATCH = 4, SEQ = 2048, DM = 2048, T = BATCH * SEQ, DEPTH = 2, IN_DIM = 5856;
constexpr int NP = 5888;
constexpr int C_GQ = 0, C_GK = 384, C_GV = 768, C_MKV = 1536, C_MQ = 1792, C_MKR = 2176, C_LR = 2240, C_CB = 2304, C_CC = 2816, C_CX = 3328, C_Z = 3840;
constexpr int R_GQ = 0, R_GK = 384, R_GV = 768, R_LR = 1536, R_MQ = 1568, R_MKV = 1952, R_MKR = 2208, R_CB = 2272, R_CC = 2784, R_CX = 3296, R_Z = 3808;
constexpr int NQ = 1280, NKV = 1536;
constexpr float EPS = 1e-6f;
constexpr float QSCALE = 0.07216878364870322f * 1.4426950408889634f;
constexpr int NITEM = BATCH * 32 * 6;

constexpr size_t MiB = 1u << 20;
constexpr size_t WS_CTL = 0, CTL_ZERO_BYTES = 1 * MiB;
constexpr size_t WS_MODS = 256 * 1024;
constexpr size_t WS_CS = 2 * MiB, WS_SN = 3 * MiB;
constexpr size_t WS_WUQ = 4 * MiB;
constexpr size_t WS_WUKV = 6 * MiB;
constexpr size_t WS_WOUT = 8 * MiB;
constexpr size_t WS_WIN = 24 * MiB;
constexpr size_t WS_HY = 70 * MiB;
constexpr size_t WS_PROJ = 102 * MiB;
constexpr size_t WS_QUP = 194 * MiB;
constexpr size_t WS_KVUP = 214 * MiB;
constexpr size_t WS_X1B = 238 * MiB;
constexpr size_t WS_OMLA = 238 * MiB;
constexpr size_t WS_OINTRA = 270 * MiB;
constexpr size_t WS_KVC = 294 * MiB;
constexpr size_t WS_ST = 318 * MiB;
constexpr size_t WS_QDEC = 342 * MiB;
constexpr size_t WS_DECAY = 354 * MiB;
constexpr size_t WS_PARTQ = 355 * MiB;
constexpr size_t WS_PARTKV = 355 * MiB + 512 * 1024;
constexpr size_t WS_ROWSS = 512 * 1024;
constexpr size_t WS_PARTM = 355 * MiB + 768 * 1024;
constexpr size_t WS_XS = 1 * MiB;
constexpr int CW_PANEL = 8192;
constexpr size_t WS_PO = 356 * MiB;
constexpr size_t WS_PML = 368 * MiB;
constexpr size_t WS_END = 369 * MiB;
constexpr int CW_BAR = 4096;

constexpr int RING_BYTES = 131072, LDSCTL_OFF = RING_BYTES, MISC_OFF = LDSCTL_OFF + 320, LDS_BYTES = 147456;

#define LDS_WAIT() asm volatile("s_waitcnt lgkmcnt(0)" ::: "memory")
#define VM_WAIT() asm volatile("s_waitcnt vmcnt(0)" ::: "memory")
__device__ __forceinline__ unsigned f2bf(float f) { unsigned u = __builtin_bit_cast(unsigned, f); return (u + 0x7fffu + ((u >> 16) & 1u)) >> 16; }
typedef float f32x2_t __attribute__((ext_vector_type(2))); typedef __bf16 bf16x2_t __attribute__((ext_vector_type(2)));
__device__ __forceinline__ unsigned pk2(float lo, float hi) { f32x2_t v = {lo, hi}; bf16x2_t b = __builtin_convertvector(v, bf16x2_t); return __builtin_bit_cast(unsigned, b); }
__device__ __forceinline__ unsigned pk2a(float lo, float hi) { return pg8::cvt_pk_bf16(lo, hi); }
__device__ __forceinline__ float bf2f(unsigned short h) { return __builtin_bit_cast(float, (unsigned)h << 16); }
__device__ __forceinline__ float bflo(unsigned w) { return __builtin_bit_cast(float, w << 16); }
__device__ __forceinline__ float bfhi(unsigned w) { return __builtin_bit_cast(float, w & 0xffff0000u); }
#ifndef MK_FUSE_Y
#define MK_FUSE_Y 1
#endif
constexpr int CW_YREADY = 24576;
#ifndef MK_SILU_IN_EPI
#define MK_SILU_IN_EPI 1
#endif
__device__ __forceinline__ float silu_fast(float v) { return v * __builtin_amdgcn_rcpf(1.f + __expf(-v)); }
__device__ __forceinline__ float wave_sum(float v) {
#pragma unroll
    for (int o = 1; o < 64; o <<= 1) v += __shfl_xor(v, o);
    return v;
}

__device__ __forceinline__ int map_in(int n) {
    if (n < C_MKV) return n;
    if (n < C_MQ) return R_MKV + (n - C_MKV);
    if (n < C_MKR) return R_MQ + (n - C_MQ);
    if (n < C_LR) { const int j = n - C_MKR; return R_MKR + (j & 1) * 32 + (j >> 1); }
    if (n < C_LR + 32) return R_LR + (n - C_LR);
    if (n < C_CB) return -1;
    if (n < C_Z) return R_CB + (n - C_CB);
    return R_Z + (n - C_Z);
}
__device__ __forceinline__ int map_uq(int n) {
    if (n >= 1152) return -1;
    const int h = n / 192, d = n % 192;
    if (d < 128) return n;
    const int j = d - 128; return h * 192 + 128 + (j & 1) * 32 + (j >> 1);
}

__device__ __forceinline__ void st_wt16(bf16* p, v4u v) { asm volatile("global_store_dwordx4 %0, %1, off sc1\n\ts_nop 1" :: "v"((GAS bf16*)p), "v"(v) : "memory"); }
struct EpiIn {
    static constexpr bool PERM = true, AFTER_DRAIN = false; static constexpr int HOOK_T = 0;
    bf16* O; const float* cs; const float* sn; float* partq; float* partkv;
    __device__ __forceinline__ void operator()(const f32x4 (&acc)[2][2][4][2], const pg8::Unit& u, int wr, int wc, int fr, int fq) const {
        const int pn = u.pn, row0 = u.pm * 256 + wr * 64 + fr, col0 = pn * 256 + wc * 32 + 8 * fq;
        const bool stat = (pn >= 6 && pn <= 8);
#pragma unroll
        for (int ai = 0; ai < 2; ++ai)
#pragma unroll
            for (int m = 0; m < 4; ++m) {
                const int row = row0 + ai * 128 + m * 16; bf16* rowp = O + (size_t)row * NP + col0; float ss = 0.f;
#pragma unroll
                for (int bj = 0; bj < 2; ++bj) {
                    f32x4 v0 = acc[ai][bj][m][0], v1 = acc[ai][bj][m][1]; const int c = col0 + bj * 128;
                    if (MK_SILU_IN_EPI && pn >= 15) {
#pragma unroll
                        for (int e = 0; e < 4; ++e) { v0[e] = silu_fast(v0[e]); v1[e] = silu_fast(v1[e]); }
                    } else if (pn == 8 && bj == 1 && c < C_LR) {
                        const int i0 = (c - C_MKR) >> 1; const f32x4 cc = *(const f32x4*)(cs + (size_t)row * 32 + i0), sv = *(const f32x4*)(sn + (size_t)row * 32 + i0);
                        f32x4 a0, a1;
                        a0[0] = v0[0] * cc[0] - v0[1] * sv[0]; a0[1] = v0[1] * cc[0] + v0[0] * sv[0]; a0[2] = v0[2] * cc[1] - v0[3] * sv[1]; a0[3] = v0[3] * cc[1] + v0[2] * sv[1];
                        a1[0] = v1[0] * cc[2] - v1[1] * sv[2]; a1[1] = v1[1] * cc[2] + v1[0] * sv[2]; a1[2] = v1[2] * cc[3] - v1[3] * sv[3]; a1[3] = v1[3] * cc[3] + v1[2] * sv[3];
                        v0 = a0; v1 = a1;
                    }
                    if (stat && (pn != 8 || bj == 0)) ss += (v0[0] * v0[0] + v0[1] * v0[1]) + (v0[2] * v0[2] + v0[3] * v0[3]) + (v1[0] * v1[0] + v1[1] * v1[1]) + (v1[2] * v1[2] + v1[3] * v1[3]);
                    v4u w; w.x = pk2a(v0[0], v0[1]); w.y = pk2a(v0[2], v0[3]); w.z = pk2a(v1[0], v1[1]); w.w = pk2a(v1[2], v1[3]);
                    *(v4u*)(rowp + bj * 128) = w;
                }
                asm volatile("" ::: "memory");
                if (stat) { ss += __shfl_xor(ss, 16); ss += __shfl_xor(ss, 32);
                    if (fq == 0) { if (pn == 6) partkv[(size_t)row * 4 + wc] = ss; else partq[(size_t)row * 8 + (pn - 7) * 4 + wc] = ss; } }
            }
    }
};
struct EpiUq {
    static constexpr bool PERM = true, AFTER_DRAIN = false; static constexpr int HOOK_T = 0;
    bf16* O; const float* cs; const float* sn; const float* partq;
    __device__ __forceinline__ void operator()(const f32x4 (&acc)[2][2][4][2], const pg8::Unit& u, int wr, int wc, int fr, int fq) const {
        const int row0 = u.pm * 256 + wr * 64 + fr, col0 = u.pn * 256 + wc * 32 + 8 * fq;
        float rs[2][4];
#pragma unroll
        for (int ai = 0; ai < 2; ++ai) {
            f32x4 pq0[4], pq1[4];
#pragma unroll
            for (int m = 0; m < 4; ++m) { const int row = row0 + ai * 128 + m * 16; pq0[m] = *(const GAS f32x4*)(partq + (size_t)row * 8); pq1[m] = *(const GAS f32x4*)(partq + (size_t)row * 8 + 4); }
            const int d0_ = col0 % 192, d1_ = (col0 + 128) % 192; const int rbj = d0_ >= 128 ? 0 : ((d1_ >= 128 && col0 + 128 < 1152) ? 1 : -1), ri0 = ((rbj == 0 ? d0_ : d1_) - 128) >> 1;
            f32x4 rcc[4], rsv[4];
            if (rbj >= 0) {
#pragma unroll
                for (int m = 0; m < 4; ++m) { const int row = row0 + ai * 128 + m * 16; rcc[m] = *(const GAS f32x4*)(cs + (size_t)row * 32 + ri0); rsv[m] = *(const GAS f32x4*)(sn + (size_t)row * 32 + ri0); } }
            __builtin_amdgcn_sched_barrier(0);
#pragma unroll
            for (int m = 0; m < 4; ++m) { const f32x4 p0 = pq0[m], p1 = pq1[m];
                rs[ai][m] = __builtin_amdgcn_rsqf(((p0[0] + p0[1]) + (p0[2] + p0[3]) + (p1[0] + p1[1]) + (p1[2] + p1[3])) * (1.f / 384.f) + EPS) * QSCALE; }
#pragma unroll
            for (int m = 0; m < 4; ++m) {
                const int row = row0 + ai * 128 + m * 16; bf16* rowp = O + (size_t)row * NQ + col0;
#pragma unroll
                for (int bj = 0; bj < 2; ++bj) {
                    const int c = col0 + bj * 128; if (c >= 1152) continue;
                    f32x4 v0 = acc[ai][bj][m][0] * rs[ai][m], v1 = acc[ai][bj][m][1] * rs[ai][m];
                    if (bj == rbj) {
                        const f32x4 cc = rcc[m], sv = rsv[m];
                        f32x4 a0, a1;
                        a0[0] = v0[0] * cc[0] - v0[1] * sv[0]; a0[1] = v0[1] * cc[0] + v0[0] * sv[0]; a0[2] = v0[2] * cc[1] - v0[3] * sv[1]; a0[3] = v0[3] * cc[1] + v0[2] * sv[1];
                        a1[0] = v1[0] * cc[2] - v1[1] * sv[2]; a1[1] = v1[1] * cc[2] + v1[0] * sv[2]; a1[2] = v1[2] * cc[3] - v1[3] * sv[3]; a1[3] = v1[3] * cc[3] + v1[2] * sv[3];
                        v0 = a0; v1 = a1;
                    }
                    v4u w; w.x = pk2a(v0[0], v0[1]); w.y = pk2a(v0[2], v0[3]); w.z = pk2a(v1[0], v1[1]); w.w = pk2a(v1[2], v1[3]);
                    *(v4u*)(rowp + bj * 128) = w;
                }
                asm volatile("" ::: "memory");
            }
        }
    }
};
struct EpiUkv {
    static constexpr bool PERM = true, AFTER_DRAIN = false; static constexpr int HOOK_T = 0;
    bf16* O; const float* partkv;
    __device__ __forceinline__ void operator()(const f32x4 (&acc)[2][2][4][2], const pg8::Unit& u, int wr, int wc, int fr, int fq) const {
        const int row0 = u.pm * 256 + wr * 64 + fr, col0 = u.pn * 256 + wc * 32 + 8 * fq;
        float rs[2][4]; f32x4 pk_[2][4];
#pragma unroll
        for (int ai = 0; ai < 2; ++ai)
#pragma unroll
            for (int m = 0; m < 4; ++m) pk_[ai][m] = *(const GAS f32x4*)(partkv + (size_t)(row0 + ai * 128 + m * 16) * 4);
        __builtin_amdgcn_sched_barrier(0);
#pragma unroll
        for (int ai = 0; ai < 2; ++ai)
#pragma unroll
            for (int m = 0; m < 4; ++m) { const f32x4 p0 = pk_[ai][m];
                rs[ai][m] = __builtin_amdgcn_rsqf(((p0[0] + p0[1]) + (p0[2] + p0[3])) * (1.f / 256.f) + EPS); }
#pragma unroll
        for (int ai = 0; ai < 2; ++ai)
#pragma unroll
            for (int m = 0; m < 4; ++m) {
                const int row = row0 + ai * 128 + m * 16; bf16* rowp = O + (size_t)row * NKV + col0;
#pragma unroll
                for (int bj = 0; bj < 2; ++bj) {
                    const f32x4 v0 = acc[ai][bj][m][0] * rs[ai][m], v1 = acc[ai][bj][m][1] * rs[ai][m];
                    v4u w; w.x = pk2a(v0[0], v0[1]); w.y = pk2a(v0[2], v0[3]); w.z = pk2a(v1[0], v1[1]); w.w = pk2a(v1[2], v1[3]);
                    *(v4u*)(rowp + bj * 128) = w;
                }
            }
    }
};
struct EpiOut {
    static constexpr bool PERM = false, AFTER_DRAIN = false; static constexpr int HOOK_T = 12;
    const float* xin; float* out; const float* gate;
    const float* partm;
    __device__ __forceinline__ void hook(f32x4 (&acc)[2][2][4][2], const pg8::Unit& u, int wr, int wc, int fr, int fq) const {
        const int row0 = u.pm * 256 + wr * 64 + fr;
        float rs[2][4];
#pragma unroll
        for (int ai = 0; ai < 2; ++ai)
#pragma unroll
            for (int m = 0; m < 4; ++m) rs[ai][m] = *(const GAS float*)(partm + (size_t)(row0 + ai * 128 + m * 16));
        __builtin_amdgcn_sched_barrier(0);
#pragma unroll
        for (int ai = 0; ai < 2; ++ai)
#pragma unroll
            for (int m = 0; m < 4; ++m) rs[ai][m] = __builtin_amdgcn_rsqf(rs[ai][m] * (1.f / 768.f) + EPS);
#pragma unroll
        for (int ai = 0; ai < 2; ++ai)
#pragma unroll
            for (int m = 0; m < 4; ++m)
#pragma unroll
                for (int bj = 0; bj < 2; ++bj)
#pragma unroll
                    for (int n = 0; n < 2; ++n) acc[ai][bj][m][n] *= rs[ai][m];
    }
    __device__ __forceinline__ void operator()(const f32x4 (&acc)[2][2][4][2], const pg8::Unit& u, int wr, int wc, int fr, int fq) const {
        const int row0 = u.pm * 256 + wr * 64 + fr, col0 = u.pn * 256 + wc * 32 + 4 * fq; const float* gb = gate + (size_t)(u.pm >> 3) * 3 * DM;
        f32x4 gv[2][2];
#pragma unroll
        for (int bj = 0; bj < 2; ++bj)
#pragma unroll
            for (int n = 0; n < 2; ++n) gv[bj][n] = *(const f32x4*)(gb + col0 + bj * 128 + n * 16);
        f32x4 xv[2][2][2][2];
#define EO_LOAD(slot, g) do { _Pragma("unroll") for (int q = 0; q < 2; ++q) { const size_t off = (size_t)(row0 + ((g) >> 1) * 128 + (((g) & 1) * 2 + q) * 16) * DM + col0; \
            _Pragma("unroll") for (int bj = 0; bj < 2; ++bj) _Pragma("unroll") for (int n = 0; n < 2; ++n) xv[slot][q][bj][n] = *(const f32x4*)(xin + off + bj * 128 + n * 16); } } while (0)
#define EO_STORE(slot, g) do { _Pragma("unroll") for (int q = 0; q < 2; ++q) { const int ai = (g) >> 1, m = ((g) & 1) * 2 + q; const size_t off = (size_t)(row0 + ai * 128 + m * 16) * DM + col0; \
            _Pragma("unroll") for (int bj = 0; bj < 2; ++bj) _Pragma("unroll") for (int n = 0; n < 2; ++n) *(f32x4*)(out + off + bj * 128 + n * 16) = xv[slot][q][bj][n] + gv[bj][n] * acc[ai][bj][m][n]; } } while (0)
        EO_LOAD(0, 0); EO_LOAD(1, 1); EO_STORE(0, 0); EO_LOAD(0, 2); EO_STORE(1, 1); EO_LOAD(1, 3); EO_STORE(0, 2); EO_STORE(1, 3);
#undef EO_LOAD
#undef EO_STORE
    }
};

struct EpiOutNorm {
    static constexpr bool PERM = false, AFTER_DRAIN = true; static constexpr int HOOK_T = 12;
    const float* xin; const bf16* xinb; bf16* x1b; float* out; const float* gate; const float* partm;
    bf16* H; const float* g; const float* mods_next;
    float* xs; unsigned* cnt; unsigned target; int last;
    __device__ __forceinline__ void hook(f32x4 (&acc)[2][2][4][2], const pg8::Unit& u, int wr, int wc, int fr, int fq) const {
        const int row0 = u.pm * 256 + wr * 64 + fr;
        float rs[2][4];
#pragma unroll
        for (int ai = 0; ai < 2; ++ai)
#pragma unroll
            for (int m = 0; m < 4; ++m) rs[ai][m] = *(const GAS float*)(partm + (size_t)(row0 + ai * 128 + m * 16));
        __builtin_amdgcn_sched_barrier(0);
#pragma unroll
        for (int ai = 0; ai < 2; ++ai)
#pragma unroll
            for (int m = 0; m < 4; ++m) rs[ai][m] = __builtin_amdgcn_rsqf(rs[ai][m] * (1.f / 768.f) + EPS);
#pragma unroll
        for (int ai = 0; ai < 2; ++ai)
#pragma unroll
            for (int m = 0; m < 4; ++m)
#pragma unroll
                for (int bj = 0; bj < 2; ++bj)
#pragma unroll
                    for (int n = 0; n < 2; ++n) acc[ai][bj][m][n] *= rs[ai][m];
    }
    __device__ __forceinline__ void fused(f32x4 (&acc)[2][2][4][2], const pg8::Unit& u, int wr, int wc, int fr, int fq, LAS unsigned char* lds, int wid, int lane) const {
        const int row0 = u.pm * 256 + wr * 64 + fr, col0 = u.pn * 256 + wc * 32 + 4 * fq, b = u.pm >> 3; const float* gb = gate + (size_t)b * 3 * DM;
        LAS float* P = (LAS float*)lds;
        LAS float* S = (LAS float*)(lds + 4096);
        f32x4 gv[2][2];
#pragma unroll
        for (int bj = 0; bj < 2; ++bj)
#pragma unroll
            for (int n = 0; n < 2; ++n) gv[bj][n] = *(const f32x4*)(gb + col0 + bj * 128 + n * 16);
        v4u xr[2][2][2][2];
#define EO_LOAD(slot, g_) do { _Pragma("unroll") for (int q = 0; q < 2; ++q) { const size_t off = (size_t)(row0 + ((g_) >> 1) * 128 + (((g_) & 1) * 2 + q) * 16) * DM + col0; \
            _Pragma("unroll") for (int bj = 0; bj < 2; ++bj) _Pragma("unroll") for (int n = 0; n < 2; ++n) { if (xinb) { const v2u w_ = *(const GAS v2u*)(xinb + off + bj * 128 + n * 16); xr[slot][q][bj][n] = (v4u){w_.x, w_.y, 0u, 0u}; } \
                else xr[slot][q][bj][n] = *(const GAS v4u*)(xin + off + bj * 128 + n * 16); } } } while (0)
#define EO_ADD(slot, g_) do { _Pragma("unroll") for (int q = 0; q < 2; ++q) { const int ai = (g_) >> 1, m = ((g_) & 1) * 2 + q; const size_t off = (size_t)(row0 + ai * 128 + m * 16) * DM + col0; \
            _Pragma("unroll") for (int bj = 0; bj < 2; ++bj) _Pragma("unroll") for (int n = 0; n < 2; ++n) { const v4u r_ = xr[slot][q][bj][n]; \
                f32x4 x_ = __builtin_bit_cast(f32x4, r_); if (xinb) x_ = (f32x4){bflo(r_.x), bfhi(r_.x), bflo(r_.y), bfhi(r_.y)}; \
                acc[ai][bj][m][n] = x_ + gv[bj][n] * acc[ai][bj][m][n]; \
                if (!last) { v2u w_; w_.x = pk2(acc[ai][bj][m][n][0], acc[ai][bj][m][n][1]); w_.y = pk2(acc[ai][bj][m][n][2], acc[ai][bj][m][n][3]); *(v2u*)(x1b + off + bj * 128 + n * 16) = w_; } } } } while (0)
        EO_LOAD(0, 0); EO_LOAD(1, 1); EO_ADD(0, 0); EO_LOAD(0, 2); EO_ADD(1, 1); EO_LOAD(1, 3); EO_ADD(0, 2); EO_ADD(1, 3);
#undef EO_LOAD
#undef EO_ADD
#pragma unroll
        for (int ai = 0; ai < 2; ++ai)
#pragma unroll
            for (int m = 0; m < 4; ++m) { float ss = 0.f;
#pragma unroll
                for (int bj = 0; bj < 2; ++bj)
#pragma unroll
                    for (int n = 0; n < 2; ++n) { const f32x4 x = acc[ai][bj][m][n]; ss += (x[0] * x[0] + x[1] * x[1]) + (x[2] * x[2] + x[3] * x[3]); }
                ss += __shfl_xor(ss, 16); ss += __shfl_xor(ss, 32);
                if (fq == 0) P[(ai * 128 + wr * 64 + m * 16 + fr) * 4 + wc] = ss; }
        asm volatile("s_waitcnt lgkmcnt(0)" ::: "memory"); __builtin_amdgcn_s_barrier(); asm volatile("" ::: "memory");
        const int tid = wid * 64 + lane;
        if (tid < 256) { const f32x4 p = *(const LAS f32x4*)(P + tid * 4);
            __hip_atomic_store(xs + (size_t)(u.pm * 256 + tid) * 8 + u.pn, (p[0] + p[1]) + (p[2] + p[3]), __ATOMIC_RELAXED, __HIP_MEMORY_SCOPE_AGENT);
            asm volatile("s_waitcnt vmcnt(0)" ::: "memory");
            if (lane == 0) __hip_atomic_fetch_add(cnt + 64 * u.pm, 1u, __ATOMIC_RELAXED, __HIP_MEMORY_SCOPE_AGENT); }
        if (wid == 0) { unsigned sp = 0u;
            while ((unsigned)__builtin_amdgcn_readfirstlane(__hip_atomic_load(cnt + 64 * u.pm, __ATOMIC_RELAXED, __HIP_MEMORY_SCOPE_AGENT)) < target) { __builtin_amdgcn_s_sleep(2); if (++sp > (1u << 22)) break; }
            __builtin_amdgcn_fence(__ATOMIC_ACQUIRE, "agent"); }
        asm volatile("s_waitcnt vmcnt(0) lgkmcnt(0)" ::: "memory"); __builtin_amdgcn_s_barrier(); asm volatile("" ::: "memory");
        if (tid < 256) { const GAS float* sl = (const GAS float*)(xs + (size_t)(u.pm * 256 + tid) * 8); f32x4 sa, sb;
            asm volatile("global_load_dwordx4 %0, %2, off sc1\n\tglobal_load_dwordx4 %1, %2, off offset:16 sc1\n\ts_waitcnt vmcnt(0)" : "=&v"(sa), "=&v"(sb) : "v"(sl) : "memory");
            const float s = ((sa[0] + sa[1]) + (sa[2] + sa[3])) + ((sb[0] + sb[1]) + (sb[2] + sb[3]));
            S[tid] = __builtin_amdgcn_rsqf(s * (1.f / DM) + EPS); }
        asm volatile("s_waitcnt lgkmcnt(0)" ::: "memory"); __builtin_amdgcn_s_barrier(); asm volatile("" ::: "memory");
        f32x4 mul[2][2], add[2][2];
#pragma unroll
        for (int bj = 0; bj < 2; ++bj)
#pragma unroll
            for (int n = 0; n < 2; ++n) { const int c = col0 + bj * 128 + n * 16; const f32x4 gg = *(const f32x4*)(g + c);
                if (last) { mul[bj][n] = gg; add[bj][n] = (f32x4){0.f, 0.f, 0.f, 0.f}; }
                else { const float* mn = mods_next + (size_t)b * 3 * DM; mul[bj][n] = gg * (*(const f32x4*)(mn + DM + c) + 1.f); add[bj][n] = *(const f32x4*)(mn + c); } }
#pragma unroll
        for (int ai = 0; ai < 2; ++ai)
#pragma unroll
            for (int m = 0; m < 4; ++m) { const int rl = ai * 128 + wr * 64 + m * 16 + fr; const float rstd = S[rl]; const size_t off = (size_t)(u.pm * 256 + rl) * DM + col0;
#pragma unroll
                for (int bj = 0; bj < 2; ++bj)
#pragma unroll
                    for (int n = 0; n < 2; ++n) { const f32x4 r = acc[ai][bj][m][n] * rstd * mul[bj][n] + add[bj][n];
                        if (last) *(f32x4*)(out + off + bj * 128 + n * 16) = r;
                        else { v2u w; w.x = pk2(r[0], r[1]); w.y = pk2(r[2], r[3]); *(v2u*)(H + off + bj * 128 + n * 16) = w; } } }
    }
};

__device__ __forceinline__ void unpack8(const v4u w, float* f) { f[0] = bflo(w.x); f[1] = bfhi(w.x); f[2] = bflo(w.y); f[3] = bfhi(w.y); f[4] = bflo(w.z); f[5] = bfhi(w.z); f[6] = bflo(w.w); f[7] = bfhi(w.w); }

__device__ __forceinline__ int stg_pos(int c, int row) { return (c & 16) | ((c ^ (row & 7) ^ ((c >> 4) << 3)) & 15); }
__device__ __forceinline__ void stage_write(LAS float* st, const f32x16* acc, int r32, int hi) {
#pragma unroll
    for (int reg = 0; reg < 16; ++reg) { const int row = (reg & 3) + 8 * (reg >> 2) + 4 * hi;
#pragma unroll
        for (int dvb = 0; dvb < 4; ++dvb) { const int col = dvb * 32 + r32; st[row * 128 + stg_pos(col >> 2, row) * 4 + (col & 3)] = acc[dvb][reg]; } }
}
__device__ __forceinline__ void stage_write1(LAS float* st, const f32x16& a, int dvb, int r32, int hi) {
#pragma unroll
    for (int reg = 0; reg < 16; ++reg) { const int row = (reg & 3) + 8 * (reg >> 2) + 4 * hi; const int col = dvb * 32 + r32; st[row * 128 + stg_pos(col >> 2, row) * 4 + (col & 3)] = a[reg]; }
}
__device__ __forceinline__ void stage_read(const LAS float* st, int lane, float* v) {
    const int row = lane >> 1, half = lane & 1;
#pragma unroll
    for (int j = 0; j < 16; ++j) { const f32x4 q = *(const LAS f32x4*)(st + row * 128 + stg_pos(16 * half + j, row) * 4); v[4 * j] = q[0]; v[4 * j + 1] = q[1]; v[4 * j + 2] = q[2]; v[4 * j + 3] = q[3]; }
}
__device__ __forceinline__ void gated_store64(const float* v, float rs, const float* __restrict__ g, const bf16* __restrict__ zrow, bf16* __restrict__ yrow) {
    v4u zz[8];
#pragma unroll
    for (int j = 0; j < 8; ++j) zz[j] = *(const v4u*)(zrow + 8 * j);
#pragma unroll
    for (int j = 0; j < 8; ++j) { const f32x4 g0 = *(const f32x4*)(g + 8 * j), g1 = *(const f32x4*)(g + 8 * j + 4); float z[8]; unpack8(zz[j], z);
        v4u w; w.x = pk2a(v[8 * j] * rs * g0[0] * z[0], v[8 * j + 1] * rs * g0[1] * z[1]); w.y = pk2a(v[8 * j + 2] * rs * g0[2] * z[2], v[8 * j + 3] * rs * g0[3] * z[3]);
        w.z = pk2a(v[8 * j + 4] * rs * g1[0] * z[4], v[8 * j + 5] * rs * g1[1] * z[5]); w.w = pk2a(v[8 * j + 6] * rs * g1[2] * z[6], v[8 * j + 7] * rs * g1[3] * z[7]);
        *(v4u*)(yrow + 8 * j) = w; }
}

template <bool NORM> __device__ __forceinline__ void rows_finish(const LAS float* st, int lane, const bf16* __restrict__ oi, const float* __restrict__ g, const bf16* __restrict__ z, bf16* __restrict__ y, float* __restrict__ part) {
    const int lr = lane >> 4, cl = lane & 15, c8 = cl * 8;
    const f32x4 g0 = *(const f32x4*)(g + c8), g1 = *(const f32x4*)(g + c8 + 4);
    v4u zz[8], oo[8];
#pragma unroll
    for (int it = 0; it < 8; ++it) { const int row = it * 4 + lr; zz[it] = *(const v4u*)(z + (size_t)row * NP + c8); if (NORM) oo[it] = *(const v4u*)(oi + (size_t)row * 768 + c8); }
#pragma unroll
    for (int it = 0; it < 8; ++it) { const int row = it * 4 + lr;
        const f32x4 a = *(const LAS f32x4*)(st + row * 128 + stg_pos(2 * cl, row) * 4), b = *(const LAS f32x4*)(st + row * 128 + stg_pos(2 * cl + 1, row) * 4);
        float v[8] = {a[0], a[1], a[2], a[3], b[0], b[1], b[2], b[3]};
        if (NORM) { float f[8]; unpack8(oo[it], f);
#pragma unroll
            for (int e = 0; e < 8; ++e) v[e] += f[e]; }
        float ss = 0.f;
#pragma unroll
        for (int e = 0; e < 8; ++e) ss += v[e] * v[e];
        ss += __shfl_xor(ss, 1); ss += __shfl_xor(ss, 2); ss += __shfl_xor(ss, 4); ss += __shfl_xor(ss, 8);
        float rs = 1.f;
        if (NORM) rs = __builtin_amdgcn_rsqf(ss * (1.f / 128.f) + EPS); else if (cl == 0) atomicAdd(part + row, ss);
        float zf[8]; unpack8(zz[it], zf);
        if (!MK_SILU_IN_EPI) {
#pragma unroll
            for (int e = 0; e < 8; ++e) zf[e] = silu_fast(zf[e]); }
        v4u w; w.x = pk2a(v[0] * rs * g0[0] * zf[0], v[1] * rs * g0[1] * zf[1]); w.y = pk2a(v[2] * rs * g0[2] * zf[2], v[3] * rs * g0[3] * zf[3]);
        w.z = pk2a(v[4] * rs * g1[0] * zf[4], v[5] * rs * g1[1] * zf[5]); w.w = pk2a(v[6] * rs * g1[2] * zf[6], v[7] * rs * g1[3] * zf[7]);
        if (MK_FUSE_Y) st_wt16(y + (size_t)row * DM + c8, w); else *(v4u*)(y + (size_t)row * DM + c8) = w; }
}

__device__ __forceinline__ const float* ld_in(int i);
namespace mla {
constexpr int NW = 8, QBLK = 32, KVBLK = 64;
constexpr int SHM_V = 16384, SHM_KN = 16384, SHM_KR = 8192;
constexpr int OFF_V = 0, OFF_KN = 2 * SHM_V, OFF_KR = OFF_KN + 2 * SHM_KN, OFF_WS = OFF_KR + 2 * SHM_KR, OFF_QR = OFF_WS + NW * 64 * 4, ATTN_LDS = OFF_QR + NW * 4096;
constexpr float THR = 8.f;
#define KSWZ(row, colB) ((row) * 256 + ((colB) ^ (((row) & 7) << 4)))
#define KRSWZ(row, colB) ((row) * 128 + ((colB) ^ ((((row) >> 1) & 7) << 4)))
#define SBAR() __builtin_amdgcn_sched_barrier(0)
__device__ __forceinline__ int crow(int r, int hi) { return (r & 3) + 8 * (r >> 2) + 4 * hi; }
__device__ __forceinline__ unsigned cvtpk(float lo, float hi) { unsigned r; asm volatile("v_cvt_pk_bf16_f32 %0, %1, %2" : "=v"(r) : "v"(lo), "v"(hi)); return r; }

__device__ __forceinline__ void partialSM(f32x16& p0, f32x16& p1, float& m_reg, float& mn, float& alpha) {
  float pmax = p0[0];
#pragma unroll
  for (int r = 1; r < 16; ++r) pmax = fmaxf(pmax, p0[r]);
#pragma unroll
  for (int r = 0; r < 16; ++r) pmax = fmaxf(pmax, p1[r]);
  { auto rr = __builtin_amdgcn_permlane32_swap(__float_as_uint(pmax), __float_as_uint(pmax), false, false);
    pmax = fmaxf(__uint_as_float(rr[0]), __uint_as_float(rr[1])); }
  if (__builtin_expect(__all(pmax - m_reg <= THR), 1)) { mn = m_reg; alpha = 1.f; }
  else { mn = fmaxf(m_reg, pmax); alpha = __builtin_amdgcn_exp2f(m_reg - mn); m_reg = mn; }
#pragma unroll
  for (int r = 0; r < 16; ++r) p0[r] = p0[r] - mn;
#pragma unroll
  for (int r = 0; r < 16; ++r) p1[r] = p1[r] - mn;
#pragma unroll
  for (int r = 0; r < 16; ++r) p0[r] = __builtin_amdgcn_exp2f(p0[r]);
}
__device__ __forceinline__ void finishSM(f32x16& p0, f32x16& p1, float alpha, float& l_reg, bf16x8& pa0, bf16x8& pa1, bf16x8& pa2, bf16x8& pa3) {
#pragma unroll
  for (int r = 0; r < 16; ++r) p1[r] = __builtin_amdgcn_exp2f(p1[r]);
  float ps = 0;
#pragma unroll
  for (int r = 0; r < 16; ++r) ps += p0[r];
#pragma unroll
  for (int r = 0; r < 16; ++r) ps += p1[r];
  { auto rr = __builtin_amdgcn_permlane32_swap(__float_as_uint(ps), __float_as_uint(ps), false, false);
    ps = __uint_as_float(rr[0]) + __uint_as_float(rr[1]); }
  l_reg = l_reg * alpha + ps;
#define PK4(P, BASE, OUT) do { unsigned a0 = cvtpk(P[BASE + 0], P[BASE + 1]), a1 = cvtpk(P[BASE + 2], P[BASE + 3]);   \
    unsigned b0 = cvtpk(P[BASE + 4], P[BASE + 5]), b1 = cvtpk(P[BASE + 6], P[BASE + 7]);                              \
    auto r0 = __builtin_amdgcn_permlane32_swap(a0, b0, false, false); auto r1 = __builtin_amdgcn_permlane32_swap(a1, b1, false, false); \
    v4u w = {r0[0], r1[0], r0[1], r1[1]}; OUT = *reinterpret_cast<bf16x8*>(&w); } while (0)
  PK4(p0, 0, pa0); PK4(p0, 8, pa1); PK4(p1, 0, pa2); PK4(p1, 8, pa3);
#undef PK4
}
__device__ __forceinline__ void qkt(f32x16& p0, f32x16& p1, const char* Kn, const char* Kr, const bf16x8* qr, const char* Qr, int r32, int hi) {
  p0 = f32x16{}; p1 = f32x16{};
  int tn = (hi * 16) ^ ((r32 & 7) << 4), tr = (hi * 16) ^ (((r32 >> 1) & 7) << 4);
  asm volatile("" : "+v"(tn), "+v"(tr));
  const char* knb = Kn + r32 * 256; const char* krb = Kr + r32 * 128; const char* qrb = Qr + r32 * 128;
#pragma unroll
  for (int d0 = 0; d0 < 8; ++d0) { const int off = (d0 * 32) ^ tn;
    const bf16x8 b0 = *reinterpret_cast<const bf16x8*>(knb + off);
    const bf16x8 b1 = *reinterpret_cast<const bf16x8*>(knb + off + 8192);
    p0 = __builtin_amdgcn_mfma_f32_32x32x16_bf16(b0, qr[d0], p0, 0, 0, 0);
    p1 = __builtin_amdgcn_mfma_f32_32x32x16_bf16(b1, qr[d0], p1, 0, 0, 0); }
#pragma unroll
  for (int d0 = 0; d0 < 4; ++d0) { const int off = (d0 * 32) ^ tr;
    const bf16x8 b0 = *reinterpret_cast<const bf16x8*>(krb + off);
    const bf16x8 b1 = *reinterpret_cast<const bf16x8*>(krb + off + 4096);
    const bf16x8 qv = *reinterpret_cast<const bf16x8*>(qrb + off);
    p0 = __builtin_amdgcn_mfma_f32_32x32x16_bf16(b0, qv, p0, 0, 0, 0);
    p1 = __builtin_amdgcn_mfma_f32_32x32x16_bf16(b1, qv, p1, 0, 0, 0); }
}
__device__ __forceinline__ int v_st(int k, int c) { const int kk = (k & ~0xC) | ((k & 4) << 1) | ((k & 8) >> 1); return ((kk >> 3) * 4 + (c >> 5)) * 512 + ((kk & 7) * 32 + (c & 31)) * 2; }
__device__ __forceinline__ int v_rd_base(int lane) { return ((lane & 3) << 3) | (((lane >> 2) & 3) << 6) | (((lane >> 4) & 1) << 5) | (((lane >> 5) & 1) << 8); }
constexpr int v_rd_off(int d0, int ks, int half) { return d0 * 512 + ks * 4096 + half * 2048; }
template <int OFF> __device__ __forceinline__ s16x4 tr_read(int vb) {
  s16x4 r; asm volatile("ds_read_b64_tr_b16 %0, %1 offset:%2" : "=&v"(r) : "v"(vb), "i"(OFF) : "memory"); return r;
}
template <int D0> __device__ __forceinline__ void pv_one(f32x16& od, int vb, bf16x8 pa0, bf16x8 pa1, bf16x8 pa2, bf16x8 pa3) {
  const s16x4 l0 = tr_read<v_rd_off(D0, 0, 0)>(vb), h0 = tr_read<v_rd_off(D0, 0, 1)>(vb), l1 = tr_read<v_rd_off(D0, 1, 0)>(vb), h1 = tr_read<v_rd_off(D0, 1, 1)>(vb);
  const s16x4 l2 = tr_read<v_rd_off(D0, 2, 0)>(vb), h2 = tr_read<v_rd_off(D0, 2, 1)>(vb), l3 = tr_read<v_rd_off(D0, 3, 0)>(vb), h3 = tr_read<v_rd_off(D0, 3, 1)>(vb);
  asm volatile("s_waitcnt lgkmcnt(0)" ::: "memory"); SBAR();
  __builtin_amdgcn_s_setprio(1);
#define PK(L, H) (bf16x8){L[0], L[1], L[2], L[3], H[0], H[1], H[2], H[3]}
  od = __builtin_amdgcn_mfma_f32_32x32x16_bf16(pa0, PK(l0, h0), od, 0, 0, 0);
  od = __builtin_amdgcn_mfma_f32_32x32x16_bf16(pa1, PK(l1, h1), od, 0, 0, 0);
  od = __builtin_amdgcn_mfma_f32_32x32x16_bf16(pa2, PK(l2, h2), od, 0, 0, 0);
  od = __builtin_amdgcn_mfma_f32_32x32x16_bf16(pa3, PK(l3, h3), od, 0, 0, 0);
  __builtin_amdgcn_s_setprio(0);
#undef PK
}
__device__ __forceinline__ void pv_d0(f32x16* o, int vb, bf16x8 pa0, bf16x8 pa1, bf16x8 pa2, bf16x8 pa3) {
  pv_one<0>(o[0], vb, pa0, pa1, pa2, pa3); pv_one<1>(o[1], vb, pa0, pa1, pa2, pa3); pv_one<2>(o[2], vb, pa0, pa1, pa2, pa3); pv_one<3>(o[3], vb, pa0, pa1, pa2, pa3);
}

__device__ __forceinline__ void attn_unit(const bf16* __restrict__ Qb, const bf16* __restrict__ Knh, const bf16* __restrict__ Vh, const bf16* __restrict__ Krh,
                                          bf16* __restrict__ Yb, const bf16* __restrict__ Zb, const float* __restrict__ gh, float* __restrict__ part, int seq, char* lds,
                                          int mode_u) {
  int tid_ = threadIdx.x; asm volatile("" : "+v"(tid_));
  const int tid = tid_, wid = tid >> 6, lane = tid & 63, r32 = lane & 31, hi = lane >> 5;
  char* V_lds = lds + OFF_V; char* KN_lds = lds + OFF_KN; char* KR_lds = lds + OFF_KR;
  float* ws = (float*)(lds + OFF_WS) + wid * 64; float* li_l = ws; float* al_l = ws + 32;
  float m_reg = -1e30f, l_reg = 0; f32x16 o[4] = {}; bf16x8 qr[8]; char* QR_lds = lds + OFF_QR + wid * 4096;
  const bf16* Qw = Qb + (long)(wid * QBLK + r32) * NQ + hi * 8;
#pragma unroll
  for (int d0 = 0; d0 < 8; ++d0) qr[d0] = *reinterpret_cast<const bf16x8*>(Qw + d0 * 16);
#pragma unroll
  for (int d0 = 0; d0 < 4; ++d0) *reinterpret_cast<bf16x8*>(QR_lds + KRSWZ(r32, (d0 * 16 + hi * 8) * 2)) = *reinterpret_cast<const bf16x8*>(Qw + 128 + d0 * 16);
  const int sr = tid >> 4, sc = (tid & 15) * 8, vst0 = v_st(sr, sc), vst1 = v_st(32 + sr, sc);
  const int krr = tid >> 3, krc = (tid & 7) * 8;
  const int vb0 = (int)(uintptr_t)V_lds + v_rd_base(lane);
  bf16x8 vs0, vs1, ks0, ks1, kr0;
#define SLOAD(k0) do { vs0 = *reinterpret_cast<const bf16x8*>(&Vh[(long)((k0) + sr) * NKV + sc]); vs1 = *reinterpret_cast<const bf16x8*>(&Vh[(long)((k0) + 32 + sr) * NKV + sc]); \
    ks0 = *reinterpret_cast<const bf16x8*>(&Knh[(long)((k0) + sr) * NKV + sc]); ks1 = *reinterpret_cast<const bf16x8*>(&Knh[(long)((k0) + 32 + sr) * NKV + sc]); \
    kr0 = *reinterpret_cast<const bf16x8*>(&Krh[(long)((k0) + krr) * NP + krc]); } while (0)
#define SWRITE(b) do { *(bf16x8*)(V_lds + (b) * SHM_V + vst0) = vs0; *(bf16x8*)(V_lds + (b) * SHM_V + vst1) = vs1; const int kc = sc * 2;   \
    *(bf16x8*)(KN_lds + (b) * SHM_KN + KSWZ(sr, kc)) = ks0; *(bf16x8*)(KN_lds + (b) * SHM_KN + KSWZ(32 + sr, kc)) = ks1;                       \
    *(bf16x8*)(KR_lds + (b) * SHM_KR + KRSWZ(krr, krc * 2)) = kr0; } while (0)
#define SWAIT() asm volatile("s_waitcnt vmcnt(0)" ::: "memory")
#define RESC(a) do { if (__any((a) < 1.f)) { if (hi == 0) al_l[r32] = (a); asm volatile("s_waitcnt lgkmcnt(0)" ::: "memory"); \
    _Pragma("unroll") for (int d = 0; d < 4; ++d) _Pragma("unroll") for (int r = 0; r < 16; ++r) o[d][r] *= al_l[crow(r, hi)]; } } while (0)
  f32x16 pA0, pA1, pB0, pB1; float mnA, mnB, alA, alB; bf16x8 pa0, pa1, pa2, pa3; const int NT = seq / KVBLK;
  SLOAD(0); SWAIT(); SWRITE(0); __syncthreads();
  qkt(pA0, pA1, KN_lds, KR_lds, qr, QR_lds, r32, hi); partialSM(pA0, pA1, m_reg, mnA, alA);
  SLOAD(KVBLK);
  SWAIT(); SWRITE(1); __syncthreads();
  for (int j = 1; j + 1 < NT; j += 2) {
    SBAR(); qkt(pB0, pB1, KN_lds + SHM_KN, KR_lds + SHM_KR, qr, QR_lds, r32, hi);
    finishSM(pA0, pA1, alA, l_reg, pa0, pa1, pa2, pa3); SBAR();
    SLOAD((j + 1) * KVBLK); SBAR();
    pv_d0(o, vb0, pa0, pa1, pa2, pa3); partialSM(pB0, pB1, m_reg, mnB, alB);
    __syncthreads(); SWAIT(); SWRITE(0);
    RESC(alB); __syncthreads();
    SBAR(); qkt(pA0, pA1, KN_lds, KR_lds, qr, QR_lds, r32, hi);
    finishSM(pB0, pB1, alB, l_reg, pa0, pa1, pa2, pa3); SBAR();
    SLOAD((j + 2) * KVBLK); SBAR();
    pv_d0(o, vb0 + SHM_V, pa0, pa1, pa2, pa3); partialSM(pA0, pA1, m_reg, mnA, alA);
    __syncthreads(); SWAIT(); SWRITE(1);
    RESC(alA); __syncthreads();
  }
  SBAR(); qkt(pB0, pB1, KN_lds + SHM_KN, KR_lds + SHM_KR, qr, QR_lds, r32, hi);
  finishSM(pA0, pA1, alA, l_reg, pa0, pa1, pa2, pa3); SBAR();
  pv_d0(o, vb0, pa0, pa1, pa2, pa3); partialSM(pB0, pB1, m_reg, mnB, alB);
  __syncthreads(); RESC(alB);
  finishSM(pB0, pB1, alB, l_reg, pa0, pa1, pa2, pa3); SBAR();
  pv_d0(o, vb0 + SHM_V, pa0, pa1, pa2, pa3);
  const int mu_ = __builtin_amdgcn_readfirstlane(mode_u);
  const int mode = mu_ & 15;
  unsigned long long* po = nullptr; float* pml = nullptr; unsigned* flag = nullptr;
  if (mode != 0) { unsigned char* wsb = (unsigned char*)::ld_in(22); const int un = (mu_ >> 4) & 255, fs = mu_ >> 12;
    po = (unsigned long long*)(wsb + WS_PO) + (size_t)un * 8192; pml = (float*)(wsb + WS_PML) + (size_t)un * 512; flag = (unsigned*)(wsb + WS_CTL) + 16384 + 2048 * fs + un * 8; }
  if (mode == 2) {
    unsigned long long* pw = po + (wid * 16) * 64 + lane;
#pragma unroll
    for (int d0 = 0; d0 < 4; ++d0)
#pragma unroll
      for (int q = 0; q < 4; ++q) { const unsigned long long w = (unsigned long long)pk2(o[d0][4 * q], o[d0][4 * q + 1]) | ((unsigned long long)pk2(o[d0][4 * q + 2], o[d0][4 * q + 3]) << 32);
        __hip_atomic_store(pw + (d0 * 4 + q) * 64, w, __ATOMIC_RELAXED, __HIP_MEMORY_SCOPE_AGENT); }
    if (hi == 0) { __hip_atomic_store(pml + (wid * QBLK + r32) * 2, m_reg, __ATOMIC_RELAXED, __HIP_MEMORY_SCOPE_AGENT); __hip_atomic_store(pml + (wid * QBLK + r32) * 2 + 1, l_reg, __ATOMIC_RELAXED, __HIP_MEMORY_SCOPE_AGENT); }
    asm volatile("s_waitcnt vmcnt(0)" ::: "memory");
    if (lane == 0) __hip_atomic_fetch_add(flag + wid, 1u, __ATOMIC_RELAXED, __HIP_MEMORY_SCOPE_AGENT);
    __syncthreads();
    return;
  }
  if (mode == 1) {
    { unsigned sp = 0u; while (__hip_atomic_load(flag + wid, __ATOMIC_RELAXED, __HIP_MEMORY_SCOPE_AGENT) == 0u) { __builtin_amdgcn_s_sleep(2); if (++sp > (1u << 22)) break; } }
    asm volatile("" ::: "memory");
    const unsigned long long* pw = po + (wid * 16) * 64 + lane;
    unsigned long long pq[16];
#pragma unroll
    for (int k = 0; k < 16; ++k) pq[k] = __hip_atomic_load(pw + k * 64, __ATOMIC_RELAXED, __HIP_MEMORY_SCOPE_AGENT);
    const float pm = __hip_atomic_load(pml + (wid * QBLK + r32) * 2, __ATOMIC_RELAXED, __HIP_MEMORY_SCOPE_AGENT), pl = __hip_atomic_load(pml + (wid * QBLK + r32) * 2 + 1, __ATOMIC_RELAXED, __HIP_MEMORY_SCOPE_AGENT);
    const float mt = fmaxf(m_reg, pm), fa0 = __builtin_amdgcn_exp2f(m_reg - mt), fb0 = __builtin_amdgcn_exp2f(pm - mt), inv = __builtin_amdgcn_rcpf(l_reg * fa0 + pl * fb0);
    if (hi == 0) { li_l[r32] = fa0 * inv; al_l[r32] = fb0 * inv; } asm volatile("s_waitcnt lgkmcnt(0)" ::: "memory");
    float ra[16], rb[16];
#pragma unroll
    for (int r = 0; r < 16; ++r) { ra[r] = li_l[crow(r, hi)]; rb[r] = al_l[crow(r, hi)]; }
#pragma unroll
    for (int d0 = 0; d0 < 4; ++d0)
#pragma unroll
      for (int q = 0; q < 4; ++q) { const unsigned lo = (unsigned)pq[d0 * 4 + q], hi2 = (unsigned)(pq[d0 * 4 + q] >> 32);
        o[d0][4 * q] = o[d0][4 * q] * ra[4 * q] + bflo(lo) * rb[4 * q]; o[d0][4 * q + 1] = o[d0][4 * q + 1] * ra[4 * q + 1] + bfhi(lo) * rb[4 * q + 1];
        o[d0][4 * q + 2] = o[d0][4 * q + 2] * ra[4 * q + 2] + bflo(hi2) * rb[4 * q + 2]; o[d0][4 * q + 3] = o[d0][4 * q + 3] * ra[4 * q + 3] + bfhi(hi2) * rb[4 * q + 3]; }
  } else {
  if (hi == 0) li_l[r32] = l_reg; asm volatile("s_waitcnt lgkmcnt(0)" ::: "memory");
  float rli[16];
#pragma unroll
  for (int r = 0; r < 16; ++r) rli[r] = __builtin_amdgcn_rcpf(li_l[crow(r, hi)]);
#pragma unroll
  for (int d0 = 0; d0 < 4; ++d0)
#pragma unroll
    for (int r = 0; r < 16; ++r) o[d0][r] *= rli[r];
  }
  __syncthreads();
  { LAS float* st = (LAS float*)(LAS unsigned char*)(lds + wid * 16384);
    stage_write(st, o, r32, hi);
    asm volatile("s_waitcnt lgkmcnt(0)" ::: "memory");
    rows_finish<false>(st, lane, nullptr, gh, Zb + (long)(wid * QBLK) * NP, Yb + (long)(wid * QBLK) * DM, part + wid * QBLK);
    if (MK_FUSE_Y) {
      asm volatile("s_waitcnt vmcnt(0)" ::: "memory");
      if (lane == 0) { const int un = (mu_ >> 4) & 255, fs = mu_ >> 12, pm = ((un >> 3) / 6) * 8 + (un & 7);
        (void)__hip_atomic_fetch_add((unsigned*)((unsigned char*)::ld_in(22) + WS_CTL) + CW_YREADY + 2048 * fs + 64 * pm, 1u, __ATOMIC_RELAXED, __HIP_MEMORY_SCOPE_AGENT); } } }
  __syncthreads();
#undef SLOAD
#undef SWRITE
#undef SWAIT
#undef RESC
}
#undef SBAR
}
struct Frame {
    LAS unsigned char* lds; char* ldsg;
    int tid, lane, wave, vcu, G;
    float* out; unsigned char* ws;
};
__device__ __forceinline__ const float* ld_in(int i) {
    const __attribute__((address_space(4))) char* ka = (const __attribute__((address_space(4))) char*)__builtin_amdgcn_kernarg_segment_ptr();
    asm volatile("" : "+s"(i));
    const GAS float* p = *(const GAS float* const __attribute__((address_space(4)))*)(ka + 8 * i);
    return (const float*)p;
}
#define WSP(T_, off) ((T_*)(F.ws + (off)))

__device__ __forceinline__ void p0_mods(Frame& F, size_t mods_off, int first, int step, int lo, int hi) {
    LAS float* sc = (LAS float*)F.lds;
    LAS float* part = (LAS float*)(F.lds + 32768);
    const float* c = ld_in(1); const float* aw = ld_in(3); const float* ab = ld_in(4);
    for (int i = F.tid; i < BATCH * DM; i += NTHR) { const float v = c[i]; sc[i] = v / (1.f + __expf(-v)); }
    __syncthreads();
    const int n_it = hi - lo, i0 = lo + (int)(((long)n_it * first) / step), i1 = lo + (int)(((long)n_it * (first + 1)) / step);
    f32x4 a[4] = {}; int cur = -1; bool bias = false;
#pragma unroll 1
    for (int item = i0; ; ++item) {
        const bool end = item >= i1; const int pair = end ? -1 : (item >> 4);
        if (cur >= 0 && pair != cur) {
            const int l = cur / 24, j0 = (cur % 24) * 256;
#pragma unroll
            for (int b = 0; b < 4; ++b) { *(LAS f32x4*)(part + (F.wave * 4 + b) * 256 + F.lane * 4) = a[b]; a[b] = f32x4{0.f, 0.f, 0.f, 0.f}; }
            __syncthreads();
            for (int o = F.tid; o < 1024; o += NTHR) { const int b = o >> 8, col = o & 255; float s = 0.f;
#pragma unroll
                for (int wv2 = 0; wv2 < 8; ++wv2) s += part[(wv2 * 4 + b) * 256 + col];
                if (bias) s += ab[l * 3 * DM + j0 + col];
                atomicAdd(WSP(float, mods_off) + ((size_t)l * BATCH + b) * 3 * DM + j0 + col, s); }
            __syncthreads();
            bias = false;
        }
        if (end) break;
        cur = pair;
        const int ks = item & 15, cb = pair % 24, l = pair / 24, j0 = cb * 256, kb = ks * 128 + F.wave * 16;
        if (ks == 0) bias = true;
        const f32x4* w = (const f32x4*)(aw + (size_t)l * DM * 3 * DM + (size_t)kb * 3 * DM + j0) + F.lane;
        f32x4 wv[16];
#pragma unroll
        for (int k = 0; k < 16; ++k) wv[k] = __builtin_nontemporal_load(w + (size_t)k * (3 * DM / 4));
#pragma unroll
        for (int k = 0; k < 16; ++k)
#pragma unroll
            for (int b = 0; b < 4; ++b) a[b] += wv[k] * sc[b * DM + kb + k];
    }
}
__device__ __forceinline__ int kmap_out(int k) { return k < 768 ? k + 768 : (k < 1536 ? k - 768 : k); }
template <int MAP, bool KMAP> __device__ __forceinline__ void p0_transpose_item(const float* W, int K, int N, bf16* WT, const float* kgain, int item, int nblk, int lane) {
    const int kb = item / nblk, nb = item % nblk, k0 = 64 * kb, n0 = 64 * nb, ks0 = KMAP ? kmap_out(k0) : k0;
    const int np = n0 + lane; const int src = MAP == 1 ? map_in(np) : (MAP == 2 ? map_uq(np) : np);
    float v[64];
#pragma unroll
    for (int i = 0; i < 64; ++i) v[i] = src >= 0 ? __builtin_nontemporal_load(W + (size_t)(ks0 + i) * N + src) : 0.f;
    if (kgain) {
        const unsigned gl = __builtin_bit_cast(unsigned, kgain[k0 + lane]);
#pragma unroll
        for (int i = 0; i < 64; ++i) v[i] *= __builtin_bit_cast(float, __builtin_amdgcn_readlane((int)gl, i));
    }
    bf16* orow = WT + (size_t)np * K + k0;
#pragma unroll
    for (int c = 0; c < 8; ++c) { v4u w; w.x = pk2(v[8 * c], v[8 * c + 1]); w.y = pk2(v[8 * c + 2], v[8 * c + 3]); w.z = pk2(v[8 * c + 4], v[8 * c + 5]); w.w = pk2(v[8 * c + 6], v[8 * c + 7]);
        *(GAS v4u*)(orow + 8 * c) = w; }
}
#ifndef MK_IDLE_GEMV
#define MK_IDLE_GEMV 160
#endif
#ifndef MK_SPARE_GEMV
#define MK_SPARE_GEMV 128
#endif
constexpr int I_IN = (DM / 64) * (NP / 64), I_OUT = (DM / 64) * (DM / 64), I_UQ = (384 / 64) * (NQ / 64), I_UKV = (256 / 64) * (NKV / 64), I_L = I_IN + I_OUT + I_UQ + I_UKV;
__device__ __forceinline__ void p0_transposes(Frame& F, int gw, int NGW, int lo, int hi) {
    for (int it = lo + gw; it < hi; it += NGW) {
        const int l = it / I_L; int r = it % I_L;
        if (r < I_IN) { p0_transpose_item<1, false>(ld_in(6) + (size_t)l * DM * IN_DIM, DM, IN_DIM, WSP(bf16, WS_WIN) + (size_t)l * NP * DM, nullptr, r, NP / 64, F.lane); continue; } r -= I_IN;
        if (r < I_OUT) { p0_transpose_item<0, true>(ld_in(19) + (size_t)l * DM * DM, DM, DM, WSP(bf16, WS_WOUT) + (size_t)l * DM * DM, nullptr, r, DM / 64, F.lane); continue; } r -= I_OUT;
        if (r < I_UQ) { p0_transpose_item<2, false>(ld_in(14) + (size_t)l * 384 * 1152, 384, 1152, WSP(bf16, WS_WUQ) + (size_t)l * NQ * 384, ld_in(12) + l * 384, r, NQ / 64, F.lane); continue; } r -= I_UQ;
        p0_transpose_item<0, false>(ld_in(15) + (size_t)l * 256 * 1536, 256, 1536, WSP(bf16, WS_WUKV) + (size_t)l * NKV * 256, ld_in(13) + l * 256, r, NKV / 64, F.lane);
    }
}
__device__ __forceinline__ void p0_prologue(Frame& F, size_t mods_off, bool defer, unsigned* mods_done) {
    p0_mods(F, mods_off, (int)blockIdx.x, F.G, 0, defer ? 768 - MK_IDLE_GEMV - MK_SPARE_GEMV : 768);
    if (mods_done) { asm volatile("s_waitcnt vmcnt(0)" ::: "memory"); __syncthreads(); if (F.tid == 0) (void)__hip_atomic_fetch_add(mods_done, 1u, __ATOMIC_RELAXED, __HIP_MEMORY_SCOPE_AGENT); }
    p0_transposes(F, F.vcu * NWAVES + F.wave, F.G * NWAVES, 0, DEPTH * I_L);
    const int* pos = (const int*)ld_in(2);
    for (int i = (int)blockIdx.x * NTHR + F.tid; i < T * 32; i += F.G * NTHR) {
        const int t = i >> 5, f = i & 31;
        const float inv = (float)exp2(-(double)f * (13.287712379549449 / 32.0));
        const float ang = (float)pos[t] * inv;
        const double rev = (double)ang * 0.15915494309189535; const float fr = (float)(rev - floor(rev));
        WSP(float, WS_CS)[i] = __builtin_amdgcn_cosf(fr); WSP(float, WS_SN)[i] = __builtin_amdgcn_sinf(fr);
    }
}
__device__ __forceinline__ void p0_deferred(Frame& F, size_t mods_off, int s, int ns) {
    p0_mods(F, mods_off, s, ns, 384, 768);
    p0_transposes(F, s * NWAVES + F.wave, ns * NWAVES, I_L, DEPTH * I_L);
}
__device__ __forceinline__ void modnorm_rows(Frame& F, const float* x, const float* g, const float* mods_l, bf16* H) {
    const int gw = F.vcu * NWAVES + F.wave, NGW = F.G * NWAVES;
    for (int t0 = gw; t0 < T; t0 += 2 * NGW) {
        const int t1 = t0 + NGW; const bool two = t1 < T;
        const GAS f32x4* xr0 = (const GAS f32x4*)(x + (size_t)t0 * DM) + F.lane; const GAS f32x4* xr1 = (const GAS f32x4*)(x + (size_t)(two ? t1 : t0) * DM) + F.lane;
        f32x4 v0[8], v1[8]; float s0 = 0.f, s1 = 0.f;
#pragma unroll
        for (int j = 0; j < 8; ++j) { v0[j] = __builtin_nontemporal_load(xr0 + 64 * j); v1[j] = __builtin_nontemporal_load(xr1 + 64 * j); }
#pragma unroll
        for (int j = 0; j < 8; ++j) { s0 += (v0[j][0] * v0[j][0] + v0[j][1] * v0[j][1]) + (v0[j][2] * v0[j][2] + v0[j][3] * v0[j][3]); s1 += (v1[j][0] * v1[j][0] + v1[j][1] * v1[j][1]) + (v1[j][2] * v1[j][2] + v1[j][3] * v1[j][3]); }
        const float r0 = __builtin_amdgcn_rsqf(wave_sum(s0) * (1.f / DM) + EPS), r1 = __builtin_amdgcn_rsqf(wave_sum(s1) * (1.f / DM) + EPS);
        const float* sh0 = mods_l + (size_t)(t0 / SEQ) * 3 * DM; const float* sh1 = mods_l + (size_t)((two ? t1 : t0) / SEQ) * 3 * DM;
        GAS v2u* o0 = (GAS v2u*)(H + (size_t)t0 * DM) + F.lane; GAS v2u* o1 = (GAS v2u*)(H + (size_t)t1 * DM) + F.lane;
#pragma unroll
        for (int jh = 0; jh < 8; jh += 4) {
            f32x4 gg[4], sv0[4], hv0[4], sv1[4], hv1[4];
#pragma unroll
            for (int j = 0; j < 4; ++j) { const int col = (F.lane + 64 * (jh + j)) * 4; gg[j] = *(const GAS f32x4*)(g + col);
                sv0[j] = *(const GAS f32x4*)(sh0 + DM + col); hv0[j] = *(const GAS f32x4*)(sh0 + col); sv1[j] = *(const GAS f32x4*)(sh1 + DM + col); hv1[j] = *(const GAS f32x4*)(sh1 + col); }
            __builtin_amdgcn_sched_barrier(0);
#pragma unroll
            for (int j = 0; j < 4; ++j) {
                { const f32x4 r = v0[jh + j] * r0 * gg[j] * (sv0[j] + 1.f) + hv0[j]; v2u w; w.x = pk2(r[0], r[1]); w.y = pk2(r[2], r[3]); o0[64 * (jh + j)] = w; }
                if (two) { const f32x4 r = v1[jh + j] * r1 * gg[j] * (sv1[j] + 1.f) + hv1[j]; v2u w; w.x = pk2(r[0], r[1]); w.y = pk2(r[2], r[3]); o1[64 * (jh + j)] = w; } }
        }
    }
}
__device__ __forceinline__ void finalnorm_rows(Frame& F, float* x, const float* g) {
    const int gw = F.vcu * NWAVES + F.wave, NGW = F.G * NWAVES;
    for (int t = gw; t < T; t += NGW) {
        GAS f32x4* xr = (GAS f32x4*)(x + (size_t)t * DM) + F.lane;
        f32x4 v[8]; float s = 0.f;
#pragma unroll
        for (int j = 0; j < 8; ++j) { v[j] = xr[64 * j]; s += (v[j][0] * v[j][0] + v[j][1] * v[j][1]) + (v[j][2] * v[j][2] + v[j][3] * v[j][3]); }
        const float rstd = __builtin_amdgcn_rsqf(wave_sum(s) * (1.f / DM) + EPS);
#pragma unroll
        for (int j = 0; j < 8; ++j) { const f32x4 gg = *(const f32x4*)(g + (F.lane + 64 * j) * 4); xr[64 * j] = v[j] * rstd * gg; }
    }
}
#ifndef MK_CONV_DEAL
#define MK_CONV_DEAL 1
#endif
__device__ __forceinline__ void conv_rows(Frame& F, int l) {
    const int gw = F.vcu * NWAVES + F.wave, NGW = F.G * NWAVES;
    const bf16* P = WSP(bf16, WS_PROJ); bf16* Y = WSP(bf16, WS_HY);
    const float* cw = ld_in(17) + l * 3 * 512; const float* cg = ld_in(18) + l * 512;
    const int ch = F.lane * 8;
    float w0[8], w1[8], w2[8], g8[8];
#pragma unroll
    for (int e = 0; e < 8; ++e) { w0[e] = cw[ch + e]; w1[e] = cw[512 + ch + e]; w2[e] = cw[1024 + ch + e]; g8[e] = cg[ch + e]; }
    int g_lo, g_hi, g_st;
    if (MK_CONV_DEAL && F.G == 256) { const int w = (int)blockIdx.x; const int base = w < 96 ? 6 * w : (w < 192 ? 576 + 9 * (w - 96) : 1440 + 10 * (w - 192)), cnt = w < 96 ? 6 : (w < 192 ? 9 : 10);
        g_lo = base + F.wave; g_hi = base + cnt < T / 4 ? base + cnt : T / 4; g_st = NWAVES; }
    else { g_lo = gw; g_hi = T / 4; g_st = NGW; }
    for (int gi = g_lo; gi < g_hi; gi += g_st) { const int t0 = 4 * gi;
        const int s0 = t0 % SEQ; const bf16* p = P + (size_t)t0 * NP;
        v4u cc[6], cx[6], cbv[4], szv[4];
#pragma unroll
        for (int d = 0; d < 6; ++d) { const int ss = s0 + d - 1; const bool ok = ss >= 0 && ss < SEQ; const bf16* q = p + (long)(ok ? d - 1 : 0) * NP;
            cc[d] = *(const v4u*)(q + C_CC + ch); cx[d] = *(const v4u*)(q + C_CX + ch); }
#pragma unroll
        for (int j = 0; j < 4; ++j) { cbv[j] = *(const v4u*)(p + (size_t)j * NP + C_CB + ch); szv[j] = *(const v4u*)(p + (size_t)j * NP + C_Z + 1536 + ch); }
        float u[6][8];
#pragma unroll
        for (int d = 0; d < 6; ++d) { const int ss = s0 + d - 1; const bool ok = ss >= 0 && ss < SEQ; float a[8], b[8]; unpack8(cc[d], a); unpack8(cx[d], b);
#pragma unroll
            for (int e = 0; e < 8; ++e) u[d][e] = ok ? a[e] * b[e] : 0.f; }
#pragma unroll
        for (int j = 0; j < 4; ++j) { float cb[8], sz[8], pre[8]; unpack8(cbv[j], cb); unpack8(szv[j], sz); float ssq = 0.f;
#pragma unroll
            for (int e = 0; e < 8; ++e) { pre[e] = cb[e] * (u[j][e] * w0[e] + u[j + 1][e] * w1[e] + u[j + 2][e] * w2[e]); ssq += pre[e] * pre[e]; }
            const float rstd = __builtin_amdgcn_rsqf(wave_sum(ssq) * (1.f / 512.f) + EPS);
            float r[8];
#pragma unroll
            for (int e = 0; e < 8; ++e) r[e] = pre[e] * rstd * g8[e] * (MK_SILU_IN_EPI ? sz[e] : silu_fast(sz[e]));
            v4u w; w.x = pk2(r[0], r[1]); w.y = pk2(r[2], r[3]); w.z = pk2(r[4], r[5]); w.w = pk2(r[6], r[7]);
            *(v4u*)(Y + (size_t)(t0 + j) * DM + 1536 + ch) = w; }
    }
}
__device__ __forceinline__ void mlaout_rows(Frame& F, int l) {
    const int gw = F.vcu * NWAVES + F.wave, NGW = F.G * NWAVES;
    const bf16* P = WSP(bf16, WS_PROJ); bf16* Y = WSP(bf16, WS_HY); const float* O = WSP(float, WS_OMLA); const float* g = ld_in(16) + l * 768;
    for (int t = gw; t < T; t += NGW) {
        f32x4 v[3]; float s = 0.f;
#pragma unroll
        for (int j = 0; j < 3; ++j) { v[j] = *(const f32x4*)(O + (size_t)t * 768 + (F.lane + 64 * j) * 4); s += (v[j][0] * v[j][0] + v[j][1] * v[j][1]) + (v[j][2] * v[j][2] + v[j][3] * v[j][3]); }
        const float rstd = __builtin_amdgcn_rsqf(wave_sum(s) * (1.f / 768.f) + EPS);
#pragma unroll
        for (int j = 0; j < 3; ++j) { const int col = (F.lane + 64 * j) * 4; const f32x4 gg = *(const f32x4*)(g + col);
            const v2u zw = *(const v2u*)(P + (size_t)t * NP + C_Z + 768 + col);
            const f32x4 r = v[j] * rstd * gg; v2u w; w.x = pk2(r[0] * bflo(zw.x), r[1] * bfhi(zw.x)); w.y = pk2(r[2] * bflo(zw.y), r[3] * bfhi(zw.y));
            *(v2u*)(Y + (size_t)t * DM + col) = w; }
    }
}


template <int KS> __device__ __forceinline__ f32x16 tile_mm(const LAS bf16* A, const LAS bf16* Bt, int r, int hh, f32x16 acc) {
#pragma unroll
    for (int s = 0; s < KS; ++s) {
        const bf16x8 a = *(const LAS bf16x8*)(A + r * 72 + 16 * s + 8 * hh), b = *(const LAS bf16x8*)(Bt + r * 72 + 16 * s + 8 * hh);
        acc = __builtin_amdgcn_mfma_f32_32x32x16_bf16(a, b, acc, 0, 0, 0);
    }
    return acc;
}
__device__ __forceinline__ float logsig16(float a) { return (fminf(a, 0.f) - __logf(1.f + __expf(-fabsf(a)))) * (1.f / 16.f); }
__device__ __forceinline__ void gla_a_item(Frame& F, int l, int item) {
    const int h = item % 6, bn = item / 6, t0 = bn * 64;
    const int tid = F.tid, lane = F.lane, wave = F.wave;
    LAS unsigned char* L = F.lds;
    LAS bf16* QB = (LAS bf16*)(L);
    LAS bf16* KB = (LAS bf16*)(L + 9216);
    LAS bf16* Mm = (LAS bf16*)(L);
    LAS bf16* VT = (LAS bf16*)(L + 18432);
    LAS float* LR = (LAS float*)(L + 36864);
    LAS float* WG = (LAS float*)(L + 36864 + 8192);
    LAS float* BG = (LAS float*)(L + 36864 + 16384);
    LAS bf16* KDT = (LAS bf16*)(L + 36864);
    LAS float* LA = (LAS float*)(L + 55296);
    LAS float* SEGT = (LAS float*)(L + 88576);
    LAS bf16* QF = (LAS bf16*)(L + 90624);
    LAS bf16* KF = (LAS bf16*)(L + 90624 + 18432);
    const bf16* P = WSP(bf16, WS_PROJ) + (size_t)t0 * NP;
    LAS bf16* LRB = (LAS bf16*)(L + 36864);
    LAS bf16* WGT = (LAS bf16*)(L + 36864 + 5120);
    v4u gq_, gk_, gv0_, gv1_, glr_ = {0u, 0u, 0u, 0u}; float gw_[8] = {0.f, 0.f, 0.f, 0.f, 0.f, 0.f, 0.f, 0.f}, gb_ = 0.f;
    { const int r = tid >> 3, c8 = (tid & 7) * 8;
      gq_ = *(const GAS v4u*)(P + (size_t)r * NP + C_GQ + h * 64 + c8); gk_ = *(const GAS v4u*)(P + (size_t)r * NP + C_GK + h * 64 + c8); }
    { const int r = tid & 63, c8 = (tid >> 6) * 8;
      gv0_ = *(const GAS v4u*)(P + (size_t)r * NP + C_GV + h * 128 + c8); gv1_ = *(const GAS v4u*)(P + (size_t)r * NP + C_GV + h * 128 + c8 + 64); }
    if (tid < 256) { const int r = tid >> 2, c8 = (tid & 3) * 8; glr_ = *(const GAS v4u*)(P + (size_t)r * NP + C_LR + c8); }
    else { const int t2 = tid - 256, dir = t2 >> 7, dk = (t2 >> 1) & 63, half = t2 & 1; const float* wgf_ = ld_in(7); const float* wgb_ = ld_in(9);
        const float* wsrc = (dir ? wgb_ : wgf_) + (size_t)l * 16 * 384 + (size_t)(8 * half) * 384 + h * 64 + dk;
#pragma unroll
        for (int j = 0; j < 8; ++j) gw_[j] = wsrc[j * 384]; }
    if (tid < 128) { const int dir = tid >> 6, dk = tid & 63; const float* bgf_ = ld_in(8); const float* bgb_ = ld_in(10); gb_ = (dir ? bgb_ : bgf_)[l * 384 + h * 64 + dk]; }
    __builtin_amdgcn_sched_barrier(0);
    { const int r = tid >> 3, c8 = (tid & 7) * 8; *(LAS v4u*)(QB + r * 72 + c8) = gq_; *(LAS v4u*)(KB + r * 72 + c8) = gk_; }
#pragma unroll
    for (int i = 0; i < 2; ++i) { const int idx = tid + i * 512, r = idx & 63, c8 = (idx >> 6) * 8;
        const v4u raw = i ? gv1_ : gv0_;
        VT[(c8 + 0) * 72 + r] = (unsigned short)(raw.x & 0xffffu); VT[(c8 + 1) * 72 + r] = (unsigned short)(raw.x >> 16);
        VT[(c8 + 2) * 72 + r] = (unsigned short)(raw.y & 0xffffu); VT[(c8 + 3) * 72 + r] = (unsigned short)(raw.y >> 16);
        VT[(c8 + 4) * 72 + r] = (unsigned short)(raw.z & 0xffffu); VT[(c8 + 5) * 72 + r] = (unsigned short)(raw.z >> 16);
        VT[(c8 + 6) * 72 + r] = (unsigned short)(raw.w & 0xffffu); VT[(c8 + 7) * 72 + r] = (unsigned short)(raw.w >> 16); }
    if (tid < 256) { const int r = tid >> 2, c8 = (tid & 3) * 8; *(LAS v4u*)(LRB + r * 40 + c8) = glr_; }
    else { const int t2 = tid - 256, dir = t2 >> 7, dk = (t2 >> 1) & 63, half = t2 & 1;
        *(LAS v4u*)(WGT + (dir * 64 + dk) * 24 + half * 8) = (v4u){pk2(gw_[0], gw_[1]), pk2(gw_[2], gw_[3]), pk2(gw_[4], gw_[5]), pk2(gw_[6], gw_[7])}; }
    if (tid < 128) { const int dir = tid >> 6, dk = tid & 63; BG[dir * 64 + dk] = gb_; }
    LDS_WAIT(); __syncthreads();
    { const int r1 = lane & 31, h1 = lane >> 5, dir = wave >> 2, tb = (wave >> 1) & 1, db = wave & 1;
      const bf16x8 a = *(const LAS bf16x8*)(LRB + (tb * 32 + r1) * 40 + dir * 16 + 8 * h1), b2 = *(const LAS bf16x8*)(WGT + (dir * 64 + db * 32 + r1) * 24 + 8 * h1);
      f32x16 lg = {}; lg = __builtin_amdgcn_mfma_f32_32x32x16_bf16(a, b2, lg, 0, 0, 0);
      const float bs = BG[dir * 64 + db * 32 + r1];
#pragma unroll
      for (int reg = 0; reg < 16; ++reg) { const int tok = tb * 32 + (reg & 3) + 8 * (reg >> 2) + 4 * h1; LA[(dir * 64 + tok) * 65 + db * 32 + r1] = logsig16(lg[reg] + bs); } }
    LDS_WAIT(); __syncthreads();
    const int cdir = (tid >> 6) & 1, cdk = tid & 63, seg = tid >> 7;
    float pb[16];
#pragma unroll
    for (int i = 0; i < 16; ++i) pb[i] = LA[(cdir * 64 + seg * 16 + i) * 65 + cdk];
    if (cdir == 0) {
#pragma unroll
        for (int i = 1; i < 16; ++i) pb[i] += pb[i - 1];
    } else {
#pragma unroll
        for (int i = 14; i >= 0; --i) pb[i] += pb[i + 1];
    }
    SEGT[(cdir * 4 + seg) * 64 + cdk] = cdir == 0 ? pb[15] : pb[0];
    LDS_WAIT(); __syncthreads();
    { float offv = 0.f, tot = 0.f;
#pragma unroll
      for (int s2 = 0; s2 < 4; ++s2) { const float sv = SEGT[(cdir * 4 + s2) * 64 + cdk]; tot += sv; if (cdir == 0 ? (s2 < seg) : (s2 > seg)) offv += sv; }
      bf16* QD = WSP(bf16, WS_QDEC) + (size_t)cdir * T * 384 + (size_t)t0 * 384 + h * 64 + cdk;
      unsigned kd[8]; const float et = __expf(tot);
#pragma unroll
      for (int i = 0; i < 16; i += 2) { float kdf[2];
#pragma unroll
          for (int u = 0; u < 2; ++u) { const int tok = seg * 16 + i + u; const float bv = pb[i + u] + offv;
              const float q = bf2f(QB[tok * 72 + cdk]), k = bf2f(KB[tok * 72 + cdk]);
              const float e1 = __expf(bv), e2 = __builtin_amdgcn_rcpf(e1);
              const unsigned w = pk2(q * 0.125f * e1, k * e2);
              QF[(cdir * 64 + tok) * 72 + cdk] = (unsigned short)(w & 0xffffu); KF[(cdir * 64 + tok) * 72 + cdk] = (unsigned short)(w >> 16); QD[(size_t)tok * 384] = (unsigned short)(w & 0xffffu);
              kdf[u] = k * (et * e2); }
          kd[i >> 1] = pk2(kdf[0], kdf[1]);
          if ((i & 3) == 2) __builtin_amdgcn_sched_barrier(0); }
      *(LAS v4u*)(KDT + (cdir * 64 + cdk) * 72 + seg * 16) = (v4u){kd[0], kd[1], kd[2], kd[3]};
      *(LAS v4u*)(KDT + (cdir * 64 + cdk) * 72 + seg * 16 + 8) = (v4u){kd[4], kd[5], kd[6], kd[7]};
      if (seg == 0) WSP(float, WS_DECAY)[((size_t)item * 2 + cdir) * 64 + cdk] = et; }
    LDS_WAIT(); __syncthreads();
    const int r = lane & 31, hh = lane >> 5;
    if (wave < 4) {
        const int pb2 = wave >> 1, jb = wave & 1; f32x16 sf = {}, sb = {};
        if (pb2 >= jb) sf = tile_mm<4>(QF + (0 * 64 + pb2 * 32) * 72, KF + (0 * 64 + jb * 32) * 72, r, hh, sf);
        if (pb2 <= jb) sb = tile_mm<4>(QF + (1 * 64 + pb2 * 32) * 72, KF + (1 * 64 + jb * 32) * 72, r, hh, sb);
#pragma unroll
        for (int reg = 0; reg < 16; ++reg) { const int p = (reg & 3) + 8 * (reg >> 2) + 4 * hh; float v;
            if (pb2 > jb) v = sf[reg]; else if (pb2 < jb) v = sb[reg]; else v = (r <= p) ? sf[reg] : sb[reg];
            Mm[(pb2 * 32 + p) * 72 + jb * 32 + r] = (unsigned short)f2bf(v); }
    } else {
        const int dvb = wave - 4; bf16* KV = WSP(bf16, WS_KVC) + (size_t)item * 2 * 8192;
#pragma unroll
        for (int dir = 0; dir < 2; ++dir)
#pragma unroll
            for (int dkb = 0; dkb < 2; ++dkb) { f32x16 a = {}; a = tile_mm<4>(VT + (dvb * 32) * 72, KDT + (dir * 64 + dkb * 32) * 72, r, hh, a);
#pragma unroll
                for (int reg = 0; reg < 16; ++reg) { const int dv = dvb * 32 + (reg & 3) + 8 * (reg >> 2) + 4 * hh; KV[(size_t)dir * 8192 + dv * 64 + dkb * 32 + r] = (unsigned short)f2bf(a[reg]); } }
    }
    LDS_WAIT(); __syncthreads();
    { const int pb2 = wave >> 2, dvb = wave & 3; f32x16 a = {}; a = tile_mm<4>(Mm + (pb2 * 32) * 72, VT + (dvb * 32) * 72, r, hh, a);
      bf16* OI = WSP(bf16, WS_OINTRA) + (size_t)(t0 + pb2 * 32) * 768 + h * 128 + dvb * 32 + r;
#pragma unroll
      for (int reg = 0; reg < 16; ++reg) { const int p = (reg & 3) + 8 * (reg >> 2) + 4 * hh; OI[(size_t)p * 768] = (unsigned short)f2bf(a[reg]); } }
    __syncthreads();
}
#ifndef MK_SCAN_GS
#define MK_SCAN_GS 16
#endif
__device__ __forceinline__ void gla_scan_witem(Frame& F, int item) {
    const int slice = item & 31, dir = (item >> 5) & 1, bh = item >> 6, b = bh / 6, h = bh % 6;
    const int e = slice * 256 + F.lane * 4, dk = e & 63;
    const size_t it0 = (size_t)((b * 32 + (dir ? 31 : 0)) * 6 + h) * 2 + dir; const long stp = dir ? -12 : 12;
    const bf16* KV = WSP(bf16, WS_KVC) + it0 * 8192 + e; const float* DC = WSP(float, WS_DECAY) + it0 * 64 + dk; bf16* ST = WSP(bf16, WS_ST) + it0 * 8192 + e;
    f32x4 st = {0.f, 0.f, 0.f, 0.f};
#pragma unroll
    for (int g = 0; g < 32 / MK_SCAN_GS; ++g) {
        v2u kw[MK_SCAN_GS]; f32x4 dc[MK_SCAN_GS];
#pragma unroll
        for (int j = 0; j < MK_SCAN_GS; ++j) { const long o = (long)(g * MK_SCAN_GS + j) * stp; kw[j] = *(const GAS v2u*)(KV + o * 8192); dc[j] = *(const GAS f32x4*)(DC + o * 64); }
#pragma unroll
        for (int j = 0; j < MK_SCAN_GS; ++j) { const long o = (long)(g * MK_SCAN_GS + j) * stp;
            const f32x4 kv = {bflo(kw[j].x), bfhi(kw[j].x), bflo(kw[j].y), bfhi(kw[j].y)};
            v2u w; w.x = pk2(st[0], st[1]); w.y = pk2(st[2], st[3]); *(GAS v2u*)(ST + o * 8192) = w;
            st = dc[j] * st + kv; }
    }
}
#ifndef MK_GC_NB
#define MK_GC_NB 2
#endif
__device__ __forceinline__ void gla_c_task(Frame& F, int l, int task) {
    const int item = task >> 1, half = task & 1, h = item % 6, bn = item / 6, tk0 = bn * 64 + half * 32;
    const int r = F.lane & 31, hh = F.lane >> 5;
    const bf16* QD = WSP(bf16, WS_QDEC); const bf16* ST = WSP(bf16, WS_ST) + (size_t)item * 2 * 8192;
    bf16x8 af[2][4];
#pragma unroll
    for (int dir = 0; dir < 2; ++dir)
#pragma unroll
        for (int s = 0; s < 4; ++s) af[dir][s] = *(const bf16x8*)(QD + (size_t)dir * T * 384 + (size_t)(tk0 + r) * 384 + h * 64 + 16 * s + 8 * hh);
    LAS float* st = (LAS float*)(F.lds + F.wave * 16384);
    bf16x8 bq[MK_GC_NB][2][4];
#define GC_LOAD(i_, dvb_) do { _Pragma("unroll") for (int dir = 0; dir < 2; ++dir) _Pragma("unroll") for (int s = 0; s < 4; ++s) \
        bq[i_][dir][s] = *(const GAS bf16x8*)(ST + (size_t)dir * 8192 + ((dvb_) * 32 + r) * 64 + 16 * s + 8 * hh); } while (0)
#define GC_MMA(i_, dvb_) do { f32x16 acc = {}; _Pragma("unroll") for (int dir = 0; dir < 2; ++dir) _Pragma("unroll") for (int s = 0; s < 4; ++s) \
        acc = __builtin_amdgcn_mfma_f32_32x32x16_bf16(af[dir][s], bq[i_][dir][s], acc, 0, 0, 0); stage_write1(st, acc, dvb_, r, hh); } while (0)
#define GC_SB() __builtin_amdgcn_sched_barrier(0)
#if MK_GC_NB == 4
    GC_LOAD(0, 0); GC_LOAD(1, 1); GC_LOAD(2, 2); GC_LOAD(3, 3); GC_SB();
    GC_MMA(0, 0); GC_MMA(1, 1); GC_MMA(2, 2); GC_MMA(3, 3);
#elif MK_GC_NB == 3
    GC_LOAD(0, 0); GC_LOAD(1, 1); GC_LOAD(2, 2); GC_SB();
    GC_MMA(0, 0); GC_SB(); GC_LOAD(0, 3); GC_SB();
    GC_MMA(1, 1); GC_MMA(2, 2); GC_MMA(0, 3);
#else
    GC_LOAD(0, 0); GC_LOAD(1, 1); GC_SB();
    GC_MMA(0, 0); GC_SB(); GC_LOAD(0, 2); GC_SB();
    GC_MMA(1, 1); GC_SB(); GC_LOAD(1, 3); GC_SB();
    GC_MMA(0, 2); GC_MMA(1, 3);
#endif
#undef GC_LOAD
#undef GC_MMA
#undef GC_SB
    LDS_WAIT(); asm volatile("" ::: "memory");
    rows_finish<true>(st, F.lane, WSP(bf16, WS_OINTRA) + (size_t)tk0 * 768 + h * 128, ld_in(11) + l * 128, WSP(bf16, WS_PROJ) + (size_t)tk0 * NP + C_Z + h * 128, WSP(bf16, WS_HY) + (size_t)tk0 * DM + 768 + h * 128, nullptr);
    if (MK_FUSE_Y) { asm volatile("s_waitcnt vmcnt(0)" ::: "memory");
        if (F.lane == 0) (void)__hip_atomic_fetch_add((unsigned*)(F.ws + WS_CTL) + CW_YREADY + 2048 * (2 * l) + 64 * (tk0 >> 8), 1u, __ATOMIC_RELAXED, __HIP_MEMORY_SCOPE_AGENT); }
    LDS_WAIT(); asm volatile("" ::: "memory");
}

__device__ __forceinline__ void gla_c_round(Frame& F, int l, int base, int n) {
    const int wave = F.wave, lane = F.lane, r = lane & 31, hh = lane >> 5;
    const bool act = wave < n; const int task = base + wave, item = task >> 1, half = task & 1, h = item % 6, bn = item / 6, tk0 = bn * 64 + half * 32;
    LAS unsigned char* tile = F.lds + (wave >> 1) * 32768;
    bf16x8 af[2][4];
    if (act && task < 2 * NITEM) {
        const bf16* ST = WSP(bf16, WS_ST) + (size_t)item * 2 * 8192; const int lp = (wave & 1) * 64 + lane;
        v4u tv[16];
#pragma unroll
        for (int j = 0; j < 16; ++j) tv[j] = *(const v4u*)(ST + (size_t)(lp + 128 * j) * 8);
        const bf16* QD = WSP(bf16, WS_QDEC);
#pragma unroll
        for (int dir = 0; dir < 2; ++dir)
#pragma unroll
            for (int s = 0; s < 4; ++s) af[dir][s] = *(const bf16x8*)(QD + (size_t)dir * T * 384 + (size_t)(tk0 + r) * 384 + h * 64 + 16 * s + 8 * hh);
#pragma unroll
        for (int j = 0; j < 16; ++j) { const int q = lp + 128 * j, row = q >> 3, c = q & 7; *(LAS v4u*)(tile + row * 128 + ((c ^ (row & 7)) << 4)) = tv[j]; }
    }
    LDS_WAIT(); __syncthreads();
    f32x16 acc[4];
    if (act && task < 2 * NITEM) {
#pragma unroll
        for (int dvb = 0; dvb < 4; ++dvb) { acc[dvb] = f32x16{}; const int row = dvb * 32 + r;
#pragma unroll
            for (int dir = 0; dir < 2; ++dir)
#pragma unroll
                for (int s = 0; s < 4; ++s) { const bf16x8 bfr = *(const LAS bf16x8*)(tile + dir * 16384 + row * 128 + (((2 * s + hh) ^ (row & 7)) << 4));
                    acc[dvb] = __builtin_amdgcn_mfma_f32_32x32x16_bf16(af[dir][s], bfr, acc[dvb], 0, 0, 0); } }
    }
    LDS_WAIT(); __syncthreads();
    if (act && task < 2 * NITEM) {
        LAS float* st = (LAS float*)(F.lds + wave * 16384);
        stage_write(st, acc, r, hh);
        LDS_WAIT(); asm volatile("" ::: "memory");
        rows_finish<true>(st, lane, WSP(bf16, WS_OINTRA) + (size_t)tk0 * 768 + h * 128, ld_in(11) + l * 128, WSP(bf16, WS_PROJ) + (size_t)tk0 * NP + C_Z + h * 128, WSP(bf16, WS_HY) + (size_t)tk0 * DM + 768 + h * 128, nullptr);
    }
    LDS_WAIT(); __syncthreads();
}

__device__ __forceinline__ void gla_seq_wg(Frame& F, int l, int bh, int dir) {
    const int b = bh / 6, h = bh % 6, tid = F.tid, lane = F.lane, wave = F.wave, r = lane & 31, hh = lane >> 5;
    LAS unsigned char* L = F.lds;
    LAS bf16* QB = (LAS bf16*)(L);
    LAS bf16* KB = (LAS bf16*)(L + 9216);
    LAS bf16* VT = (LAS bf16*)(L + 18432);
    LAS bf16* QF = (LAS bf16*)(L + 36864);
    LAS bf16* KF = (LAS bf16*)(L + 46080);
    LAS bf16* KDT = (LAS bf16*)(L + 55296);
    LAS bf16* MM = (LAS bf16*)(L + 64512);
    LAS bf16* STT = (LAS bf16*)(L + 73728);
    LAS float* LR = (LAS float*)(L + 92160);
    LAS float* SEGT = (LAS float*)(L + 96256);
    LAS float* DEC = (LAS float*)(L + 98304);
    const bf16* P = WSP(bf16, WS_PROJ) + (size_t)b * SEQ * NP;
    bf16* OD = WSP(bf16, dir ? WS_OINTRA : WS_OMLA) + (size_t)b * SEQ * 768 + h * 128;
    float wgt[16]; { const float* wg = ld_in(dir ? 9 : 7) + (size_t)l * 16 * 384 + h * 64 + lane;
#pragma unroll
        for (int q = 0; q < 16; ++q) wgt[q] = wg[q * 384]; }
    const float bias = ld_in(dir ? 10 : 8)[l * 384 + h * 64 + lane];
    for (int i = tid; i < (73728 + 18432 - 64512) / 4; i += NTHR) ((LAS unsigned*)(L + 64512))[i] = 0u;
    f32x16 sacc = {};
    const int tokb = wave >> 2, dvb = wave & 3;
    v4u pq, pk, pv0, pv1, plr;
    const int qrow = tid >> 3, qc8 = (tid & 7) * 8, vtok = tid & 63, vcb = tid >> 6;
#define GS_PREFETCH(n_) do { const bf16* pc = P + (size_t)((n_) * 64) * NP; \
        pq = *(const v4u*)(pc + (size_t)qrow * NP + C_GQ + h * 64 + qc8); pk = *(const v4u*)(pc + (size_t)qrow * NP + C_GK + h * 64 + qc8); \
        pv0 = *(const v4u*)(pc + (size_t)vtok * NP + C_GV + h * 128 + vcb * 8); pv1 = *(const v4u*)(pc + (size_t)vtok * NP + C_GV + h * 128 + (vcb + 8) * 8); \
        if (tid < 128) plr = *(const v4u*)(pc + (size_t)(tid >> 1) * NP + C_LR + dir * 16 + (tid & 1) * 8); } while (0)
    GS_PREFETCH(dir ? 31 : 0);
    __syncthreads();
#pragma unroll 1
    for (int s = 0; s < 32; ++s) {
        const int n = dir ? 31 - s : s;
#ifdef GS_NOPREFETCH
        GS_PREFETCH(n);
#endif
        *(LAS v4u*)(QB + qrow * 72 + qc8) = pq; *(LAS v4u*)(KB + qrow * 72 + qc8) = pk;
        { const unsigned w0[4] = {pv0.x, pv0.y, pv0.z, pv0.w}, w1[4] = {pv1.x, pv1.y, pv1.z, pv1.w};
#pragma unroll
          for (int e = 0; e < 4; ++e) { VT[(vcb * 8 + 2 * e) * 72 + vtok] = (unsigned short)(w0[e] & 0xffffu); VT[(vcb * 8 + 2 * e + 1) * 72 + vtok] = (unsigned short)(w0[e] >> 16);
              VT[((vcb + 8) * 8 + 2 * e) * 72 + vtok] = (unsigned short)(w1[e] & 0xffffu); VT[((vcb + 8) * 8 + 2 * e + 1) * 72 + vtok] = (unsigned short)(w1[e] >> 16); } }
        if (tid < 128) { float f[8]; unpack8(plr, f);
#pragma unroll
            for (int e = 0; e < 8; ++e) LR[(tid >> 1) * 16 + (tid & 1) * 8 + e] = f[e]; }
#ifndef GS_NOPREFETCH
        if (s + 1 < 32) GS_PREFETCH(dir ? 30 - s : s + 1);
#endif
        LDS_WAIT(); __syncthreads();
        float pb8[8];
#pragma unroll
        for (int i = 0; i < 8; ++i) { const LAS float* lr = LR + (wave * 8 + i) * 16; float a = bias;
#pragma unroll
            for (int q = 0; q < 16; ++q) a += lr[q] * wgt[q];
            pb8[i] = logsig16(a); }
        if (dir == 0) {
#pragma unroll
            for (int i = 1; i < 8; ++i) pb8[i] += pb8[i - 1];
        } else {
#pragma unroll
            for (int i = 6; i >= 0; --i) pb8[i] += pb8[i + 1];
        }
        SEGT[wave * 64 + lane] = dir == 0 ? pb8[7] : pb8[0];
        LDS_WAIT(); __syncthreads();
        { float offv = 0.f, tot = 0.f;
#pragma unroll
          for (int s2 = 0; s2 < 8; ++s2) { const float sv = SEGT[s2 * 64 + lane]; tot += sv; if (dir == 0 ? (s2 < wave) : (s2 > wave)) offv += sv; }
          unsigned kd[4];
#pragma unroll
          for (int i = 0; i < 8; ++i) { const int tok = wave * 8 + i; const float bv = pb8[i] + offv;
              const float q = bf2f(QB[tok * 72 + lane]), k = bf2f(KB[tok * 72 + lane]);
              QF[tok * 72 + lane] = (unsigned short)f2bf(q * 0.125f * __expf(bv)); KF[tok * 72 + lane] = (unsigned short)f2bf(k * __expf(-bv));
              const unsigned kdv = f2bf(k * __expf(tot - bv)); if (i & 1) kd[i >> 1] |= kdv << 16; else kd[i >> 1] = kdv; }
          *(LAS v4u*)(KDT + lane * 72 + wave * 8) = (v4u){kd[0], kd[1], kd[2], kd[3]};
          if (wave == 0) DEC[lane] = __expf(tot); }
        LDS_WAIT(); __syncthreads();
        f32x16 oacc = {};
        oacc = tile_mm<4>(QF + tokb * 32 * 72, STT + dvb * 32 * 72, r, hh, oacc);
        if (wave < 3) { const int pb2 = dir == 0 ? (wave + 1) >> 1 : wave >> 1, jb = dir == 0 ? wave >> 1 : (wave + 1) >> 1;
            f32x16 sc = {}; sc = tile_mm<4>(QF + pb2 * 32 * 72, KF + jb * 32 * 72, r, hh, sc);
#pragma unroll
            for (int reg = 0; reg < 16; ++reg) { const int p = (reg & 3) + 8 * (reg >> 2) + 4 * hh; float v = sc[reg];
                if (pb2 == jb) v = (dir == 0 ? (r <= p) : (r > p)) ? v : 0.f;
                MM[(pb2 * 32 + p) * 72 + jb * 32 + r] = (unsigned short)f2bf(v); } }
        LDS_WAIT(); __syncthreads();
        oacc = tile_mm<4>(MM + tokb * 32 * 72, VT + dvb * 32 * 72, r, hh, oacc);
        { bf16* o = OD + (size_t)(n * 64 + tokb * 32) * 768 + dvb * 32 + r;
#pragma unroll
          for (int reg = 0; reg < 16; ++reg) { const int p = (reg & 3) + 8 * (reg >> 2) + 4 * hh; o[(size_t)p * 768] = (unsigned short)f2bf(oacc[reg]); } }
#pragma unroll
        for (int g4 = 0; g4 < 4; ++g4) { const f32x4 dc = *(const LAS f32x4*)(DEC + tokb * 32 + 8 * g4 + 4 * hh);
#pragma unroll
            for (int e = 0; e < 4; ++e) sacc[4 * g4 + e] *= dc[e]; }
        sacc = tile_mm<4>(KDT + tokb * 32 * 72, VT + dvb * 32 * 72, r, hh, sacc);
#pragma unroll
        for (int g4 = 0; g4 < 4; ++g4) { v2u w; w.x = pk2(sacc[4 * g4], sacc[4 * g4 + 1]); w.y = pk2(sacc[4 * g4 + 2], sacc[4 * g4 + 3]);
            *(LAS v2u*)(STT + (dvb * 32 + r) * 72 + tokb * 32 + 8 * g4 + 4 * hh) = w; }
        LDS_WAIT(); __syncthreads();
    }
#undef GS_PREFETCH
}
__device__ __forceinline__ void gla_comb_rows(Frame& F, int l) {
    const int gw = F.vcu * NWAVES + F.wave, NGW = F.G * NWAVES, sub = F.lane >> 4, c8 = (F.lane & 15) * 8;
    const bf16* OF = WSP(bf16, WS_OMLA); const bf16* OB = WSP(bf16, WS_OINTRA); const bf16* P = WSP(bf16, WS_PROJ); bf16* Y = WSP(bf16, WS_HY);
    const float* g = ld_in(11) + l * 128 + c8; const f32x4 g0 = *(const f32x4*)g, g1 = *(const f32x4*)(g + 4); const float gg[8] = {g0[0], g0[1], g0[2], g0[3], g1[0], g1[1], g1[2], g1[3]};
    for (int it = gw; it < T * 6 / 4; it += NGW) { const int pair = it * 4 + sub, t = pair / 6, h = pair % 6; const size_t o = (size_t)t * 768 + h * 128 + c8;
        float a[8], b2[8], z[8]; unpack8(*(const v4u*)(OF + o), a); unpack8(*(const v4u*)(OB + o), b2); unpack8(*(const v4u*)(P + (size_t)t * NP + C_Z + h * 128 + c8), z);
        float ss = 0.f;
#pragma unroll
        for (int e = 0; e < 8; ++e) { a[e] += b2[e]; ss += a[e] * a[e]; }
        ss += __shfl_xor(ss, 1); ss += __shfl_xor(ss, 2); ss += __shfl_xor(ss, 4); ss += __shfl_xor(ss, 8);
        const float rstd = __builtin_amdgcn_rsqf(ss * (1.f / 128.f) + EPS);
        v4u w; w.x = pk2(a[0] * rstd * gg[0] * z[0], a[1] * rstd * gg[1] * z[1]); w.y = pk2(a[2] * rstd * gg[2] * z[2], a[3] * rstd * gg[3] * z[3]);
        w.z = pk2(a[4] * rstd * gg[4] * z[4], a[5] * rstd * gg[5] * z[5]); w.w = pk2(a[6] * rstd * gg[6] * z[6], a[7] * rstd * gg[7] * z[7]);
        *(v4u*)(Y + (size_t)t * DM + 768 + h * 128 + c8) = w; }
}
#define XB_TMO      128
#define XB_XCNT(j)  (256  + 64 * (j))
#define XB_XSUB(j)  (1280 + 64 * (j))
#define XB_XGEN(j)  (2304 + 64 * (j))
#define XB_TOP      3328
#define XB_TOPGEN   3392
#define XCD_BAR_WORDS 3456
#define XB_SPIN_CAP (1u << 18)
__device__ __forceinline__ unsigned xb_ld(unsigned* p)              { return __hip_atomic_load(p, __ATOMIC_RELAXED, __HIP_MEMORY_SCOPE_AGENT); }
__device__ __forceinline__ unsigned xb_add(unsigned* p, unsigned v) { return __hip_atomic_fetch_add(p, v, __ATOMIC_RELAXED, __HIP_MEMORY_SCOPE_AGENT); }
__device__ __forceinline__ unsigned xb_xcc_id() { return (unsigned)__builtin_amdgcn_s_getreg((3 << 11) | 20) & 0xFu; }
#define XB_SPIN(cond, bar) do { unsigned _sp = 0; while (cond) { __builtin_amdgcn_s_sleep(1); \
    if ((++_sp & 255u) == 0u) { if (xb_ld(&(bar)[XB_TMO])) break; if (_sp > XB_SPIN_CAP) { atomicAdd(&(bar)[XB_TMO], 1u); break; } } } } while (0)
struct XcdBarrier { unsigned* bar; unsigned x; volatile LAS unsigned* st; };
__device__ __forceinline__ XcdBarrier xcd_barrier_post(unsigned* bar, volatile LAS unsigned* st) {
    XcdBarrier b; b.bar = bar; b.x = xb_xcc_id(); b.st = st;
    if (threadIdx.x == 0) (void)xb_add(&bar[XB_XCNT(b.x)], 1u);
    return b;
}
__device__ __forceinline__ void xcd_barrier_complete(unsigned* bar, unsigned x, unsigned& nloc, unsigned& nx) {
    const unsigned G = gridDim.x * gridDim.y * gridDim.z;
    unsigned sum, cnt, mine, sp = 0u;
    for (;;) {
        sum = 0u; cnt = 0u; mine = 0u;
        unsigned c_[16]; { const GAS unsigned* p_ = (const GAS unsigned*)&bar[XB_XCNT(0)];
            asm volatile("global_load_dword %0, %16, off sc1\n\tglobal_load_dword %1, %16, off offset:256 sc1\n\tglobal_load_dword %2, %16, off offset:512 sc1\n\tglobal_load_dword %3, %16, off offset:768 sc1\n\t"
                         "global_load_dword %4, %16, off offset:1024 sc1\n\tglobal_load_dword %5, %16, off offset:1280 sc1\n\tglobal_load_dword %6, %16, off offset:1536 sc1\n\tglobal_load_dword %7, %16, off offset:1792 sc1\n\t"
                         "global_load_dword %8, %16, off offset:2048 sc1\n\tglobal_load_dword %9, %16, off offset:2304 sc1\n\tglobal_load_dword %10, %16, off offset:2560 sc1\n\tglobal_load_dword %11, %16, off offset:2816 sc1\n\t"
                         "global_load_dword %12, %16, off offset:3072 sc1\n\tglobal_load_dword %13, %16, off offset:3328 sc1\n\tglobal_load_dword %14, %16, off offset:3584 sc1\n\tglobal_load_dword %15, %16, off offset:3840 sc1\n\ts_waitcnt vmcnt(0)"
                         : "=&v"(c_[0]), "=&v"(c_[1]), "=&v"(c_[2]), "=&v"(c_[3]), "=&v"(c_[4]), "=&v"(c_[5]), "=&v"(c_[6]), "=&v"(c_[7]), "=&v"(c_[8]), "=&v"(c_[9]), "=&v"(c_[10]), "=&v"(c_[11]), "=&v"(c_[12]), "=&v"(c_[13]), "=&v"(c_[14]), "=&v"(c_[15])
                         : "v"(p_) : "memory"); }
#pragma unroll
        for (unsigned j = 0; j < 16; ++j) { const unsigned c = c_[j]; sum += c; cnt += (c > 0u) ? 1u : 0u; mine = (j == x) ? c : mine; }
        if (sum == G) break;
        __builtin_amdgcn_s_sleep(1);
        if ((++sp & 255u) == 0u) { if (xb_ld(&bar[XB_TMO])) break; if (sp > XB_SPIN_CAP) { atomicAdd(&bar[XB_TMO], 1u); break; } }
    }
    nloc = mine > 0u ? mine : 1u; nx = cnt > 0u ? cnt : 1u;
}
__device__ __forceinline__ void xcd_barrier(const XcdBarrier& b) {
    asm volatile("s_waitcnt vmcnt(0)" ::: "memory");
    __syncthreads();
    if (threadIdx.x == 0) {
        unsigned* bar = b.bar;
        __builtin_amdgcn_s_waitcnt(0);
        unsigned nloc = b.st[0], nx = b.st[1];
        if (nloc == 0u) { xcd_barrier_complete(bar, b.x, nloc, nx); b.st[0] = nloc; b.st[1] = nx; }
        const unsigned old = xb_add(&bar[XB_XSUB(b.x)], 1u);
        const unsigned gen = old / nloc;
        if (old + 1u == (gen + 1u) * nloc) {
            __builtin_amdgcn_fence(__ATOMIC_RELEASE, "agent");
            asm volatile("s_waitcnt vmcnt(0)" ::: "memory");
            const unsigned og = xb_add(&bar[XB_TOP], 1u);
            const unsigned tg = og / nx;
            if (og + 1u == (tg + 1u) * nx) xb_add(&bar[XB_TOPGEN], 1u);
            else XB_SPIN(xb_ld(&bar[XB_TOPGEN]) == tg, bar);
            __builtin_amdgcn_fence(__ATOMIC_ACQUIRE, "agent");
            xb_add(&bar[XB_XGEN(b.x)], 1u);
            asm volatile("s_waitcnt vmcnt(0)" ::: "memory");
        } else {
            XB_SPIN(xb_ld(&bar[XB_XGEN(b.x)]) == gen, bar);
            __builtin_amdgcn_fence(__ATOMIC_ACQUIRE, "agent");
            asm volatile("s_waitcnt vmcnt(0)" ::: "memory");
        }
    }
    __syncthreads();
}

__device__ __forceinline__ void sub_barrier(unsigned* cnt, unsigned target) {
    asm volatile("s_waitcnt vmcnt(0)" ::: "memory");
    __syncthreads();
    if (threadIdx.x == 0) {
        __builtin_amdgcn_fence(__ATOMIC_RELEASE, "agent");
        asm volatile("s_waitcnt vmcnt(0)" ::: "memory");
        (void)xb_add(cnt, 1u);
        unsigned sp = 0u; while (xb_ld(cnt) < target) { __builtin_amdgcn_s_sleep(2); if (++sp > (1u << 22)) break; }
        __builtin_amdgcn_fence(__ATOMIC_ACQUIRE, "agent");
        asm volatile("s_waitcnt vmcnt(0)" ::: "memory");
    }
    __syncthreads();
}

__device__ __forceinline__ unsigned wg_fetch(unsigned* cnt, unsigned n, volatile LAS unsigned* slot) {
    __syncthreads();
    if (threadIdx.x == 0) *slot = xb_add(cnt, n);
    __syncthreads();
    return *slot;
}
__device__ __forceinline__ void wait_counter(unsigned* cnt, unsigned target) {
    if (threadIdx.x == 0) { unsigned sp = 0u; while (xb_ld(cnt) < target) { __builtin_amdgcn_s_sleep(2); if (++sp > (1u << 22)) break; }
        __builtin_amdgcn_fence(__ATOMIC_ACQUIRE, "agent"); asm volatile("s_waitcnt vmcnt(0)" ::: "memory"); }
    __syncthreads();
}

#ifndef MK_MAIN_HELP
#define MK_MAIN_HELP 0
#endif
#ifndef MK_NT_TAIL
#define MK_NT_TAIL 0
#endif
#ifndef MK_LATE_FETCH
#define MK_LATE_FETCH 2u
#endif
struct Args { const float* in[21]; float* out; unsigned char* ws; int ph_lo, ph_hi; };
constexpr int N_PHASES = 2 + 6 * DEPTH;
__global__ void __launch_bounds__(NTHR, 2) mega_fwd(Args args) {
    extern __shared__ __attribute__((aligned(16))) unsigned char lds[];
    Frame F;
    F.lds = (LAS unsigned char*)lds; F.ldsg = (char*)lds;
    F.tid = threadIdx.x; F.lane = F.tid & 63; F.wave = __builtin_amdgcn_readfirstlane(F.tid >> 6);
    F.G = gridDim.x; { const int bx = blockIdx.x; F.vcu = (F.G % 8 == 0) ? (bx % 8) * (F.G / 8) + bx / 8 : bx; }
    F.out = args.out; F.ws = args.ws;
    volatile LAS unsigned* MISC = (volatile LAS unsigned*)(F.lds + MISC_OFF);
    for (int u = F.tid; u < (LDS_BYTES - LDSCTL_OFF) / 4; u += NTHR) ((LAS unsigned*)(F.lds + LDSCTL_OFF))[u] = 0u;
    __syncthreads();
    XcdBarrier bar = xcd_barrier_post((unsigned*)(F.ws + WS_CTL) + CW_BAR, MISC + 8);
    const int lo = args.ph_lo, hi = args.ph_hi; int nstamp = 0;
#ifndef MK_MASK
#define MK_MASK 0xFF
#endif
#define PHON(b) ((MK_MASK >> (b)) & 1)
#ifndef MK_REP_PH
#define MK_REP_PH -1
#endif
#define REPS(ph) for (int rep_ = 0; rep_ < ((ph) == MK_REP_PH ? 2 : 1); ++rep_)
#define REPBAR() do { if (rep_ == 0 && false) {} } while (0)
#define IN(k) (lo <= (k) && (k) < hi)
#define FRESH() do { int t_ = threadIdx.x; asm volatile("" : "+v"(t_)); F.tid = t_; F.lane = t_ & 63; F.wave = __builtin_amdgcn_readfirstlane(t_ >> 6); GAS unsigned char* w_ = (GAS unsigned char*)args.ws; asm volatile("" : "+s"(w_)); F.ws = (unsigned char*)w_; GAS float* o_ = (GAS float*)args.out; asm volatile("" : "+s"(o_)); F.out = (float*)o_; } while (0)
#ifndef MK_DIAG_A
#define MK_DIAG_A -1
#define MK_DIAG_B -1
#endif
#define STAMP() do { if (MK_DIAG_A >= 0 && blockIdx.x == 0 && threadIdx.x == 0) { ((unsigned long long*)(args.ws + WS_CTL + 131072))[nstamp] = __builtin_amdgcn_s_memrealtime(); } ++nstamp; } while (0)
#define SEAM(k) do { if (IN(k) && IN((k) + 1)) { xcd_barrier(bar); STAMP(); } } while (0)
    STAMP();
#ifndef MK_FUSE_P0B
#define MK_FUSE_P0B 1
#endif
    { if (PHON(0) && IN(0)) { p0_prologue(F, WS_MODS, MK_IDLE_GEMV > 0 && F.G == 256, (MK_FUSE_P0B && IN(1)) ? (unsigned*)(F.ws + WS_CTL) + 32 : (unsigned*)nullptr); } if (!(MK_FUSE_P0B && IN(0) && IN(1))) SEAM(0); }
    REPS(101) { if (PHON(1) && IN(1)) {
        if (MK_FUSE_P0B && IN(0) && rep_ == 0) { FRESH(); wait_counter((unsigned*)(F.ws + WS_CTL) + 32, (unsigned)F.G); }
        modnorm_rows(F, ld_in(0), ld_in(5), WSP(float, WS_MODS), WSP(bf16, WS_HY)); } SEAM(1); }
#pragma unroll 1
    for (int l = 0; l < DEPTH; ++l) {
        const int pb = 2 + 6 * l;
#define mods_l (WSP(float, WS_MODS) + (size_t)l * BATCH * 3 * DM)
        REPS(0) { if (PHON(2) && IN(pb)) {
            FRESH();
            pg8::Gemm g{WSP(bf16, WS_HY), WSP(bf16, WS_WIN) + (size_t)l * NP * DM, T, NP, DM, DM}; pg8::StaticOrder S; S.init(T, NP, F.G, (int)blockIdx.x);
            EpiIn E{WSP(bf16, WS_PROJ), WSP(float, WS_CS), WSP(float, WS_SN), WSP(float, WS_PARTQ), WSP(float, WS_PARTKV)};
            pg8::gemm_phase<EpiIn, pg8::StaticOrder, true, true>(F.lds, g, S, E);
            if (MK_IDLE_GEMV > 0 && F.G == 256 && l == 0 && rep_ == 0 && (int)blockIdx.x >= 224) {
                __syncthreads(); FRESH(); p0_mods(F, WS_MODS, (int)blockIdx.x - 224, 32, 768 - MK_IDLE_GEMV, 768); }
        } SEAM(pb); }
        REPS(1) { if (PHON(3) && IN(pb + 1)) {
#ifndef MK_SUB
#define MK_SUB 0xFF
#endif
            for (int rr_ = 0; rr_ < (MK_REP_PH == 9 ? 2 : 1); ++rr_) {
            FRESH();
            if (MK_SUB & 1) { pg8::Gemm g{WSP(bf16, WS_PROJ) + C_MKV, WSP(bf16, WS_WUKV) + (size_t)l * NKV * 256, T, NKV, 256, NP}; pg8::StaticOrder S; S.init(T, NKV, F.G, (int)blockIdx.x);
              EpiUkv E{WSP(bf16, WS_KVUP), WSP(float, WS_PARTKV)};
              pg8::gemm_phase<EpiUkv, pg8::StaticOrder, true, true>(F.lds, g, S, E); }
            FRESH();
            if (MK_SUB & 2) { pg8::Gemm g{WSP(bf16, WS_PROJ) + C_MQ, WSP(bf16, WS_WUQ) + (size_t)l * NQ * 384, T, NQ, 384, NP}; pg8::StaticOrder S; S.init(T, NQ, F.G, ((int)blockIdx.x + 64) % F.G);
              EpiUq E{WSP(bf16, WS_QUP), WSP(float, WS_CS), WSP(float, WS_SN), WSP(float, WS_PARTQ)};
              pg8::gemm_phase<EpiUq, pg8::StaticOrder, true, true>(F.lds, g, S, E); }
            __syncthreads(); }
            FRESH();
            for (int rr_ = 0; rr_ < (MK_REP_PH == 10 ? 2 : 1); ++rr_)
            if (MK_SUB & 4) {
                const int w = (int)blockIdx.x;
#pragma unroll 1
                for (int j = 0; ; ++j) { int it;
                    if (F.G == 256) it = w < 96 ? (j < 2 ? 2 * w + j : NITEM) : 192 + (w - 96) + 160 * j; else it = w + j * F.G;
                    if (it >= NITEM) break; gla_a_item(F, l, it); }
            }
            FRESH(); conv_rows(F, l);
        } SEAM(pb + 1); }
        if (F.G <= 192) { REPS(7) { if (PHON(3) && IN(pb + 2)) {
            FRESH(); { const int gw = F.vcu * NWAVES + F.wave, NGW = F.G * NWAVES; for (int it = gw; it < 1536; it += NGW) gla_scan_witem(F, it); }
        } SEAM(pb + 2); } }
        REPS(2) { if (PHON(4) && IN(pb + 3)) {
            const int bx = (int)blockIdx.x; FRESH();
            const int natt = F.G > 192 ? 192 : F.G;
            const bool split = MK_NT_TAIL > 0 && F.G == 256, spare = F.G > 192 && bx >= 192;
            unsigned* scan_done = (unsigned*)(F.ws + WS_CTL) + 64 + 64 * (l * 2 + rep_); unsigned* queue = (unsigned*)(F.ws + WS_CTL) + 1024 + 64 * (l * 2 + rep_);
            if (spare) { const int gw = (bx - 192) * NWAVES + F.wave, NGW = (F.G - 192) * NWAVES;
                for (int rr_ = 0; rr_ < (MK_REP_PH == 21 ? 2 : 1); ++rr_)
                for (int it = gw; it < 1536; it += NGW) gla_scan_witem(F, it);
                sub_barrier(scan_done, (unsigned)(F.G - 192)); }
#pragma unroll 1
            for (int pass = 0; pass < 2; ++pass) {
                if (F.G > 192 && pass == (spare ? 0 : 1) && (spare || (!split && MK_MAIN_HELP))) {
                    if (!spare) wait_counter(scan_done, (unsigned)(F.G - 192));
                    FRESH();
                    const unsigned nf = spare ? (unsigned)NWAVES : MK_LATE_FETCH;
                    for (int rr_ = 0; rr_ < (MK_REP_PH == 22 ? 2 : 1); ++rr_)
                    for (;;) { const unsigned base = wg_fetch(queue + 32 * rr_, nf, MISC + 16); if (base >= 2u * NITEM) break;
                        const int task = (int)base + F.wave; if ((unsigned)F.wave < nf && task < 2 * NITEM) gla_c_task(F, l, task); }
                    if (MK_SPARE_GEMV > 0 && MK_IDLE_GEMV > 0 && F.G == 256 && l == 0 && rep_ == 0 && spare) {
                        FRESH(); p0_mods(F, WS_MODS, bx - 192, 64, 768 - MK_IDLE_GEMV - MK_SPARE_GEMV, 768 - MK_IDLE_GEMV);
                        if (MK_FUSE_Y) { asm volatile("s_waitcnt vmcnt(0)" ::: "memory"); __syncthreads();
                            if (F.tid < 32) (void)__hip_atomic_fetch_add((unsigned*)(F.ws + WS_CTL) + CW_YREADY + 2048 * (2 * l) + 64 * F.tid, 1u, __ATOMIC_RELAXED, __HIP_MEMORY_SCOPE_AGENT); } }
                }
                if (pass == 0) {
                    FRESH();
                    const int nun = spare ? (split ? 3 : 0) : (bx < natt ? (192 - bx + natt - 1) / natt : 0);
                    for (int rr_ = 0; rr_ < ((MK_REP_PH == 20 || (MK_REP_PH == 23 && spare) || (MK_REP_PH == 24 && !spare)) ? 2 : 1); ++rr_)
#pragma unroll 1
                    for (int i = 0; i < nun; ++i) { int u, mode, kt0, nt;
                        if (spare) { const int s_ = bx - 192; u = (s_ & 7) * 24 + 3 * (s_ >> 3) + i; mode = 2; kt0 = 32 - MK_NT_TAIL; nt = MK_NT_TAIL; }
                        else { const int u0 = bx + i * natt; u = (natt == 192) ? (u0 & 7) * 24 + (u0 >> 3) : u0; mode = split ? 1 : 0; kt0 = 0; nt = split ? 32 - MK_NT_TAIL : 32; }
                        const int bh = u >> 3, qb = u & 7, b = bh / 6, h = bh % 6; const size_t row0 = (size_t)b * SEQ, qrow = row0 + qb * 256, krow = row0 + (size_t)kt0 * 64;
                        mla::attn_unit(WSP(bf16, WS_QUP) + qrow * NQ + h * 192, WSP(bf16, WS_KVUP) + krow * NKV + h * 256, WSP(bf16, WS_KVUP) + krow * NKV + h * 256 + 128,
                                       WSP(bf16, WS_PROJ) + krow * NP + C_MKR, WSP(bf16, WS_HY) + qrow * DM + h * 128, WSP(bf16, WS_PROJ) + qrow * NP + C_Z + 768 + h * 128,
                                       ld_in(16) + l * 768 + h * 128, WSP(float, WS_CTL + WS_ROWSS) + (size_t)l * T + qrow, nt * 64, F.ldsg,
                                       mode | (u << 4) | ((l * 2 + rep_) << 12)); }
                }
            }
            if (F.G <= 192) { FRESH(); const int gw = F.vcu * NWAVES + F.wave, NGW = F.G * NWAVES; for (int task = gw; task < 2 * NITEM; task += NGW) gla_c_task(F, l, task); }
        } if (!(MK_FUSE_Y && F.G == 256 && MK_REP_PH != 4 && IN(pb + 3) && IN(pb + 4))) SEAM(pb + 3); }
        for (int rep_ = 0; rep_ < ((MK_REP_PH == 4 && l == 0) ? 2 : 1); ++rep_) { if (PHON(6) && IN(pb + 4)) {
            FRESH();
            pg8::Gemm g{WSP(bf16, WS_HY), WSP(bf16, WS_WOUT) + (size_t)l * DM * DM, T, DM, DM, DM}; pg8::StaticOrder S; S.init(T, DM, F.G, (int)blockIdx.x);
            if (MK_FUSE_Y && F.G == 256 && MK_REP_PH != 4 && IN(pb + 3)) {
                pg8::Unit u0; if (S.next(0, u0)) wait_counter((unsigned*)(F.ws + WS_CTL) + CW_YREADY + 2048 * (2 * l) + 64 * u0.pm, 96u + ((MK_SPARE_GEMV > 0 && MK_IDLE_GEMV > 0 && l == 0) ? 64u : 0u)); }
            if (F.G == 256 && MK_REP_PH != 4) {
                const int last = (l + 1 == DEPTH);
                EpiOutNorm E{ld_in(0), l == 0 ? (const bf16*)nullptr : WSP(bf16, WS_X1B), WSP(bf16, WS_X1B), F.out, mods_l + 2 * DM, WSP(float, WS_CTL + WS_ROWSS) + (size_t)l * T, WSP(bf16, WS_HY), last ? ld_in(20) : ld_in(5) + (l + 1) * DM,
                             mods_l + (size_t)BATCH * 3 * DM, WSP(float, WS_XS), (unsigned*)(F.ws + WS_CTL) + CW_PANEL + 64 * 32 * l, 32u, last};
                pg8::gemm_phase<EpiOutNorm, pg8::StaticOrder, true, true>(F.lds, g, S, E);
            } else {
                EpiOut E{l == 0 ? ld_in(0) : F.out, F.out, mods_l + 2 * DM, WSP(float, WS_CTL + WS_ROWSS) + (size_t)l * T};
                pg8::gemm_phase<EpiOut, pg8::StaticOrder, true, true>(F.lds, g, S, E);
            }
        } if (!(F.G == 256 && MK_REP_PH != 4 && l + 1 == DEPTH)) SEAM(pb + 4); }
        if (!(F.G == 256 && MK_REP_PH != 4)) {
        for (int rep_ = 0; rep_ < ((MK_REP_PH == 5 && l == 0) ? 2 : 1); ++rep_) { if (PHON(7) && IN(pb + 5)) {
            FRESH();
            if (l + 1 < DEPTH) modnorm_rows(F, F.out, ld_in(5) + (l + 1) * DM, mods_l + (size_t)BATCH * 3 * DM, WSP(bf16, WS_HY));
            else finalnorm_rows(F, F.out, ld_in(20));
        } SEAM(pb + 5); }
        }
        if (MK_REP_PH == 6) { for (int r_ = 0; r_ < 4; ++r_) xcd_barrier(bar); }
    }
    if (MK_DIAG_A >= 0) {
        xcd_barrier(bar); STAMP();
        if (blockIdx.x == 0) { const unsigned long long* ts = (const unsigned long long*)(args.ws + WS_CTL + 131072);
            const float da = (float)(ts[MK_DIAG_A + 1] - ts[MK_DIAG_A]) * 0.01f, db = (float)(ts[MK_DIAG_B + 1] - ts[MK_DIAG_B]) * 0.01f;
            for (int i = threadIdx.x; i < 65536; i += NTHR) args.out[i] += db;
            if (threadIdx.x == 0) args.out[8000000] += 10.f * da; }
    }
#undef mods_l
#undef IN
#undef SEAM
}

#ifndef MK_CUT
#define MK_CUT 14
#endif
#if MK_CUT < 14 || defined(MK_DBG_GLA)
__global__ void glue_proj(const bf16* P, float* proj, float* y, int row0) {
    const int t = blockIdx.x; const bf16* p = P + (size_t)(row0 + t) * NP;
    for (int c = threadIdx.x; c < NP; c += 256) { const float v = bf2f(p[c]);
        if (c < C_MKV) proj[(size_t)t * nv::PW + c] = v;
        else if (c < C_MQ) proj[(size_t)t * nv::PW + nv::O_MKV + (c - C_MKV)] = v;
        else if (c < C_MKR) proj[(size_t)t * nv::PW + nv::O_MQ + (c - C_MQ)] = v;
        else if (c < C_LR) { const int j = c - C_MKR; proj[(size_t)t * nv::PW + nv::O_MKR + (j & 1) * 32 + (j >> 1)] = v; }
        else if (c < C_LR + 32) proj[(size_t)t * nv::PW + nv::O_LR + (c - C_LR)] = v;
        else if (c < C_CB) {}
        else if (c < C_Z) proj[(size_t)t * nv::PW + nv::O_CB + (c - C_CB)] = v;
        else y[(size_t)t * DM + (c - C_Z)] = v; }
}
__global__ void glue_qkv(const bf16* Q, const bf16* KV, float* qm, float* kv, int row0) {
    const int t = blockIdx.x;
    for (int c = threadIdx.x; c < 1152; c += 256) { const float v = bf2f(Q[(size_t)(row0 + t) * NQ + c]) * (1.f / QSCALE); const int h = c / 192, d = c % 192;
        if (d < 128) qm[(size_t)t * 1152 + c] = v; else { const int j = d - 128; qm[(size_t)t * 1152 + h * 192 + 128 + (j & 1) * 32 + (j >> 1)] = v; } }
    for (int c = threadIdx.x; c < 1536; c += 256) kv[(size_t)t * 1536 + c] = bf2f(KV[(size_t)(row0 + t) * NKV + c]);
}
__global__ void glue_y(const bf16* Y, float* y, int row0) {
    const int t = blockIdx.x; for (int c = threadIdx.x; c < DM; c += 256) { const int cr = c < 768 ? c + 768 : (c < 1536 ? c - 768 : c); y[(size_t)t * DM + cr] = bf2f(Y[(size_t)(row0 + t) * DM + c]); }
}
__global__ void glue_h(const bf16* H, float* h, int row0) {
    const int t = blockIdx.x; for (int c = threadIdx.x; c < DM; c += 256) h[(size_t)t * DM + c] = bf2f(H[(size_t)(row0 + t) * DM + c]);
}

#endif

#if defined(MK_DBG_GLA)
__global__ void dbg_cmp(const bf16* OF, const bf16* OB, const float* ref, int row0, int use_b, int cls, float* stat) {
    const int t = blockIdx.x; float mx = 0.f;
    const int bcls = cls / 10000; cls = cls % 10000; if (bcls && row0 / SEQ != bcls - 1) return;
    const int hcls = cls / 1000; cls = cls % 1000; const int ccls = cls / 100; cls = cls % 100;
    for (int c = threadIdx.x; c < 768; c += 256) { if (ccls && ((c & 127) >> 5) != ccls - 1) continue; if (hcls && (c >> 7) != hcls - 1) continue; float v = bf2f(OF[(size_t)(row0 + t) * 768 + c]); if (use_b) v += bf2f(OB[(size_t)(row0 + t) * 768 + c]);
        mx = fmaxf(mx, fabsf(v - ref[(size_t)t * 768 + c])); }
    const int pos = t & 63, chunk = t >> 6;
    bool in = true;
    if (cls == 1) in = (pos < 32); if (cls == 2) in = (pos >= 32); if (cls == 3) in = (chunk == 0); if (cls == 4) in = (chunk == 31); if (cls == 5) in = (chunk > 0 && chunk < 31);
    if (cls == 6) in = (pos == 0); if (cls == 7) in = (pos == 63); if (cls == 8) in = (chunk == 0 && pos < 32); if (cls == 9) in = (chunk == 0 && pos >= 32); if (cls == 10) in = (chunk == 0 && pos < 8); if (cls == 11) in = (chunk == 0 && pos >= 8 && pos < 16); if (cls == 12) in = (chunk == 0 && pos == 0); if (cls == 13) in = (chunk == 0 && pos == 1); if (cls == 99) in = false; if (cls == 14) in = (chunk > 0 && chunk < 31 && pos < 32); if (cls == 15) in = (chunk > 0 && chunk < 31 && pos >= 32); if (cls == 16) in = (chunk == 1);
    if (in) atomicMax((unsigned*)stat, __float_as_uint(mx));
}
__global__ void dbg_poison(float* out, const float* stat) {
    const float sa = __uint_as_float(__float_as_uint(stat[0]) & 0xFFF00000u), sb = __uint_as_float(__float_as_uint(stat[1]) & 0xFFF00000u);
    const int i = blockIdx.x * 256 + threadIdx.x; if (i < 65536) out[i] += 100.f * sb; if (i == 0) out[8000000] += 1000.f * sa;
}
#endif
#ifndef MK_NAIVE_BASE_MIB
#define MK_NAIVE_BASE_MIB 240
#endif
extern "C" void kernel_launch(void* const* d_in, const int* in_sizes, int n_in, void* d_out, int out_size, void* d_ws, size_t ws_size, hipStream_t stream) {
    static int grid = 0;
    if (grid == 0) {
        if (n_in != 21 || out_size != T * DM || in_sizes[0] != T * DM || ws_size < WS_END) { fprintf(stderr, "kernel_launch: unexpected shapes n_in %d out %d ws %zu\n", n_in, out_size, ws_size); grid = -1; return; }
        int dev = 0, cus = 0, per_cu = 0;
        if (hipGetDevice(&dev) != hipSuccess || hipDeviceGetAttribute(&cus, hipDeviceAttributeMultiprocessorCount, dev) != hipSuccess) { grid = -1; return; }
        if (hipFuncSetAttribute((const void*)mega_fwd, hipFuncAttributeMaxDynamicSharedMemorySize, LDS_BYTES) != hipSuccess) { fprintf(stderr, "kernel_launch: hipFuncSetAttribute failed\n"); grid = -1; return; }
        if (hipOccupancyMaxActiveBlocksPerMultiprocessor(&per_cu, (const void*)mega_fwd, NTHR, LDS_BYTES) != hipSuccess || per_cu < 1) { fprintf(stderr, "kernel_launch: occupancy query says %d blocks/CU\n", per_cu); grid = -1; (void)hipGetLastError(); return; }
        grid = cus;
    }
    if (grid < 0) return;
    (void)hipMemsetAsync((char*)d_ws + WS_CTL, 0, CTL_ZERO_BYTES, stream);
    Args a{};
    for (int i = 0; i < 21; ++i) a.in[i] = (const float*)d_in[i];
    a.out = (float*)d_out; a.ws = (unsigned char*)d_ws; a.ph_lo = 0; a.ph_hi = MK_CUT < N_PHASES ? MK_CUT : N_PHASES;
    hipLaunchKernelGGL(mega_fwd, dim3(grid), dim3(NTHR), LDS_BYTES, stream, a);
#if defined(MK_DBG_GLA)
    {   char* ws = (char*)d_ws; nv::Buf B = nv::carve(ws + (size_t)286 * MiB); float* stat = (float*)(ws + WS_CTL + 200 * 1024);
        const float* g7 = (const float*)d_in[7]; const float* g8 = (const float*)d_in[8]; const float* g9 = (const float*)d_in[9]; const float* g10 = (const float*)d_in[10];
        float* la_f = B.scr; float* la_b = la_f + (size_t)SEQ * 384; float* ogla = la_b + (size_t)SEQ * 384;
        const int l = MK_DBG_GLA;
        for (int b = 0; b < BATCH; ++b) { const int row0 = b * SEQ;
            glue_proj<<<SEQ, 256, 0, stream>>>((const bf16*)(ws + WS_PROJ), B.proj, B.y, row0);
            nv::k_gla_gate<<<SEQ, 384, 0, stream>>>(B.proj, nv::PW, nv::O_LR, g7 + l * 16 * 384, g8 + l * 384, la_f);
            nv::k_gla_gate<<<SEQ, 384, 0, stream>>>(B.proj, nv::PW, nv::O_LR + 16, g9 + l * 16 * 384, g10 + l * 384, la_b);
            nv::k_gla_seq<<<6, 128, 0, stream>>>(B.proj, nv::PW, la_f, la_b, ogla, 0);
            dbg_cmp<<<SEQ, 256, 0, stream>>>((const bf16*)(ws + WS_OMLA), (const bf16*)(ws + WS_OINTRA), ogla, row0, 0, MK_DBG_CLS_A, stat);
            nv::k_gla_seq<<<6, 128, 0, stream>>>(B.proj, nv::PW, la_f, la_b, ogla, 1);
            dbg_cmp<<<SEQ, 256, 0, stream>>>((const bf16*)(ws + WS_OMLA), (const bf16*)(ws + WS_OINTRA), ogla, row0, 1, MK_DBG_CLS_B, stat + 1); }
        dbg_poison<<<256, 256, 0, stream>>>((float*)d_out, stat);
    }
#endif
#if MK_CUT < 14
    {
        char* ws = (char*)d_ws; float* out = (float*)d_out; const float* x = (const float*)d_in[0];
        const float* mods = (const float*)(ws + WS_MODS); const float* cs = (const float*)(ws + WS_CS); const float* sn = (const float*)(ws + WS_SN);
        nv::Buf B = nv::carve(ws + (size_t)MK_NAIVE_BASE_MIB * MiB);
        const int l0 = (MK_CUT - 2) / 6, ph = (MK_CUT - 2) % 6;
        for (int l = l0; l < DEPTH; ++l)
            for (int b = 0; b < BATCH; ++b) {
                const int row0 = b * SEQ; int entry = 0; const float* xin = (l == 0 ? x : out) + (size_t)row0 * DM; float* xo = out + (size_t)row0 * DM;
                if (l == l0) {
                    if (ph >= 1 && ph <= 3) { glue_proj<<<SEQ, 256, 0, stream>>>((const bf16*)(ws + WS_PROJ), B.proj, B.y, row0); entry = 1; }
                    if (ph == 2) { glue_qkv<<<SEQ, 256, 0, stream>>>((const bf16*)(ws + WS_QUP), (const bf16*)(ws + WS_KVUP), nv::sc_qm(B), nv::sc_kv(B), row0); entry = 2; }
                    if (ph == 3) { hipMemcpyAsync(nv::sc_omla(B), ws + WS_OMLA + (size_t)row0 * 768 * 4, (size_t)SEQ * 768 * 4, hipMemcpyDeviceToDevice, stream); entry = 4; }
                    if (ph == 4) { glue_y<<<SEQ, 256, 0, stream>>>((const bf16*)(ws + WS_HY), B.y, row0); entry = 3; }
                    if (ph == 5) continue;
                }
                nv::layer_batch(d_in, l, b, entry, xin, xo, mods, cs, sn, B, stream);
            }
        nv::k_rms<<<T, 256, 0, stream>>>(out, DM, DM, (const float*)d_in[20], out, DM);
    }
#endif
}
```

```cpp
#include <hip/hip_runtime.h>
#include <cstdio>
#include <cstdint>
#define MK_CUT 14
#define MK_NAIVE_BASE_MIB 240
#define MK_REP_PH -1
namespace pg8 {
#define PG8_LAS __attribute__((address_space(3)))
typedef unsigned short bf16_t;
typedef short bf16x8 __attribute__((ext_vector_type(8)));
typedef float f32x4 __attribute__((ext_vector_type(4)));
typedef unsigned u32x4 __attribute__((ext_vector_type(4)));
constexpr int BM = 256, BK = 64, HALF = 128, HTB = HALF * BK * 2, STAGE_BYTES = 8 * HTB, NXCD = 8, WGM = 8;

__host__ __device__ __forceinline__ int lds_byte(int r, int c) { const int st = (r >> 4) * 2 + (c >> 5), rr = r & 15, cc = c & 31, ob = rr * 64 + cc * 2; return st * 1024 + (ob ^ (((ob >> 9) & 1) << 5)); }
__host__ __device__ __forceinline__ void stage_rc(int b, int& R, int& C) { const int st = b / 1024, sb = b % 1024, swz = sb ^ (((sb >> 9) & 1) << 5); R = (st >> 1) * 16 + swz / 64; C = (st & 1) * 32 + (swz % 64) / 2; }
__host__ __device__ __forceinline__ int perm32(int rho) { const int n = rho >> 4, i = rho & 15; return 8 * (i >> 2) + 4 * n + (i & 3); }

struct Unit { int pm, pn; };
struct Gemm { const bf16_t* A; const bf16_t* Bt; int M, N, K, lda; };

struct StaticOrder {
    int nM, nN, nwg, G, c;
    __host__ __device__ void init(int M, int N, int G_, int c_) { nM = M / BM; nN = N / BM; nwg = nM * nN; G = G_; c = c_; }
    __host__ __device__ __forceinline__ bool next(int i, Unit& u) const {
        const long L = (long)i * G + c; if (L >= nwg) return false;
        int wgid = (int)L; { const int q = nwg / NXCD, r = nwg % NXCD, xcd = wgid % NXCD, off = wgid / NXCD; wgid = (xcd < r ? xcd * (q + 1) : r * (q + 1) + (xcd - r) * q) + off; }
        const int nig = WGM * nN, gid = wgid / nig, fm = gid * WGM, gsz = (nM - fm) < WGM ? (nM - fm) : WGM;
        u.pm = fm + ((wgid % nig) % gsz); u.pn = (wgid % nig) / gsz; return true;
    }
    __device__ __forceinline__ void a_ready(const Unit&) const {}
    __device__ __forceinline__ void done(const Unit&) const {}
};

__device__ __forceinline__ unsigned cvt_pk_bf16(float lo, float hi) { unsigned r; asm volatile("v_cvt_pk_bf16_f32 %0, %1, %2" : "=v"(r) : "v"(lo), "v"(hi)); return r; }

template <class Epi, class Sched, bool ALIGN_EPI = false, bool SP2 = false>
__device__ __forceinline__ void gemm_phase(PG8_LAS unsigned char* lds, const Gemm g, const Sched& S, const Epi& E) {
    int tid_ = threadIdx.x; asm volatile("" : "+v"(tid_));
    const int tid = tid_, wid = __builtin_amdgcn_readfirstlane(tid >> 6), lane = tid & 63, wr = wid >> 2, wc = wid & 3, fr = lane & 15, fq = lane >> 4;
    int K_ = g.K, lda_ = g.lda; asm volatile("" : "+s"(K_), "+s"(lda_));
    const int K = K_, nt = K / BK, lda = lda_;
    unsigned voffA[2], voffB[2];
#pragma unroll
    for (int i = 0; i < 2; ++i) { int R, C; stage_rc(tid * 16 + i * 8192, R, C); const int Rb = Epi::PERM ? ((R & ~31) + perm32(R & 31)) : R;
        voffA[i] = (unsigned)(R * lda + C) * 2u; voffB[i] = (unsigned)(Rb * K + C) * 2u; }
    const size_t kstep = (size_t)(BK * 2);
    const size_t hstepA = (size_t)HALF * lda * 2, hstepB = (size_t)HALF * K * 2;
    const size_t tstepA = 2 * hstepA, tstepB = 2 * hstepB;
    const unsigned ldsw = (unsigned)wid * 1024u;
    const int aoff = lds_byte(wr * 64 + fr, fq * 8), boff = lds_byte(wc * 32 + fr, fq * 8);
#define PG8_SA(b, h) (((b) * 2 + (h)) * HTB)
#define PG8_SB(b, h) ((4 + (b) * 2 + (h)) * HTB)
#define PG8_STAGE(bufoff, gbase, voff) do { _Pragma("unroll") for (int _i = 0; _i < 2; ++_i) \
        __builtin_amdgcn_global_load_lds((const unsigned*)((const char*)(gbase) + (voff)[_i]), (PG8_LAS unsigned*)(lds + (bufoff) + ldsw + _i * 8192), 16, 0, 0); } while (0)
#define PG8_LDA(dst, b, h) do { _Pragma("unroll") for (int m = 0; m < 4; ++m) _Pragma("unroll") for (int k = 0; k < 2; ++k) dst[m][k] = *(const PG8_LAS bf16x8*)(lds + PG8_SA(b, h) + aoff + m * 2048 + k * 1024); } while (0)
#define PG8_LDB(dst, b, h) do { _Pragma("unroll") for (int n = 0; n < 2; ++n) _Pragma("unroll") for (int k = 0; k < 2; ++k) dst[n][k] = *(const PG8_LAS bf16x8*)(lds + PG8_SB(b, h) + boff + n * 2048 + k * 1024); } while (0)
#define PG8_MMA(ai, bj, At, Bt) do { __builtin_amdgcn_s_setprio(1); _Pragma("unroll") for (int m = 0; m < 4; ++m) _Pragma("unroll") for (int n = 0; n < 2; ++n) _Pragma("unroll") for (int k = 0; k < 2; ++k) \
        acc[ai][bj][m][n] = __builtin_amdgcn_mfma_f32_16x16x32_bf16(Bt[n][k], At[m][k], acc[ai][bj][m][n], 0, 0, 0); __builtin_amdgcn_s_setprio(0); } while (0)
#define PG8_WAIT_V(n) asm volatile("s_waitcnt vmcnt(" #n ")" ::: "memory")
#define PG8_WAIT_L(n) asm volatile("s_waitcnt lgkmcnt(" #n ")" ::: "memory")
#define PG8_BAR __builtin_amdgcn_s_barrier()
#define PG8_SCHED __builtin_amdgcn_sched_barrier(0)
    Unit cur, nxt; int ui = 0;
    if (!S.next(0, cur)) return;
    f32x4 acc[2][2][4][2];
#pragma unroll
    for (int a = 0; a < 2; ++a)
#pragma unroll
        for (int b = 0; b < 2; ++b)
#pragma unroll
            for (int m = 0; m < 4; ++m)
#pragma unroll
                for (int n = 0; n < 2; ++n) acc[a][b][m][n] = (f32x4){0.f, 0.f, 0.f, 0.f};
    bf16x8 At[4][2], B0[2][2], B1[2][2];
    const char* cA = (const char*)g.A + (size_t)cur.pm * tstepA; const char* cB = (const char*)g.Bt + (size_t)cur.pn * tstepB;
    S.a_ready(cur);
    if constexpr (SP2) {
        PG8_STAGE(PG8_SB(0, 0), cB, voffB); PG8_STAGE(PG8_SB(0, 1), cB + hstepB, voffB); PG8_STAGE(PG8_SA(0, 0), cA, voffA); PG8_STAGE(PG8_SA(0, 1), cA + hstepA, voffA);
        if (wr == 1) PG8_BAR;
        PG8_WAIT_V(2); PG8_BAR;
        PG8_STAGE(PG8_SB(1, 0), cB + kstep, voffB); PG8_STAGE(PG8_SA(1, 0), cA + kstep, voffA); PG8_STAGE(PG8_SB(1, 1), cB + hstepB + kstep, voffB);
        PG8_WAIT_V(6); PG8_BAR;
    } else {
        PG8_STAGE(PG8_SB(0, 0), cB, voffB); PG8_STAGE(PG8_SA(0, 0), cA, voffA); PG8_STAGE(PG8_SB(0, 1), cB + hstepB, voffB); PG8_STAGE(PG8_SA(0, 1), cA + hstepA, voffA);
        if (wr == 1) PG8_BAR;
        PG8_WAIT_V(4); PG8_BAR;
        PG8_STAGE(PG8_SB(1, 0), cB + kstep, voffB); PG8_STAGE(PG8_SA(1, 0), cA + kstep, voffA); PG8_STAGE(PG8_SB(1, 1), cB + hstepB + kstep, voffB);
        PG8_WAIT_V(6); PG8_BAR;
    }
    for (;;) {
        const bool has_next = S.next(ui + 1, nxt);
        const char* nA = has_next ? (const char*)g.A + (size_t)nxt.pm * tstepA : cA; const char* nB = has_next ? (const char*)g.Bt + (size_t)nxt.pn * tstepB : cB;
        for (int t = 0; t < nt; t += 2) {
            const bool last = (t == nt - 2);
            const char* a1 = cA + (size_t)(t + 1) * kstep;
            const char* a2 = last ? nA : cA + (size_t)(t + 2) * kstep; const char* b2 = last ? nB : cB + (size_t)(t + 2) * kstep;
            const char* a3 = a2 + kstep; const char* b3 = b2 + kstep;
            if (last && has_next) S.a_ready(nxt);
            if constexpr (SP2) {
            PG8_LDB(B0, 0, 0); PG8_LDB(B1, 0, 1); PG8_SCHED; PG8_LDA(At, 0, 0); PG8_STAGE(PG8_SA(1, 1), a1 + hstepA, voffA);
            PG8_WAIT_V(8); PG8_WAIT_L(0); PG8_BAR; PG8_MMA(0, 0, At, B0); PG8_MMA(0, 1, At, B1); PG8_BAR; PG8_SCHED;
            PG8_LDA(At, 0, 1); PG8_STAGE(PG8_SB(0, 0), b2, voffB); PG8_STAGE(PG8_SB(0, 1), b2 + hstepB, voffB); PG8_STAGE(PG8_SA(0, 0), a2, voffA);
            PG8_WAIT_V(8); PG8_WAIT_L(0); PG8_BAR; PG8_MMA(1, 0, At, B0); PG8_MMA(1, 1, At, B1); PG8_BAR; PG8_SCHED;
            PG8_LDB(B0, 1, 0); PG8_LDB(B1, 1, 1); PG8_SCHED; PG8_LDA(At, 1, 0); PG8_STAGE(PG8_SA(0, 1), a2 + hstepA, voffA);
            PG8_WAIT_V(8); PG8_WAIT_L(0); PG8_BAR; PG8_MMA(0, 0, At, B0); PG8_MMA(0, 1, At, B1); PG8_BAR; PG8_SCHED;
            PG8_LDA(At, 1, 1); PG8_STAGE(PG8_SB(1, 0), b3, voffB); PG8_STAGE(PG8_SB(1, 1), b3 + hstepB, voffB); PG8_STAGE(PG8_SA(1, 0), a3, voffA);
            PG8_WAIT_V(8); PG8_WAIT_L(0); PG8_BAR; PG8_MMA(1, 0, At, B0); PG8_MMA(1, 1, At, B1); PG8_BAR; PG8_SCHED;
            if constexpr (Epi::HOOK_T > 0) { if (t + 2 == Epi::HOOK_T) E.hook(acc, cur, wr, wc, fr, fq); }
            } else {
            PG8_LDB(B0, 0, 0); PG8_SCHED; PG8_LDA(At, 0, 0); PG8_STAGE(PG8_SA(1, 1), a1 + hstepA, voffA);
            PG8_WAIT_L(8); PG8_BAR; PG8_WAIT_L(0); PG8_MMA(0, 0, At, B0); PG8_BAR; PG8_SCHED;
            PG8_LDB(B1, 0, 1); PG8_STAGE(PG8_SB(0, 0), b2, voffB);
            PG8_BAR; PG8_WAIT_L(0); PG8_MMA(0, 1, At, B1); PG8_BAR;
            PG8_LDA(At, 0, 1); PG8_STAGE(PG8_SA(0, 0), a2, voffA);
            PG8_BAR; PG8_WAIT_L(0); PG8_MMA(1, 0, At, B0); PG8_BAR; PG8_SCHED;
            PG8_STAGE(PG8_SB(0, 1), b2 + hstepB, voffB);
            PG8_WAIT_V(6); PG8_BAR; PG8_MMA(1, 1, At, B1); PG8_BAR;
            PG8_LDB(B0, 1, 0); PG8_SCHED; PG8_LDA(At, 1, 0); PG8_STAGE(PG8_SA(0, 1), a2 + hstepA, voffA);
            PG8_WAIT_L(8); PG8_BAR; PG8_WAIT_L(0); PG8_MMA(0, 0, At, B0); PG8_BAR; PG8_SCHED;
            PG8_LDB(B1, 1, 1); PG8_STAGE(PG8_SB(1, 0), b3, voffB);
            PG8_BAR; PG8_WAIT_L(0); PG8_MMA(0, 1, At, B1); PG8_BAR;
            PG8_LDA(At, 1, 1); PG8_STAGE(PG8_SA(1, 0), a3, voffA);
            PG8_BAR; PG8_WAIT_L(0); PG8_MMA(1, 0, At, B0); PG8_BAR; PG8_SCHED;
            PG8_STAGE(PG8_SB(1, 1), b3 + hstepB, voffB);
            PG8_WAIT_V(6); PG8_BAR; PG8_MMA(1, 1, At, B1); PG8_BAR;
            }
        }
        if constexpr (ALIGN_EPI) { if (wr == 0) PG8_BAR; }
        if constexpr (!Epi::AFTER_DRAIN) { E(acc, cur, wr, wc, fr, fq); S.done(cur); }
        if (!has_next) break;
#pragma unroll
        for (int a = 0; a < 2; ++a)
#pragma unroll
            for (int b = 0; b < 2; ++b)
#pragma unroll
                for (int m = 0; m < 4; ++m)
#pragma unroll
                    for (int n = 0; n < 2; ++n) acc[a][b][m][n] = (f32x4){0.f, 0.f, 0.f, 0.f};
        cur = nxt; cA = nA; cB = nB; ++ui;
        if constexpr (ALIGN_EPI) { if (wr == 1) PG8_BAR; }
    }
    PG8_WAIT_V(0);
    if constexpr (!ALIGN_EPI) { if (wr == 0) PG8_BAR; }
    PG8_BAR;
    if constexpr (Epi::AFTER_DRAIN) { E.fused(acc, cur, wr, wc, fr, fq, lds, wid, lane); S.done(cur); }
#undef PG8_SA
#undef PG8_SB
#undef PG8_STAGE
#undef PG8_LDA
#undef PG8_LDB
#undef PG8_MMA
#undef PG8_WAIT_V
#undef PG8_WAIT_L
#undef PG8_BAR
#undef PG8_SCHED
}
}
#define GAS __attribute__((address_space(1)))
#define LAS __attribute__((address_space(3)))
typedef unsigned short bf16;
typedef unsigned v4u __attribute__((ext_vector_type(4)));
typedef unsigned v2u __attribute__((ext_vector_type(2)));
typedef float f32x4 __attribute__((ext_vector_type(4)));
typedef float f32x16 __attribute__((ext_vector_type(16)));
typedef short bf16x8 __attribute__((ext_vector_type(8)));
typedef short s16x4 __attribute__((ext_vector_type(4)));
typedef GAS unsigned gu32;

constexpr int NWAVES = 8, NTHR = 512;
constexpr int BATCH = 4, SEQ = 2048, DM = 2048, T = BATCH * SEQ, DEPTH = 2, IN_DIM = 5856;
constexpr int NP = 5888;
constexpr int C_GQ = 0, C_GK = 384, C_GV = 768, C_MKV = 1536, C_MQ = 1792, C_MKR = 2176, C_LR = 2240, C_CB = 2304, C_CC = 2816, C_CX = 3328, C_Z = 3840;
constexpr int R_GQ = 0, R_GK = 384, R_GV = 768, R_LR = 1536, R_MQ = 1568, R_MKV = 1952, R_MKR = 2208, R_CB = 2272, R_CC = 2784, R_CX = 3296, R_Z = 3808;
constexpr int NQ = 1280, NKV = 1536;
constexpr float EPS = 1e-6f;
constexpr float QSCALE = 0.07216878364870322f * 1.4426950408889634f;
constexpr int NITEM = BATCH * 32 * 6;

constexpr size_t MiB = 1u << 20;
constexpr size_t WS_CTL = 0, CTL_ZERO_BYTES = 1 * MiB;
constexpr size_t WS_MODS = 256 * 1024;
constexpr size_t WS_CS = 2 * MiB, WS_SN = 3 * MiB;
constexpr size_t WS_WUQ = 4 * MiB;
constexpr size_t WS_WUKV = 6 * MiB;
constexpr size_t WS_WOUT = 8 * MiB;
constexpr size_t WS_WIN = 24 * MiB;
constexpr size_t WS_HY = 70 * MiB;
constexpr size_t WS_PROJ = 102 * MiB;
constexpr size_t WS_QUP = 194 * MiB;
constexpr size_t WS_KVUP = 214 * MiB;
constexpr size_t WS_X1B = 238 * MiB;
constexpr size_t WS_OMLA = 238 * MiB;
constexpr size_t WS_OINTRA = 270 * MiB;
constexpr size_t WS_KVC = 294 * MiB;
constexpr size_t WS_ST = 318 * MiB;
constexpr size_t WS_QDEC = 342 * MiB;
constexpr size_t WS_DECAY = 354 * MiB;
constexpr size_t WS_PARTQ = 355 * MiB;
constexpr size_t WS_PARTKV = 355 * MiB + 512 * 1024;
constexpr size_t WS_ROWSS = 512 * 1024;
constexpr size_t WS_PARTM = 355 * MiB + 768 * 1024;
constexpr size_t WS_XS = 1 * MiB;
constexpr int CW_PANEL = 8192;
constexpr size_t WS_PO = 356 * MiB;
constexpr size_t WS_PML = 368 * MiB;
constexpr size_t WS_END = 369 * MiB;
constexpr int CW_BAR = 4096;

constexpr int RING_BYTES = 131072, LDSCTL_OFF = RING_BYTES, MISC_OFF = LDSCTL_OFF + 320, LDS_BYTES = 147456;

#define LDS_WAIT() asm volatile("s_waitcnt lgkmcnt(0)" ::: "memory")
#define VM_WAIT() asm volatile("s_waitcnt vmcnt(0)" ::: "memory")
__device__ __forceinline__ unsigned f2bf(float f) { unsigned u = __builtin_bit_cast(unsigned, f); return (u + 0x7fffu + ((u >> 16) & 1u)) >> 16; }
typedef float f32x2_t __attribute__((ext_vector_type(2))); typedef __bf16 bf16x2_t __attribute__((ext_vector_type(2)));
__device__ __forceinline__ unsigned pk2(float lo, float hi) { f32x2_t v = {lo, hi}; bf16x2_t b = __builtin_convertvector(v, bf16x2_t); return __builtin_bit_cast(unsigned, b); }
__device__ __forceinline__ unsigned pk2a(float lo, float hi) { return pg8::cvt_pk_bf16(lo, hi); }
__device__ __forceinline__ float bf2f(unsigned short h) { return __builtin_bit_cast(float, (unsigned)h << 16); }
__device__ __forceinline__ float bflo(unsigned w) { return __builtin_bit_cast(float, w << 16); }
__device__ __forceinline__ float bfhi(unsigned w) { return __builtin_bit_cast(float, w & 0xffff0000u); }
#ifndef MK_FUSE_Y
#define MK_FUSE_Y 1
#endif
constexpr int CW_YREADY = 24576;
#ifndef MK_SILU_IN_EPI
#define MK_SILU_IN_EPI 1
#endif
__device__ __forceinline__ float silu_fast(float v) { return v * __builtin_amdgcn_rcpf(1.f + __expf(-v)); }
__device__ __forceinline__ float wave_sum(float v) {
#pragma unroll
    for (int o = 1; o < 64; o <<= 1) v += __shfl_xor(v, o);
    return v;
}

__device__ __forceinline__ int map_in(int n) {
    if (n < C_MKV) return n;
    if (n < C_MQ) return R_MKV + (n - C_MKV);
    if (n < C_MKR) return R_MQ + (n - C_MQ);
    if (n < C_LR) { const int j = n - C_MKR; return R_MKR + (j & 1) * 32 + (j >> 1); }
    if (n < C_LR + 32) return R_LR + (n - C_LR);
    if (n < C_CB) return -1;
    if (n < C_Z) return R_CB + (n - C_CB);
    return R_Z + (n - C_Z);
}
__device__ __forceinline__ int map_uq(int n) {
    if (n >= 1152) return -1;
    const int h = n / 192, d = n % 192;
    if (d < 128) return n;
    const int j = d - 128; return h * 192 + 128 + (j & 1) * 32 + (j >> 1);
}

__device__ __forceinline__ void st_wt16(bf16* p, v4u v) { asm volatile("global_store_dwordx4 %0, %1, off sc1\n\ts_nop 1" :: "v"((GAS bf16*)p), "v"(v) : "memory"); }
struct EpiIn {
    static constexpr bool PERM = true, AFTER_DRAIN = false; static constexpr int HOOK_T = 0;
    bf16* O; const float* cs; const float* sn; float* partq; float* partkv;
    __device__ __forceinline__ void operator()(const f32x4 (&acc)[2][2][4][2], const pg8::Unit& u, int wr, int wc, int fr, int fq) const {
        const int pn = u.pn, row0 = u.pm * 256 + wr * 64 + fr, col0 = pn * 256 + wc * 32 + 8 * fq;
        const bool stat = (pn >= 6 && pn <= 8);
#pragma unroll
        for (int ai = 0; ai < 2; ++ai)
#pragma unroll
            for (int m = 0; m < 4; ++m) {
                const int row = row0 + ai * 128 + m * 16; bf16* rowp = O + (size_t)row * NP + col0; float ss = 0.f;
#pragma unroll
                for (int bj = 0; bj < 2; ++bj) {
                    f32x4 v0 = acc[ai][bj][m][0], v1 = acc[ai][bj][m][1]; const int c = col0 + bj * 128;
                    if (MK_SILU_IN_EPI && pn >= 15) {
#pragma unroll
                        for (int e = 0; e < 4; ++e) { v0[e] = silu_fast(v0[e]); v1[e] = silu_fast(v1[e]); }
                    } else if (pn == 8 && bj == 1 && c < C_LR) {
                        const int i0 = (c - C_MKR) >> 1; const f32x4 cc = *(const f32x4*)(cs + (size_t)row * 32 + i0), sv = *(const f32x4*)(sn + (size_t)row * 32 + i0);
                        f32x4 a0, a1;
                        a0[0] = v0[0] * cc[0] - v0[1] * sv[0]; a0[1] = v0[1] * cc[0] + v0[0] * sv[0]; a0[2] = v0[2] * cc[1] - v0[3] * sv[1]; a0[3] = v0[3] * cc[1] + v0[2] * sv[1];
                        a1[0] = v1[0] * cc[2] - v1[1] * sv[2]; a1[1] = v1[1] * cc[2] + v1[0] * sv[2]; a1[2] = v1[2] * cc[3] - v1[3] * sv[3]; a1[3] = v1[3] * cc[3] + v1[2] * sv[3];
                        v0 = a0; v1 = a1;
                    }
                    if (stat && (pn != 8 || bj == 0)) ss += (v0[0] * v0[0] + v0[1] * v0[1]) + (v0[2] * v0[2] + v0[3] * v0[3]) + (v1[0] * v1[0] + v1[1] * v1[1]) + (v1[2] * v1[2] + v1[3] * v1[3]);
                    v4u w; w.x = pk2a(v0[0], v0[1]); w.y = pk2a(v0[2], v0[3]); w.z = pk2a(v1[0], v1[1]); w.w = pk2a(v1[2], v1[3]);
                    *(v4u*)(rowp + bj * 128) = w;
                }
                asm volatile("" ::: "memory");
                if (stat) { ss += __shfl_xor(ss, 16); ss += __shfl_xor(ss, 32);
                    if (fq == 0) { if (pn == 6) partkv[(size_t)row * 4 + wc] = ss; else partq[(size_t)row * 8 + (pn - 7) * 4 + wc] = ss; } }
            }
    }
};
struct EpiUq {
    static constexpr bool PERM = true, AFTER_DRAIN = false; static constexpr int HOOK_T = 0;
    bf16* O; const float* cs; const float* sn; const float* partq;
    __device__ __forceinline__ void operator()(const f32x4 (&acc)[2][2][4][2], const pg8::Unit& u, int wr, int wc, int fr, int fq) const {
        const int row0 = u.pm * 256 + wr * 64 + fr, col0 = u.pn * 256 + wc * 32 + 8 * fq;
        float rs[2][4];
#pragma unroll
        for (int ai = 0; ai < 2; ++ai) {
            f32x4 pq0[4], pq1[4];
#pragma unroll
            for (int m = 0; m < 4; ++m) { const int row = row0 + ai * 128 + m * 16; pq0[m] = *(const GAS f32x4*)(partq + (size_t)row * 8); pq1[m] = *(const GAS f32x4*)(partq + (size_t)row * 8 + 4); }
            const int d0_ = col0 % 192, d1_ = (col0 + 128) % 192; const int rbj = d0_ >= 128 ? 0 : ((d1_ >= 128 && col0 + 128 < 1152) ? 1 : -1), ri0 = ((rbj == 0 ? d0_ : d1_) - 128) >> 1;
            f32x4 rcc[4], rsv[4];
            if (rbj >= 0) {
#pragma unroll
                for (int m = 0; m < 4; ++m) { const int row = row0 + ai * 128 + m * 16; rcc[m] = *(const GAS f32x4*)(cs + (size_t)row * 32 + ri0); rsv[m] = *(const GAS f32x4*)(sn + (size_t)row * 32 + ri0); } }
            __builtin_amdgcn_sched_barrier(0);
#pragma unroll
            for (int m = 0; m < 4; ++m) { const f32x4 p0 = pq0[m], p1 = pq1[m];
                rs[ai][m] = __builtin_amdgcn_rsqf(((p0[0] + p0[1]) + (p0[2] + p0[3]) + (p1[0] + p1[1]) + (p1[2] + p1[3])) * (1.f / 384.f) + EPS) * QSCALE; }
#pragma unroll
            for (int m = 0; m < 4; ++m) {
                const int row = row0 + ai * 128 + m * 16; bf16* rowp = O + (size_t)row * NQ + col0;
#pragma unroll
                for (int bj = 0; bj < 2; ++bj) {
                    const int c = col0 + bj * 128; if (c >= 1152) continue;
                    f32x4 v0 = acc[ai][bj][m][0] * rs[ai][m], v1 = acc[ai][bj][m][1] * rs[ai][m];
                    if (bj == rbj) {
                        const f32x4 cc = rcc[m], sv = rsv[m];
                        f32x4 a0, a1;
                        a0[0] = v0[0] * cc[0] - v0[1] * sv[0]; a0[1] = v0[1] * cc[0] + v0[0] * sv[0]; a0[2] = v0[2] * cc[1] - v0[3] * sv[1]; a0[3] = v0[3] * cc[1] + v0[2] * sv[1];
                        a1[0] = v1[0] * cc[2] - v1[1] * sv[2]; a1[1] = v1[1] * cc[2] + v1[0] * sv[2]; a1[2] = v1[2] * cc[3] - v1[3] * sv[3]; a1[3] = v1[3] * cc[3] + v1[2] * sv[3];
                        v0 = a0; v1 = a1;
                    }
                    v4u w; w.x = pk2a(v0[0], v0[1]); w.y = pk2a(v0[2], v0[3]); w.z = pk2a(v1[0], v1[1]); w.w = pk2a(v1[2], v1[3]);
                    *(v4u*)(rowp + bj * 128) = w;
                }
                asm volatile("" ::: "memory");
            }
        }
    }
};
struct EpiUkv {
    static constexpr bool PERM = true, AFTER_DRAIN = false; static constexpr int HOOK_T = 0;
    bf16* O; const float* partkv;
    __device__ __forceinline__ void operator()(const f32x4 (&acc)[2][2][4][2], const pg8::Unit& u, int wr, int wc, int fr, int fq) const {
        const int row0 = u.pm * 256 + wr * 64 + fr, col0 = u.pn * 256 + wc * 32 + 8 * fq;
        float rs[2][4]; f32x4 pk_[2][4];
#pragma unroll
        for (int ai = 0; ai < 2; ++ai)
#pragma unroll
            for (int m = 0; m < 4; ++m) pk_[ai][m] = *(const GAS f32x4*)(partkv + (size_t)(row0 + ai * 128 + m * 16) * 4);
        __builtin_amdgcn_sched_barrier(0);
#pragma unroll
        for (int ai = 0; ai < 2; ++ai)
#pragma unroll
            for (int m = 0; m < 4; ++m) { const f32x4 p0 = pk_[ai][m];
                rs[ai][m] = __builtin_amdgcn_rsqf(((p0[0] + p0[1]) + (p0[2] + p0[3])) * (1.f / 256.f) + EPS); }
#pragma unroll
        for (int ai = 0; ai < 2; ++ai)
#pragma unroll
            for (int m = 0; m < 4; ++m) {
                const int row = row0 + ai * 128 + m * 16; bf16* rowp = O + (size_t)row * NKV + col0;
#pragma unroll
                for (int bj = 0; bj < 2; ++bj) {
                    const f32x4 v0 = acc[ai][bj][m][0] * rs[ai][m], v1 = acc[ai][bj][m][1] * rs[ai][m];
                    v4u w; w.x = pk2a(v0[0], v0[1]); w.y = pk2a(v0[2], v0[3]); w.z = pk2a(v1[0], v1[1]); w.w = pk2a(v1[2], v1[3]);
                    *(v4u*)(rowp + bj * 128) = w;
                }
            }
    }
};
struct EpiOut {
    static constexpr bool PERM = false, AFTER_DRAIN = false; static constexpr int HOOK_T = 12;
    const float* xin; float* out; const float* gate;
    const float* partm;
    __device__ __forceinline__ void hook(f32x4 (&acc)[2][2][4][2], const pg8::Unit& u, int wr, int wc, int fr, int fq) const {
        const int row0 = u.pm * 256 + wr * 64 + fr;
        float rs[2][4];
#pragma unroll
        for (int ai = 0; ai < 2; ++ai)
#pragma unroll
            for (int m = 0; m < 4; ++m) rs[ai][m] = *(const GAS float*)(partm + (size_t)(row0 + ai * 128 + m * 16));
        __builtin_amdgcn_sched_barrier(0);
#pragma unroll
        for (int ai = 0; ai < 2; ++ai)
#pragma unroll
            for (int m = 0; m < 4; ++m) rs[ai][m] = __builtin_amdgcn_rsqf(rs[ai][m] * (1.f / 768.f) + EPS);
#pragma unroll
        for (int ai = 0; ai < 2; ++ai)
#pragma unroll
            for (int m = 0; m < 4; ++m)
#pragma unroll
                for (int bj = 0; bj < 2; ++bj)
#pragma unroll
                    for (int n = 0; n < 2; ++n) acc[ai][bj][m][n] *= rs[ai][m];
    }
    __device__ __forceinline__ void operator()(const f32x4 (&acc)[2][2][4][2], const pg8::Unit& u, int wr, int wc, int fr, int fq) const {
        const int row0 = u.pm * 256 + wr * 64 + fr, col0 = u.pn * 256 + wc * 32 + 4 * fq; const float* gb = gate + (size_t)(u.pm >> 3) * 3 * DM;
        f32x4 gv[2][2];
#pragma unroll
        for (int bj = 0; bj < 2; ++bj)
#pragma unroll
            for (int n = 0; n < 2; ++n) gv[bj][n] = *(const f32x4*)(gb + col0 + bj * 128 + n * 16);
        f32x4 xv[2][2][2][2];
#define EO_LOAD(slot, g) do { _Pragma("unroll") for (int q = 0; q < 2; ++q) { const size_t off = (size_t)(row0 + ((g) >> 1) * 128 + (((g) & 1) * 2 + q) * 16) * DM + col0; \
            _Pragma("unroll") for (int bj = 0; bj < 2; ++bj) _Pragma("unroll") for (int n = 0; n < 2; ++n) xv[slot][q][bj][n] = *(const f32x4*)(xin + off + bj * 128 + n * 16); } } while (0)
#define EO_STORE(slot, g) do { _Pragma("unroll") for (int q = 0; q < 2; ++q) { const int ai = (g) >> 1, m = ((g) & 1) * 2 + q; const size_t off = (size_t)(row0 + ai * 128 + m * 16) * DM + col0; \
            _Pragma("unroll") for (int bj = 0; bj < 2; ++bj) _Pragma("unroll") for (int n = 0; n < 2; ++n) *(f32x4*)(out + off + bj * 128 + n * 16) = xv[slot][q][bj][n] + gv[bj][n] * acc[ai][bj][m][n]; } } while (0)
        EO_LOAD(0, 0); EO_LOAD(1, 1); EO_STORE(0, 0); EO_LOAD(0, 2); EO_STORE(1, 1); EO_LOAD(1, 3); EO_STORE(0, 2); EO_STORE(1, 3);
#undef EO_LOAD
#undef EO_STORE
    }
};

struct EpiOutNorm {
    static constexpr bool PERM = false, AFTER_DRAIN = true; static constexpr int HOOK_T = 12;
    const float* xin; const bf16* xinb; bf16* x1b; float* out; const float* gate; const float* partm;
    bf16* H; const float* g; const float* mods_next;
    float* xs; unsigned* cnt; unsigned target; int last;
    __device__ __forceinline__ void hook(f32x4 (&acc)[2][2][4][2], const pg8::Unit& u, int wr, int wc, int fr, int fq) const {
        const int row0 = u.pm * 256 + wr * 64 + fr;
        float rs[2][4];
#pragma unroll
        for (int ai = 0; ai < 2; ++ai)
#pragma unroll
            for (int m = 0; m < 4; ++m) rs[ai][m] = *(const GAS float*)(partm + (size_t)(row0 + ai * 128 + m * 16));
        __builtin_amdgcn_sched_barrier(0);
#pragma unroll
        for (int ai = 0; ai < 2; ++ai)
#pragma unroll
            for (int m = 0; m < 4; ++m) rs[ai][m] = __builtin_amdgcn_rsqf(rs[ai][m] * (1.f / 768.f) + EPS);
#pragma unroll
        for (int ai = 0; ai < 2; ++ai)
#pragma unroll
            for (int m = 0; m < 4; ++m)
#pragma unroll
                for (int bj = 0; bj < 2; ++bj)
#pragma unroll
                    for (int n = 0; n < 2; ++n) acc[ai][bj][m][n] *= rs[ai][m];
    }
    __device__ __forceinline__ void fused(f32x4 (&acc)[2][2][4][2], const pg8::Unit& u, int wr, int wc, int fr, int fq, LAS unsigned char* lds, int wid, int lane) const {
        const int row0 = u.pm * 256 + wr * 64 + fr, col0 = u.pn * 256 + wc * 32 + 4 * fq, b = u.pm >> 3; const float* gb = gate + (size_t)b * 3 * DM;
        LAS float* P = (LAS float*)lds;
        LAS float* S = (LAS float*)(lds + 4096);
        f32x4 gv[2][2];
#pragma unroll
        for (int bj = 0; bj < 2; ++bj)
#pragma unroll
            for (int n = 0; n < 2; ++n) gv[bj][n] = *(const f32x4*)(gb + col0 + bj * 128 + n * 16);
        v4u xr[2][2][2][2];
#define EO_LOAD(slot, g_) do { _Pragma("unroll") for (int q = 0; q < 2; ++q) { const size_t off = (size_t)(row0 + ((g_) >> 1) * 128 + (((g_) & 1) * 2 + q) * 16) * DM + col0; \
            _Pragma("unroll") for (int bj = 0; bj < 2; ++bj) _Pragma("unroll") for (int n = 0; n < 2; ++n) { if (xinb) { const v2u w_ = *(const GAS v2u*)(xinb + off + bj * 128 + n * 16); xr[slot][q][bj][n] = (v4u){w_.x, w_.y, 0u, 0u}; } \
                else xr[slot][q][bj][n] = *(const GAS v4u*)(xin + off + bj * 128 + n * 16); } } } while (0)
#define EO_ADD(slot, g_) do { _Pragma("unroll") for (int q = 0; q < 2; ++q) { const int ai = (g_) >> 1, m = ((g_) & 1) * 2 + q; const size_t off = (size_t)(row0 + ai * 128 + m * 16) * DM + col0; \
            _Pragma("unroll") for (int bj = 0; bj < 2; ++bj) _Pragma("unroll") for (int n = 0; n < 2; ++n) { const v4u r_ = xr[slot][q][bj][n]; \
                f32x4 x_ = __builtin_bit_cast(f32x4, r_); if (xinb) x_ = (f32x4){bflo(r_.x), bfhi(r_.x), bflo(r_.y), bfhi(r_.y)}; \
                acc[ai][bj][m][n] = x_ + gv[bj][n] * acc[ai][bj][m][n]; \
                if (!last) { v2u w_; w_.x = pk2(acc[ai][bj][m][n][0], acc[ai][bj][m][n][1]); w_.y = pk2(acc[ai][bj][m][n][2], acc[ai][bj][m][n][3]); *(v2u*)(x1b + off + bj * 128 + n * 16) = w_; } } } } while (0)
        EO_LOAD(0, 0); EO_LOAD(1, 1); EO_ADD(0, 0); EO_LOAD(0, 2); EO_ADD(1, 1); EO_LOAD(1, 3); EO_ADD(0, 2); EO_ADD(1, 3);
#undef EO_LOAD
#undef EO_ADD
#pragma unroll
        for (int ai = 0; ai < 2; ++ai)
#pragma unroll
            for (int m = 0; m < 4; ++m) { float ss = 0.f;
#pragma unroll
                for (int bj = 0; bj < 2; ++bj)
#pragma unroll
                    for (int n = 0; n < 2; ++n) { const f32x4 x = acc[ai][bj][m][n]; ss += (x[0] * x[0] + x[1] * x[1]) + (x[2] * x[2] + x[3] * x[3]); }
                ss += __shfl_xor(ss, 16); ss += __shfl_xor(ss, 32);
                if (fq == 0) P[(ai * 128 + wr * 64 + m * 16 + fr) * 4 + wc] = ss; }
        asm volatile("s_waitcnt lgkmcnt(0)" ::: "memory"); __builtin_amdgcn_s_barrier(); asm volatile("" ::: "memory");
        const int tid = wid * 64 + lane;
        if (tid < 256) { const f32x4 p = *(const LAS f32x4*)(P + tid * 4);
            __hip_atomic_store(xs + (size_t)(u.pm * 256 + tid) * 8 + u.pn, (p[0] + p[1]) + (p[2] + p[3]), __ATOMIC_RELAXED, __HIP_MEMORY_SCOPE_AGENT);
            asm volatile("s_waitcnt vmcnt(0)" ::: "memory");
            if (lane == 0) __hip_atomic_fetch_add(cnt + 64 * u.pm, 1u, __ATOMIC_RELAXED, __HIP_MEMORY_SCOPE_AGENT); }
        if (wid == 0) { unsigned sp = 0u;
            while ((unsigned)__builtin_amdgcn_readfirstlane(__hip_atomic_load(cnt + 64 * u.pm, __ATOMIC_RELAXED, __HIP_MEMORY_SCOPE_AGENT)) < target) { __builtin_amdgcn_s_sleep(2); if (++sp > (1u << 22)) break; }
            __builtin_amdgcn_fence(__ATOMIC_ACQUIRE, "agent"); }
        asm volatile("s_waitcnt vmcnt(0) lgkmcnt(0)" ::: "memory"); __builtin_amdgcn_s_barrier(); asm volatile("" ::: "memory");
        if (tid < 256) { const GAS float* sl = (const GAS float*)(xs + (size_t)(u.pm * 256 + tid) * 8); f32x4 sa, sb;
            asm volatile("global_load_dwordx4 %0, %2, off sc1\n\tglobal_load_dwordx4 %1, %2, off offset:16 sc1\n\ts_waitcnt vmcnt(0)" : "=&v"(sa), "=&v"(sb) : "v"(sl) : "memory");
            const float s = ((sa[0] + sa[1]) + (sa[2] + sa[3])) + ((sb[0] + sb[1]) + (sb[2] + sb[3]));
            S[tid] = __builtin_amdgcn_rsqf(s * (1.f / DM) + EPS); }
        asm volatile("s_waitcnt lgkmcnt(0)" ::: "memory"); __builtin_amdgcn_s_barrier(); asm volatile("" ::: "memory");
        f32x4 mul[2][2], add[2][2];
#pragma unroll
        for (int bj = 0; bj < 2; ++bj)
#pragma unroll
            for (int n = 0; n < 2; ++n) { const int c = col0 + bj * 128 + n * 16; const f32x4 gg = *(const f32x4*)(g + c);
                if (last) { mul[bj][n] = gg; add[bj][n] = (f32x4){0.f, 0.f, 0.f, 0.f}; }
                else { const float* mn = mods_next + (size_t)b * 3 * DM; mul[bj][n] = gg * (*(const f32x4*)(mn + DM + c) + 1.f); add[bj][n] = *(const f32x4*)(mn + c); } }
#pragma unroll
        for (int ai = 0; ai < 2; ++ai)
#pragma unroll
            for (int m = 0; m < 4; ++m) { const int rl = ai * 128 + wr * 64 + m * 16 + fr; const float rstd = S[rl]; const size_t off = (size_t)(u.pm * 256 + rl) * DM + col0;
#pragma unroll
                for (int bj = 0; bj < 2; ++bj)
#pragma unroll
                    for (int n = 0; n < 2; ++n) { const f32x4 r = acc[ai][bj][m][n] * rstd * mul[bj][n] + add[bj][n];
                        if (last) *(f32x4*)(out + off + bj * 128 + n * 16) = r;
                        else { v2u w; w.x = pk2(r[0], r[1]); w.y = pk2(r[2], r[3]); *(v2u*)(H + off + bj * 128 + n * 16) = w; } } }
    }
};

__device__ __forceinline__ void unpack8(const v4u w, float* f) { f[0] = bflo(w.x); f[1] = bfhi(w.x); f[2] = bflo(w.y); f[3] = bfhi(w.y); f[4] = bflo(w.z); f[5] = bfhi(w.z); f[6] = bflo(w.w); f[7] = bfhi(w.w); }

__device__ __forceinline__ int stg_pos(int c, int row) { return (c & 16) | ((c ^ (row & 7) ^ ((c >> 4) << 3)) & 15); }
__device__ __forceinline__ void stage_write(LAS float* st, const f32x16* acc, int r32, int hi) {
#pragma unroll
    for (int reg = 0; reg < 16; ++reg) { const int row = (reg & 3) + 8 * (reg >> 2) + 4 * hi;
#pragma unroll
        for (int dvb = 0; dvb < 4; ++dvb) { const int col = dvb * 32 + r32; st[row * 128 + stg_pos(col >> 2, row) * 4 + (col & 3)] = acc[dvb][reg]; } }
}
__device__ __forceinline__ void stage_write1(LAS float* st, const f32x16& a, int dvb, int r32, int hi) {
#pragma unroll
    for (int reg = 0; reg < 16; ++reg) { const int row = (reg & 3) + 8 * (reg >> 2) + 4 * hi; const int col = dvb * 32 + r32; st[row * 128 + stg_pos(col >> 2, row) * 4 + (col & 3)] = a[reg]; }
}
__device__ __forceinline__ void stage_read(const LAS float* st, int lane, float* v) {
    const int row = lane >> 1, half = lane & 1;
#pragma unroll
    for (int j = 0; j < 16; ++j) { const f32x4 q = *(const LAS f32x4*)(st + row * 128 + stg_pos(16 * half + j, row) * 4); v[4 * j] = q[0]; v[4 * j + 1] = q[1]; v[4 * j + 2] = q[2]; v[4 * j + 3] = q[3]; }
}
__device__ __forceinline__ void gated_store64(const float* v, float rs, const float* __restrict__ g, const bf16* __restrict__ zrow, bf16* __restrict__ yrow) {
    v4u zz[8];
#pragma unroll
    for (int j = 0; j < 8; ++j) zz[j] = *(const v4u*)(zrow + 8 * j);
#pragma unroll
    for (int j = 0; j < 8; ++j) { const f32x4 g0 = *(const f32x4*)(g + 8 * j), g1 = *(const f32x4*)(g + 8 * j + 4); float z[8]; unpack8(zz[j], z);
        v4u w; w.x = pk2a(v[8 * j] * rs * g0[0] * z[0], v[8 * j + 1] * rs * g0[1] * z[1]); w.y = pk2a(v[8 * j + 2] * rs * g0[2] * z[2], v[8 * j + 3] * rs * g0[3] * z[3]);
        w.z = pk2a(v[8 * j + 4] * rs * g1[0] * z[4], v[8 * j + 5] * rs * g1[1] * z[5]); w.w = pk2a(v[8 * j + 6] * rs * g1[2] * z[6], v[8 * j + 7] * rs * g1[3] * z[7]);
        *(v4u*)(yrow + 8 * j) = w; }
}

template <bool NORM> __device__ __forceinline__ void rows_finish(const LAS float* st, int lane, const bf16* __restrict__ oi, const float* __restrict__ g, const bf16* __restrict__ z, bf16* __restrict__ y, float* __restrict__ part) {
    const int lr = lane >> 4, cl = lane & 15, c8 = cl * 8;
    const f32x4 g0 = *(const f32x4*)(g + c8), g1 = *(const f32x4*)(g + c8 + 4);
    v4u zz[8], oo[8];
#pragma unroll
    for (int it = 0; it < 8; ++it) { const int row = it * 4 + lr; zz[it] = *(const v4u*)(z + (size_t)row * NP + c8); if (NORM) oo[it] = *(const v4u*)(oi + (size_t)row * 768 + c8); }
#pragma unroll
    for (int it = 0; it < 8; ++it) { const int row = it * 4 + lr;
        const f32x4 a = *(const LAS f32x4*)(st + row * 128 + stg_pos(2 * cl, row) * 4), b = *(const LAS f32x4*)(st + row * 128 + stg_pos(2 * cl + 1, row) * 4);
        float v[8] = {a[0], a[1], a[2], a[3], b[0], b[1], b[2], b[3]};
        if (NORM) { float f[8]; unpack8(oo[it], f);
#pragma unroll
            for (int e = 0; e < 8; ++e) v[e] += f[e]; }
        float ss = 0.f;
#pragma unroll
        for (int e = 0; e < 8; ++e) ss += v[e] * v[e];
        ss += __shfl_xor(ss, 1); ss += __shfl_xor(ss, 2); ss += __shfl_xor(ss, 4); ss += __shfl_xor(ss, 8);
        float rs = 1.f;
        if (NORM) rs = __builtin_amdgcn_rsqf(ss * (1.f / 128.f) + EPS); else if (cl == 0) atomicAdd(part + row, ss);
        float zf[8]; unpack8(zz[it], zf);
        if (!MK_SILU_IN_EPI) {
#pragma unroll
            for (int e = 0; e < 8; ++e) zf[e] = silu_fast(zf[e]); }
        v4u w; w.x = pk2a(v[0] * rs * g0[0] * zf[0], v[1] * rs * g0[1] * zf[1]); w.y = pk2a(v[2] * rs * g0[2] * zf[2], v[3] * rs * g0[3] * zf[3]);
        w.z = pk2a(v[4] * rs * g1[0] * zf[4], v[5] * rs * g1[1] * zf[5]); w.w = pk2a(v[6] * rs * g1[2] * zf[6], v[7] * rs * g1[3] * zf[7]);
        if (MK_FUSE_Y) st_wt16(y + (size_t)row * DM + c8, w); else *(v4u*)(y + (size_t)row * DM + c8) = w; }
}

__device__ __forceinline__ const float* ld_in(int i);
namespace mla {
constexpr int NW = 8, QBLK = 32, KVBLK = 64;
constexpr int SHM_V = 16384, SHM_KN = 16384, SHM_KR = 8192;
constexpr int OFF_V = 0, OFF_KN = 2 * SHM_V, OFF_KR = OFF_KN + 2 * SHM_KN, OFF_WS = OFF_KR + 2 * SHM_KR, OFF_QR = OFF_WS + NW * 64 * 4, ATTN_LDS = OFF_QR + NW * 4096;
constexpr float THR = 8.f;
#define KSWZ(row, colB) ((row) * 256 + ((colB) ^ (((row) & 7) << 4)))
#define KRSWZ(row, colB) ((row) * 128 + ((colB) ^ ((((row) >> 1) & 7) << 4)))
#define SBAR() __builtin_amdgcn_sched_barrier(0)
__device__ __forceinline__ int crow(int r, int hi) { return (r & 3) + 8 * (r >> 2) + 4 * hi; }
__device__ __forceinline__ unsigned cvtpk(float lo, float hi) { unsigned r; asm volatile("v_cvt_pk_bf16_f32 %0, %1, %2" : "=v"(r) : "v"(lo), "v"(hi)); return r; }

__device__ __forceinline__ void partialSM(f32x16& p0, f32x16& p1, float& m_reg, float& mn, float& alpha) {
  float pmax = p0[0];
#pragma unroll
  for (int r = 1; r < 16; ++r) pmax = fmaxf(pmax, p0[r]);
#pragma unroll
  for (int r = 0; r < 16; ++r) pmax = fmaxf(pmax, p1[r]);
  { auto rr = __builtin_amdgcn_permlane32_swap(__float_as_uint(pmax), __float_as_uint(pmax), false, false);
    pmax = fmaxf(__uint_as_float(rr[0]), __uint_as_float(rr[1])); }
  if (__builtin_expect(__all(pmax - m_reg <= THR), 1)) { mn = m_reg; alpha = 1.f; }
  else { mn = fmaxf(m_reg, pmax); alpha = __builtin_amdgcn_exp2f(m_reg - mn); m_reg = mn; }
#pragma unroll
  for (int r = 0; r < 16; ++r) p0[r] = p0[r] - mn;
#pragma unroll
  for (int r = 0; r < 16; ++r) p1[r] = p1[r] - mn;
#pragma unroll
  for (int r = 0; r < 16; ++r) p0[r] = __builtin_amdgcn_exp2f(p0[r]);
}
__device__ __forceinline__ void finishSM(f32x16& p0, f32x16& p1, float alpha, float& l_reg, bf16x8& pa0, bf16x8& pa1, bf16x8& pa2, bf16x8& pa3) {
#pragma unroll
  for (int r = 0; r < 16; ++r) p1[r] = __builtin_amdgcn_exp2f(p1[r]);
  float ps = 0;
#pragma unroll
  for (int r = 0; r < 16; ++r) ps += p0[r];
#pragma unroll
  for (int r = 0; r < 16; ++r) ps += p1[r];
  { auto rr = __builtin_amdgcn_permlane32_swap(__float_as_uint(ps), __float_as_uint(ps), false, false);
    ps = __uint_as_float(rr[0]) + __uint_as_float(rr[1]); }
  l_reg = l_reg * alpha + ps;
#define PK4(P, BASE, OUT) do { unsigned a0 = cvtpk(P[BASE + 0], P[BASE + 1]), a1 = cvtpk(P[BASE + 2], P[BASE + 3]);   \
    unsigned b0 = cvtpk(P[BASE + 4], P[BASE + 5]), b1 = cvtpk(P[BASE + 6], P[BASE + 7]);                              \
    auto r0 = __builtin_amdgcn_permlane32_swap(a0, b0, false, false); auto r1 = __builtin_amdgcn_permlane32_swap(a1, b1, false, false); \
    v4u w = {r0[0], r1[0], r0[1], r1[1]}; OUT = *reinterpret_cast<bf16x8*>(&w); } while (0)
  PK4(p0, 0, pa0); PK4(p0, 8, pa1); PK4(p1, 0, pa2); PK4(p1, 8, pa3);
#undef PK4
}
__device__ __forceinline__ void qkt(f32x16& p0, f32x16& p1, const char* Kn, const char* Kr, const bf16x8* qr, const char* Qr, int r32, int hi) {
  p0 = f32x16{}; p1 = f32x16{};
  int tn = (hi * 16) ^ ((r32 & 7) << 4), tr = (hi * 16) ^ (((r32 >> 1) & 7) << 4);
  asm volatile("" : "+v"(tn), "+v"(tr));
  const char* knb = Kn + r32 * 256; const char* krb = Kr + r32 * 128; const char* qrb = Qr + r32 * 128;
#pragma unroll
  for (int d0 = 0; d0 < 8; ++d0) { const int off = (d0 * 32) ^ tn;
    const bf16x8 b0 = *reinterpret_cast<const bf16x8*>(knb + off);
    const bf16x8 b1 = *reinterpret_cast<const bf16x8*>(knb + off + 8192);
    p0 = __builtin_amdgcn_mfma_f32_32x32x16_bf16(b0, qr[d0], p0, 0, 0, 0);
    p1 = __builtin_amdgcn_mfma_f32_32x32x16_bf16(b1, qr[d0], p1, 0, 0, 0); }
#pragma unroll
  for (int d0 = 0; d0 < 4; ++d0) { const int off = (d0 * 32) ^ tr;
    const bf16x8 b0 = *reinterpret_cast<const bf16x8*>(krb + off);
    const bf16x8 b1 = *reinterpret_cast<const bf16x8*>(krb + off + 4096);
    const bf16x8 qv = *reinterpret_cast<const bf16x8*>(qrb + off);
    p0 = __builtin_amdgcn_mfma_f32_32x32x16_bf16(b0, qv, p0, 0, 0, 0);
    p1 = __builtin_amdgcn_mfma_f32_32x32x16_bf16(b1, qv, p1, 0, 0, 0); }
}
__device__ __forceinline__ int v_st(int k, int c) { const int kk = (k & ~0xC) | ((k & 4) << 1) | ((k & 8) >> 1); return ((kk >> 3) * 4 + (c >> 5)) * 512 + ((kk & 7) * 32 + (c & 31)) * 2; }
__device__ __forceinline__ int v_rd_base(int lane) { return ((lane & 3) << 3) | (((lane >> 2) & 3) << 6) | (((lane >> 4) & 1) << 5) | (((lane >> 5) & 1) << 8); }
constexpr int v_rd_off(int d0, int ks, int half) { return d0 * 512 + ks * 4096 + half * 2048; }
template <int OFF> __device__ __forceinline__ s16x4 tr_read(int vb) {
  s16x4 r; asm volatile("ds_read_b64_tr_b16 %0, %1 offset:%2" : "=&v"(r) : "v"(vb), "i"(OFF) : "memory"); return r;
}
template <int D0> __device__ __forceinline__ void pv_one(f32x16& od, int vb, bf16x8 pa0, bf16x8 pa1, bf16x8 pa2, bf16x8 pa3) {
  const s16x4 l0 = tr_read<v_rd_off(D0, 0, 0)>(vb), h0 = tr_read<v_rd_off(D0, 0, 1)>(vb), l1 = tr_read<v_rd_off(D0, 1, 0)>(vb), h1 = tr_read<v_rd_off(D0, 1, 1)>(vb);
  const s16x4 l2 = tr_read<v_rd_off(D0, 2, 0)>(vb), h2 = tr_read<v_rd_off(D0, 2, 1)>(vb), l3 = tr_read<v_rd_off(D0, 3, 0)>(vb), h3 = tr_read<v_rd_off(D0, 3, 1)>(vb);
  asm volatile("s_waitcnt lgkmcnt(0)" ::: "memory"); SBAR();
  __builtin_amdgcn_s_setprio(1);
#define PK(L, H) (bf16x8){L[0], L[1], L[2], L[3], H[0], H[1], H[2], H[3]}
  od = __builtin_amdgcn_mfma_f32_32x32x16_bf16(pa0, PK(l0, h0), od, 0, 0, 0);
  od = __builtin_amdgcn_mfma_f32_32x32x16_bf16(pa1, PK(l1, h1), od, 0, 0, 0);
  od = __builtin_amdgcn_mfma_f32_32x32x16_bf16(pa2, PK(l2, h2), od, 0, 0, 0);
  od = __builtin_amdgcn_mfma_f32_32x32x16_bf16(pa3, PK(l3, h3), od, 0, 0, 0);
  __builtin_amdgcn_s_setprio(0);
#undef PK
}
__device__ __forceinline__ void pv_d0(f32x16* o, int vb, bf16x8 pa0, bf16x8 pa1, bf16x8 pa2, bf16x8 pa3) {
  pv_one<0>(o[0], vb, pa0, pa1, pa2, pa3); pv_one<1>(o[1], vb, pa0, pa1, pa2, pa3); pv_one<2>(o[2], vb, pa0, pa1, pa2, pa3); pv_one<3>(o[3], vb, pa0, pa1, pa2, pa3);
}

__device__ __forceinline__ void attn_unit(const bf16* __restrict__ Qb, const bf16* __restrict__ Knh, const bf16* __restrict__ Vh, const bf16* __restrict__ Krh,
                                          bf16* __restrict__ Yb, const bf16* __restrict__ Zb, const float* __restrict__ gh, float* __restrict__ part, int seq, char* lds,
                                          int mode_u) {
  int tid_ = threadIdx.x; asm volatile("" : "+v"(tid_));
  const int tid = tid_, wid = tid >> 6, lane = tid & 63, r32 = lane & 31, hi = lane >> 5;
  char* V_lds = lds + OFF_V; char* KN_lds = lds + OFF_KN; char* KR_lds = lds + OFF_KR;
  float* ws = (float*)(lds + OFF_WS) + wid * 64; float* li_l = ws; float* al_l = ws + 32;
  float m_reg = -1e30f, l_reg = 0; f32x16 o[4] = {}; bf16x8 qr[8]; char* QR_lds = lds + OFF_QR + wid * 4096;
  const bf16* Qw = Qb + (long)(wid * QBLK + r32) * NQ + hi * 8;
#pragma unroll
  for (int d0 = 0; d0 < 8; ++d0) qr[d0] = *reinterpret_cast<const bf16x8*>(Qw + d0 * 16);
#pragma unroll
  for (int d0 = 0; d0 < 4; ++d0) *reinterpret_cast<bf16x8*>(QR_lds + KRSWZ(r32, (d0 * 16 + hi * 8) * 2)) = *reinterpret_cast<const bf16x8*>(Qw + 128 + d0 * 16);
  const int sr = tid >> 4, sc = (tid & 15) * 8, vst0 = v_st(sr, sc), vst1 = v_st(32 + sr, sc);
  const int krr = tid >> 3, krc = (tid & 7) * 8;
  const int vb0 = (int)(uintptr_t)V_lds + v_rd_base(lane);
  bf16x8 vs0, vs1, ks0, ks1, kr0;
#define SLOAD(k0) do { vs0 = *reinterpret_cast<const bf16x8*>(&Vh[(long)((k0) + sr) * NKV + sc]); vs1 = *reinterpret_cast<const bf16x8*>(&Vh[(long)((k0) + 32 + sr) * NKV + sc]); \
    ks0 = *reinterpret_cast<const bf16x8*>(&Knh[(long)((k0) + sr) * NKV + sc]); ks1 = *reinterpret_cast<const bf16x8*>(&Knh[(long)((k0) + 32 + sr) * NKV + sc]); \
    kr0 = *reinterpret_cast<const bf16x8*>(&Krh[(long)((k0) + krr) * NP + krc]); } while (0)
#define SWRITE(b) do { *(bf16x8*)(V_lds + (b) * SHM_V + vst0) = vs0; *(bf16x8*)(V_lds + (b) * SHM_V + vst1) = vs1; const int kc = sc * 2;   \
    *(bf16x8*)(KN_lds + (b) * SHM_KN + KSWZ(sr, kc)) = ks0; *(bf16x8*)(KN_lds + (b) * SHM_KN + KSWZ(32 + sr, kc)) = ks1;                       \
    *(bf16x8*)(KR_lds + (b) * SHM_KR + KRSWZ(krr, krc * 2)) = kr0; } while (0)
#define SWAIT() asm volatile("s_waitcnt vmcnt(0)" ::: "memory")
#define RESC(a) do { if (__any((a) < 1.f)) { if (hi == 0) al_l[r32] = (a); asm volatile("s_waitcnt lgkmcnt(0)" ::: "memory"); \
    _Pragma("unroll") for (int d = 0; d < 4; ++d) _Pragma("unroll") for (int r = 0; r < 16; ++r) o[d][r] *= al_l[crow(r, hi)]; } } while (0)
  f32x16 pA0, pA1, pB0, pB1; float mnA, mnB, alA, alB; bf16x8 pa0, pa1, pa2, pa3; const int NT = seq / KVBLK;
  SLOAD(0); SWAIT(); SWRITE(0); __syncthreads();
  qkt(pA0, pA1, KN_lds, KR_lds, qr, QR_lds, r32, hi); partialSM(pA0, pA1, m_reg, mnA, alA);
  SLOAD(KVBLK);
  SWAIT(); SWRITE(1); __syncthreads();
  for (int j = 1; j + 1 < NT; j += 2) {
    SBAR(); qkt(pB0, pB1, KN_lds + SHM_KN, KR_lds + SHM_KR, qr, QR_lds, r32, hi);
    finishSM(pA0, pA1, alA, l_reg, pa0, pa1, pa2, pa3); SBAR();
    SLOAD((j + 1) * KVBLK); SBAR();
    pv_d0(o, vb0, pa0, pa1, pa2, pa3); partialSM(pB0, pB1, m_reg, mnB, alB);
    __syncthreads(); SWAIT(); SWRITE(0);
    RESC(alB); __syncthreads();
    SBAR(); qkt(pA0, pA1, KN_lds, KR_lds, qr, QR_lds, r32, hi);
    finishSM(pB0, pB1, alB, l_reg, pa0, pa1, pa2, pa3); SBAR();
    SLOAD((j + 2) * KVBLK); SBAR();
    pv_d0(o, vb0 + SHM_V, pa0, pa1, pa2, pa3); partialSM(pA0, pA1, m_reg, mnA, alA);
    __syncthreads(); SWAIT(); SWRITE(1);
    RESC(alA); __syncthreads();
  }
  SBAR(); qkt(pB0, pB1, KN_lds + SHM_KN, KR_lds + SHM_KR, qr, QR_lds, r32, hi);
  finishSM(pA0, pA1, alA, l_reg, pa0, pa1, pa2, pa3); SBAR();
  pv_d0(o, vb0, pa0, pa1, pa2, pa3); partialSM(pB0, pB1, m_reg, mnB, alB);
  __syncthreads(); RESC(alB);
  finishSM(pB0, pB1, alB, l_reg, pa0, pa1, pa2, pa3); SBAR();
  pv_d0(o, vb0 + SHM_V, pa0, pa1, pa2, pa3);
  const int mu_ = __builtin_amdgcn_readfirstlane(mode_u);
  const int mode = mu_ & 15;
  unsigned long long* po = nullptr; float* pml = nullptr; unsigned* flag = nullptr;
  if (mode != 0) { unsigned char* wsb = (unsigned char*)::ld_in(22); const int un = (mu_ >> 4) & 255, fs = mu_ >> 12;
    po = (unsigned long long*)(wsb + WS_PO) + (size_t)un * 8192; pml = (float*)(wsb + WS_PML) + (size_t)un * 512; flag = (unsigned*)(wsb + WS_CTL) + 16384 + 2048 * fs + un * 8; }
  if (mode == 2) {
    unsigned long long* pw = po + (wid * 16) * 64 + lane;
#pragma unroll
    for (int d0 = 0; d0 < 4; ++d0)
#pragma unroll
      for (int q = 0; q < 4; ++q) { const unsigned long long w = (unsigned long long)pk2(o[d0][4 * q], o[d0][4 * q + 1]) | ((unsigned long long)pk2(o[d0][4 * q + 2], o[d0][4 * q + 3]) << 32);
        __hip_atomic_store(pw + (d0 * 4 + q) * 64, w, __ATOMIC_RELAXED, __HIP_MEMORY_SCOPE_AGENT); }
    if (hi == 0) { __hip_atomic_store(pml + (wid * QBLK + r32) * 2, m_reg, __ATOMIC_RELAXED, __HIP_MEMORY_SCOPE_AGENT); __hip_atomic_store(pml + (wid * QBLK + r32) * 2 + 1, l_reg, __ATOMIC_RELAXED, __HIP_MEMORY_SCOPE_AGENT); }
    asm volatile("s_waitcnt vmcnt(0)" ::: "memory");
    if (lane == 0) __hip_atomic_fetch_add(flag + wid, 1u, __ATOMIC_RELAXED, __HIP_MEMORY_SCOPE_AGENT);
    __syncthreads();
    return;
  }
  if (mode == 1) {
    { unsigned sp = 0u; while (__hip_atomic_load(flag + wid, __ATOMIC_RELAXED, __HIP_MEMORY_SCOPE_AGENT) == 0u) { __builtin_amdgcn_s_sleep(2); if (++sp > (1u << 22)) break; } }
    asm volatile("" ::: "memory");
    const unsigned long long* pw = po + (wid * 16) * 64 + lane;
    unsigned long long pq[16];
#pragma unroll
    for (int k = 0; k < 16; ++k) pq[k] = __hip_atomic_load(pw + k * 64, __ATOMIC_RELAXED, __HIP_MEMORY_SCOPE_AGENT);
    const float pm = __hip_atomic_load(pml + (wid * QBLK + r32) * 2, __ATOMIC_RELAXED, __HIP_MEMORY_SCOPE_AGENT), pl = __hip_atomic_load(pml + (wid * QBLK + r32) * 2 + 1, __ATOMIC_RELAXED, __HIP_MEMORY_SCOPE_AGENT);
    const float mt = fmaxf(m_reg, pm), fa0 = __builtin_amdgcn_exp2f(m_reg - mt), fb0 = __builtin_amdgcn_exp2f(pm - mt), inv = __builtin_amdgcn_rcpf(l_reg * fa0 + pl * fb0);
    if (hi == 0) { li_l[r32] = fa0 * inv; al_l[r32] = fb0 * inv; } asm volatile("s_waitcnt lgkmcnt(0)" ::: "memory");
    float ra[16], rb[16];
#pragma unroll
    for (int r = 0; r < 16; ++r) { ra[r] = li_l[crow(r, hi)]; rb[r] = al_l[crow(r, hi)]; }
#pragma unroll
    for (int d0 = 0; d0 < 4; ++d0)
#pragma unroll
      for (int q = 0; q < 4; ++q) { const unsigned lo = (unsigned)pq[d0 * 4 + q], hi2 = (unsigned)(pq[d0 * 4 + q] >> 32);
        o[d0][4 * q] = o[d0][4 * q] * ra[4 * q] + bflo(lo) * rb[4 * q]; o[d0][4 * q + 1] = o[d0][4 * q + 1] * ra[4 * q + 1] + bfhi(lo) * rb[4 * q + 1];
        o[d0][4 * q + 2] = o[d0][4 * q + 2] * ra[4 * q + 2] + bflo(hi2) * rb[4 * q + 2]; o[d0][4 * q + 3] = o[d0][4 * q + 3] * ra[4 * q + 3] + bfhi(hi2) * rb[4 * q + 3]; }
  } else {
  if (hi == 0) li_l[r32] = l_reg; asm volatile("s_waitcnt lgkmcnt(0)" ::: "memory");
  float rli[16];
#pragma unroll
  for (int r = 0; r < 16; ++r) rli[r] = __builtin_amdgcn_rcpf(li_l[crow(r, hi)]);
#pragma unroll
  for (int d0 = 0; d0 < 4; ++d0)
#pragma unroll
    for (int r = 0; r < 16; ++r) o[d0][r] *= rli[r];
  }
  __syncthreads();
  { LAS float* st = (LAS float*)(LAS unsigned char*)(lds + wid * 16384);
    stage_write(st, o, r32, hi);
    asm volatile("s_waitcnt lgkmcnt(0)" ::: "memory");
    rows_finish<false>(st, lane, nullptr, gh, Zb + (long)(wid * QBLK) * NP, Yb + (long)(wid * QBLK) * DM, part + wid * QBLK);
    if (MK_FUSE_Y) {
      asm volatile("s_waitcnt vmcnt(0)" ::: "memory");
      if (lane == 0) { const int un = (mu_ >> 4) & 255, fs = mu_ >> 12, pm = ((un >> 3) / 6) * 8 + (un & 7);
        (void)__hip_atomic_fetch_add((unsigned*)((unsigned char*)::ld_in(22) + WS_CTL) + CW_YREADY + 2048 * fs + 64 * pm, 1u, __ATOMIC_RELAXED, __HIP_MEMORY_SCOPE_AGENT); } } }
  __syncthreads();
#undef SLOAD
#undef SWRITE
#undef SWAIT
#undef RESC
}
#undef SBAR
}
struct Frame {
    LAS unsigned char* lds; char* ldsg;
    int tid, lane, wave, vcu, G;
    float* out; unsigned char* ws;
};
__device__ __forceinline__ const float* ld_in(int i) {
    const __attribute__((address_space(4))) char* ka = (const __attribute__((address_space(4))) char*)__builtin_amdgcn_kernarg_segment_ptr();
    asm volatile("" : "+s"(i));
    const GAS float* p = *(const GAS float* const __attribute__((address_space(4)))*)(ka + 8 * i);
    return (const float*)p;
}
#define WSP(T_, off) ((T_*)(F.ws + (off)))

__device__ __forceinline__ void p0_mods(Frame& F, size_t mods_off, int first, int step, int lo, int hi) {
    LAS float* sc = (LAS float*)F.lds;
    LAS float* part = (LAS float*)(F.lds + 32768);
    const float* c = ld_in(1); const float* aw = ld_in(3); const float* ab = ld_in(4);
    for (int i = F.tid; i < BATCH * DM; i += NTHR) { const float v = c[i]; sc[i] = v / (1.f + __expf(-v)); }
    __syncthreads();
    const int n_it = hi - lo, i0 = lo + (int)(((long)n_it * first) / step), i1 = lo + (int)(((long)n_it * (first + 1)) / step);
    f32x4 a[4] = {}; int cur = -1; bool bias = false;
#pragma unroll 1
    for (int item = i0; ; ++item) {
        const bool end = item >= i1; const int pair = end ? -1 : (item >> 4);
        if (cur >= 0 && pair != cur) {
            const int l = cur / 24, j0 = (cur % 24) * 256;
#pragma unroll
            for (int b = 0; b < 4; ++b) { *(LAS f32x4*)(part + (F.wave * 4 + b) * 256 + F.lane * 4) = a[b]; a[b] = f32x4{0.f, 0.f, 0.f, 0.f}; }
            __syncthreads();
            for (int o = F.tid; o < 1024; o += NTHR) { const int b = o >> 8, col = o & 255; float s = 0.f;
#pragma unroll
                for (int wv2 = 0; wv2 < 8; ++wv2) s += part[(wv2 * 4 + b) * 256 + col];
                if (bias) s += ab[l * 3 * DM + j0 + col];
                atomicAdd(WSP(float, mods_off) + ((size_t)l * BATCH + b) * 3 * DM + j0 + col, s); }
            __syncthreads();
            bias = false;
        }
        if (end) break;
        cur = pair;
        const int ks = item & 15, cb = pair % 24, l = pair / 24, j0 = cb * 256, kb = ks * 128 + F.wave * 16;
        if (ks == 0) bias = true;
        const f32x4* w = (const f32x4*)(aw + (size_t)l * DM * 3 * DM + (size_t)kb * 3 * DM + j0) + F.lane;
        f32x4 wv[16];
#pragma unroll
        for (int k = 0; k < 16; ++k) wv[k] = __builtin_nontemporal_load(w + (size_t)k * (3 * DM / 4));
#pragma unroll
        for (int k = 0; k < 16; ++k)
#pragma unroll
            for (int b = 0; b < 4; ++b) a[b] += wv[k] * sc[b * DM + kb + k];
    }
}
__device__ __forceinline__ int kmap_out(int k) { return k < 768 ? k + 768 : (k < 1536 ? k - 768 : k); }
template <int MAP, bool KMAP> __device__ __forceinline__ void p0_transpose_item(const float* W, int K, int N, bf16* WT, const float* kgain, int item, int nblk, int lane, LAS unsigned char* stg) {
    const int kb = item / nblk, nb = item % nblk, k0 = 64 * kb, n0 = 64 * nb, ks0 = KMAP ? kmap_out(k0) : k0;
    const int np = n0 + lane; const int src = MAP == 1 ? map_in(np) : (MAP == 2 ? map_uq(np) : np);
    float v[64];
#pragma unroll
    for (int i = 0; i < 64; ++i) v[i] = src >= 0 ? __builtin_nontemporal_load(W + (size_t)(ks0 + i) * N + src) : 0.f;
    if (kgain) {
        const unsigned gl = __builtin_bit_cast(unsigned, kgain[k0 + lane]);
#pragma unroll
        for (int i = 0; i < 64; ++i) v[i] *= __builtin_bit_cast(float, __builtin_amdgcn_readlane((int)gl, i));
    }
#pragma unroll
    for (int c = 0; c < 8; ++c) { v4u w; w.x = pk2(v[8 * c], v[8 * c + 1]); w.y = pk2(v[8 * c + 2], v[8 * c + 3]); w.z = pk2(v[8 * c + 4], v[8 * c + 5]); w.w = pk2(v[8 * c + 6], v[8 * c + 7]);
        *(LAS v4u*)(stg + lane * 144 + c * 16) = w; }
    LDS_WAIT();
    bf16* obase = WT + (size_t)n0 * K + k0 + (lane & 7) * 8;
#pragma unroll
    for (int j = 0; j < 8; ++j) { const int row = j * 8 + (lane >> 3); const v4u w = *(const LAS v4u*)(stg + row * 144 + (lane & 7) * 16);
        *(GAS v4u*)(obase + (size_t)row * K) = w; }
    LDS_WAIT();
}
#ifndef MK_IDLE_GEMV
#define MK_IDLE_GEMV 160
#endif
#ifndef MK_SPARE_GEMV
#define MK_SPARE_GEMV 128
#endif
constexpr int I_IN = (DM / 64) * (NP / 64), I_OUT = (DM / 64) * (DM / 64), I_UQ = (384 / 64) * (NQ / 64), I_UKV = (256 / 64) * (NKV / 64), I_L = I_IN + I_OUT + I_UQ + I_UKV;
__device__ __forceinline__ void p0_transposes(Frame& F, int gw, int NGW, int lo, int hi) {
    for (int it = lo + gw; it < hi; it += NGW) {
        const int l = it / I_L; int r = it % I_L;
        if (r < I_IN) { p0_transpose_item<1, false>(ld_in(6) + (size_t)l * DM * IN_DIM, DM, IN_DIM, WSP(bf16, WS_WIN) + (size_t)l * NP * DM, nullptr, r, NP / 64, F.lane, F.lds + F.wave * 9216); continue; } r -= I_IN;
        if (r < I_OUT) { p0_transpose_item<0, true>(ld_in(19) + (size_t)l * DM * DM, DM, DM, WSP(bf16, WS_WOUT) + (size_t)l * DM * DM, nullptr, r, DM / 64, F.lane, F.lds + F.wave * 9216); continue; } r -= I_OUT;
        if (r < I_UQ) { p0_transpose_item<2, false>(ld_in(14) + (size_t)l * 384 * 1152, 384, 1152, WSP(bf16, WS_WUQ) + (size_t)l * NQ * 384, ld_in(12) + l * 384, r, NQ / 64, F.lane, F.lds + F.wave * 9216); continue; } r -= I_UQ;
        p0_transpose_item<0, false>(ld_in(15) + (size_t)l * 256 * 1536, 256, 1536, WSP(bf16, WS_WUKV) + (size_t)l * NKV * 256, ld_in(13) + l * 256, r, NKV / 64, F.lane, F.lds + F.wave * 9216);
    }
}
__device__ __forceinline__ void p0_prologue(Frame& F, size_t mods_off, bool defer, unsigned* mods_done) {
    p0_mods(F, mods_off, (int)blockIdx.x, F.G, 0, defer ? 768 - MK_IDLE_GEMV - MK_SPARE_GEMV : 768);
    if (mods_done) { asm volatile("s_waitcnt vmcnt(0)" ::: "memory"); __syncthreads(); if (F.tid == 0) (void)__hip_atomic_fetch_add(mods_done, 1u, __ATOMIC_RELAXED, __HIP_MEMORY_SCOPE_AGENT); }
    p0_transposes(F, F.vcu * NWAVES + F.wave, F.G * NWAVES, 0, DEPTH * I_L);
    const int* pos = (const int*)ld_in(2);
    for (int i = (int)blockIdx.x * NTHR + F.tid; i < T * 32; i += F.G * NTHR) {
        const int t = i >> 5, f = i & 31;
        const float inv = (float)exp2(-(double)f * (13.287712379549449 / 32.0));
        const float ang = (float)pos[t] * inv;
        const double rev = (double)ang * 0.15915494309189535; const float fr = (float)(rev - floor(rev));
        WSP(float, WS_CS)[i] = __builtin_amdgcn_cosf(fr); WSP(float, WS_SN)[i] = __builtin_amdgcn_sinf(fr);
    }
}
__device__ __forceinline__ void p0_deferred(Frame& F, size_t mods_off, int s, int ns) {
    p0_mods(F, mods_off, s, ns, 384, 768);
    p0_transposes(F, s * NWAVES + F.wave, ns * NWAVES, I_L, DEPTH * I_L);
}
__device__ __forceinline__ void modnorm_rows(Frame& F, const float* x, const float* g, const float* mods_l, bf16* H) {
    const int gw = F.vcu * NWAVES + F.wave, NGW = F.G * NWAVES;
    for (int t0 = gw; t0 < T; t0 += 2 * NGW) {
        const int t1 = t0 + NGW; const bool two = t1 < T;
        const GAS f32x4* xr0 = (const GAS f32x4*)(x + (size_t)t0 * DM) + F.lane; const GAS f32x4* xr1 = (const GAS f32x4*)(x + (size_t)(two ? t1 : t0) * DM) + F.lane;
        f32x4 v0[8], v1[8]; float s0 = 0.f, s1 = 0.f;
#pragma unroll
        for (int j = 0; j < 8; ++j) { v0[j] = __builtin_nontemporal_load(xr0 + 64 * j); v1[j] = __builtin_nontemporal_load(xr1 + 64 * j); }
#pragma unroll
        for (int j = 0; j < 8; ++j) { s0 += (v0[j][0] * v0[j][0] + v0[j][1] * v0[j][1]) + (v0[j][2] * v0[j][2] + v0[j][3] * v0[j][3]); s1 += (v1[j][0] * v1[j][0] + v1[j][1] * v1[j][1]) + (v1[j][2] * v1[j][2] + v1[j][3] * v1[j][3]); }
        const float r0 = __builtin_amdgcn_rsqf(wave_sum(s0) * (1.f / DM) + EPS), r1 = __builtin_amdgcn_rsqf(wave_sum(s1) * (1.f / DM) + EPS);
        const float* sh0 = mods_l + (size_t)(t0 / SEQ) * 3 * DM; const float* sh1 = mods_l + (size_t)((two ? t1 : t0) / SEQ) * 3 * DM;
        GAS v2u* o0 = (GAS v2u*)(H + (size_t)t0 * DM) + F.lane; GAS v2u* o1 = (GAS v2u*)(H + (size_t)t1 * DM) + F.lane;
#pragma unroll
        for (int jh = 0; jh < 8; jh += 4) {
            f32x4 gg[4], sv0[4], hv0[4], sv1[4], hv1[4];
#pragma unroll
            for (int j = 0; j < 4; ++j) { const int col = (F.lane + 64 * (jh + j)) * 4; gg[j] = *(const GAS f32x4*)(g + col);
                sv0[j] = *(const GAS f32x4*)(sh0 + DM + col); hv0[j] = *(const GAS f32x4*)(sh0 + col); sv1[j] = *(const GAS f32x4*)(sh1 + DM + col); hv1[j] = *(const GAS f32x4*)(sh1 + col); }
            __builtin_amdgcn_sched_barrier(0);
#pragma unroll
            for (int j = 0; j < 4; ++j) {
                { const f32x4 r = v0[jh + j] * r0 * gg[j] * (sv0[j] + 1.f) + hv0[j]; v2u w; w.x = pk2(r[0], r[1]); w.y = pk2(r[2], r[3]); o0[64 * (jh + j)] = w; }
                if (two) { const f32x4 r = v1[jh + j] * r1 * gg[j] * (sv1[j] + 1.f) + hv1[j]; v2u w; w.x = pk2(r[0], r[1]); w.y = pk2(r[2], r[3]); o1[64 * (jh + j)] = w; } }
        }
    }
}
__device__ __forceinline__ void finalnorm_rows(Frame& F, float* x, const float* g) {
    const int gw = F.vcu * NWAVES + F.wave, NGW = F.G * NWAVES;
    for (int t = gw; t < T; t += NGW) {
        GAS f32x4* xr = (GAS f32x4*)(x + (size_t)t * DM) + F.lane;
        f32x4 v[8]; float s = 0.f;
#pragma unroll
        for (int j = 0; j < 8; ++j) { v[j] = xr[64 * j]; s += (v[j][0] * v[j][0] + v[j][1] * v[j][1]) + (v[j][2] * v[j][2] + v[j][3] * v[j][3]); }
        const float rstd = __builtin_amdgcn_rsqf(wave_sum(s) * (1.f / DM) + EPS);
#pragma unroll
        for (int j = 0; j < 8; ++j) { const f32x4 gg = *(const f32x4*)(g + (F.lane + 64 * j) * 4); xr[64 * j] = v[j] * rstd * gg; }
    }
}
__device__ __forceinline__ void conv_rows(Frame& F, int l) {
    const int gw = F.vcu * NWAVES + F.wave, NGW = F.G * NWAVES;
    const bf16* P = WSP(bf16, WS_PROJ); bf16* Y = WSP(bf16, WS_HY);
    const float* cw = ld_in(17) + l * 3 * 512; const float* cg = ld_in(18) + l * 512;
    const int ch = F.lane * 8;
    float w0[8], w1[8], w2[8], g8[8];
#pragma unroll
    for (int e = 0; e < 8; ++e) { w0[e] = cw[ch + e]; w1[e] = cw[512 + ch + e]; w2[e] = cw[1024 + ch + e]; g8[e] = cg[ch + e]; }
    for (int t0 = 4 * gw; t0 < T; t0 += 4 * NGW) {
        const int s0 = t0 % SEQ; const bf16* p = P + (size_t)t0 * NP;
        v4u cc[6], cx[6], cbv[4], szv[4];
#pragma unroll
        for (int d = 0; d < 6; ++d) { const int ss = s0 + d - 1; const bool ok = ss >= 0 && ss < SEQ; const bf16* q = p + (long)(ok ? d - 1 : 0) * NP;
            cc[d] = *(const v4u*)(q + C_CC + ch); cx[d] = *(const v4u*)(q + C_CX + ch); }
#pragma unroll
        for (int j = 0; j < 4; ++j) { cbv[j] = *(const v4u*)(p + (size_t)j * NP + C_CB + ch); szv[j] = *(const v4u*)(p + (size_t)j * NP + C_Z + 1536 + ch); }
        float u[6][8];
#pragma unroll
        for (int d = 0; d < 6; ++d) { const int ss = s0 + d - 1; const bool ok = ss >= 0 && ss < SEQ; float a[8], b[8]; unpack8(cc[d], a); unpack8(cx[d], b);
#pragma unroll
            for (int e = 0; e < 8; ++e) u[d][e] = ok ? a[e] * b[e] : 0.f; }
#pragma unroll
        for (int j = 0; j < 4; ++j) { float cb[8], sz[8], pre[8]; unpack8(cbv[j], cb); unpack8(szv[j], sz); float ssq = 0.f;
#pragma unroll
            for (int e = 0; e < 8; ++e) { pre[e] = cb[e] * (u[j][e] * w0[e] + u[j + 1][e] * w1[e] + u[j + 2][e] * w2[e]); ssq += pre[e] * pre[e]; }
            const float rstd = __builtin_amdgcn_rsqf(wave_sum(ssq) * (1.f / 512.f) + EPS);
            float r[8];
#pragma unroll
            for (int e = 0; e < 8; ++e) r[e] = pre[e] * rstd * g8[e] * (MK_SILU_IN_EPI ? sz[e] : silu_fast(sz[e]));
            v4u w; w.x = pk2(r[0], r[1]); w.y = pk2(r[2], r[3]); w.z = pk2(r[4], r[5]); w.w = pk2(r[6], r[7]);
            *(v4u*)(Y + (size_t)(t0 + j) * DM + 1536 + ch) = w; }
    }
}
__device__ __forceinline__ void mlaout_rows(Frame& F, int l) {
    const int gw = F.vcu * NWAVES + F.wave, NGW = F.G * NWAVES;
    const bf16* P = WSP(bf16, WS_PROJ); bf16* Y = WSP(bf16, WS_HY); const float* O = WSP(float, WS_OMLA); const float* g = ld_in(16) + l * 768;
    for (int t = gw; t < T; t += NGW) {
        f32x4 v[3]; float s = 0.f;
#pragma unroll
        for (int j = 0; j < 3; ++j) { v[j] = *(const f32x4*)(O + (size_t)t * 768 + (F.lane + 64 * j) * 4); s += (v[j][0] * v[j][0] + v[j][1] * v[j][1]) + (v[j][2] * v[j][2] + v[j][3] * v[j][3]); }
        const float rstd = __builtin_amdgcn_rsqf(wave_sum(s) * (1.f / 768.f) + EPS);
#pragma unroll
        for (int j = 0; j < 3; ++j) { const int col = (F.lane + 64 * j) * 4; const f32x4 gg = *(const f32x4*)(g + col);
            const v2u zw = *(const v2u*)(P + (size_t)t * NP + C_Z + 768 + col);
            const f32x4 r = v[j] * rstd * gg; v2u w; w.x = pk2(r[0] * bflo(zw.x), r[1] * bfhi(zw.x)); w.y = pk2(r[2] * bflo(zw.y), r[3] * bfhi(zw.y));
            *(v2u*)(Y + (size_t)t * DM + col) = w; }
    }
}


template <int KS> __device__ __forceinline__ f32x16 tile_mm(const LAS bf16* A, const LAS bf16* Bt, int r, int hh, f32x16 acc) {
#pragma unroll
    for (int s = 0; s < KS; ++s) {
        const bf16x8 a = *(const LAS bf16x8*)(A + r * 72 + 16 * s + 8 * hh), b = *(const LAS bf16x8*)(Bt + r * 72 + 16 * s + 8 * hh);
        acc = __builtin_amdgcn_mfma_f32_32x32x16_bf16(a, b, acc, 0, 0, 0);
    }
    return acc;
}
__device__ __forceinline__ float logsig16(float a) { return (fminf(a, 0.f) - __logf(1.f + __expf(-fabsf(a)))) * (1.f / 16.f); }
__device__ __forceinline__ void gla_a_item(Frame& F, int l, int item) {
    const int h = item % 6, bn = item / 6, t0 = bn * 64;
    const int tid = F.tid, lane = F.lane, wave = F.wave;
    LAS unsigned char* L = F.lds;
    LAS bf16* QB = (LAS bf16*)(L);
    LAS bf16* KB = (LAS bf16*)(L + 9216);
    LAS bf16* Mm = (LAS bf16*)(L);
    LAS bf16* VT = (LAS bf16*)(L + 18432);
    LAS float* LR = (LAS float*)(L + 36864);
    LAS float* WG = (LAS float*)(L + 36864 + 8192);
    LAS float* BG = (LAS float*)(L + 36864 + 16384);
    LAS bf16* KDT = (LAS bf16*)(L + 36864);
    LAS float* LA = (LAS float*)(L + 55296);
    LAS float* SEGT = (LAS float*)(L + 88576);
    LAS bf16* QF = (LAS bf16*)(L + 90624);
    LAS bf16* KF = (LAS bf16*)(L + 90624 + 18432);
    const bf16* P = WSP(bf16, WS_PROJ) + (size_t)t0 * NP;
    LAS bf16* LRB = (LAS bf16*)(L + 36864);
    LAS bf16* WGT = (LAS bf16*)(L + 36864 + 5120);
    v4u gq_, gk_, gv0_, gv1_, glr_ = {0u, 0u, 0u, 0u}; float gw_[8] = {0.f, 0.f, 0.f, 0.f, 0.f, 0.f, 0.f, 0.f}, gb_ = 0.f;
    { const int r = tid >> 3, c8 = (tid & 7) * 8;
      gq_ = *(const GAS v4u*)(P + (size_t)r * NP + C_GQ + h * 64 + c8); gk_ = *(const GAS v4u*)(P + (size_t)r * NP + C_GK + h * 64 + c8); }
    { const int r = tid & 63, c8 = (tid >> 6) * 8;
      gv0_ = *(const GAS v4u*)(P + (size_t)r * NP + C_GV + h * 128 + c8); gv1_ = *(const GAS v4u*)(P + (size_t)r * NP + C_GV + h * 128 + c8 + 64); }
    if (tid < 256) { const int r = tid >> 2, c8 = (tid & 3) * 8; glr_ = *(const GAS v4u*)(P + (size_t)r * NP + C_LR + c8); }
    else { const int t2 = tid - 256, dir = t2 >> 7, dk = (t2 >> 1) & 63, half = t2 & 1; const float* wgf_ = ld_in(7); const float* wgb_ = ld_in(9);
        const float* wsrc = (dir ? wgb_ : wgf_) + (size_t)l * 16 * 384 + (size_t)(8 * half) * 384 + h * 64 + dk;
#pragma unroll
        for (int j = 0; j < 8; ++j) gw_[j] = wsrc[j * 384]; }
    if (tid < 128) { const int dir = tid >> 6, dk = tid & 63; const float* bgf_ = ld_in(8); const float* bgb_ = ld_in(10); gb_ = (dir ? bgb_ : bgf_)[l * 384 + h * 64 + dk]; }
    __builtin_amdgcn_sched_barrier(0);
    { const int r = tid >> 3, c8 = (tid & 7) * 8; *(LAS v4u*)(QB + r * 72 + c8) = gq_; *(LAS v4u*)(KB + r * 72 + c8) = gk_; }
#pragma unroll
    for (int i = 0; i < 2; ++i) { const int idx = tid + i * 512, r = idx & 63, c8 = (idx >> 6) * 8;
        const v4u raw = i ? gv1_ : gv0_;
        VT[(c8 + 0) * 72 + r] = (unsigned short)(raw.x & 0xffffu); VT[(c8 + 1) * 72 + r] = (unsigned short)(raw.x >> 16);
        VT[(c8 + 2) * 72 + r] = (unsigned short)(raw.y & 0xffffu); VT[(c8 + 3) * 72 + r] = (unsigned short)(raw.y >> 16);
        VT[(c8 + 4) * 72 + r] = (unsigned short)(raw.z & 0xffffu); VT[(c8 + 5) * 72 + r] = (unsigned short)(raw.z >> 16);
        VT[(c8 + 6) * 72 + r] = (unsigned short)(raw.w & 0xffffu); VT[(c8 + 7) * 72 + r] = (unsigned short)(raw.w >> 16); }
    if (tid < 256) { const int r = tid >> 2, c8 = (tid & 3) * 8; *(LAS v4u*)(LRB + r * 40 + c8) = glr_; }
    else { const int t2 = tid - 256, dir = t2 >> 7, dk = (t2 >> 1) & 63, half = t2 & 1;
        *(LAS v4u*)(WGT + (dir * 64 + dk) * 24 + half * 8) = (v4u){pk2(gw_[0], gw_[1]), pk2(gw_[2], gw_[3]), pk2(gw_[4], gw_[5]), pk2(gw_[6], gw_[7])}; }
    if (tid < 128) { const int dir = tid >> 6, dk = tid & 63; BG[dir * 64 + dk] = gb_; }
    LDS_WAIT(); __syncthreads();
    { const int r1 = lane & 31, h1 = lane >> 5, dir = wave >> 2, tb = (wave >> 1) & 1, db = wave & 1;
      const bf16x8 a = *(const LAS bf16x8*)(LRB + (tb * 32 + r1) * 40 + dir * 16 + 8 * h1), b2 = *(const LAS bf16x8*)(WGT + (dir * 64 + db * 32 + r1) * 24 + 8 * h1);
      f32x16 lg = {}; lg = __builtin_amdgcn_mfma_f32_32x32x16_bf16(a, b2, lg, 0, 0, 0);
      const float bs = BG[dir * 64 + db * 32 + r1];
#pragma unroll
      for (int reg = 0; reg < 16; ++reg) { const int tok = tb * 32 + (reg & 3) + 8 * (reg >> 2) + 4 * h1; LA[(dir * 64 + tok) * 65 + db * 32 + r1] = logsig16(lg[reg] + bs); } }
    LDS_WAIT(); __syncthreads();
    const int cdir = (tid >> 6) & 1, cdk = tid & 63, seg = tid >> 7;
    float pb[16];
#pragma unroll
    for (int i = 0; i < 16; ++i) pb[i] = LA[(cdir * 64 + seg * 16 + i) * 65 + cdk];
    if (cdir == 0) {
#pragma unroll
        for (int i = 1; i < 16; ++i) pb[i] += pb[i - 1];
    } else {
#pragma unroll
        for (int i = 14; i >= 0; --i) pb[i] += pb[i + 1];
    }
    SEGT[(cdir * 4 + seg) * 64 + cdk] = cdir == 0 ? pb[15] : pb[0];
    LDS_WAIT(); __syncthreads();
    { float offv = 0.f, tot = 0.f;
#pragma unroll
      for (int s2 = 0; s2 < 4; ++s2) { const float sv = SEGT[(cdir * 4 + s2) * 64 + cdk]; tot += sv; if (cdir == 0 ? (s2 < seg) : (s2 > seg)) offv += sv; }
      bf16* QD = WSP(bf16, WS_QDEC) + (size_t)cdir * T * 384 + (size_t)t0 * 384 + h * 64 + cdk;
      unsigned kd[8]; const float et = __expf(tot);
#pragma unroll
      for (int i = 0; i < 16; i += 2) { float kdf[2];
#pragma unroll
          for (int u = 0; u < 2; ++u) { const int tok = seg * 16 + i + u; const float bv = pb[i + u] + offv;
              const float q = bf2f(QB[tok * 72 + cdk]), k = bf2f(KB[tok * 72 + cdk]);
              const float e1 = __expf(bv), e2 = __builtin_amdgcn_rcpf(e1);
              const unsigned w = pk2(q * 0.125f * e1, k * e2);
              QF[(cdir * 64 + tok) * 72 + cdk] = (unsigned short)(w & 0xffffu); KF[(cdir * 64 + tok) * 72 + cdk] = (unsigned short)(w >> 16); QD[(size_t)tok * 384] = (unsigned short)(w & 0xffffu);
              kdf[u] = k * (et * e2); }
          kd[i >> 1] = pk2(kdf[0], kdf[1]);
          if ((i & 3) == 2) __builtin_amdgcn_sched_barrier(0); }
      *(LAS v4u*)(KDT + (cdir * 64 + cdk) * 72 + seg * 16) = (v4u){kd[0], kd[1], kd[2], kd[3]};
      *(LAS v4u*)(KDT + (cdir * 64 + cdk) * 72 + seg * 16 + 8) = (v4u){kd[4], kd[5], kd[6], kd[7]};
      if (seg == 0) WSP(float, WS_DECAY)[((size_t)item * 2 + cdir) * 64 + cdk] = et; }
    LDS_WAIT(); __syncthreads();
    const int r = lane & 31, hh = lane >> 5;
    if (wave < 4) {
        const int pb2 = wave >> 1, jb = wave & 1; f32x16 sf = {}, sb = {};
        if (pb2 >= jb) sf = tile_mm<4>(QF + (0 * 64 + pb2 * 32) * 72, KF + (0 * 64 + jb * 32) * 72, r, hh, sf);
        if (pb2 <= jb) sb = tile_mm<4>(QF + (1 * 64 + pb2 * 32) * 72, KF + (1 * 64 + jb * 32) * 72, r, hh, sb);
#pragma unroll
        for (int reg = 0; reg < 16; ++reg) { const int p = (reg & 3) + 8 * (reg >> 2) + 4 * hh; float v;
            if (pb2 > jb) v = sf[reg]; else if (pb2 < jb) v = sb[reg]; else v = (r <= p) ? sf[reg] : sb[reg];
            Mm[(pb2 * 32 + p) * 72 + jb * 32 + r] = (unsigned short)f2bf(v); }
    } else {
        const int dvb = wave - 4; bf16* KV = WSP(bf16, WS_KVC) + (size_t)item * 2 * 8192;
#pragma unroll
        for (int dir = 0; dir < 2; ++dir)
#pragma unroll
            for (int dkb = 0; dkb < 2; ++dkb) { f32x16 a = {}; a = tile_mm<4>(VT + (dvb * 32) * 72, KDT + (dir * 64 + dkb * 32) * 72, r, hh, a);
#pragma unroll
                for (int reg = 0; reg < 16; ++reg) { const int dv = dvb * 32 + (reg & 3) + 8 * (reg >> 2) + 4 * hh; KV[(size_t)dir * 8192 + dv * 64 + dkb * 32 + r] = (unsigned short)f2bf(a[reg]); } }
    }
    LDS_WAIT(); __syncthreads();
    { const int pb2 = wave >> 2, dvb = wave & 3; f32x16 a = {}; a = tile_mm<4>(Mm + (pb2 * 32) * 72, VT + (dvb * 32) * 72, r, hh, a);
      bf16* OI = WSP(bf16, WS_OINTRA) + (size_t)(t0 + pb2 * 32) * 768 + h * 128 + dvb * 32 + r;
#pragma unroll
      for (int reg = 0; reg < 16; ++reg) { const int p = (reg & 3) + 8 * (reg >> 2) + 4 * hh; OI[(size_t)p * 768] = (unsigned short)f2bf(a[reg]); } }
    __syncthreads();
}
#ifndef MK_SCAN_GS
#define MK_SCAN_GS 16
#endif
__device__ __forceinline__ void gla_scan_witem(Frame& F, int item) {
    const int slice = item & 31, dir = (item >> 5) & 1, bh = item >> 6, b = bh / 6, h = bh % 6;
    const int e = slice * 256 + F.lane * 4, dk = e & 63;
    const size_t it0 = (size_t)((b * 32 + (dir ? 31 : 0)) * 6 + h) * 2 + dir; const long stp = dir ? -12 : 12;
    const bf16* KV = WSP(bf16, WS_KVC) + it0 * 8192 + e; const float* DC = WSP(float, WS_DECAY) + it0 * 64 + dk; bf16* ST = WSP(bf16, WS_ST) + it0 * 8192 + e;
    f32x4 st = {0.f, 0.f, 0.f, 0.f};
#pragma unroll
    for (int g = 0; g < 32 / MK_SCAN_GS; ++g) {
        v2u kw[MK_SCAN_GS]; f32x4 dc[MK_SCAN_GS];
#pragma unroll
        for (int j = 0; j < MK_SCAN_GS; ++j) { const long o = (long)(g * MK_SCAN_GS + j) * stp; kw[j] = *(const GAS v2u*)(KV + o * 8192); dc[j] = *(const GAS f32x4*)(DC + o * 64); }
#pragma unroll
        for (int j = 0; j < MK_SCAN_GS; ++j) { const long o = (long)(g * MK_SCAN_GS + j) * stp;
            const f32x4 kv = {bflo(kw[j].x), bfhi(kw[j].x), bflo(kw[j].y), bfhi(kw[j].y)};
            v2u w; w.x = pk2(st[0], st[1]); w.y = pk2(st[2], st[3]); *(GAS v2u*)(ST + o * 8192) = w;
            st = dc[j] * st + kv; }
    }
}
#ifndef MK_GC_NB
#define MK_GC_NB 2
#endif
__device__ __forceinline__ void gla_c_task(Frame& F, int l, int task) {
    const int item = task >> 1, half = task & 1, h = item % 6, bn = item / 6, tk0 = bn * 64 + half * 32;
    const int r = F.lane & 31, hh = F.lane >> 5;
    const bf16* QD = WSP(bf16, WS_QDEC); const bf16* ST = WSP(bf16, WS_ST) + (size_t)item * 2 * 8192;
    bf16x8 af[2][4];
#pragma unroll
    for (int dir = 0; dir < 2; ++dir)
#pragma unroll
        for (int s = 0; s < 4; ++s) af[dir][s] = *(const bf16x8*)(QD + (size_t)dir * T * 384 + (size_t)(tk0 + r) * 384 + h * 64 + 16 * s + 8 * hh);
    LAS float* st = (LAS float*)(F.lds + F.wave * 16384);
    bf16x8 bq[MK_GC_NB][2][4];
#define GC_LOAD(i_, dvb_) do { _Pragma("unroll") for (int dir = 0; dir < 2; ++dir) _Pragma("unroll") for (int s = 0; s < 4; ++s) \
        bq[i_][dir][s] = *(const GAS bf16x8*)(ST + (size_t)dir * 8192 + ((dvb_) * 32 + r) * 64 + 16 * s + 8 * hh); } while (0)
#define GC_MMA(i_, dvb_) do { f32x16 acc = {}; _Pragma("unroll") for (int dir = 0; dir < 2; ++dir) _Pragma("unroll") for (int s = 0; s < 4; ++s) \
        acc = __builtin_amdgcn_mfma_f32_32x32x16_bf16(af[dir][s], bq[i_][dir][s], acc, 0, 0, 0); stage_write1(st, acc, dvb_, r, hh); } while (0)
#define GC_SB() __builtin_amdgcn_sched_barrier(0)
#if MK_GC_NB == 4
    GC_LOAD(0, 0); GC_LOAD(1, 1); GC_LOAD(2, 2); GC_LOAD(3, 3); GC_SB();
    GC_MMA(0, 0); GC_MMA(1, 1); GC_MMA(2, 2); GC_MMA(3, 3);
#elif MK_GC_NB == 3
    GC_LOAD(0, 0); GC_LOAD(1, 1); GC_LOAD(2, 2); GC_SB();
    GC_MMA(0, 0); GC_SB(); GC_LOAD(0, 3); GC_SB();
    GC_MMA(1, 1); GC_MMA(2, 2); GC_MMA(0, 3);
#else
    GC_LOAD(0, 0); GC_LOAD(1, 1); GC_SB();
    GC_MMA(0, 0); GC_SB(); GC_LOAD(0, 2); GC_SB();
    GC_MMA(1, 1); GC_SB(); GC_LOAD(1, 3); GC_SB();
    GC_MMA(0, 2); GC_MMA(1, 3);
#endif
#undef GC_LOAD
#undef GC_MMA
#undef GC_SB
    LDS_WAIT(); asm volatile("" ::: "memory");
    rows_finish<true>(st, F.lane, WSP(bf16, WS_OINTRA) + (size_t)tk0 * 768 + h * 128, ld_in(11) + l * 128, WSP(bf16, WS_PROJ) + (size_t)tk0 * NP + C_Z + h * 128, WSP(bf16, WS_HY) + (size_t)tk0 * DM + 768 + h * 128, nullptr);
    if (MK_FUSE_Y) { asm volatile("s_waitcnt vmcnt(0)" ::: "memory");
        if (F.lane == 0) (void)__hip_atomic_fetch_add((unsigned*)(F.ws + WS_CTL) + CW_YREADY + 2048 * (2 * l) + 64 * (tk0 >> 8), 1u, __ATOMIC_RELAXED, __HIP_MEMORY_SCOPE_AGENT); }
    LDS_WAIT(); asm volatile("" ::: "memory");
}

__device__ __forceinline__ void gla_c_round(Frame& F, int l, int base, int n) {
    const int wave = F.wave, lane = F.lane, r = lane & 31, hh = lane >> 5;
    const bool act = wave < n; const int task = base + wave, item = task >> 1, half = task & 1, h = item % 6, bn = item / 6, tk0 = bn * 64 + half * 32;
    LAS unsigned char* tile = F.lds + (wave >> 1) * 32768;
    bf16x8 af[2][4];
    if (act && task < 2 * NITEM) {
        const bf16* ST = WSP(bf16, WS_ST) + (size_t)item * 2 * 8192; const int lp = (wave & 1) * 64 + lane;
        v4u tv[16];
#pragma unroll
        for (int j = 0; j < 16; ++j) tv[j] = *(const v4u*)(ST + (size_t)(lp + 128 * j) * 8);
        const bf16* QD = WSP(bf16, WS_QDEC);
#pragma unroll
        for (int dir = 0; dir < 2; ++dir)
#pragma unroll
            for (int s = 0; s < 4; ++s) af[dir][s] = *(const bf16x8*)(QD + (size_t)dir * T * 384 + (size_t)(tk0 + r) * 384 + h * 64 + 16 * s + 8 * hh);
#pragma unroll
        for (int j = 0; j < 16; ++j) { const int q = lp + 128 * j, row = q >> 3, c = q & 7; *(LAS v4u*)(tile + row * 128 + ((c ^ (row & 7)) << 4)) = tv[j]; }
    }
    LDS_WAIT(); __syncthreads();
    f32x16 acc[4];
    if (act && task < 2 * NITEM) {
#pragma unroll
        for (int dvb = 0; dvb < 4; ++dvb) { acc[dvb] = f32x16{}; const int row = dvb * 32 + r;
#pragma unroll
            for (int dir = 0; dir < 2; ++dir)
#pragma unroll
                for (int s = 0; s < 4; ++s) { const bf16x8 bfr = *(const LAS bf16x8*)(tile + dir * 16384 + row * 128 + (((2 * s + hh) ^ (row & 7)) << 4));
                    acc[dvb] = __builtin_amdgcn_mfma_f32_32x32x16_bf16(af[dir][s], bfr, acc[dvb], 0, 0, 0); } }
    }
    LDS_WAIT(); __syncthreads();
    if (act && task < 2 * NITEM) {
        LAS float* st = (LAS float*)(F.lds + wave * 16384);
        stage_write(st, acc, r, hh);
        LDS_WAIT(); asm volatile("" ::: "memory");
        rows_finish<true>(st, lane, WSP(bf16, WS_OINTRA) + (size_t)tk0 * 768 + h * 128, ld_in(11) + l * 128, WSP(bf16, WS_PROJ) + (size_t)tk0 * NP + C_Z + h * 128, WSP(bf16, WS_HY) + (size_t)tk0 * DM + 768 + h * 128, nullptr);
    }
    LDS_WAIT(); __syncthreads();
}

__device__ __forceinline__ void gla_seq_wg(Frame& F, int l, int bh, int dir) {
    const int b = bh / 6, h = bh % 6, tid = F.tid, lane = F.lane, wave = F.wave, r = lane & 31, hh = lane >> 5;
    LAS unsigned char* L = F.lds;
    LAS bf16* QB = (LAS bf16*)(L);
    LAS bf16* KB = (LAS bf16*)(L + 9216);
    LAS bf16* VT = (LAS bf16*)(L + 18432);
    LAS bf16* QF = (LAS bf16*)(L + 36864);
    LAS bf16* KF = (LAS bf16*)(L + 46080);
    LAS bf16* KDT = (LAS bf16*)(L + 55296);
    LAS bf16* MM = (LAS bf16*)(L + 64512);
    LAS bf16* STT = (LAS bf16*)(L + 73728);
    LAS float* LR = (LAS float*)(L + 92160);
    LAS float* SEGT = (LAS float*)(L + 96256);
    LAS float* DEC = (LAS float*)(L + 98304);
    const bf16* P = WSP(bf16, WS_PROJ) + (size_t)b * SEQ * NP;
    bf16* OD = WSP(bf16, dir ? WS_OINTRA : WS_OMLA) + (size_t)b * SEQ * 768 + h * 128;
    float wgt[16]; { const float* wg = ld_in(dir ? 9 : 7) + (size_t)l * 16 * 384 + h * 64 + lane;
#pragma unroll
        for (int q = 0; q < 16; ++q) wgt[q] = wg[q * 384]; }
    const float bias = ld_in(dir ? 10 : 8)[l * 384 + h * 64 + lane];
    for (int i = tid; i < (73728 + 18432 - 64512) / 4; i += NTHR) ((LAS unsigned*)(L + 64512))[i] = 0u;
    f32x16 sacc = {};
    const int tokb = wave >> 2, dvb = wave & 3;
    v4u pq, pk, pv0, pv1, plr;
    const int qrow = tid >> 3, qc8 = (tid & 7) * 8, vtok = tid & 63, vcb = tid >> 6;
#define GS_PREFETCH(n_) do { const bf16* pc = P + (size_t)((n_) * 64) * NP; \
        pq = *(const v4u*)(pc + (size_t)qrow * NP + C_GQ + h * 64 + qc8); pk = *(const v4u*)(pc + (size_t)qrow * NP + C_GK + h * 64 + qc8); \
        pv0 = *(const v4u*)(pc + (size_t)vtok * NP + C_GV + h * 128 + vcb * 8); pv1 = *(const v4u*)(pc + (size_t)vtok * NP + C_GV + h * 128 + (vcb + 8) * 8); \
        if (tid < 128) plr = *(const v4u*)(pc + (size_t)(tid >> 1) * NP + C_LR + dir * 16 + (tid & 1) * 8); } while (0)
    GS_PREFETCH(dir ? 31 : 0);
    __syncthreads();
#pragma unroll 1
    for (int s = 0; s < 32; ++s) {
        const int n = dir ? 31 - s : s;
#ifdef GS_NOPREFETCH
        GS_PREFETCH(n);
#endif
        *(LAS v4u*)(QB + qrow * 72 + qc8) = pq; *(LAS v4u*)(KB + qrow * 72 + qc8) = pk;
        { const unsigned w0[4] = {pv0.x, pv0.y, pv0.z, pv0.w}, w1[4] = {pv1.x, pv1.y, pv1.z, pv1.w};
#pragma unroll
          for (int e = 0; e < 4; ++e) { VT[(vcb * 8 + 2 * e) * 72 + vtok] = (unsigned short)(w0[e] & 0xffffu); VT[(vcb * 8 + 2 * e + 1) * 72 + vtok] = (unsigned short)(w0[e] >> 16);
              VT[((vcb + 8) * 8 + 2 * e) * 72 + vtok] = (unsigned short)(w1[e] & 0xffffu); VT[((vcb + 8) * 8 + 2 * e + 1) * 72 + vtok] = (unsigned short)(w1[e] >> 16); } }
        if (tid < 128) { float f[8]; unpack8(plr, f);
#pragma unroll
            for (int e = 0; e < 8; ++e) LR[(tid >> 1) * 16 + (tid & 1) * 8 + e] = f[e]; }
#ifndef GS_NOPREFETCH
        if (s + 1 < 32) GS_PREFETCH(dir ? 30 - s : s + 1);
#endif
        LDS_WAIT(); __syncthreads();
        float pb8[8];
#pragma unroll
        for (int i = 0; i < 8; ++i) { const LAS float* lr = LR + (wave * 8 + i) * 16; float a = bias;
#pragma unroll
            for (int q = 0; q < 16; ++q) a += lr[q] * wgt[q];
            pb8[i] = logsig16(a); }
        if (dir == 0) {
#pragma unroll
            for (int i = 1; i < 8; ++i) pb8[i] += pb8[i - 1];
        } else {
#pragma unroll
            for (int i = 6; i >= 0; --i) pb8[i] += pb8[i + 1];
        }
        SEGT[wave * 64 + lane] = dir == 0 ? pb8[7] : pb8[0];
        LDS_WAIT(); __syncthreads();
        { float offv = 0.f, tot = 0.f;
#pragma unroll
          for (int s2 = 0; s2 < 8; ++s2) { const float sv = SEGT[s2 * 64 + lane]; tot += sv; if (dir == 0 ? (s2 < wave) : (s2 > wave)) offv += sv; }
          unsigned kd[4];
#pragma unroll
          for (int i = 0; i < 8; ++i) { const int tok = wave * 8 + i; const float bv = pb8[i] + offv;
              const float q = bf2f(QB[tok * 72 + lane]), k = bf2f(KB[tok * 72 + lane]);
              QF[tok * 72 + lane] = (unsigned short)f2bf(q * 0.125f * __expf(bv)); KF[tok * 72 + lane] = (unsigned short)f2bf(k * __expf(-bv));
              const unsigned kdv = f2bf(k * __expf(tot - bv)); if (i & 1) kd[i >> 1] |= kdv << 16; else kd[i >> 1] = kdv; }
          *(LAS v4u*)(KDT + lane * 72 + wave * 8) = (v4u){kd[0], kd[1], kd[2], kd[3]};
          if (wave == 0) DEC[lane] = __expf(tot); }
        LDS_WAIT(); __syncthreads();
        f32x16 oacc = {};
        oacc = tile_mm<4>(QF + tokb * 32 * 72, STT + dvb * 32 * 72, r, hh, oacc);
        if (wave < 3) { const int pb2 = dir == 0 ? (wave + 1) >> 1 : wave >> 1, jb = dir == 0 ? wave >> 1 : (wave + 1) >> 1;
            f32x16 sc = {}; sc = tile_mm<4>(QF + pb2 * 32 * 72, KF + jb * 32 * 72, r, hh, sc);
#pragma unroll
            for (int reg = 0; reg < 16; ++reg) { const int p = (reg & 3) + 8 * (reg >> 2) + 4 * hh; float v = sc[reg];
                if (pb2 == jb) v = (dir == 0 ? (r <= p) : (r > p)) ? v : 0.f;
                MM[(pb2 * 32 + p) * 72 + jb * 32 + r] = (unsigned short)f2bf(v); } }
        LDS_WAIT(); __syncthreads();
        oacc = tile_mm<4>(MM + tokb * 32 * 72, VT + dvb * 32 * 72, r, hh, oacc);
        { bf16* o = OD + (size_t)(n * 64 + tokb * 32) * 768 + dvb * 32 + r;
#pragma unroll
          for (int reg = 0; reg < 16; ++reg) { const int p = (reg & 3) + 8 * (reg >> 2) + 4 * hh; o[(size_t)p * 768] = (unsigned short)f2bf(oacc[reg]); } }
#pragma unroll
        for (int g4 = 0; g4 < 4; ++g4) { const f32x4 dc = *(const LAS f32x4*)(DEC + tokb * 32 + 8 * g4 + 4 * hh);
#pragma unroll
            for (int e = 0; e < 4; ++e) sacc[4 * g4 + e] *= dc[e]; }
        sacc = tile_mm<4>(KDT + tokb * 32 * 72, VT + dvb * 32 * 72, r, hh, sacc);
#pragma unroll
        for (int g4 = 0; g4 < 4; ++g4) { v2u w; w.x = pk2(sacc[4 * g4], sacc[4 * g4 + 1]); w.y = pk2(sacc[4 * g4 + 2], sacc[4 * g4 + 3]);
            *(LAS v2u*)(STT + (dvb * 32 + r) * 72 + tokb * 32 + 8 * g4 + 4 * hh) = w; }
        LDS_WAIT(); __syncthreads();
    }
#undef GS_PREFETCH
}
__device__ __forceinline__ void gla_comb_rows(Frame& F, int l) {
    const int gw = F.vcu * NWAVES + F.wave, NGW = F.G * NWAVES, sub = F.lane >> 4, c8 = (F.lane & 15) * 8;
    const bf16* OF = WSP(bf16, WS_OMLA); const bf16* OB = WSP(bf16, WS_OINTRA); const bf16* P = WSP(bf16, WS_PROJ); bf16* Y = WSP(bf16, WS_HY);
    const float* g = ld_in(11) + l * 128 + c8; const f32x4 g0 = *(const f32x4*)g, g1 = *(const f32x4*)(g + 4); const float gg[8] = {g0[0], g0[1], g0[2], g0[3], g1[0], g1[1], g1[2], g1[3]};
    for (int it = gw; it < T * 6 / 4; it += NGW) { const int pair = it * 4 + sub, t = pair / 6, h = pair % 6; const size_t o = (size_t)t * 768 + h * 128 + c8;
        float a[8], b2[8], z[8]; unpack8(*(const v4u*)(OF + o), a); unpack8(*(const v4u*)(OB + o), b2); unpack8(*(const v4u*)(P + (size_t)t * NP + C_Z + h * 128 + c8), z);
        float ss = 0.f;
#pragma unroll
        for (int e = 0; e < 8; ++e) { a[e] += b2[e]; ss += a[e] * a[e]; }
        ss += __shfl_xor(ss, 1); ss += __shfl_xor(ss, 2); ss += __shfl_xor(ss, 4); ss += __shfl_xor(ss, 8);
        const float rstd = __builtin_amdgcn_rsqf(ss * (1.f / 128.f) + EPS);
        v4u w; w.x = pk2(a[0] * rstd * gg[0] * z[0], a[1] * rstd * gg[1] * z[1]); w.y = pk2(a[2] * rstd * gg[2] * z[2], a[3] * rstd * gg[3] * z[3]);
        w.z = pk2(a[4] * rstd * gg[4] * z[4], a[5] * rstd * gg[5] * z[5]); w.w = pk2(a[6] * rstd * gg[6] * z[6], a[7] * rstd * gg[7] * z[7]);
        *(v4u*)(Y + (size_t)t * DM + 768 + h * 128 + c8) = w; }
}
#define XB_TMO      128
#define XB_XCNT(j)  (256  + 64 * (j))
#define XB_XSUB(j)  (1280 + 64 * (j))
#define XB_XGEN(j)  (2304 + 64 * (j))
#define XB_TOP      3328
#define XB_TOPGEN   3392
#define XCD_BAR_WORDS 3456
#define XB_SPIN_CAP (1u << 18)
__device__ __forceinline__ unsigned xb_ld(unsigned* p)              { return __hip_atomic_load(p, __ATOMIC_RELAXED, __HIP_MEMORY_SCOPE_AGENT); }
__device__ __forceinline__ unsigned xb_add(unsigned* p, unsigned v) { return __hip_atomic_fetch_add(p, v, __ATOMIC_RELAXED, __HIP_MEMORY_SCOPE_AGENT); }
__device__ __forceinline__ unsigned xb_xcc_id() { return (unsigned)__builtin_amdgcn_s_getreg((3 << 11) | 20) & 0xFu; }
#define XB_SPIN(cond, bar) do { unsigned _sp = 0; while (cond) { __builtin_amdgcn_s_sleep(1); \
    if ((++_sp & 255u) == 0u) { if (xb_ld(&(bar)[XB_TMO])) break; if (_sp > XB_SPIN_CAP) { atomicAdd(&(bar)[XB_TMO], 1u); break; } } } } while (0)
struct XcdBarrier { unsigned* bar; unsigned x; volatile LAS unsigned* st; };
__device__ __forceinline__ XcdBarrier xcd_barrier_post(unsigned* bar, volatile LAS unsigned* st) {
    XcdBarrier b; b.bar = bar; b.x = xb_xcc_id(); b.st = st;
    if (threadIdx.x == 0) (void)xb_add(&bar[XB_XCNT(b.x)], 1u);
    return b;
}
__device__ __forceinline__ void xcd_barrier_complete(unsigned* bar, unsigned x, unsigned& nloc, unsigned& nx) {
    const unsigned G = gridDim.x * gridDim.y * gridDim.z;
    unsigned sum, cnt, mine, sp = 0u;
    for (;;) {
        sum = 0u; cnt = 0u; mine = 0u;
        unsigned c_[16]; { const GAS unsigned* p_ = (const GAS unsigned*)&bar[XB_XCNT(0)];
            asm volatile("global_load_dword %0, %16, off sc1\n\tglobal_load_dword %1, %16, off offset:256 sc1\n\tglobal_load_dword %2, %16, off offset:512 sc1\n\tglobal_load_dword %3, %16, off offset:768 sc1\n\t"
                         "global_load_dword %4, %16, off offset:1024 sc1\n\tglobal_load_dword %5, %16, off offset:1280 sc1\n\tglobal_load_dword %6, %16, off offset:1536 sc1\n\tglobal_load_dword %7, %16, off offset:1792 sc1\n\t"
                         "global_load_dword %8, %16, off offset:2048 sc1\n\tglobal_load_dword %9, %16, off offset:2304 sc1\n\tglobal_load_dword %10, %16, off offset:2560 sc1\n\tglobal_load_dword %11, %16, off offset:2816 sc1\n\t"
                         "global_load_dword %12, %16, off offset:3072 sc1\n\tglobal_load_dword %13, %16, off offset:3328 sc1\n\tglobal_load_dword %14, %16, off offset:3584 sc1\n\tglobal_load_dword %15, %16, off offset:3840 sc1\n\ts_waitcnt vmcnt(0)"
                         : "=&v"(c_[0]), "=&v"(c_[1]), "=&v"(c_[2]), "=&v"(c_[3]), "=&v"(c_[4]), "=&v"(c_[5]), "=&v"(c_[6]), "=&v"(c_[7]), "=&v"(c_[8]), "=&v"(c_[9]), "=&v"(c_[10]), "=&v"(c_[11]), "=&v"(c_[12]), "=&v"(c_[13]), "=&v"(c_[14]), "=&v"(c_[15])
                         : "v"(p_) : "memory"); }
#pragma unroll
        for (unsigned j = 0; j < 16; ++j) { const unsigned c = c_[j]; sum += c; cnt += (c > 0u) ? 1u : 0u; mine = (j == x) ? c : mine; }
        if (sum == G) break;
        __builtin_amdgcn_s_sleep(1);
        if ((++sp & 255u) == 0u) { if (xb_ld(&bar[XB_TMO])) break; if (sp > XB_SPIN_CAP) { atomicAdd(&bar[XB_TMO], 1u); break; } }
    }
    nloc = mine > 0u ? mine : 1u; nx = cnt > 0u ? cnt : 1u;
}
__device__ __forceinline__ void xcd_barrier(const XcdBarrier& b) {
    asm volatile("s_waitcnt vmcnt(0)" ::: "memory");
    __syncthreads();
    if (threadIdx.x == 0) {
        unsigned* bar = b.bar;
        __builtin_amdgcn_s_waitcnt(0);
        unsigned nloc = b.st[0], nx = b.st[1];
        if (nloc == 0u) { xcd_barrier_complete(bar, b.x, nloc, nx); b.st[0] = nloc; b.st[1] = nx; }
        const unsigned old = xb_add(&bar[XB_XSUB(b.x)], 1u);
        const unsigned gen = old / nloc;
        if (old + 1u == (gen + 1u) * nloc) {
            __builtin_amdgcn_fence(__ATOMIC_RELEASE, "agent");
            asm volatile("s_waitcnt vmcnt(0)" ::: "memory");
            const unsigned og = xb_add(&bar[XB_TOP], 1u);
            const unsigned tg = og / nx;
            if (og + 1u == (tg + 1u) * nx) xb_add(&bar[XB_TOPGEN], 1u);
            else XB_SPIN(xb_ld(&bar[XB_TOPGEN]) == tg, bar);
            __builtin_amdgcn_fence(__ATOMIC_ACQUIRE, "agent");
            xb_add(&bar[XB_XGEN(b.x)], 1u);
            asm volatile("s_waitcnt vmcnt(0)" ::: "memory");
        } else {
            XB_SPIN(xb_ld(&bar[XB_XGEN(b.x)]) == gen, bar);
            __builtin_amdgcn_fence(__ATOMIC_ACQUIRE, "agent");
            asm volatile("s_waitcnt vmcnt(0)" ::: "memory");
        }
    }
    __syncthreads();
}

__device__ __forceinline__ void sub_barrier(unsigned* cnt, unsigned target) {
    asm volatile("s_waitcnt vmcnt(0)" ::: "memory");
    __syncthreads();
    if (threadIdx.x == 0) {
        __builtin_amdgcn_fence(__ATOMIC_RELEASE, "agent");
        asm volatile("s_waitcnt vmcnt(0)" ::: "memory");
        (void)xb_add(cnt, 1u);
        unsigned sp = 0u; while (xb_ld(cnt) < target) { __builtin_amdgcn_s_sleep(2); if (++sp > (1u << 22)) break; }
        __builtin_amdgcn_fence(__ATOMIC_ACQUIRE, "agent");
        asm volatile("s_waitcnt vmcnt(0)" ::: "memory");
    }
    __syncthreads();
}

__device__ __forceinline__ unsigned wg_fetch(unsigned* cnt, unsigned n, volatile LAS unsigned* slot) {
    __syncthreads();
    if (threadIdx.x == 0) *slot = xb_add(cnt, n);
    __syncthreads();
    return *slot;
}
__device__ __forceinline__ void wait_counter(unsigned* cnt, unsigned target) {
    if (threadIdx.x == 0) { unsigned sp = 0u; while (xb_ld(cnt) < target) { __builtin_amdgcn_s_sleep(2); if (++sp > (1u << 22)) break; }
        __builtin_amdgcn_fence(__ATOMIC_ACQUIRE, "agent"); asm volatile("s_waitcnt vmcnt(0)" ::: "memory"); }
    __syncthreads();
}

#ifndef MK_MAIN_HELP
#define MK_MAIN_HELP 0
#endif
#ifndef MK_NT_TAIL
#define MK_NT_TAIL 0
#endif
#ifndef MK_LATE_FETCH
#define MK_LATE_FETCH 2u
#endif
struct Args { const float* in[21]; float* out; unsigned char* ws; int ph_lo, ph_hi; };
constexpr int N_PHASES = 2 + 6 * DEPTH;
__global__ void __launch_bounds__(NTHR, 2) mega_fwd(Args args) {
    extern __shared__ __attribute__((aligned(16))) unsigned char lds[];
    Frame F;
    F.lds = (LAS unsigned char*)lds; F.ldsg = (char*)lds;
    F.tid = threadIdx.x; F.lane = F.tid & 63; F.wave = __builtin_amdgcn_readfirstlane(F.tid >> 6);
    F.G = gridDim.x; { const int bx = blockIdx.x; F.vcu = (F.G % 8 == 0) ? (bx % 8) * (F.G / 8) + bx / 8 : bx; }
    F.out = args.out; F.ws = args.ws;
    volatile LAS unsigned* MISC = (volatile LAS unsigned*)(F.lds + MISC_OFF);
    for (int u = F.tid; u < (LDS_BYTES - LDSCTL_OFF) / 4; u += NTHR) ((LAS unsigned*)(F.lds + LDSCTL_OFF))[u] = 0u;
    __syncthreads();
    XcdBarrier bar = xcd_barrier_post((unsigned*)(F.ws + WS_CTL) + CW_BAR, MISC + 8);
    const int lo = args.ph_lo, hi = args.ph_hi; int nstamp = 0;
#ifndef MK_MASK
#define MK_MASK 0xFF
#endif
#define PHON(b) ((MK_MASK >> (b)) & 1)
#ifndef MK_REP_PH
#define MK_REP_PH -1
#endif
#define REPS(ph) for (int rep_ = 0; rep_ < ((ph) == MK_REP_PH ? 2 : 1); ++rep_)
#define REPBAR() do { if (rep_ == 0 && false) {} } while (0)
#define IN(k) (lo <= (k) && (k) < hi)
#define FRESH() do { int t_ = threadIdx.x; asm volatile("" : "+v"(t_)); F.tid = t_; F.lane = t_ & 63; F.wave = __builtin_amdgcn_readfirstlane(t_ >> 6); GAS unsigned char* w_ = (GAS unsigned char*)args.ws; asm volatile("" : "+s"(w_)); F.ws = (unsigned char*)w_; GAS float* o_ = (GAS float*)args.out; asm volatile("" : "+s"(o_)); F.out = (float*)o_; } while (0)
#ifndef MK_DIAG_A
#define MK_DIAG_A -1
#define MK_DIAG_B -1
#endif
#define STAMP() do { if (MK_DIAG_A >= 0 && blockIdx.x == 0 && threadIdx.x == 0) { ((unsigned long long*)(args.ws + WS_CTL + 131072))[nstamp] = __builtin_amdgcn_s_memrealtime(); } ++nstamp; } while (0)
#define SEAM(k) do { if (IN(k) && IN((k) + 1)) { xcd_barrier(bar); STAMP(); } } while (0)
    STAMP();
#ifndef MK_FUSE_P0B
#define MK_FUSE_P0B 1
#endif
    { if (PHON(0) && IN(0)) { p0_prologue(F, WS_MODS, MK_IDLE_GEMV > 0 && F.G == 256, (MK_FUSE_P0B && IN(1)) ? (unsigned*)(F.ws + WS_CTL) + 32 : (unsigned*)nullptr); } if (!(MK_FUSE_P0B && IN(0) && IN(1))) SEAM(0); }
    REPS(101) { if (PHON(1) && IN(1)) {
        if (MK_FUSE_P0B && IN(0) && rep_ == 0) { FRESH(); wait_counter((unsigned*)(F.ws + WS_CTL) + 32, (unsigned)F.G); }
        modnorm_rows(F, ld_in(0), ld_in(5), WSP(float, WS_MODS), WSP(bf16, WS_HY)); } SEAM(1); }
#pragma unroll 1
    for (int l = 0; l < DEPTH; ++l) {
        const int pb = 2 + 6 * l;
#define mods_l (WSP(float, WS_MODS) + (size_t)l * BATCH * 3 * DM)
        REPS(0) { if (PHON(2) && IN(pb)) {
            FRESH();
            pg8::Gemm g{WSP(bf16, WS_HY), WSP(bf16, WS_WIN) + (size_t)l * NP * DM, T, NP, DM, DM}; pg8::StaticOrder S; S.init(T, NP, F.G, (int)blockIdx.x);
            EpiIn E{WSP(bf16, WS_PROJ), WSP(float, WS_CS), WSP(float, WS_SN), WSP(float, WS_PARTQ), WSP(float, WS_PARTKV)};
            pg8::gemm_phase<EpiIn, pg8::StaticOrder, true, true>(F.lds, g, S, E);
            if (MK_IDLE_GEMV > 0 && F.G == 256 && l == 0 && rep_ == 0 && (int)blockIdx.x >= 224) {
                __syncthreads(); FRESH(); p0_mods(F, WS_MODS, (int)blockIdx.x - 224, 32, 768 - MK_IDLE_GEMV, 768); }
        } SEAM(pb); }
        REPS(1) { if (PHON(3) && IN(pb + 1)) {
#ifndef MK_SUB
#define MK_SUB 0xFF
#endif
            for (int rr_ = 0; rr_ < (MK_REP_PH == 9 ? 2 : 1); ++rr_) {
            FRESH();
            if (MK_SUB & 1) { pg8::Gemm g{WSP(bf16, WS_PROJ) + C_MKV, WSP(bf16, WS_WUKV) + (size_t)l * NKV * 256, T, NKV, 256, NP}; pg8::StaticOrder S; S.init(T, NKV, F.G, (int)blockIdx.x);
              EpiUkv E{WSP(bf16, WS_KVUP), WSP(float, WS_PARTKV)};
              pg8::gemm_phase<EpiUkv, pg8::StaticOrder, true, true>(F.lds, g, S, E); }
            FRESH();
            if (MK_SUB & 2) { pg8::Gemm g{WSP(bf16, WS_PROJ) + C_MQ, WSP(bf16, WS_WUQ) + (size_t)l * NQ * 384, T, NQ, 384, NP}; pg8::StaticOrder S; S.init(T, NQ, F.G, ((int)blockIdx.x + 64) % F.G);
              EpiUq E{WSP(bf16, WS_QUP), WSP(float, WS_CS), WSP(float, WS_SN), WSP(float, WS_PARTQ)};
              pg8::gemm_phase<EpiUq, pg8::StaticOrder, true, true>(F.lds, g, S, E); }
            __syncthreads(); }
            FRESH();
            for (int rr_ = 0; rr_ < (MK_REP_PH == 10 ? 2 : 1); ++rr_)
            if (MK_SUB & 4) {
                const int w = (int)blockIdx.x;
#pragma unroll 1
                for (int j = 0; ; ++j) { int it;
                    if (F.G == 256) it = w < 96 ? (j < 2 ? 2 * w + j : NITEM) : 192 + (w - 96) + 160 * j; else it = w + j * F.G;
                    if (it >= NITEM) break; gla_a_item(F, l, it); }
            }
            FRESH(); conv_rows(F, l);
        } SEAM(pb + 1); }
        if (F.G <= 192) { REPS(7) { if (PHON(3) && IN(pb + 2)) {
            FRESH(); { const int gw = F.vcu * NWAVES + F.wave, NGW = F.G * NWAVES; for (int it = gw; it < 1536; it += NGW) gla_scan_witem(F, it); }
        } SEAM(pb + 2); } }
        REPS(2) { if (PHON(4) && IN(pb + 3)) {
            const int bx = (int)blockIdx.x; FRESH();
            const int natt = F.G > 192 ? 192 : F.G;
            const bool split = MK_NT_TAIL > 0 && F.G == 256, spare = F.G > 192 && bx >= 192;
            unsigned* scan_done = (unsigned*)(F.ws + WS_CTL) + 64 + 64 * (l * 2 + rep_); unsigned* queue = (unsigned*)(F.ws + WS_CTL) + 1024 + 64 * (l * 2 + rep_);
            if (spare) { const int gw = (bx - 192) * NWAVES + F.wave, NGW = (F.G - 192) * NWAVES;
                for (int rr_ = 0; rr_ < (MK_REP_PH == 21 ? 2 : 1); ++rr_)
                for (int it = gw; it < 1536; it += NGW) gla_scan_witem(F, it);
                sub_barrier(scan_done, (unsigned)(F.G - 192)); }
#pragma unroll 1
            for (int pass = 0; pass < 2; ++pass) {
                if (F.G > 192 && pass == (spare ? 0 : 1) && (spare || (!split && MK_MAIN_HELP))) {
                    if (!spare) wait_counter(scan_done, (unsigned)(F.G - 192));
                    FRESH();
                    const unsigned nf = spare ? (unsigned)NWAVES : MK_LATE_FETCH;
                    for (int rr_ = 0; rr_ < (MK_REP_PH == 22 ? 2 : 1); ++rr_)
                    for (;;) { const unsigned base = wg_fetch(queue + 32 * rr_, nf, MISC + 16); if (base >= 2u * NITEM) break;
                        const int task = (int)base + F.wave; if ((unsigned)F.wave < nf && task < 2 * NITEM) gla_c_task(F, l, task); }
                    if (MK_SPARE_GEMV > 0 && MK_IDLE_GEMV > 0 && F.G == 256 && l == 0 && rep_ == 0 && spare) {
                        FRESH(); p0_mods(F, WS_MODS, bx - 192, 64, 768 - MK_IDLE_GEMV - MK_SPARE_GEMV, 768 - MK_IDLE_GEMV);
                        if (MK_FUSE_Y) { asm volatile("s_waitcnt vmcnt(0)" ::: "memory"); __syncthreads();
                            if (F.tid < 32) (void)__hip_atomic_fetch_add((unsigned*)(F.ws + WS_CTL) + CW_YREADY + 2048 * (2 * l) + 64 * F.tid, 1u, __ATOMIC_RELAXED, __HIP_MEMORY_SCOPE_AGENT); } }
                }
                if (pass == 0) {
                    FRESH();
                    const int nun = spare ? (split ? 3 : 0) : (bx < natt ? (192 - bx + natt - 1) / natt : 0);
                    for (int rr_ = 0; rr_ < ((MK_REP_PH == 20 || (MK_REP_PH == 23 && spare) || (MK_REP_PH == 24 && !spare)) ? 2 : 1); ++rr_)
#pragma unroll 1
                    for (int i = 0; i < nun; ++i) { int u, mode, kt0, nt;
                        if (spare) { const int s_ = bx - 192; u = (s_ & 7) * 24 + 3 * (s_ >> 3) + i; mode = 2; kt0 = 32 - MK_NT_TAIL; nt = MK_NT_TAIL; }
                        else { const int u0 = bx + i * natt; u = (natt == 192) ? (u0 & 7) * 24 + (u0 >> 3) : u0; mode = split ? 1 : 0; kt0 = 0; nt = split ? 32 - MK_NT_TAIL : 32; }
                        const int bh = u >> 3, qb = u & 7, b = bh / 6, h = bh % 6; const size_t row0 = (size_t)b * SEQ, qrow = row0 + qb * 256, krow = row0 + (size_t)kt0 * 64;
                        mla::attn_unit(WSP(bf16, WS_QUP) + qrow * NQ + h * 192, WSP(bf16, WS_KVUP) + krow * NKV + h * 256, WSP(bf16, WS_KVUP) + krow * NKV + h * 256 + 128,
                                       WSP(bf16, WS_PROJ) + krow * NP + C_MKR, WSP(bf16, WS_HY) + qrow * DM + h * 128, WSP(bf16, WS_PROJ) + qrow * NP + C_Z + 768 + h * 128,
                                       ld_in(16) + l * 768 + h * 128, WSP(float, WS_CTL + WS_ROWSS) + (size_t)l * T + qrow, nt * 64, F.ldsg,
                                       mode | (u << 4) | ((l * 2 + rep_) << 12)); }
                }
            }
            if (F.G <= 192) { FRESH(); const int gw = F.vcu * NWAVES + F.wave, NGW = F.G * NWAVES; for (int task = gw; task < 2 * NITEM; task += NGW) gla_c_task(F, l, task); }
        } if (!(MK_FUSE_Y && F.G == 256 && MK_REP_PH != 4 && IN(pb + 3) && IN(pb + 4))) SEAM(pb + 3); }
        for (int rep_ = 0; rep_ < ((MK_REP_PH == 4 && l == 0) ? 2 : 1); ++rep_) { if (PHON(6) && IN(pb + 4)) {
            FRESH();
            pg8::Gemm g{WSP(bf16, WS_HY), WSP(bf16, WS_WOUT) + (size_t)l * DM * DM, T, DM, DM, DM}; pg8::StaticOrder S; S.init(T, DM, F.G, (int)blockIdx.x);
            if (MK_FUSE_Y && F.G == 256 && MK_REP_PH != 4 && IN(pb + 3)) {
                pg8::Unit u0; if (S.next(0, u0)) wait_counter((unsigned*)(F.ws + WS_CTL) + CW_YREADY + 2048 * (2 * l) + 64 * u0.pm, 96u + ((MK_SPARE_GEMV > 0 && MK_IDLE_GEMV > 0 && l == 0) ? 64u : 0u)); }
            if (F.G == 256 && MK_REP_PH != 4) {
                const int last = (l + 1 == DEPTH);
                EpiOutNorm E{ld_in(0), l == 0 ? (const bf16*)nullptr : WSP(bf16, WS_X1B), WSP(bf16, WS_X1B), F.out, mods_l + 2 * DM, WSP(float, WS_CTL + WS_ROWSS) + (size_t)l * T, WSP(bf16, WS_HY), last ? ld_in(20) : ld_in(5) + (l + 1) * DM,
                             mods_l + (size_t)BATCH * 3 * DM, WSP(float, WS_XS), (unsigned*)(F.ws + WS_CTL) + CW_PANEL + 64 * 32 * l, 32u, last};
                pg8::gemm_phase<EpiOutNorm, pg8::StaticOrder, true, true>(F.lds, g, S, E);
            } else {
                EpiOut E{l == 0 ? ld_in(0) : F.out, F.out, mods_l + 2 * DM, WSP(float, WS_CTL + WS_ROWSS) + (size_t)l * T};
                pg8::gemm_phase<EpiOut, pg8::StaticOrder, true, true>(F.lds, g, S, E);
            }
        } if (!(F.G == 256 && MK_REP_PH != 4 && l + 1 == DEPTH)) SEAM(pb + 4); }
        if (!(F.G == 256 && MK_REP_PH != 4)) {
        for (int rep_ = 0; rep_ < ((MK_REP_PH == 5 && l == 0) ? 2 : 1); ++rep_) { if (PHON(7) && IN(pb + 5)) {
            FRESH();
            if (l + 1 < DEPTH) modnorm_rows(F, F.out, ld_in(5) + (l + 1) * DM, mods_l + (size_t)BATCH * 3 * DM, WSP(bf16, WS_HY));
            else finalnorm_rows(F, F.out, ld_in(20));
        } SEAM(pb + 5); }
        }
        if (MK_REP_PH == 6) { for (int r_ = 0; r_ < 4; ++r_) xcd_barrier(bar); }
    }
    if (MK_DIAG_A >= 0) {
        xcd_barrier(bar); STAMP();
        if (blockIdx.x == 0) { const unsigned long long* ts = (const unsigned long long*)(args.ws + WS_CTL + 131072);
            const float da = (float)(ts[MK_DIAG_A + 1] - ts[MK_DIAG_A]) * 0.01f, db = (float)(ts[MK_DIAG_B + 1] - ts[MK_DIAG_B]) * 0.01f;
            for (int i = threadIdx.x; i < 65536; i += NTHR) args.out[i] += db;
            if (threadIdx.x == 0) args.out[8000000] += 10.f * da; }
    }
#undef mods_l
#undef IN
#undef SEAM
}

#ifndef MK_CUT
#define MK_CUT 14
#endif
#if MK_CUT < 14 || defined(MK_DBG_GLA)
__global__ void glue_proj(const bf16* P, float* proj, float* y, int row0) {
    const int t = blockIdx.x; const bf16* p = P + (size_t)(row0 + t) * NP;
    for (int c = threadIdx.x; c < NP; c += 256) { const float v = bf2f(p[c]);
        if (c < C_MKV) proj[(size_t)t * nv::PW + c] = v;
        else if (c < C_MQ) proj[(size_t)t * nv::PW + nv::O_MKV + (c - C_MKV)] = v;
        else if (c < C_MKR) proj[(size_t)t * nv::PW + nv::O_MQ + (c - C_MQ)] = v;
        else if (c < C_LR) { const int j = c - C_MKR; proj[(size_t)t * nv::PW + nv::O_MKR + (j & 1) * 32 + (j >> 1)] = v; }
        else if (c < C_LR + 32) proj[(size_t)t * nv::PW + nv::O_LR + (c - C_LR)] = v;
        else if (c < C_CB) {}
        else if (c < C_Z) proj[(size_t)t * nv::PW + nv::O_CB + (c - C_CB)] = v;
        else y[(size_t)t * DM + (c - C_Z)] = v; }
}
__global__ void glue_qkv(const bf16* Q, const bf16* KV, float* qm, float* kv, int row0) {
    const int t = blockIdx.x;
    for (int c = threadIdx.x; c < 1152; c += 256) { const float v = bf2f(Q[(size_t)(row0 + t) * NQ + c]) * (1.f / QSCALE); const int h = c / 192, d = c % 192;
        if (d < 128) qm[(size_t)t * 1152 + c] = v; else { const int j = d - 128; qm[(size_t)t * 1152 + h * 192 + 128 + (j & 1) * 32 + (j >> 1)] = v; } }
    for (int c = threadIdx.x; c < 1536; c += 256) kv[(size_t)t * 1536 + c] = bf2f(KV[(size_t)(row0 + t) * NKV + c]);
}
__global__ void glue_y(const bf16* Y, float* y, int row0) {
    const int t = blockIdx.x; for (int c = threadIdx.x; c < DM; c += 256) { const int cr = c < 768 ? c + 768 : (c < 1536 ? c - 768 : c); y[(size_t)t * DM + cr] = bf2f(Y[(size_t)(row0 + t) * DM + c]); }
}
__global__ void glue_h(const bf16* H, float* h, int row0) {
    const int t = blockIdx.x; for (int c = threadIdx.x; c < DM; c += 256) h[(size_t)t * DM + c] = bf2f(H[(size_t)(row0 + t) * DM + c]);
}

#endif

#if defined(MK_DBG_GLA)
__global__ void dbg_cmp(const bf16* OF, const bf16* OB, const float* ref, int row0, int use_b, int cls, float* stat) {
    const int t = blockIdx.x; float mx = 0.f;
    const int bcls = cls / 10000; cls = cls % 10000; if (bcls && row0 / SEQ != bcls - 1) return;
    const int hcls = cls / 1000; cls = cls % 1000; const int ccls = cls / 100; cls = cls % 100;
    for (int c = threadIdx.x; c < 768; c += 256) { if (ccls && ((c & 127) >> 5) != ccls - 1) continue; if (hcls && (c >> 7) != hcls - 1) continue; float v = bf2f(OF[(size_t)(row0 + t) * 768 + c]); if (use_b) v += bf2f(OB[(size_t)(row0 + t) * 768 + c]);
        mx = fmaxf(mx, fabsf(v - ref[(size_t)t * 768 + c])); }
    const int pos = t & 63, chunk = t >> 6;
    bool in = true;
    if (cls == 1) in = (pos < 32); if (cls == 2) in = (pos >= 32); if (cls == 3) in = (chunk == 0); if (cls == 4) in = (chunk == 31); if (cls == 5) in = (chunk > 0 && chunk < 31);
    if (cls == 6) in = (pos == 0); if (cls == 7) in = (pos == 63); if (cls == 8) in = (chunk == 0 && pos < 32); if (cls == 9) in = (chunk == 0 && pos >= 32); if (cls == 10) in = (chunk == 0 && pos < 8); if (cls == 11) in = (chunk == 0 && pos >= 8 && pos < 16); if (cls == 12) in = (chunk == 0 && pos == 0); if (cls == 13) in = (chunk == 0 && pos == 1); if (cls == 99) in = false; if (cls == 14) in = (chunk > 0 && chunk < 31 && pos < 32); if (cls == 15) in = (chunk > 0 && chunk < 31 && pos >= 32); if (cls == 16) in = (chunk == 1);
    if (in) atomicMax((unsigned*)stat, __float_as_uint(mx));
}
__global__ void dbg_poison(float* out, const float* stat) {
    const float sa = __uint_as_float(__float_as_uint(stat[0]) & 0xFFF00000u), sb = __uint_as_float(__float_as_uint(stat[1]) & 0xFFF00000u);
    const int i = blockIdx.x * 256 + threadIdx.x; if (i < 65536) out[i] += 100.f * sb; if (i == 0) out[8000000] += 1000.f * sa;
}
#endif
#ifndef MK_NAIVE_BASE_MIB
#define MK_NAIVE_BASE_MIB 240
#endif
extern "C" void kernel_launch(void* const* d_in, const int* in_sizes, int n_in, void* d_out, int out_size, void* d_ws, size_t ws_size, hipStream_t stream) {
    static int grid = 0;
    if (grid == 0) {
        if (n_in != 21 || out_size != T * DM || in_sizes[0] != T * DM || ws_size < WS_END) { fprintf(stderr, "kernel_launch: unexpected shapes n_in %d out %d ws %zu\n", n_in, out_size, ws_size); grid = -1; return; }
        int dev = 0, cus = 0, per_cu = 0;
        if (hipGetDevice(&dev) != hipSuccess || hipDeviceGetAttribute(&cus, hipDeviceAttributeMultiprocessorCount, dev) != hipSuccess) { grid = -1; return; }
        if (hipFuncSetAttribute((const void*)mega_fwd, hipFuncAttributeMaxDynamicSharedMemorySize, LDS_BYTES) != hipSuccess) { fprintf(stderr, "kernel_launch: hipFuncSetAttribute failed\n"); grid = -1; return; }
        if (hipOccupancyMaxActiveBlocksPerMultiprocessor(&per_cu, (const void*)mega_fwd, NTHR, LDS_BYTES) != hipSuccess || per_cu < 1) { fprintf(stderr, "kernel_launch: occupancy query says %d blocks/CU\n", per_cu); grid = -1; (void)hipGetLastError(); return; }
        grid = cus;
    }
    if (grid < 0) return;
    (void)hipMemsetAsync((char*)d_ws + WS_CTL, 0, CTL_ZERO_BYTES, stream);
    Args a{};
    for (int i = 0; i < 21; ++i) a.in[i] = (const float*)d_in[i];
    a.out = (float*)d_out; a.ws = (unsigned char*)d_ws; a.ph_lo = 0; a.ph_hi = MK_CUT < N_PHASES ? MK_CUT : N_PHASES;
    hipLaunchKernelGGL(mega_fwd, dim3(grid), dim3(NTHR), LDS_BYTES, stream, a);
#if defined(MK_DBG_GLA)
    {   char* ws = (char*)d_ws; nv::Buf B = nv::carve(ws + (size_t)286 * MiB); float* stat = (float*)(ws + WS_CTL + 200 * 1024);
        const float* g7 = (const float*)d_in[7]; const float* g8 = (const float*)d_in[8]; const float* g9 = (const float*)d_in[9]; const float* g10 = (const float*)d_in[10];
        float* la_f = B.scr; float* la_b = la_f + (size_t)SEQ * 384; float* ogla = la_b + (size_t)SEQ * 384;
        const int l = MK_DBG_GLA;
        for (int b = 0; b < BATCH; ++b) { const int row0 = b * SEQ;
            glue_proj<<<SEQ, 256, 0, stream>>>((const bf16*)(ws + WS_PROJ), B.proj, B.y, row0);
            nv::k_gla_gate<<<SEQ, 384, 0, stream>>>(B.proj, nv::PW, nv::O_LR, g7 + l * 16 * 384, g8 + l * 384, la_f);
            nv::k_gla_gate<<<SEQ, 384, 0, stream>>>(B.proj, nv::PW, nv::O_LR + 16, g9 + l * 16 * 384, g10 + l * 384, la_b);
            nv::k_gla_seq<<<6, 128, 0, stream>>>(B.proj, nv::PW, la_f, la_b, ogla, 0);
            dbg_cmp<<<SEQ, 256, 0, stream>>>((const bf16*)(ws + WS_OMLA), (const bf16*)(ws + WS_OINTRA), ogla, row0, 0, MK_DBG_CLS_A, stat);
            nv::k_gla_seq<<<6, 128, 0, stream>>>(B.proj, nv::PW, la_f, la_b, ogla, 1);
            dbg_cmp<<<SEQ, 256, 0, stream>>>((const bf16*)(ws + WS_OMLA), (const bf16*)(ws + WS_OINTRA), ogla, row0, 1, MK_DBG_CLS_B, stat + 1); }
        dbg_poison<<<256, 256, 0, stream>>>((float*)d_out, stat);
    }
#endif
#if MK_CUT < 14
    {
        char* ws = (char*)d_ws; float* out = (float*)d_out; const float* x = (const float*)d_in[0];
        const float* mods = (const float*)(ws + WS_MODS); const float* cs = (const float*)(ws + WS_CS); const float* sn = (const float*)(ws + WS_SN);
        nv::Buf B = nv::carve(ws + (size_t)MK_NAIVE_BASE_MIB * MiB);
        const int l0 = (MK_CUT - 2) / 6, ph = (MK_CUT - 2) % 6;
        for (int l = l0; l < DEPTH; ++l)
            for (int b = 0; b < BATCH; ++b) {
                const int row0 = b * SEQ; int entry = 0; const float* xin = (l == 0 ? x : out) + (size_t)row0 * DM; float* xo = out + (size_t)row0 * DM;
                if (l == l0) {
                    if (ph >= 1 && ph <= 3) { glue_proj<<<SEQ, 256, 0, stream>>>((const bf16*)(ws + WS_PROJ), B.proj, B.y, row0); entry = 1; }
                    if (ph == 2) { glue_qkv<<<SEQ, 256, 0, stream>>>((const bf16*)(ws + WS_QUP), (const bf16*)(ws + WS_KVUP), nv::sc_qm(B), nv::sc_kv(B), row0); entry = 2; }
                    if (ph == 3) { hipMemcpyAsync(nv::sc_omla(B), ws + WS_OMLA + (size_t)row0 * 768 * 4, (size_t)SEQ * 768 * 4, hipMemcpyDeviceToDevice, stream); entry = 4; }
                    if (ph == 4) { glue_y<<<SEQ, 256, 0, stream>>>((const bf16*)(ws + WS_HY), B.y, row0); entry = 3; }
                    if (ph == 5) continue;
                }
                nv::layer_batch(d_in, l, b, entry, xin, xo, mods, cs, sn, B, stream);
            }
        nv::k_rms<<<T, 256, 0, stream>>>(out, DM, DM, (const float*)d_in[20], out, DM);
    }
#endif
}
```
